# Optimizing an MI355X kernel written in HIP

```python
import math
import jax, jax.numpy as jnp
from jax import lax
import numpy as np

D_MODEL = 1024
BATCH = 1
SEQ = 16384
DEPTH = 2

CHUNK = 64
N_A_LAYERS = DEPTH // 2
N_B_LAYERS = DEPTH - N_A_LAYERS
SSM_GROUP = 16
N_GROUPS = D_MODEL // SSM_GROUP
SSM_STATE = 64
DT_MIN = 1e-3
DT_MAX = 1e-1
N_HEADS = 8
HEAD_DIM = 64
V_DIM = 2 * HEAD_DIM
ROT_DIM = HEAD_DIM // 4
ROPE_THETA = 500000.0
Q_BLOCK = 128
LAMBDA_INIT_STD = 0.1
FFN_HIDDEN = ((8 * D_MODEL + 3 * 256 - 1) // (3 * 256)) * 256
EPS = 1e-6

kernel_name = "s5_then_shared_kv_diff_attention_trunk"


def rmsnorm(x, g):
    xf = x.astype(jnp.float32)
    xf = xf * lax.rsqrt(jnp.mean(xf * xf, axis=-1, keepdims=True) + EPS)
    return (xf * g.astype(jnp.float32)).astype(x.dtype)


def apply_partial_rope(x, pos):
    half = ROT_DIM // 2
    inv_freq = ROPE_THETA ** (-jnp.arange(half, dtype=jnp.float32) * 2.0 / ROT_DIM)
    ang = pos.astype(jnp.float32)[:, None] * inv_freq[None, :]
    cos = jnp.cos(ang)[None, :, None, :]
    sin = jnp.sin(ang)[None, :, None, :]
    xf = x.astype(jnp.float32)
    x1 = xf[..., :half]
    x2 = xf[..., half:ROT_DIM]
    rest = xf[..., ROT_DIM:]
    return jnp.concatenate([x1 * cos - x2 * sin, x2 * cos + x1 * sin, rest], axis=-1)


def swiglu(hn, w1, w3, w2):
    return (jax.nn.silu(hn @ w1) * (hn @ w3)) @ w2


def _cdiag_combine(e1, e2):
    a1r, a1i, b1r, b1i = e1
    a2r, a2i, b2r, b2i = e2
    return (a2r * a1r - a2i * a1i,
            a2r * a1i + a2i * a1r,
            a2r * b1r - a2i * b1i + b2r,
            a2r * b1i + a2i * b1r + b2i)


def s5_mixer(u, lam_re, lam_im, log_dt, b_re, b_im, c_re, c_im, d_skip, w_glu):
    f32 = jnp.float32
    bsz, L, _ = u.shape
    uf = u.astype(f32)
    lr, li = lam_re.astype(f32), lam_im.astype(f32)
    dt = jnp.exp(log_dt.astype(f32))[:, None]
    mag = jnp.exp(lr * dt)
    abar_re, abar_im = mag * jnp.cos(li * dt), mag * jnp.sin(li * dt)
    nr, ni = abar_re - 1.0, abar_im
    den = lr * lr + li * li
    fr = (nr * lr + ni * li) / den
    fi = (ni * lr - nr * li) / den
    br, bi = b_re.astype(f32), b_im.astype(f32)
    bb_re = fr[..., None] * br - fi[..., None] * bi
    bb_im = fr[..., None] * bi + fi[..., None] * br
    ug = uf.reshape(bsz, L, N_GROUPS, SSM_GROUP)
    bu_re = jnp.einsum('blgc,gpc->blgp', ug, bb_re)
    bu_im = jnp.einsum('blgc,gpc->blgp', ug, bb_im)
    a_re = jnp.broadcast_to(abar_re, bu_re.shape)
    a_im = jnp.broadcast_to(abar_im, bu_im.shape)
    _, _, s_re, s_im = lax.associative_scan(_cdiag_combine, (a_re, a_im, bu_re, bu_im), axis=1)
    y = (jnp.einsum('blgp,gcp->blgc', s_re, c_re.astype(f32))
         - jnp.einsum('blgp,gcp->blgc', s_im, c_im.astype(f32)))
    y = y.reshape(bsz, L, D_MODEL) + d_skip.astype(f32) * uf
    z = jax.nn.gelu(y)
    za, zb = jnp.split(z @ w_glu.astype(f32), 2, axis=-1)
    return (za * jax.nn.sigmoid(zb)).astype(u.dtype)


def shared_kv(h, kv_norm_g, w_kv, pos):
    bsz, L, _ = h.shape
    kv = rmsnorm(h, kv_norm_g) @ w_kv
    hk = N_HEADS * HEAD_DIM
    k1 = kv[..., :hk].reshape(bsz, L, N_HEADS, HEAD_DIM)
    k2 = kv[..., hk:2 * hk].reshape(bsz, L, N_HEADS, HEAD_DIM)
    v = kv[..., 2 * hk:].reshape(bsz, L, N_HEADS, V_DIM).astype(jnp.float32)
    return apply_partial_rope(k1, pos), apply_partial_rope(k2, pos), v


def diff_attention(hn, k1, k2, v, w_q, lq1, lk1, lq2, lk2, subln_g, w_o, lam_init, pos):
    f32 = jnp.float32
    bsz, L, _ = hn.shape
    hq = N_HEADS * HEAD_DIM
    q = hn @ w_q
    q1 = apply_partial_rope(q[..., :hq].reshape(bsz, L, N_HEADS, HEAD_DIM), pos)
    q2 = apply_partial_rope(q[..., hq:].reshape(bsz, L, N_HEADS, HEAD_DIM), pos)
    lam = (jnp.exp(jnp.sum(lq1.astype(f32) * lk1.astype(f32)))
           - jnp.exp(jnp.sum(lq2.astype(f32) * lk2.astype(f32))) + lam_init)
    nblk = L // Q_BLOCK
    q1b = q1.reshape(bsz, nblk, Q_BLOCK, N_HEADS, HEAD_DIM).transpose(1, 0, 2, 3, 4)
    q2b = q2.reshape(bsz, nblk, Q_BLOCK, N_HEADS, HEAD_DIM).transpose(1, 0, 2, 3, 4)
    qpos = pos.reshape(nblk, Q_BLOCK)
    k_chunk = pos // CHUNK
    scale = HEAD_DIM ** -0.5

    def block(args):
        q1c, q2c, qp = args
        mask = (k_chunk[None, :] <= (qp // CHUNK)[:, None])[None, None]
        s1 = jnp.einsum('bqhd,bkhd->bhqk', q1c, k1) * scale
        s2 = jnp.einsum('bqhd,bkhd->bhqk', q2c, k2) * scale
        p1 = jax.nn.softmax(jnp.where(mask, s1, -jnp.inf), axis=-1)
        p2 = jax.nn.softmax(jnp.where(mask, s2, -jnp.inf), axis=-1)
        return jnp.einsum('bhqk,bkhe->bqhe', p1 - lam * p2, v)

    o = lax.map(block, (q1b, q2b, qpos))
    o = o.transpose(1, 0, 2, 3, 4).reshape(bsz, L, N_HEADS, V_DIM)
    o = rmsnorm(o, subln_g) * (1.0 - lam_init)
    return o.reshape(bsz, L, N_HEADS * V_DIM).astype(hn.dtype) @ w_o


def setup_inputs(seed: int = 0) -> dict:
    key = jax.random.key(seed)
    ks = jax.random.split(key, 32)
    f32 = jnp.float32
    D, F, G, P, C = D_MODEL, FFN_HIDDEN, N_GROUPS, SSM_STATE, SSM_GROUP
    nrm = lambda k, shape, s: jax.random.normal(k, shape, f32) * s
    x = jax.random.normal(ks[0], (BATCH, SEQ, D), f32)
    norm_mix_g = 1.0 + nrm(ks[1], (DEPTH, D), 0.02)
    norm_ffn_g = 1.0 + nrm(ks[2], (DEPTH, D), 0.02)
    ffn_w1 = nrm(ks[3], (DEPTH, D, F), D ** -0.5)
    ffn_w3 = nrm(ks[4], (DEPTH, D, F), D ** -0.5)
    ffn_w2 = nrm(ks[5], (DEPTH, F, D), F ** -0.5)
    ssm_lam_re = -0.5 + nrm(ks[6], (N_A_LAYERS, G, P), 0.01)
    ssm_lam_im = math.pi * jnp.arange(P, dtype=f32)[None, None, :] + nrm(ks[7], (N_A_LAYERS, G, P), 0.01)
    ssm_log_dt = jax.random.uniform(ks[8], (N_A_LAYERS, G), f32, math.log(DT_MIN), math.log(DT_MAX))
    ssm_b_re = nrm(ks[9], (N_A_LAYERS, G, P, C), (0.5 / C) ** 0.5)
    ssm_b_im = nrm(ks[10], (N_A_LAYERS, G, P, C), (0.5 / C) ** 0.5)
    ssm_c_re = nrm(ks[11], (N_A_LAYERS, G, C, P), (0.5 / P) ** 0.5)
    ssm_c_im = nrm(ks[12], (N_A_LAYERS, G, C, P), (0.5 / P) ** 0.5)
    ssm_d = nrm(ks[13], (N_A_LAYERS, D), 1.0)
    ssm_w_glu = nrm(ks[14], (N_A_LAYERS, D, 2 * D), D ** -0.5)
    kv_norm_g = 1.0 + nrm(ks[15], (D,), 0.02)
    w_kv = nrm(ks[16], (D, 2 * N_HEADS * HEAD_DIM + N_HEADS * V_DIM), D ** -0.5)
    attn_w_q = nrm(ks[17], (N_B_LAYERS, D, 2 * N_HEADS * HEAD_DIM), D ** -0.5)
    attn_lq1 = nrm(ks[18], (N_B_LAYERS, HEAD_DIM), LAMBDA_INIT_STD)
    attn_lk1 = nrm(ks[19], (N_B_LAYERS, HEAD_DIM), LAMBDA_INIT_STD)
    attn_lq2 = nrm(ks[20], (N_B_LAYERS, HEAD_DIM), LAMBDA_INIT_STD)
    attn_lk2 = nrm(ks[21], (N_B_LAYERS, HEAD_DIM), LAMBDA_INIT_STD)
    attn_subln_g = 1.0 + nrm(ks[22], (N_B_LAYERS, V_DIM), 0.02)
    attn_w_o = nrm(ks[23], (N_B_LAYERS, N_HEADS * V_DIM, D), (N_HEADS * V_DIM) ** -0.5)
    final_norm_g = 1.0 + nrm(ks[24], (D,), 0.02)
    return {"x": x, "norm_mix_g": norm_mix_g, "norm_ffn_g": norm_ffn_g,
            "ffn_w1": ffn_w1, "ffn_w3": ffn_w3, "ffn_w2": ffn_w2,
            "ssm_lam_re": ssm_lam_re, "ssm_lam_im": ssm_lam_im, "ssm_log_dt": ssm_log_dt,
            "ssm_b_re": ssm_b_re, "ssm_b_im": ssm_b_im, "ssm_c_re": ssm_c_re, "ssm_c_im": ssm_c_im,
            "ssm_d": ssm_d, "ssm_w_glu": ssm_w_glu, "kv_norm_g": kv_norm_g, "w_kv": w_kv,
            "attn_w_q": attn_w_q, "attn_lq1": attn_lq1, "attn_lk1": attn_lk1,
            "attn_lq2": attn_lq2, "attn_lk2": attn_lk2, "attn_subln_g": attn_subln_g,
            "attn_w_o": attn_w_o, "final_norm_g": final_norm_g}


def reference(x, norm_mix_g, norm_ffn_g, ffn_w1, ffn_w3, ffn_w2,
              ssm_lam_re, ssm_lam_im, ssm_log_dt, ssm_b_re, ssm_b_im, ssm_c_re, ssm_c_im,
              ssm_d, ssm_w_glu, kv_norm_g, w_kv,
              attn_w_q, attn_lq1, attn_lk1, attn_lq2, attn_lk2, attn_subln_g, attn_w_o,
              final_norm_g):
    L = x.shape[1]
    pos = jnp.arange(L, dtype=jnp.int32)
    h = x
    k1 = k2 = v = None
    for l in range(DEPTH):
        hn = rmsnorm(h, norm_mix_g[l])
        if l < N_A_LAYERS:
            h = h + s5_mixer(hn, ssm_lam_re[l], ssm_lam_im[l], ssm_log_dt[l],
                             ssm_b_re[l], ssm_b_im[l], ssm_c_re[l], ssm_c_im[l],
                             ssm_d[l], ssm_w_glu[l])
        else:
            if l == N_A_LAYERS:
                k1, k2, v = shared_kv(h, kv_norm_g, w_kv, pos)
            j = l - N_A_LAYERS
            lam_init = 0.8 - 0.6 * math.exp(-0.3 * l)
            h = h + diff_attention(hn, k1, k2, v, attn_w_q[j], attn_lq1[j], attn_lk1[j],
                                   attn_lq2[j], attn_lk2[j], attn_subln_g[j], attn_w_o[j],
                                   lam_init, pos)
        h = h + swiglu(rmsnorm(h, norm_ffn_g[l]), ffn_w1[l], ffn_w3[l], ffn_w2[l])
    return rmsnorm(h, final_norm_g)
```

```cpp
#include <hip/hip_runtime.h>
#include <hip/hip_cooperative_groups.h>
#include <stdint.h>
#include <string.h>
#include <stdio.h>
namespace cg = cooperative_groups;

typedef unsigned short bf16_t;
typedef short bf16x8 __attribute__((ext_vector_type(8)));
typedef float f32x16 __attribute__((ext_vector_type(16)));
typedef float f32x4 __attribute__((ext_vector_type(4)));
typedef float f32x2 __attribute__((ext_vector_type(2)));
typedef unsigned u32x4 __attribute__((ext_vector_type(4)));
typedef unsigned u32x2 __attribute__((ext_vector_type(2)));

#define L_SEQ 16384
#define DM 1024
#define FFN 2816
#define NTHREADS 512
#define LDS_BYTES 131072
#define EPSV 1e-6f
#define LAM_INIT 0.35550906759096927f
#define QSCALE 0.18033688011112042f

static constexpr size_t MiB = 1024ull * 1024ull;
static constexpr size_t OFF_WGLU = 0;
static constexpr size_t OFF_WUP0 = 4 * MiB;
static constexpr size_t OFF_WDN0 = 15 * MiB;
static constexpr size_t OFF_WKVQ = 20 * MiB + MiB / 2;
static constexpr size_t OFF_WO = 26 * MiB + MiB / 2;
static constexpr size_t OFF_WUP1 = 28 * MiB + MiB / 2;
static constexpr size_t OFF_WDN1 = 39 * MiB + MiB / 2;
static constexpr size_t OFF_SSQ = 45 * MiB;
static constexpr size_t OFF_A64 = 49 * MiB;
static constexpr size_t OFF_A = 50 * MiB;
static constexpr size_t OFF_HN0 = OFF_A;
static constexpr size_t OFF_Z = OFF_A + 32 * MiB;
static constexpr size_t OFF_ACT = OFF_A;
static constexpr size_t OFF_K1 = OFF_A;
static constexpr size_t OFF_K2 = OFF_A + 16 * MiB;
static constexpr size_t OFF_VT = OFF_A + 32 * MiB;
static constexpr size_t OFF_Q1 = OFF_A + 64 * MiB;
static constexpr size_t OFF_Q2 = OFF_A + 80 * MiB;
static constexpr size_t OFF_B = 146 * MiB;
static constexpr size_t OFF_KT = OFF_B;
static constexpr size_t OFF_W1 = OFF_B + 4 * MiB;
static constexpr size_t OFF_W3 = OFF_B + 20 * MiB;
static constexpr size_t OFF_SLOC = OFF_B + 36 * MiB;
static constexpr size_t OFF_SPREV = OFF_B + 44 * MiB;
static constexpr size_t OFF_HB = OFF_B;
static constexpr size_t OFF_ON = OFF_B + 32 * MiB;

struct WJob { const float* src; bf16_t* dst; const float* gain; int K; int N; int ldsrc; int col0; int mode; int rowoff; float scale; int tile0; int ntn; int pad; };

struct Params {
    const float *x, *norm_mix_g, *norm_ffn_g, *ffn_w1, *ffn_w3, *ffn_w2;
    const float *lam_re, *lam_im, *log_dt, *b_re, *b_im, *c_re, *c_im, *ssm_d, *w_glu;
    const float *kv_norm_g, *w_kv, *w_q, *lq1, *lk1, *lq2, *lk2, *subln_g, *w_o, *final_g;
    float* out;
    char* ws;
    WJob jobs[12];
    int njobs; int ntiles_w;
};

__device__ __forceinline__ unsigned pk_bf16(float lo, float hi) { unsigned r; asm("v_cvt_pk_bf16_f32 %0, %1, %2" : "=v"(r) : "v"(lo), "v"(hi)); return r; }
__device__ __forceinline__ float bf_lo(unsigned u) { return __uint_as_float(u << 16); }
__device__ __forceinline__ float bf_hi(unsigned u) { return __uint_as_float(u & 0xffff0000u); }
__device__ __forceinline__ float fast_rcp(float x) { return __builtin_amdgcn_rcpf(x); }
__device__ __forceinline__ float fast_exp2(float x) { return __builtin_amdgcn_exp2f(x); }
__device__ __forceinline__ float sigmoidf_(float x) { return fast_rcp(1.0f + fast_exp2(-1.4426950408889634f * x)); }
__device__ __forceinline__ float gelu_tanh(float x) {
    const float u = 0.7978845608028654f * x * (1.0f + 0.044715f * x * x);
    return x * fast_rcp(1.0f + fast_exp2(-2.8853900817779268f * u));
}

struct Seg { const bf16_t* W; long wrs; long wkhi; const bf16_t* X; long xrs; long xkhi; };

struct TileCtx { int wn, wm, lane; };

template <class Epi>
__device__ __forceinline__ void gemm_tile(char* lds, const Seg s0, const int nk0, const Seg s1, const int nk1, Epi& epi) {
    int tid = threadIdx.x; asm volatile("" : "+v"(tid));
    const int lane = tid & 63, wid = tid >> 6;
    const int wn = wid >> 2, wm = wid & 3;
    const int r0 = tid >> 3, c8 = tid & 7;
    const int wofs = r0 * 128 + ((c8 ^ ((r0 >> 1) & 7)) << 4);
    f32x16 acc[4][2];
#pragma unroll
    for (int a = 0; a < 4; ++a)
#pragma unroll
        for (int b = 0; b < 2; ++b)
#pragma unroll
            for (int r = 0; r < 16; ++r) acc[a][b][r] = 0.f;
    const int nk = nk0 + nk1;
    u32x4 wr[4], xr[4];
    auto gload = [&](int it) {
        const bool first = it < nk0;
        const bf16_t* W = first ? s0.W : s1.W; const bf16_t* X = first ? s0.X : s1.X;
        const long wrs = first ? s0.wrs : s1.wrs, xrs = first ? s0.xrs : s1.xrs;
        const long wkhi = first ? s0.wkhi : s1.wkhi, xkhi = first ? s0.xkhi : s1.xkhi;
        const int kt = first ? it : it - nk0;
        const long kc = kt * 4 + (c8 >> 1);
        const bf16_t* wp = W + (long)r0 * wrs + kc * wkhi + (c8 & 1) * 8;
        const bf16_t* xp = X + (long)r0 * xrs + kc * xkhi + (c8 & 1) * 8;
#pragma unroll
        for (int i = 0; i < 4; ++i) { wr[i] = *(const u32x4*)(wp + (long)(64 * i) * wrs); xr[i] = *(const u32x4*)(xp + (long)(64 * i) * xrs); }
    };
    auto lstore = [&](int buf) {
        char* wt = lds + buf * 65536 + wofs; char* xt = wt + 32768;
#pragma unroll
        for (int i = 0; i < 4; ++i) { *(u32x4*)(wt + i * 8192) = wr[i]; *(u32x4*)(xt + i * 8192) = xr[i]; }
    };
    const int lr = lane & 31, h = lane >> 5, sw = (lane >> 1) & 7;
    gload(0); lstore(0); __syncthreads();
    for (int it = 0; it < nk; ++it) {
        if (it + 1 < nk) gload(it + 1);
        const char* wt = lds + (it & 1) * 65536 + (wn * 128 + lr) * 128;
        const char* xt = lds + (it & 1) * 65536 + 32768 + (wm * 64 + lr) * 128;
#pragma unroll
        for (int ks = 0; ks < 4; ++ks) {
            const int ch = ((2 * ks + h) ^ sw) << 4;
            bf16x8 a[4], b[2];
#pragma unroll
            for (int nb = 0; nb < 4; ++nb) a[nb] = *(const bf16x8*)(wt + nb * 4096 + ch);
#pragma unroll
            for (int mb = 0; mb < 2; ++mb) b[mb] = *(const bf16x8*)(xt + mb * 4096 + ch);
#pragma unroll
            for (int nb = 0; nb < 4; ++nb)
#pragma unroll
                for (int mb = 0; mb < 2; ++mb) acc[nb][mb] = __builtin_amdgcn_mfma_f32_32x32x16_bf16(a[nb], b[mb], acc[nb][mb], 0, 0, 0);
        }
        if (it + 1 < nk) lstore((it + 1) & 1);
        __syncthreads();
    }
    TileCtx c; c.wn = wn; c.wm = wm; c.lane = lane;
    epi(acc, c);
}

__device__ __forceinline__ float rstd_from(const float* ssq, int npart, int token) {
    float s = 0.f;
    for (int i = 0; i < npart; ++i) s += ssq[(size_t)i * L_SEQ + token];
    return rsqrtf(s * (1.0f / DM) + EPSV);
}

struct EpiSloc {
    float* dst;
    __device__ __forceinline__ void operator()(f32x16 (&acc)[4][2], const TileCtx& c) const {
        if (c.wn != 0) return;
        const int lr = c.lane & 31, h = c.lane >> 5;
#pragma unroll
        for (int mb = 0; mb < 2; ++mb) { const int m = c.wm * 64 + mb * 32 + lr;
#pragma unroll
            for (int nb = 0; nb < 4; ++nb)
#pragma unroll
                for (int rq = 0; rq < 4; ++rq) { const int n = nb * 32 + rq * 8 + 4 * h;
                    f32x4 v = {acc[nb][mb][4 * rq], acc[nb][mb][4 * rq + 1], acc[nb][mb][4 * rq + 2], acc[nb][mb][4 * rq + 3]};
                    *(f32x4*)(dst + (size_t)m * 128 + n) = v; } }
    }
};

struct EpiS5 {
    const bf16_t* hn0; const float* dskip; bf16_t* z; int g; int n0;
    __device__ __forceinline__ void operator()(f32x16 (&acc)[4][2], const TileCtx& c) const {
        const int lr = c.lane & 31, h = c.lane >> 5;
#pragma unroll
        for (int mb = 0; mb < 2; ++mb) { const int j = c.wm * 64 + mb * 32 + lr;
#pragma unroll
            for (int nb = 0; nb < 4; ++nb)
#pragma unroll
                for (int rq = 0; rq < 4; ++rq) { const int n = n0 + c.wn * 128 + nb * 32 + rq * 8 + 4 * h; const int t = n >> 4, cc = n & 15;
                    const size_t off = (size_t)(j * 64 + t) * DM + g * 16 + cc;
                    const u32x2 uu = *(const u32x2*)(hn0 + off); const f32x4 d4 = *(const f32x4*)(dskip + g * 16 + cc);
                    const float y0 = acc[nb][mb][4 * rq] + d4[0] * bf_lo(uu[0]), y1 = acc[nb][mb][4 * rq + 1] + d4[1] * bf_hi(uu[0]);
                    const float y2 = acc[nb][mb][4 * rq + 2] + d4[2] * bf_lo(uu[1]), y3 = acc[nb][mb][4 * rq + 3] + d4[3] * bf_hi(uu[1]);
                    u32x2 o; o[0] = pk_bf16(gelu_tanh(y0), gelu_tanh(y1)); o[1] = pk_bf16(gelu_tanh(y2), gelu_tanh(y3));
                    *(u32x2*)(z + off) = o; } }
    }
};

struct EpiGlu {
    const float* x; float* out; bf16_t* hb; float* ssq; int n0, m0;
    __device__ __forceinline__ void operator()(f32x16 (&acc)[4][2], const TileCtx& c) const {
        const int lr = c.lane & 31, h = c.lane >> 5;
#pragma unroll
        for (int mb = 0; mb < 2; ++mb) { const int m = m0 + c.wm * 64 + mb * 32 + lr; float s = 0.f;
#pragma unroll
            for (int nb = 0; nb < 4; ++nb)
#pragma unroll
                for (int rg = 0; rg < 2; ++rg) { const int f = ((n0 + c.wn * 128 + nb * 32) >> 1) + rg * 8 + 4 * h;
                    const size_t off = (size_t)m * DM + f; const f32x4 xv = *(const f32x4*)(x + off); f32x4 o;
#pragma unroll
                    for (int e = 0; e < 4; ++e) { o[e] = xv[e] + acc[nb][mb][rg * 8 + e] * sigmoidf_(acc[nb][mb][rg * 8 + 4 + e]); s += o[e] * o[e]; }
                    *(f32x4*)(out + off) = o; u32x2 b; b[0] = pk_bf16(o[0], o[1]); b[1] = pk_bf16(o[2], o[3]); *(u32x2*)(hb + off) = b; }
            s += __shfl_xor(s, 32);
            if (h == 0) ssq[(size_t)((n0 >> 8) * 2 + c.wn) * L_SEQ + m] = s; }
    }
};

struct EpiUp {
    const float* ssq; int npart; bf16_t* act; int n0, m0;
    __device__ __forceinline__ void operator()(f32x16 (&acc)[4][2], const TileCtx& c) const {
        const int lr = c.lane & 31, h = c.lane >> 5;
#pragma unroll
        for (int mb = 0; mb < 2; ++mb) { const int m = m0 + c.wm * 64 + mb * 32 + lr; const float rs = rstd_from(ssq, npart, m);
#pragma unroll
            for (int nb = 0; nb < 4; ++nb)
#pragma unroll
                for (int rg = 0; rg < 2; ++rg) { const int f = ((n0 + c.wn * 128 + nb * 32) >> 1) + rg * 8 + 4 * h; float o[4];
#pragma unroll
                    for (int e = 0; e < 4; ++e) { const float a = acc[nb][mb][rg * 8 + e] * rs, b = acc[nb][mb][rg * 8 + 4 + e] * rs; o[e] = a * sigmoidf_(a) * b; }
                    u32x2 bb; bb[0] = pk_bf16(o[0], o[1]); bb[1] = pk_bf16(o[2], o[3]); *(u32x2*)(act + (size_t)m * FFN + f) = bb; } }
    }
};

struct EpiRes {
    float* out; bf16_t* hb; float* ssq; int n0, m0;
    __device__ __forceinline__ void operator()(f32x16 (&acc)[4][2], const TileCtx& c) const {
        const int lr = c.lane & 31, h = c.lane >> 5;
#pragma unroll
        for (int mb = 0; mb < 2; ++mb) { const int m = m0 + c.wm * 64 + mb * 32 + lr; float s = 0.f;
#pragma unroll
            for (int nb = 0; nb < 4; ++nb)
#pragma unroll
                for (int rq = 0; rq < 4; ++rq) { const int f = n0 + c.wn * 128 + nb * 32 + rq * 8 + 4 * h;
                    const size_t off = (size_t)m * DM + f; f32x4 o = *(const f32x4*)(out + off);
#pragma unroll
                    for (int e = 0; e < 4; ++e) { o[e] += acc[nb][mb][4 * rq + e]; s += o[e] * o[e]; }
                    *(f32x4*)(out + off) = o;
                    if (hb) { u32x2 b; b[0] = pk_bf16(o[0], o[1]); b[1] = pk_bf16(o[2], o[3]); *(u32x2*)(hb + off) = b; } }
            s += __shfl_xor(s, 32);
            if (h == 0) ssq[(size_t)((n0 >> 8) * 2 + c.wn) * L_SEQ + m] = s; }
    }
};

struct EpiKvq {
    const float* ssq; int npart; char* ws; int n0, m0;
    __device__ __forceinline__ void operator()(f32x16 (&acc)[4][2], const TileCtx& c) const {
        const int lr = c.lane & 31, h = c.lane >> 5;
        const bool isV = (n0 >= 1024 && n0 < 2048);
#pragma unroll
        for (int mb = 0; mb < 2; ++mb) { const int m = m0 + c.wm * 64 + mb * 32 + lr; const float rs = rstd_from(ssq, npart, m);
            if (isV) {
                const int mp = (m & ~12) | ((m & 4) << 1) | ((m & 8) >> 1);
                bf16_t* vt = (bf16_t*)(ws + OFF_VT);
#pragma unroll
                for (int nb = 0; nb < 4; ++nb)
#pragma unroll
                    for (int r = 0; r < 16; ++r) { const int nl = n0 - 1024 + c.wn * 128 + nb * 32 + (r & 3) + 8 * (r >> 2) + 4 * h;
                        vt[(size_t)nl * L_SEQ + mp] = (bf16_t)(pk_bf16(acc[nb][mb][r] * rs, 0.f) & 0xffffu); }
            } else {
                size_t base; int nl;
                if (n0 < 512) { base = OFF_K1; nl = n0; } else if (n0 < 1024) { base = OFF_K2; nl = n0 - 512; } else if (n0 < 2560) { base = OFF_Q1; nl = n0 - 2048; } else { base = OFF_Q2; nl = n0 - 2560; }
                bf16_t* dst = (bf16_t*)(ws + base);
                float cs[4], sn[4];
#pragma unroll
                for (int e = 0; e < 4; ++e) { const int i = 4 * h + e;
                    const float invf = (i == 0) ? 1.0f : (i == 1) ? 0.19391188f : (i == 2) ? 0.037601817f : (i == 3) ? 0.0072914392f : (i == 4) ? 0.0014142136f : (i == 5) ? 0.00027423282f : (i == 6) ? 5.3176997e-05f : 1.0311653e-05f;
                    const float ang = (float)m * invf; double rev = (double)ang * 0.15915494309189535; rev -= rint(rev); const float fr = (float)rev;
                    cs[e] = __builtin_amdgcn_cosf(fr); sn[e] = __builtin_amdgcn_sinf(fr); }
#pragma unroll
                for (int nb = 0; nb < 4; ++nb) {
                    const int nn = nl + c.wn * 128 + nb * 32; const int head = nn >> 6, d0 = nn & 63;
                    float v[16];
#pragma unroll
                    for (int r = 0; r < 16; ++r) v[r] = acc[nb][mb][r] * rs;
                    if (d0 == 0) {
#pragma unroll
                        for (int e = 0; e < 4; ++e) { const float x1 = v[e], x2 = v[4 + e]; v[e] = x1 * cs[e] - x2 * sn[e]; v[4 + e] = x2 * cs[e] + x1 * sn[e]; }
                    }
#pragma unroll
                    for (int rq = 0; rq < 4; ++rq) { u32x2 b; b[0] = pk_bf16(v[4 * rq], v[4 * rq + 1]); b[1] = pk_bf16(v[4 * rq + 2], v[4 * rq + 3]);
                        *(u32x2*)(dst + ((size_t)head * L_SEQ + m) * 64 + d0 + rq * 8 + 4 * h) = b; }
                }
            } }
    }
};

__device__ __forceinline__ void s5_tables(const Params& p, int g, char* lds) {
    f32x2* apow = (f32x2*)lds;
    f32x2* bb = apow + 65 * 64;
    f32x2* cc = bb + 1024;
    f32x2* zf = cc + 1024;
    int tid = threadIdx.x; asm volatile("" : "+v"(tid));
    const float dt = expf(p.log_dt[g]);
    for (int e = tid; e < 65 * 64; e += NTHREADS) {
        const int lag = e >> 6, pp = e & 63;
        const float lr = p.lam_re[g * 64 + pp], li = p.lam_im[g * 64 + pp];
        const float mag = expf(lr * dt * (float)lag);
        double rev = (double)li * (double)dt * (double)lag * 0.15915494309189535; rev -= rint(rev);
        const float fr = (float)rev;
        f32x2 v; v[0] = mag * __builtin_amdgcn_cosf(fr); v[1] = mag * __builtin_amdgcn_sinf(fr); apow[e] = v;
    }
    if (tid < 64) {
        const float lr = p.lam_re[g * 64 + tid], li = p.lam_im[g * 64 + tid];
        const float em1 = expm1f(lr * dt);
        double rev = (double)li * (double)dt * 0.15915494309189535; const double rh = rev * 0.5; rev -= rint(rev);
        const double rh2 = rh - rint(rh);
        const float cth = __builtin_amdgcn_cosf((float)rev), sth = __builtin_amdgcn_sinf((float)rev), shalf = __builtin_amdgcn_sinf((float)rh2);
        const float nr = em1 * cth - 2.0f * shalf * shalf, ni = (1.0f + em1) * sth;
        const float den = lr * lr + li * li;
        f32x2 f; f[0] = (nr * lr + ni * li) / den; f[1] = (ni * lr - nr * li) / den; zf[tid] = f;
    }
    __syncthreads();
    for (int e = tid; e < 1024; e += NTHREADS) {
        const int pp = e >> 4;
        const float br = p.b_re[(size_t)g * 1024 + e], bi = p.b_im[(size_t)g * 1024 + e];
        const f32x2 f = zf[pp]; f32x2 v; v[0] = f[0] * br - f[1] * bi; v[1] = f[0] * bi + f[1] * br; bb[e] = v;
        f32x2 cv; cv[0] = p.c_re[(size_t)g * 1024 + e]; cv[1] = p.c_im[(size_t)g * 1024 + e]; cc[e] = cv;
    }
    __syncthreads();
    bf16_t* kt = (bf16_t*)(p.ws + OFF_KT) + (size_t)g * 127 * 256;
    bf16_t* w1 = (bf16_t*)(p.ws + OFF_W1) + (size_t)g * 128 * 1024;
    bf16_t* w3 = (bf16_t*)(p.ws + OFF_W3) + (size_t)g * 1024 * 128;
    {
        const int cp = tid & 255, c = cp >> 4, c2 = cp & 15, half = tid >> 8;
        float acc[32];
#pragma unroll
        for (int l = 0; l < 32; ++l) acc[l] = 0.f;
        for (int pp = 0; pp < 64; ++pp) {
            const f32x2 cv = cc[c * 64 + pp], bv = bb[pp * 16 + c2];
            const float cbr = cv[0] * bv[0] - cv[1] * bv[1], cbi = cv[0] * bv[1] + cv[1] * bv[0];
#pragma unroll
            for (int l = 0; l < 32; ++l) { const f32x2 a = apow[(half * 32 + l) * 64 + pp]; acc[l] += cbr * a[0] - cbi * a[1]; }
        }
#pragma unroll
        for (int l = 0; l < 32; ++l) kt[(size_t)(63 + half * 32 + l) * 256 + cp] = (bf16_t)(pk_bf16(acc[l], 0.f) & 0xffffu);
        for (int e = tid; e < 63 * 256 / 8; e += NTHREADS) { u32x4 zz = {0u, 0u, 0u, 0u}; *(u32x4*)(kt + e * 8) = zz; }
    }
    for (int q = tid; q < 128 * 128; q += NTHREADS) {
        const int pq = q >> 7, kc = q & 127, tau = kc >> 1, c0 = (kc & 1) * 8, pp = pq & 63, im = pq >> 6;
        const f32x2 a = apow[(63 - tau) * 64 + pp]; float v[8];
#pragma unroll
        for (int e = 0; e < 8; ++e) { const f32x2 b = bb[pp * 16 + c0 + e]; v[e] = im ? (a[0] * b[1] + a[1] * b[0]) : (a[0] * b[0] - a[1] * b[1]); }
        u32x4 o; o[0] = pk_bf16(v[0], v[1]); o[1] = pk_bf16(v[2], v[3]); o[2] = pk_bf16(v[4], v[5]); o[3] = pk_bf16(v[6], v[7]);
        *(u32x4*)(w1 + (size_t)pq * 1024 + kc * 8) = o;
    }
    for (int q = tid; q < 1024 * 16; q += NTHREADS) {
        const int n = q >> 4, p0 = (q & 15) * 8, t = n >> 4, c = n & 15, im = p0 >> 6; float v[8];
#pragma unroll
        for (int e = 0; e < 8; ++e) { const int pp = (p0 + e) & 63; const f32x2 a = apow[(t + 1) * 64 + pp]; const f32x2 cv = cc[c * 64 + pp];
            v[e] = im ? -(cv[0] * a[1] + cv[1] * a[0]) : (cv[0] * a[0] - cv[1] * a[1]); }
        u32x4 o; o[0] = pk_bf16(v[0], v[1]); o[1] = pk_bf16(v[2], v[3]); o[2] = pk_bf16(v[4], v[5]); o[3] = pk_bf16(v[6], v[7]);
        *(u32x4*)(w3 + (size_t)n * 128 + p0) = o;
    }
    if (tid < 64) ((f32x2*)(p.ws + OFF_A64))[g * 64 + tid] = apow[64 * 64 + tid];
    __syncthreads();
}

__device__ __forceinline__ void wtile(const Params& p, int t, char* lds) {
    int j = 0;
    for (int i = 1; i < p.njobs; ++i) if (t >= p.jobs[i].tile0) j = i;
    const WJob& J = p.jobs[j];
    const int lt = t - J.tile0, kt = lt / J.ntn, nt = lt - kt * J.ntn;
    const int k0 = kt * 64, nl0 = nt * 64;
    float* T = (float*)lds;
    int tid = threadIdx.x; asm volatile("" : "+v"(tid));
#pragma unroll
    for (int i = 0; i < 8; ++i) { const int kk = i * 8 + (tid >> 6), nn = tid & 63;
        float v = J.src[(size_t)(k0 + kk) * J.ldsrc + J.col0 + nl0 + nn] * J.scale;
        if (J.gain) v *= J.gain[k0 + kk];
        T[kk * 65 + nn] = v; }
    __syncthreads();
    { const int nn = tid >> 3, kc = (tid & 7) * 8; float v[8];
#pragma unroll
        for (int e = 0; e < 8; ++e) v[e] = T[(kc + e) * 65 + nn];
        const int n = nl0 + nn; int row = (J.mode == 0) ? n : ((n >> 3) * 16 + (n & 7) + (J.mode == 2 ? 8 : 0)); row += J.rowoff;
        u32x4 o; o[0] = pk_bf16(v[0], v[1]); o[1] = pk_bf16(v[2], v[3]); o[2] = pk_bf16(v[4], v[5]); o[3] = pk_bf16(v[6], v[7]);
        *(u32x4*)(J.dst + (size_t)row * J.K + k0 + kc) = o; }
    __syncthreads();
}

__device__ __forceinline__ void rms0_item(const Params& p, int item) {
    const int lane = threadIdx.x & 63, wid = threadIdx.x >> 6;
    bf16_t* hn0 = (bf16_t*)(p.ws + OFF_HN0);
    for (int r = 0; r < 8; ++r) {
        const int row = item * 64 + wid * 8 + r;
        f32x4 v[4]; float s = 0.f;
#pragma unroll
        for (int i = 0; i < 4; ++i) { v[i] = *(const f32x4*)(p.x + (size_t)row * DM + lane * 4 + 256 * i); s += v[i][0] * v[i][0] + v[i][1] * v[i][1] + v[i][2] * v[i][2] + v[i][3] * v[i][3]; }
#pragma unroll
        for (int o = 32; o >= 1; o >>= 1) s += __shfl_xor(s, o);
        const float rs = rsqrtf(s * (1.0f / DM) + EPSV);
#pragma unroll
        for (int i = 0; i < 4; ++i) { const f32x4 g = *(const f32x4*)(p.norm_mix_g + lane * 4 + 256 * i);
            u32x2 o; o[0] = pk_bf16(v[i][0] * rs * g[0], v[i][1] * rs * g[1]); o[1] = pk_bf16(v[i][2] * rs * g[2], v[i][3] * rs * g[3]);
            *(u32x2*)(hn0 + (size_t)row * DM + lane * 4 + 256 * i) = o; }
    }
}

__device__ __forceinline__ void attn_item(const Params& p, int head, int qb, float lam, char* lds) {
    int tid = threadIdx.x; asm volatile("" : "+v"(tid));
    const int lane = tid & 63, wid = tid >> 6;
    const int mp = wid >> 2, g = wid & 3;
    const int lr = lane & 31, h = lane >> 5, sw = (lane >> 1) & 7;
    const bf16_t* K1 = (const bf16_t*)(p.ws + OFF_K1) + (size_t)head * L_SEQ * 64;
    const bf16_t* K2 = (const bf16_t*)(p.ws + OFF_K2) + (size_t)head * L_SEQ * 64;
    const bf16_t* VT = (const bf16_t*)(p.ws + OFF_VT) + (size_t)head * 128 * L_SEQ;
    const bf16_t* Q = (const bf16_t*)(p.ws + (mp ? OFF_Q2 : OFF_Q1)) + (size_t)head * L_SEQ * 64;
    const int q0 = qb * 128 + g * 32;
    bf16x8 qf[4];
#pragma unroll
    for (int s = 0; s < 4; ++s) qf[s] = *(const bf16x8*)(Q + (size_t)(q0 + lr) * 64 + 16 * s + 8 * h);
    const int nkt = 2 * qb + 2;
    const int my_last = 2 * qb + (g >> 1);
    f32x16 O[4];
#pragma unroll
    for (int e = 0; e < 4; ++e)
#pragma unroll
        for (int r = 0; r < 16; ++r) O[e][r] = 0.f;
    float m_run = -1e30f, l_run = 0.f;
    const int r0 = tid >> 3, c8 = tid & 7;
    const int kofs = r0 * 128 + ((c8 ^ ((r0 >> 1) & 7)) << 4);
    u32x4 sk1, sk2, sv0, sv1;
    auto gload = [&](int kt) {
        sk1 = *(const u32x4*)(K1 + (size_t)(kt * 64 + r0) * 64 + c8 * 8);
        sk2 = *(const u32x4*)(K2 + (size_t)(kt * 64 + r0) * 64 + c8 * 8);
        sv0 = *(const u32x4*)(VT + (size_t)r0 * L_SEQ + kt * 64 + c8 * 8);
        sv1 = *(const u32x4*)(VT + (size_t)(r0 + 64) * L_SEQ + kt * 64 + c8 * 8);
    };
    auto lstore = [&](int buf) {
        char* b = lds + buf * 32768 + kofs;
        *(u32x4*)(b) = sk1; *(u32x4*)(b + 8192) = sk2; *(u32x4*)(b + 16384) = sv0; *(u32x4*)(b + 16384 + 8192) = sv1;
    };
    gload(0); lstore(0); __syncthreads();
    for (int kt = 0; kt < nkt; ++kt) {
        if (kt + 1 < nkt) gload(kt + 1);
        if (kt <= my_last) {
            const char* kb_ = lds + (kt & 1) * 32768 + mp * 8192 + lr * 128;
            const char* vb_ = lds + (kt & 1) * 32768 + 16384 + lr * 128;
            f32x16 S[2];
#pragma unroll
            for (int kb = 0; kb < 2; ++kb) {
#pragma unroll
                for (int r = 0; r < 16; ++r) S[kb][r] = 0.f;
#pragma unroll
                for (int s = 0; s < 4; ++s) { const bf16x8 kf = *(const bf16x8*)(kb_ + kb * 4096 + (((2 * s + h) ^ sw) << 4));
                    S[kb] = __builtin_amdgcn_mfma_f32_32x32x16_bf16(kf, qf[s], S[kb], 0, 0, 0); }
            }
            float mt = S[0][0];
#pragma unroll
            for (int r = 1; r < 16; ++r) mt = fmaxf(mt, S[0][r]);
#pragma unroll
            for (int r = 0; r < 16; ++r) mt = fmaxf(mt, S[1][r]);
            mt = fmaxf(mt, __shfl_xor(mt, 32));
            const bool need = mt > m_run + 8.0f;
            if (__any(need)) {
                const float mnew = need ? mt : m_run;
                const float alpha = fast_exp2(m_run - mnew);
                m_run = mnew; l_run *= alpha;
#pragma unroll
                for (int e = 0; e < 4; ++e)
#pragma unroll
                    for (int r = 0; r < 16; ++r) O[e][r] *= alpha;
            }
            float ls = 0.f;
            bf16x8 pf[2][2];
#pragma unroll
            for (int kb = 0; kb < 2; ++kb)
#pragma unroll
                for (int s = 0; s < 2; ++s) { float e_[8];
#pragma unroll
                    for (int j = 0; j < 8; ++j) { e_[j] = fast_exp2(S[kb][8 * s + j] - m_run); ls += e_[j]; }
                    u32x4 pk; pk[0] = pk_bf16(e_[0], e_[1]); pk[1] = pk_bf16(e_[2], e_[3]); pk[2] = pk_bf16(e_[4], e_[5]); pk[3] = pk_bf16(e_[6], e_[7]);
                    pf[kb][s] = __builtin_bit_cast(bf16x8, pk); }
            l_run += ls;
#pragma unroll
            for (int kb = 0; kb < 2; ++kb)
#pragma unroll
                for (int s = 0; s < 2; ++s)
#pragma unroll
                    for (int e = 0; e < 4; ++e) { const bf16x8 vf = *(const bf16x8*)(vb_ + e * 4096 + (((4 * kb + 2 * s + h) ^ sw) << 4));
                        O[e] = __builtin_amdgcn_mfma_f32_32x32x16_bf16(vf, pf[kb][s], O[e], 0, 0, 0); }
        }
        if (kt + 1 < nkt) lstore((kt + 1) & 1);
        __syncthreads();
    }
    const float lt = l_run + __shfl_xor(l_run, 32);
    const float inv = fast_rcp(lt) * (mp ? lam : 1.0f);
    float* ex = (float*)lds;
    if (mp == 1) {
#pragma unroll
        for (int e = 0; e < 4; ++e)
#pragma unroll
            for (int r = 0; r < 16; ++r) ex[((g * 4 + e) * 16 + r) * 64 + lane] = O[e][r] * inv;
    }
    __syncthreads();
    if (mp == 0) {
        float ss = 0.f;
#pragma unroll
        for (int e = 0; e < 4; ++e)
#pragma unroll
            for (int r = 0; r < 16; ++r) { const float o = O[e][r] * inv - ex[((g * 4 + e) * 16 + r) * 64 + lane]; O[e][r] = o; ss += o * o; }
        ss += __shfl_xor(ss, 32);
        const float rs = rsqrtf(ss * (1.0f / 128.0f) + EPSV) * (1.0f - LAM_INIT);
        bf16_t* on = (bf16_t*)(p.ws + OFF_ON) + (size_t)(q0 + lr) * DM + head * 128;
#pragma unroll
        for (int e = 0; e < 4; ++e)
#pragma unroll
            for (int rq = 0; rq < 4; ++rq) { const int ee = e * 32 + rq * 8 + 4 * h; const f32x4 gg = *(const f32x4*)(p.subln_g + ee);
                u32x2 b; b[0] = pk_bf16(O[e][4 * rq] * rs * gg[0], O[e][4 * rq + 1] * rs * gg[1]); b[1] = pk_bf16(O[e][4 * rq + 2] * rs * gg[2], O[e][4 * rq + 3] * rs * gg[3]);
                *(u32x2*)(on + ee) = b; }
    }
    __syncthreads();
}

__global__ void __launch_bounds__(NTHREADS) mega(const Params p) {
    __shared__ __attribute__((aligned(16))) char lds[LDS_BYTES];
    cg::grid_group grid = cg::this_grid();
    const int nb = gridDim.x, bid = blockIdx.x, tid = threadIdx.x;
    char* ws = p.ws;
    bf16_t* hn0 = (bf16_t*)(ws + OFF_HN0);
    bf16_t* hb = (bf16_t*)(ws + OFF_HB);
    float* ssq0 = (float*)(ws + OFF_SSQ);
    float* ssq1 = ssq0 + 16 * L_SEQ; float* ssq2 = ssq1 + 16 * L_SEQ; float* ssq3 = ssq2 + 16 * L_SEQ;
    const Seg nul = {nullptr, 0, 0, nullptr, 0, 0};

    { const int nitems = 64 + p.ntiles_w + 256;
      for (int it = bid; it < nitems; it += nb) {
          if (it < 64) s5_tables(p, it, lds);
          else if (it < 64 + p.ntiles_w) wtile(p, it - 64, lds);
          else rms0_item(p, it - 64 - p.ntiles_w);
      } }
    grid.sync();
    for (int g = bid; g < 64; g += nb) {
        Seg s = {(const bf16_t*)(ws + OFF_W1) + (size_t)g * 128 * 1024, 1024, 16, hn0 + g * 16, 65536, 1024};
        EpiSloc e = {(float*)(ws + OFF_SLOC) + (size_t)g * 256 * 128};
        gemm_tile(lds, s, 16, nul, 0, e);
    }
    grid.sync();
    for (int t = bid; t < 256; t += nb) {
        const int g = t >> 2, i = 3 - (t & 3);
        bf16_t* sprev = (bf16_t*)(ws + OFF_SPREV) + (size_t)t * 256 * 128;
        if (tid < 64) {
            const f32x2 a = ((const f32x2*)(ws + OFF_A64))[g * 64 + tid];
            const float* sl = (const float*)(ws + OFF_SLOC) + (size_t)g * 256 * 128;
            float sr = 0.f, si = 0.f;
            for (int j = 0; j < 256; ++j) {
                sprev[j * 128 + tid] = (bf16_t)(pk_bf16(sr, 0.f) & 0xffffu); sprev[j * 128 + 64 + tid] = (bf16_t)(pk_bf16(si, 0.f) & 0xffffu);
                const float lr_ = sl[j * 128 + tid], li_ = sl[j * 128 + 64 + tid];
                const float nr = a[0] * sr - a[1] * si + lr_, ni = a[0] * si + a[1] * sr + li_; sr = nr; si = ni;
            }
            __threadfence();
        }
        __syncthreads();
        Seg s0 = {(const bf16_t*)(ws + OFF_KT) + (size_t)g * 127 * 256 + 63 * 256 + (size_t)(i * 256) * 16, 16, -256, hn0 + g * 16, 65536, 1024};
        Seg s1 = {(const bf16_t*)(ws + OFF_W3) + (size_t)g * 1024 * 128 + (size_t)(i * 256) * 128, 128, 16, sprev, 128, 16};
        EpiS5 e = {hn0, p.ssm_d, (bf16_t*)(ws + OFF_Z), g, i * 256};
        gemm_tile(lds, s0, 4 * (i + 1), s1, 2, e);
    }
    grid.sync();
    for (int t = bid; t < 8 * 64; t += nb) {
        const int nt = t & 7, mt = t >> 3;
        Seg s = {(const bf16_t*)(ws + OFF_WGLU) + (size_t)nt * 256 * DM, DM, 16, (const bf16_t*)(ws + OFF_Z) + (size_t)mt * 256 * DM, DM, 16};
        EpiGlu e = {p.x, p.out, hb, ssq0, nt * 256, mt * 256};
        gemm_tile(lds, s, 16, nul, 0, e);
    }
    grid.sync();
#pragma unroll
    for (int layer = 0; layer < 2; ++layer) {
        if (layer == 1) {
            for (int t = bid; t < 12 * 64; t += nb) {
                const int nt = t % 12, mt = t / 12;
                Seg s = {(const bf16_t*)(ws + OFF_WKVQ) + (size_t)nt * 256 * DM, DM, 16, hb + (size_t)mt * 256 * DM, DM, 16};
                EpiKvq e = {ssq1, 8, ws, nt * 256, mt * 256};
                gemm_tile(lds, s, 16, nul, 0, e);
            }
            grid.sync();
            {
                float a1 = 0.f, a2 = 0.f;
                for (int i = 0; i < 64; ++i) { a1 += p.lq1[i] * p.lk1[i]; a2 += p.lq2[i] * p.lk2[i]; }
                const float lam = expf(a1) - expf(a2) + LAM_INIT;
                for (int it = bid; it < 1024; it += nb) {
                    const int head = it & 7, r = it >> 3, rnd = r >> 5, j = r & 31;
                    const int qb = (rnd == 0) ? 127 - j : (rnd == 1) ? 64 + j : (rnd == 2) ? 63 - j : j;
                    attn_item(p, head, qb, lam, lds);
                }
            }
            grid.sync();
            for (int t = bid; t < 4 * 64; t += nb) {
                const int nt = t & 3, mt = t >> 2;
                Seg s = {(const bf16_t*)(ws + OFF_WO) + (size_t)nt * 256 * DM, DM, 16, (const bf16_t*)(ws + OFF_ON) + (size_t)mt * 256 * DM, DM, 16};
                EpiRes e = {p.out, hb, ssq2, nt * 256, mt * 256};
                gemm_tile(lds, s, 16, nul, 0, e);
            }
            grid.sync();
        }
        {
            const bf16_t* wup = (const bf16_t*)(ws + (layer ? OFF_WUP1 : OFF_WUP0));
            const float* sq = layer ? ssq2 : ssq0; const int npart = layer ? 8 : 16;
            for (int t = bid; t < 22 * 64; t += nb) {
                const int nt = t % 22, mt = t / 22;
                Seg s = {wup + (size_t)nt * 256 * DM, DM, 16, hb + (size_t)mt * 256 * DM, DM, 16};
                EpiUp e = {sq, npart, (bf16_t*)(ws + OFF_ACT), nt * 256, mt * 256};
                gemm_tile(lds, s, 16, nul, 0, e);
            }
        }
        grid.sync();
        {
            const bf16_t* wdn = (const bf16_t*)(ws + (layer ? OFF_WDN1 : OFF_WDN0));
            for (int t = bid; t < 4 * 64; t += nb) {
                const int nt = t & 3, mt = t >> 2;
                Seg s = {wdn + (size_t)nt * 256 * FFN, FFN, 16, (const bf16_t*)(ws + OFF_ACT) + (size_t)mt * 256 * FFN, FFN, 16};
                EpiRes e = {p.out, layer ? (bf16_t*)nullptr : hb, layer ? ssq3 : ssq1, nt * 256, mt * 256};
                gemm_tile(lds, s, FFN / 64, nul, 0, e);
            }
        }
        grid.sync();
    }
    {
        const int lane = tid & 63, wid = tid >> 6;
        for (int row = bid * 8 + wid; row < L_SEQ; row += nb * 8) {
            float s = 0.f;
            for (int i = 0; i < 8; ++i) s += ssq3[(size_t)i * L_SEQ + row];
            const float rs = rsqrtf(s * (1.0f / DM) + EPSV);
#pragma unroll
            for (int i = 0; i < 4; ++i) { const size_t off = (size_t)row * DM + lane * 4 + 256 * i;
                f32x4 v = *(const f32x4*)(p.out + off); const f32x4 g = *(const f32x4*)(p.final_g + lane * 4 + 256 * i);
                v[0] *= rs * g[0]; v[1] *= rs * g[1]; v[2] *= rs * g[2]; v[3] *= rs * g[3]; *(f32x4*)(p.out + off) = v; }
        }
    }
}

static void add_job(Params& P, int& nt, const float* src, bf16_t* dst, const float* gain, int K, int N, int ld, int col0, int mode, int rowoff, float scale) {
    WJob& J = P.jobs[P.njobs++];
    J.src = src; J.dst = dst; J.gain = gain; J.K = K; J.N = N; J.ldsrc = ld; J.col0 = col0; J.mode = mode; J.rowoff = rowoff; J.scale = scale; J.tile0 = nt; J.ntn = N / 64; J.pad = 0;
    nt += (K / 64) * (N / 64);
}

extern "C" void kernel_launch(void* const* d_in, const int* in_sizes, int n_in, void* d_out, int out_size, void* d_ws, size_t ws_size, hipStream_t stream) {
    Params P; memset(&P, 0, sizeof(P));
    P.x = (const float*)d_in[0]; P.norm_mix_g = (const float*)d_in[1]; P.norm_ffn_g = (const float*)d_in[2];
    P.ffn_w1 = (const float*)d_in[3]; P.ffn_w3 = (const float*)d_in[4]; P.ffn_w2 = (const float*)d_in[5];
    P.lam_re = (const float*)d_in[6]; P.lam_im = (const float*)d_in[7]; P.log_dt = (const float*)d_in[8];
    P.b_re = (const float*)d_in[9]; P.b_im = (const float*)d_in[10]; P.c_re = (const float*)d_in[11]; P.c_im = (const float*)d_in[12];
    P.ssm_d = (const float*)d_in[13]; P.w_glu = (const float*)d_in[14]; P.kv_norm_g = (const float*)d_in[15]; P.w_kv = (const float*)d_in[16];
    P.w_q = (const float*)d_in[17]; P.lq1 = (const float*)d_in[18]; P.lk1 = (const float*)d_in[19]; P.lq2 = (const float*)d_in[20]; P.lk2 = (const float*)d_in[21];
    P.subln_g = (const float*)d_in[22]; P.w_o = (const float*)d_in[23]; P.final_g = (const float*)d_in[24];
    P.out = (float*)d_out; P.ws = (char*)d_ws;
    char* ws = (char*)d_ws; int nt = 0;
    const size_t FW = (size_t)DM * FFN;
    add_job(P, nt, P.w_glu, (bf16_t*)(ws + OFF_WGLU), nullptr, DM, 1024, 2048, 0, 1, 0, 1.0f);
    add_job(P, nt, P.w_glu, (bf16_t*)(ws + OFF_WGLU), nullptr, DM, 1024, 2048, 1024, 2, 0, 1.0f);
    add_job(P, nt, P.ffn_w1, (bf16_t*)(ws + OFF_WUP0), P.norm_ffn_g, DM, FFN, FFN, 0, 1, 0, 1.0f);
    add_job(P, nt, P.ffn_w3, (bf16_t*)(ws + OFF_WUP0), P.norm_ffn_g, DM, FFN, FFN, 0, 2, 0, 1.0f);
    add_job(P, nt, P.ffn_w2, (bf16_t*)(ws + OFF_WDN0), nullptr, FFN, DM, DM, 0, 0, 0, 1.0f);
    add_job(P, nt, P.w_kv, (bf16_t*)(ws + OFF_WKVQ), P.kv_norm_g, DM, 2048, 2048, 0, 0, 0, 1.0f);
    add_job(P, nt, P.w_q, (bf16_t*)(ws + OFF_WKVQ), P.norm_mix_g + DM, DM, 1024, 1024, 0, 0, 2048, QSCALE);
    add_job(P, nt, P.w_o, (bf16_t*)(ws + OFF_WO), nullptr, DM, DM, DM, 0, 0, 0, 1.0f);
    add_job(P, nt, P.ffn_w1 + FW, (bf16_t*)(ws + OFF_WUP1), P.norm_ffn_g + DM, DM, FFN, FFN, 0, 1, 0, 1.0f);
    add_job(P, nt, P.ffn_w3 + FW, (bf16_t*)(ws + OFF_WUP1), P.norm_ffn_g + DM, DM, FFN, FFN, 0, 2, 0, 1.0f);
    add_job(P, nt, P.ffn_w2 + FW, (bf16_t*)(ws + OFF_WDN1), nullptr, FFN, DM, DM, 0, 0, 0, 1.0f);
    P.ntiles_w = nt;
    static int grid_blocks = 0;
    if (!grid_blocks) {
        int dev = 0, cus = 0, per_cu = 0;
        hipGetDevice(&dev);
        hipDeviceGetAttribute(&cus, hipDeviceAttributeMultiprocessorCount, dev);
        hipOccupancyMaxActiveBlocksPerMultiprocessor(&per_cu, mega, NTHREADS, 0);
        if (per_cu < 1) per_cu = 1;
        grid_blocks = cus * 1;
    }
    void* args[] = {&P};
    hipError_t e = hipLaunchCooperativeKernel((void*)mega, dim3(grid_blocks), dim3(NTHREADS), args, 0, stream);
    if (e != hipSuccess) fprintf(stderr, "cooperative launch failed: %s (grid %d)\n", hipGetErrorString(e), grid_blocks);
}
```

```cpp
#include <hip/hip_runtime.h>
#include <hip/hip_cooperative_groups.h>
#include <stdint.h>
#include <string.h>
#include <stdio.h>
namespace cg = cooperative_groups;

typedef unsigned short bf16_t;
typedef short bf16x8 __attribute__((ext_vector_type(8)));
typedef float f32x16 __attribute__((ext_vector_type(16)));
typedef float f32x4 __attribute__((ext_vector_type(4)));
typedef float f32x2 __attribute__((ext_vector_type(2)));
typedef unsigned u32x4 __attribute__((ext_vector_type(4)));
typedef unsigned u32x2 __attribute__((ext_vector_type(2)));

#define L_SEQ 16384
#define DM 1024
#define FFN 2816
#define NTHREADS 512
#ifndef REP_ATTN
#define REP_ATTN 1
#endif
#ifndef REP_UP
#define REP_UP 1
#endif
#define LDS_BYTES 131072
#define EPSV 1e-6f
#define LAM_INIT 0.35550906759096927f
#define QSCALE 0.18033688011112042f

static constexpr size_t MiB = 1024ull * 1024ull;
static constexpr size_t OFF_WGLU = 0;
static constexpr size_t OFF_WUP0 = 4 * MiB;
static constexpr size_t OFF_WDN0 = 15 * MiB;
static constexpr size_t OFF_WKVQ = 20 * MiB + MiB / 2;
static constexpr size_t OFF_WO = 26 * MiB + MiB / 2;
static constexpr size_t OFF_WUP1 = 28 * MiB + MiB / 2;
static constexpr size_t OFF_WDN1 = 39 * MiB + MiB / 2;
static constexpr size_t OFF_SSQ = 45 * MiB;
static constexpr size_t OFF_A64 = 49 * MiB;
static constexpr size_t OFF_BAR = 49 * MiB + MiB / 2;
static constexpr size_t OFF_A = 50 * MiB;
static constexpr size_t OFF_HN0 = OFF_A;
static constexpr size_t OFF_Z = OFF_A + 32 * MiB;
static constexpr size_t OFF_ACT = OFF_A;
static constexpr size_t OFF_K1 = OFF_A;
static constexpr size_t OFF_K2 = OFF_A + 16 * MiB;
static constexpr size_t OFF_VT = OFF_A + 32 * MiB;
static constexpr size_t OFF_Q1 = OFF_A + 64 * MiB;
static constexpr size_t OFF_Q2 = OFF_A + 80 * MiB;
static constexpr size_t OFF_B = 146 * MiB;
static constexpr size_t OFF_KT = OFF_B;
static constexpr size_t OFF_W1 = OFF_B + 4 * MiB;
static constexpr size_t OFF_W3 = OFF_B + 20 * MiB;
static constexpr size_t OFF_SLOC = OFF_B + 36 * MiB;
static constexpr size_t OFF_SPREV = OFF_B + 44 * MiB;
static constexpr size_t OFF_HB = OFF_B;
static constexpr size_t OFF_ON = OFF_B + 32 * MiB;

struct WJob { const float* src; bf16_t* dst; const float* gain; int K; int N; int ldsrc; int col0; int mode; int rowoff; float scale; int tile0; int ntn; int pad; };

struct Params {
    const float *x, *norm_mix_g, *norm_ffn_g, *ffn_w1, *ffn_w3, *ffn_w2;
    const float *lam_re, *lam_im, *log_dt, *b_re, *b_im, *c_re, *c_im, *ssm_d, *w_glu;
    const float *kv_norm_g, *w_kv, *w_q, *lq1, *lk1, *lq2, *lk2, *subln_g, *w_o, *final_g;
    float* out;
    char* ws;
    WJob jobs[12];
    int njobs; int ntiles_w;
};

__device__ __forceinline__ int get_tid(int wave_s) { int t = wave_s * 64 + (int)__builtin_amdgcn_mbcnt_hi(~0u, __builtin_amdgcn_mbcnt_lo(~0u, 0u)); asm volatile("" : "+v"(t)); return t; }
__device__ __forceinline__ unsigned pk_bf16(float lo, float hi) { unsigned r; asm("v_cvt_pk_bf16_f32 %0, %1, %2" : "=v"(r) : "v"(lo), "v"(hi)); return r; }
__device__ __forceinline__ float bf_lo(unsigned u) { return __uint_as_float(u << 16); }
__device__ __forceinline__ float bf_hi(unsigned u) { return __uint_as_float(u & 0xffff0000u); }
__device__ __forceinline__ float fast_rcp(float x) { return __builtin_amdgcn_rcpf(x); }
__device__ __forceinline__ float fast_exp2(float x) { return __builtin_amdgcn_exp2f(x); }
__device__ __forceinline__ float sigmoidf_(float x) { return fast_rcp(1.0f + fast_exp2(-1.4426950408889634f * x)); }
__device__ __forceinline__ float gelu_tanh(float x) {
    const float u = 0.7978845608028654f * x * (1.0f + 0.044715f * x * x);
    return x * fast_rcp(1.0f + fast_exp2(-2.8853900817779268f * u));
}

struct Seg { const bf16_t* W; long wrs; long wkhi; const bf16_t* X; long xrs; long xkhi; };

struct TileCtx { int wn, wm, lane; };

template <class Epi>
__device__ __forceinline__ void gemm_tile(const int wave_s, char* lds, const Seg s0, const int nk0, const Seg s1, const int nk1, Epi& epi) {
    int tid = get_tid(wave_s); asm volatile("" : "+v"(tid));
    const int lane = tid & 63, wid = tid >> 6;
    const int wn = wid >> 2, wm = wid & 3;
    const int r0 = tid >> 3, c8 = tid & 7;
    const int wofs = r0 * 128 + ((c8 ^ ((r0 >> 1) & 7)) << 4);
    f32x16 acc[4][2];
#pragma unroll
    for (int a = 0; a < 4; ++a)
#pragma unroll
        for (int b = 0; b < 2; ++b)
#pragma unroll
            for (int r = 0; r < 16; ++r) acc[a][b][r] = 0.f;
    const int nk = nk0 + nk1;
    u32x4 wr[4], xr[4];
    auto gload = [&](int it) {
        const bool first = it < nk0;
        const bf16_t* W = first ? s0.W : s1.W; const bf16_t* X = first ? s0.X : s1.X;
        const long wrs = first ? s0.wrs : s1.wrs, xrs = first ? s0.xrs : s1.xrs;
        const long wkhi = first ? s0.wkhi : s1.wkhi, xkhi = first ? s0.xkhi : s1.xkhi;
        const int kt = first ? it : it - nk0;
        const long kc = kt * 4 + (c8 >> 1);
        const bf16_t* wp = W + (long)r0 * wrs + kc * wkhi + (c8 & 1) * 8;
        const bf16_t* xp = X + (long)r0 * xrs + kc * xkhi + (c8 & 1) * 8;
#pragma unroll
        for (int i = 0; i < 4; ++i) { wr[i] = *(const u32x4*)(wp + (long)(64 * i) * wrs); xr[i] = *(const u32x4*)(xp + (long)(64 * i) * xrs); }
    };
    auto lstore = [&](int buf) {
        char* wt = lds + buf * 65536 + wofs; char* xt = wt + 32768;
#pragma unroll
        for (int i = 0; i < 4; ++i) { *(u32x4*)(wt + i * 8192) = wr[i]; *(u32x4*)(xt + i * 8192) = xr[i]; }
    };
    const int lr = lane & 31, h = lane >> 5, sw = (lane >> 1) & 7;
    gload(0); lstore(0); __syncthreads();
    for (int it = 0; it < nk; ++it) {
        if (it + 1 < nk) gload(it + 1);
        const char* wt = lds + (it & 1) * 65536 + (wn * 128 + lr) * 128;
        const char* xt = lds + (it & 1) * 65536 + 32768 + (wm * 64 + lr) * 128;
#pragma unroll
        for (int ks = 0; ks < 4; ++ks) {
            const int ch = ((2 * ks + h) ^ sw) << 4;
            bf16x8 a[4], b[2];
#pragma unroll
            for (int nb = 0; nb < 4; ++nb) a[nb] = *(const bf16x8*)(wt + nb * 4096 + ch);
#pragma unroll
            for (int mb = 0; mb < 2; ++mb) b[mb] = *(const bf16x8*)(xt + mb * 4096 + ch);
#pragma unroll
            for (int nb = 0; nb < 4; ++nb)
#pragma unroll
                for (int mb = 0; mb < 2; ++mb) acc[nb][mb] = __builtin_amdgcn_mfma_f32_32x32x16_bf16(a[nb], b[mb], acc[nb][mb], 0, 0, 0);
        }
        if (it + 1 < nk) lstore((it + 1) & 1);
        __syncthreads();
    }
    TileCtx c; c.wn = wn; c.wm = wm; c.lane = lane;
    epi(acc, c);
}

__device__ __forceinline__ float rstd_from(const float* ssq, int npart, int token) {
    float s = 0.f;
    for (int i = 0; i < npart; ++i) s += ssq[(size_t)i * L_SEQ + token];
    return rsqrtf(s * (1.0f / DM) + EPSV);
}

struct EpiSloc {
    float* dst;
    __device__ __forceinline__ void operator()(f32x16 (&acc)[4][2], const TileCtx& c) const {
        if (c.wn != 0) return;
        const int lr = c.lane & 31, h = c.lane >> 5;
#pragma unroll
        for (int mb = 0; mb < 2; ++mb) { const int m = c.wm * 64 + mb * 32 + lr;
#pragma unroll
            for (int nb = 0; nb < 4; ++nb)
#pragma unroll
                for (int rq = 0; rq < 4; ++rq) { const int n = nb * 32 + rq * 8 + 4 * h;
                    f32x4 v = {acc[nb][mb][4 * rq], acc[nb][mb][4 * rq + 1], acc[nb][mb][4 * rq + 2], acc[nb][mb][4 * rq + 3]};
                    *(f32x4*)(dst + (size_t)m * 128 + n) = v; } }
    }
};

struct EpiS5 {
    const bf16_t* hn0; const float* dskip; bf16_t* z; int g; int n0;
    __device__ __forceinline__ void operator()(f32x16 (&acc)[4][2], const TileCtx& c) const {
        const int lr = c.lane & 31, h = c.lane >> 5;
#pragma unroll
        for (int mb = 0; mb < 2; ++mb) { const int j = c.wm * 64 + mb * 32 + lr;
#pragma unroll
            for (int nb = 0; nb < 4; ++nb)
#pragma unroll
                for (int rq = 0; rq < 4; ++rq) { const int n = n0 + c.wn * 128 + nb * 32 + rq * 8 + 4 * h; const int t = n >> 4, cc = n & 15;
                    const size_t off = (size_t)(j * 64 + t) * DM + g * 16 + cc;
                    const u32x2 uu = *(const u32x2*)(hn0 + off); const f32x4 d4 = *(const f32x4*)(dskip + g * 16 + cc);
                    const float y0 = acc[nb][mb][4 * rq] + d4[0] * bf_lo(uu[0]), y1 = acc[nb][mb][4 * rq + 1] + d4[1] * bf_hi(uu[0]);
                    const float y2 = acc[nb][mb][4 * rq + 2] + d4[2] * bf_lo(uu[1]), y3 = acc[nb][mb][4 * rq + 3] + d4[3] * bf_hi(uu[1]);
                    u32x2 o; o[0] = pk_bf16(gelu_tanh(y0), gelu_tanh(y1)); o[1] = pk_bf16(gelu_tanh(y2), gelu_tanh(y3));
                    *(u32x2*)(z + off) = o; } }
    }
};

struct EpiGlu {
    const float* x; float* out; bf16_t* hb; float* ssq; int n0, m0;
    __device__ __forceinline__ void operator()(f32x16 (&acc)[4][2], const TileCtx& c) const {
        const int lr = c.lane & 31, h = c.lane >> 5;
#pragma unroll
        for (int mb = 0; mb < 2; ++mb) { const int m = m0 + c.wm * 64 + mb * 32 + lr; float s = 0.f;
#pragma unroll
            for (int nb = 0; nb < 4; ++nb)
#pragma unroll
                for (int rg = 0; rg < 2; ++rg) { const int f = ((n0 + c.wn * 128 + nb * 32) >> 1) + rg * 8 + 4 * h;
                    const size_t off = (size_t)m * DM + f; const f32x4 xv = *(const f32x4*)(x + off); f32x4 o;
#pragma unroll
                    for (int e = 0; e < 4; ++e) { o[e] = xv[e] + acc[nb][mb][rg * 8 + e] * sigmoidf_(acc[nb][mb][rg * 8 + 4 + e]); s += o[e] * o[e]; }
                    *(f32x4*)(out + off) = o; u32x2 b; b[0] = pk_bf16(o[0], o[1]); b[1] = pk_bf16(o[2], o[3]); *(u32x2*)(hb + off) = b; }
            s += __shfl_xor(s, 32);
            if (h == 0) ssq[(size_t)((n0 >> 8) * 2 + c.wn) * L_SEQ + m] = s; }
    }
};

struct EpiUp {
    const float* ssq; int npart; bf16_t* act; int n0, m0;
    __device__ __forceinline__ void operator()(f32x16 (&acc)[4][2], const TileCtx& c) const {
        const int lr = c.lane & 31, h = c.lane >> 5;
#pragma unroll
        for (int mb = 0; mb < 2; ++mb) { const int m = m0 + c.wm * 64 + mb * 32 + lr; const float rs = rstd_from(ssq, npart, m);
#pragma unroll
            for (int nb = 0; nb < 4; ++nb)
#pragma unroll
                for (int rg = 0; rg < 2; ++rg) { const int f = ((n0 + c.wn * 128 + nb * 32) >> 1) + rg * 8 + 4 * h; float o[4];
#pragma unroll
                    for (int e = 0; e < 4; ++e) { const float a = acc[nb][mb][rg * 8 + e] * rs, b = acc[nb][mb][rg * 8 + 4 + e] * rs; o[e] = a * sigmoidf_(a) * b; }
                    u32x2 bb; bb[0] = pk_bf16(o[0], o[1]); bb[1] = pk_bf16(o[2], o[3]); *(u32x2*)(act + (size_t)m * FFN + f) = bb; } }
    }
};

struct EpiRes {
    float* out; bf16_t* hb; float* ssq; int n0, m0;
    __device__ __forceinline__ void operator()(f32x16 (&acc)[4][2], const TileCtx& c) const {
        const int lr = c.lane & 31, h = c.lane >> 5;
#pragma unroll
        for (int mb = 0; mb < 2; ++mb) { const int m = m0 + c.wm * 64 + mb * 32 + lr; float s = 0.f;
#pragma unroll
            for (int nb = 0; nb < 4; ++nb)
#pragma unroll
                for (int rq = 0; rq < 4; ++rq) { const int f = n0 + c.wn * 128 + nb * 32 + rq * 8 + 4 * h;
                    const size_t off = (size_t)m * DM + f; f32x4 o = *(const f32x4*)(out + off);
#pragma unroll
                    for (int e = 0; e < 4; ++e) { o[e] += acc[nb][mb][4 * rq + e]; s += o[e] * o[e]; }
                    *(f32x4*)(out + off) = o;
                    if (hb) { u32x2 b; b[0] = pk_bf16(o[0], o[1]); b[1] = pk_bf16(o[2], o[3]); *(u32x2*)(hb + off) = b; } }
            s += __shfl_xor(s, 32);
            if (h == 0) ssq[(size_t)((n0 >> 8) * 2 + c.wn) * L_SEQ + m] = s; }
    }
};

struct EpiKvq {
    const float* ssq; int npart; char* ws; int n0, m0;
    __device__ __forceinline__ void operator()(f32x16 (&acc)[4][2], const TileCtx& c) const {
        const int lr = c.lane & 31, h = c.lane >> 5;
        const bool isV = (n0 >= 1024 && n0 < 2048);
#pragma unroll
        for (int mb = 0; mb < 2; ++mb) { const int m = m0 + c.wm * 64 + mb * 32 + lr; const float rs = rstd_from(ssq, npart, m);
            if (isV) {
                const int mp = (m & ~12) | ((m & 4) << 1) | ((m & 8) >> 1);
                bf16_t* vt = (bf16_t*)(ws + OFF_VT);
#pragma unroll
                for (int nb = 0; nb < 4; ++nb)
#pragma unroll
                    for (int r = 0; r < 16; ++r) { const int nl = n0 - 1024 + c.wn * 128 + nb * 32 + (r & 3) + 8 * (r >> 2) + 4 * h;
                        vt[(size_t)nl * L_SEQ + mp] = (bf16_t)(pk_bf16(acc[nb][mb][r] * rs, 0.f) & 0xffffu); }
            } else {
                size_t base; int nl;
                if (n0 < 512) { base = OFF_K1; nl = n0; } else if (n0 < 1024) { base = OFF_K2; nl = n0 - 512; } else if (n0 < 2560) { base = OFF_Q1; nl = n0 - 2048; } else { base = OFF_Q2; nl = n0 - 2560; }
                bf16_t* dst = (bf16_t*)(ws + base);
                float cs[4], sn[4];
#pragma unroll
                for (int e = 0; e < 4; ++e) { const int i = 4 * h + e;
                    const float invf = (i == 0) ? 1.0f : (i == 1) ? 0.19391188f : (i == 2) ? 0.037601817f : (i == 3) ? 0.0072914392f : (i == 4) ? 0.0014142136f : (i == 5) ? 0.00027423282f : (i == 6) ? 5.3176997e-05f : 1.0311653e-05f;
                    const float ang = (float)m * invf; double rev = (double)ang * 0.15915494309189535; rev -= rint(rev); const float fr = (float)rev;
                    cs[e] = __builtin_amdgcn_cosf(fr); sn[e] = __builtin_amdgcn_sinf(fr); }
#pragma unroll
                for (int nb = 0; nb < 4; ++nb) {
                    const int nn = nl + c.wn * 128 + nb * 32; const int head = nn >> 6, d0 = nn & 63;
                    float v[16];
#pragma unroll
                    for (int r = 0; r < 16; ++r) v[r] = acc[nb][mb][r] * rs;
                    if (d0 == 0) {
#pragma unroll
                        for (int e = 0; e < 4; ++e) { const float x1 = v[e], x2 = v[4 + e]; v[e] = x1 * cs[e] - x2 * sn[e]; v[4 + e] = x2 * cs[e] + x1 * sn[e]; }
                    }
#pragma unroll
                    for (int rq = 0; rq < 4; ++rq) { u32x2 b; b[0] = pk_bf16(v[4 * rq], v[4 * rq + 1]); b[1] = pk_bf16(v[4 * rq + 2], v[4 * rq + 3]);
                        *(u32x2*)(dst + ((size_t)head * L_SEQ + m) * 64 + d0 + rq * 8 + 4 * h) = b; }
                }
            } }
    }
};

__device__ __forceinline__ void s5_tables(const int wave_s, const Params& p, int g, char* lds) {
    f32x2* apow = (f32x2*)lds;
    f32x2* bb = apow + 65 * 64;
    f32x2* cc = bb + 1024;
    f32x2* zf = cc + 1024;
    int tid = get_tid(wave_s); asm volatile("" : "+v"(tid));
    const float dt = expf(p.log_dt[g]);
    for (int e = tid; e < 65 * 64; e += NTHREADS) {
        const int lag = e >> 6, pp = e & 63;
        const float lr = p.lam_re[g * 64 + pp], li = p.lam_im[g * 64 + pp];
        const float mag = expf(lr * dt * (float)lag);
        double rev = (double)li * (double)dt * (double)lag * 0.15915494309189535; rev -= rint(rev);
        const float fr = (float)rev;
        f32x2 v; v[0] = mag * __builtin_amdgcn_cosf(fr); v[1] = mag * __builtin_amdgcn_sinf(fr); apow[e] = v;
    }
    if (tid < 64) {
        const float lr = p.lam_re[g * 64 + tid], li = p.lam_im[g * 64 + tid];
        const float em1 = expm1f(lr * dt);
        double rev = (double)li * (double)dt * 0.15915494309189535; const double rh = rev * 0.5; rev -= rint(rev);
        const double rh2 = rh - rint(rh);
        const float cth = __builtin_amdgcn_cosf((float)rev), sth = __builtin_amdgcn_sinf((float)rev), shalf = __builtin_amdgcn_sinf((float)rh2);
        const float nr = em1 * cth - 2.0f * shalf * shalf, ni = (1.0f + em1) * sth;
        const float den = lr * lr + li * li;
        f32x2 f; f[0] = (nr * lr + ni * li) / den; f[1] = (ni * lr - nr * li) / den; zf[tid] = f;
    }
    __syncthreads();
    for (int e = tid; e < 1024; e += NTHREADS) {
        const int pp = e >> 4;
        const float br = p.b_re[(size_t)g * 1024 + e], bi = p.b_im[(size_t)g * 1024 + e];
        const f32x2 f = zf[pp]; f32x2 v; v[0] = f[0] * br - f[1] * bi; v[1] = f[0] * bi + f[1] * br; bb[e] = v;
        f32x2 cv; cv[0] = p.c_re[(size_t)g * 1024 + e]; cv[1] = p.c_im[(size_t)g * 1024 + e]; cc[e] = cv;
    }
    __syncthreads();
    bf16_t* kt = (bf16_t*)(p.ws + OFF_KT) + (size_t)g * 127 * 256;
    bf16_t* w1 = (bf16_t*)(p.ws + OFF_W1) + (size_t)g * 128 * 1024;
    bf16_t* w3 = (bf16_t*)(p.ws + OFF_W3) + (size_t)g * 1024 * 128;
    {
        const int cp = tid & 255, c = cp >> 4, c2 = cp & 15, half = tid >> 8;
        float acc[32];
#pragma unroll
        for (int l = 0; l < 32; ++l) acc[l] = 0.f;
        for (int pp = 0; pp < 64; ++pp) {
            const f32x2 cv = cc[c * 64 + pp], bv = bb[pp * 16 + c2];
            const float cbr = cv[0] * bv[0] - cv[1] * bv[1], cbi = cv[0] * bv[1] + cv[1] * bv[0];
#pragma unroll
            for (int l = 0; l < 32; ++l) { const f32x2 a = apow[(half * 32 + l) * 64 + pp]; acc[l] += cbr * a[0] - cbi * a[1]; }
        }
#pragma unroll
        for (int l = 0; l < 32; ++l) kt[(size_t)(63 + half * 32 + l) * 256 + cp] = (bf16_t)(pk_bf16(acc[l], 0.f) & 0xffffu);
        for (int e = tid; e < 63 * 256 / 8; e += NTHREADS) { u32x4 zz = {0u, 0u, 0u, 0u}; *(u32x4*)(kt + e * 8) = zz; }
    }
    for (int q = tid; q < 128 * 128; q += NTHREADS) {
        const int pq = q >> 7, kc = q & 127, tau = kc >> 1, c0 = (kc & 1) * 8, pp = pq & 63, im = pq >> 6;
        const f32x2 a = apow[(63 - tau) * 64 + pp]; float v[8];
#pragma unroll
        for (int e = 0; e < 8; ++e) { const f32x2 b = bb[pp * 16 + c0 + e]; v[e] = im ? (a[0] * b[1] + a[1] * b[0]) : (a[0] * b[0] - a[1] * b[1]); }
        u32x4 o; o[0] = pk_bf16(v[0], v[1]); o[1] = pk_bf16(v[2], v[3]); o[2] = pk_bf16(v[4], v[5]); o[3] = pk_bf16(v[6], v[7]);
        *(u32x4*)(w1 + (size_t)pq * 1024 + kc * 8) = o;
    }
    for (int q = tid; q < 1024 * 16; q += NTHREADS) {
        const int n = q >> 4, p0 = (q & 15) * 8, t = n >> 4, c = n & 15, im = p0 >> 6; float v[8];
#pragma unroll
        for (int e = 0; e < 8; ++e) { const int pp = (p0 + e) & 63; const f32x2 a = apow[(t + 1) * 64 + pp]; const f32x2 cv = cc[c * 64 + pp];
            v[e] = im ? -(cv[0] * a[1] + cv[1] * a[0]) : (cv[0] * a[0] - cv[1] * a[1]); }
        u32x4 o; o[0] = pk_bf16(v[0], v[1]); o[1] = pk_bf16(v[2], v[3]); o[2] = pk_bf16(v[4], v[5]); o[3] = pk_bf16(v[6], v[7]);
        *(u32x4*)(w3 + (size_t)n * 128 + p0) = o;
    }
    if (tid < 64) ((f32x2*)(p.ws + OFF_A64))[g * 64 + tid] = apow[64 * 64 + tid];
    __syncthreads();
}

__device__ __forceinline__ void wtile(const int wave_s, const Params& p, int t, char* lds) {
    int j = 0;
    for (int i = 1; i < p.njobs; ++i) if (t >= p.jobs[i].tile0) j = i;
    const WJob& J = p.jobs[j];
    const int lt = t - J.tile0, kt = lt / J.ntn, nt = lt - kt * J.ntn;
    const int k0 = kt * 64, nl0 = nt * 64;
    float* T = (float*)lds;
    int tid = get_tid(wave_s); asm volatile("" : "+v"(tid));
#pragma unroll
    for (int i = 0; i < 2; ++i) { const int kk = i * 32 + (tid >> 4), n4 = (tid & 15) * 4;
        f32x4 v = *(const f32x4*)(J.src + (size_t)(k0 + kk) * J.ldsrc + J.col0 + nl0 + n4);
        float sc = J.scale; if (J.gain) sc *= J.gain[k0 + kk];
        T[kk * 65 + n4] = v[0] * sc; T[kk * 65 + n4 + 1] = v[1] * sc; T[kk * 65 + n4 + 2] = v[2] * sc; T[kk * 65 + n4 + 3] = v[3] * sc; }
    __syncthreads();
    { const int nn = tid >> 3, kc = (tid & 7) * 8; float v[8];
#pragma unroll
        for (int e = 0; e < 8; ++e) v[e] = T[(kc + e) * 65 + nn];
        const int n = nl0 + nn; int row = (J.mode == 0) ? n : ((n >> 3) * 16 + (n & 7) + (J.mode == 2 ? 8 : 0)); row += J.rowoff;
        u32x4 o; o[0] = pk_bf16(v[0], v[1]); o[1] = pk_bf16(v[2], v[3]); o[2] = pk_bf16(v[4], v[5]); o[3] = pk_bf16(v[6], v[7]);
        *(u32x4*)(J.dst + (size_t)row * J.K + k0 + kc) = o; }
    __syncthreads();
}

__device__ __forceinline__ void rms0_item(const int wave_s, const Params& p, int item) {
    const int lane = get_tid(wave_s) & 63, wid = wave_s;
    bf16_t* hn0 = (bf16_t*)(p.ws + OFF_HN0);
    for (int r = 0; r < 8; ++r) {
        const int row = item * 64 + wid * 8 + r;
        f32x4 v[4]; float s = 0.f;
#pragma unroll
        for (int i = 0; i < 4; ++i) { v[i] = *(const f32x4*)(p.x + (size_t)row * DM + lane * 4 + 256 * i); s += v[i][0] * v[i][0] + v[i][1] * v[i][1] + v[i][2] * v[i][2] + v[i][3] * v[i][3]; }
#pragma unroll
        for (int o = 32; o >= 1; o >>= 1) s += __shfl_xor(s, o);
        const float rs = rsqrtf(s * (1.0f / DM) + EPSV);
#pragma unroll
        for (int i = 0; i < 4; ++i) { const f32x4 g = *(const f32x4*)(p.norm_mix_g + lane * 4 + 256 * i);
            u32x2 o; o[0] = pk_bf16(v[i][0] * rs * g[0], v[i][1] * rs * g[1]); o[1] = pk_bf16(v[i][2] * rs * g[2], v[i][3] * rs * g[3]);
            *(u32x2*)(hn0 + (size_t)row * DM + lane * 4 + 256 * i) = o; }
    }
}

__device__ __forceinline__ void attn_item(const int wave_s, const Params& p, int head, int qb, float lam, char* lds) {
    int tid = get_tid(wave_s); asm volatile("" : "+v"(tid));
    const int lane = tid & 63, wid = tid >> 6;
    const int mp = wid >> 2, g = wid & 3;
    const int lr = lane & 31, h = lane >> 5, sw = (lane >> 1) & 7;
    const bf16_t* K1 = (const bf16_t*)(p.ws + OFF_K1) + (size_t)head * L_SEQ * 64;
    const bf16_t* K2 = (const bf16_t*)(p.ws + OFF_K2) + (size_t)head * L_SEQ * 64;
    const bf16_t* VT = (const bf16_t*)(p.ws + OFF_VT) + (size_t)head * 128 * L_SEQ;
    const bf16_t* Q = (const bf16_t*)(p.ws + (mp ? OFF_Q2 : OFF_Q1)) + (size_t)head * L_SEQ * 64;
    const int q0 = qb * 128 + g * 32;
    bf16x8 qf[4];
#pragma unroll
    for (int s = 0; s < 4; ++s) qf[s] = *(const bf16x8*)(Q + (size_t)(q0 + lr) * 64 + 16 * s + 8 * h);
    const int nkt = 2 * qb + 2;
    const int my_last = 2 * qb + (g >> 1);
    f32x16 O[4];
#pragma unroll
    for (int e = 0; e < 4; ++e)
#pragma unroll
        for (int r = 0; r < 16; ++r) O[e][r] = 0.f;
    float m_run = -1e30f, l_run = 0.f;
    const int r0 = tid >> 3, c8 = tid & 7;
    const int kofs = r0 * 128 + ((c8 ^ ((r0 >> 1) & 7)) << 4);
    u32x4 sk1, sk2, sv0, sv1;
    auto gload = [&](int kt) {
        sk1 = *(const u32x4*)(K1 + (size_t)(kt * 64 + r0) * 64 + c8 * 8);
        sk2 = *(const u32x4*)(K2 + (size_t)(kt * 64 + r0) * 64 + c8 * 8);
        sv0 = *(const u32x4*)(VT + (size_t)r0 * L_SEQ + kt * 64 + c8 * 8);
        sv1 = *(const u32x4*)(VT + (size_t)(r0 + 64) * L_SEQ + kt * 64 + c8 * 8);
    };
    auto lstore = [&](int buf) {
        char* b = lds + buf * 32768 + kofs;
        *(u32x4*)(b) = sk1; *(u32x4*)(b + 8192) = sk2; *(u32x4*)(b + 16384) = sv0; *(u32x4*)(b + 16384 + 8192) = sv1;
    };
    gload(0); lstore(0); __syncthreads();
    for (int kt = 0; kt < nkt; ++kt) {
        if (kt + 1 < nkt) gload(kt + 1);
        if (kt <= my_last) {
            const char* kb_ = lds + (kt & 1) * 32768 + mp * 8192 + lr * 128;
            const char* vb_ = lds + (kt & 1) * 32768 + 16384 + lr * 128;
            f32x16 S[2];
#pragma unroll
            for (int kb = 0; kb < 2; ++kb) {
#pragma unroll
                for (int r = 0; r < 16; ++r) S[kb][r] = 0.f;
#pragma unroll
                for (int s = 0; s < 4; ++s) { const bf16x8 kf = *(const bf16x8*)(kb_ + kb * 4096 + (((2 * s + h) ^ sw) << 4));
                    S[kb] = __builtin_amdgcn_mfma_f32_32x32x16_bf16(kf, qf[s], S[kb], 0, 0, 0); }
            }
            float mt = S[0][0];
#pragma unroll
            for (int r = 1; r < 16; ++r) mt = fmaxf(mt, S[0][r]);
#pragma unroll
            for (int r = 0; r < 16; ++r) mt = fmaxf(mt, S[1][r]);
            mt = fmaxf(mt, __shfl_xor(mt, 32));
            const bool need = mt > m_run + 8.0f;
            if (__any(need)) {
                const float mnew = need ? mt : m_run;
                const float alpha = fast_exp2(m_run - mnew);
                m_run = mnew; l_run *= alpha;
#pragma unroll
                for (int e = 0; e < 4; ++e)
#pragma unroll
                    for (int r = 0; r < 16; ++r) O[e][r] *= alpha;
            }
            float ls = 0.f;
            bf16x8 pf[2][2];
#pragma unroll
            for (int kb = 0; kb < 2; ++kb)
#pragma unroll
                for (int s = 0; s < 2; ++s) { float e_[8];
#pragma unroll
                    for (int j = 0; j < 8; ++j) { e_[j] = fast_exp2(S[kb][8 * s + j] - m_run); ls += e_[j]; }
                    u32x4 pk; pk[0] = pk_bf16(e_[0], e_[1]); pk[1] = pk_bf16(e_[2], e_[3]); pk[2] = pk_bf16(e_[4], e_[5]); pk[3] = pk_bf16(e_[6], e_[7]);
                    pf[kb][s] = __builtin_bit_cast(bf16x8, pk); }
            l_run += ls;
#pragma unroll
            for (int kb = 0; kb < 2; ++kb)
#pragma unroll
                for (int s = 0; s < 2; ++s)
#pragma unroll
                    for (int e = 0; e < 4; ++e) { const bf16x8 vf = *(const bf16x8*)(vb_ + e * 4096 + (((4 * kb + 2 * s + h) ^ sw) << 4));
                        O[e] = __builtin_amdgcn_mfma_f32_32x32x16_bf16(vf, pf[kb][s], O[e], 0, 0, 0); }
        }
        if (kt + 1 < nkt) lstore((kt + 1) & 1);
        __syncthreads();
    }
    const float lt = l_run + __shfl_xor(l_run, 32);
    const float inv = fast_rcp(lt) * (mp ? lam : 1.0f);
    float* ex = (float*)lds;
    if (mp == 1) {
#pragma unroll
        for (int e = 0; e < 4; ++e)
#pragma unroll
            for (int r = 0; r < 16; ++r) ex[((g * 4 + e) * 16 + r) * 64 + lane] = O[e][r] * inv;
    }
    __syncthreads();
    if (mp == 0) {
        float ss = 0.f;
#pragma unroll
        for (int e = 0; e < 4; ++e)
#pragma unroll
            for (int r = 0; r < 16; ++r) { const float o = O[e][r] * inv - ex[((g * 4 + e) * 16 + r) * 64 + lane]; O[e][r] = o; ss += o * o; }
        ss += __shfl_xor(ss, 32);
        const float rs = rsqrtf(ss * (1.0f / 128.0f) + EPSV) * (1.0f - LAM_INIT);
        bf16_t* on = (bf16_t*)(p.ws + OFF_ON) + (size_t)(q0 + lr) * DM + head * 128;
#pragma unroll
        for (int e = 0; e < 4; ++e)
#pragma unroll
            for (int rq = 0; rq < 4; ++rq) { const int ee = e * 32 + rq * 8 + 4 * h; const f32x4 gg = *(const f32x4*)(p.subln_g + ee);
                u32x2 b; b[0] = pk_bf16(O[e][4 * rq] * rs * gg[0], O[e][4 * rq + 1] * rs * gg[1]); b[1] = pk_bf16(O[e][4 * rq + 2] * rs * gg[2], O[e][4 * rq + 3] * rs * gg[3]);
                *(u32x2*)(on + ee) = b; }
    }
    __syncthreads();
}


__device__ __forceinline__ void gbar(const int wave_s, unsigned* ctr, unsigned target) {
    __syncthreads();
    if (get_tid(wave_s) == 0) {
        __builtin_amdgcn_fence(__ATOMIC_RELEASE, "agent");
        asm volatile("s_waitcnt vmcnt(0)" ::: "memory");
        __hip_atomic_fetch_add(ctr, 1u, __ATOMIC_RELAXED, __HIP_MEMORY_SCOPE_AGENT);
        while (__hip_atomic_load(ctr, __ATOMIC_RELAXED, __HIP_MEMORY_SCOPE_AGENT) < target) __builtin_amdgcn_s_sleep(2);
        __builtin_amdgcn_fence(__ATOMIC_ACQUIRE, "agent");
        asm volatile("s_waitcnt vmcnt(0)" ::: "memory");
    }
    __syncthreads();
}

__global__ void __launch_bounds__(NTHREADS) mega(const Params p) {
    __shared__ __attribute__((aligned(16))) char lds[LDS_BYTES];
    cg::grid_group grid = cg::this_grid();
    const int wave_s = __builtin_amdgcn_readfirstlane((int)(threadIdx.x >> 6));
    const int nb = gridDim.x, bid = blockIdx.x;
    char* ws = p.ws;
    bf16_t* hn0 = (bf16_t*)(ws + OFF_HN0);
    bf16_t* hb = (bf16_t*)(ws + OFF_HB);
    float* ssq0 = (float*)(ws + OFF_SSQ);
    float* ssq1 = ssq0 + 16 * L_SEQ; float* ssq2 = ssq1 + 16 * L_SEQ; float* ssq3 = ssq2 + 16 * L_SEQ;
    const Seg nul = {nullptr, 0, 0, nullptr, 0, 0};
    unsigned* bar = (unsigned*)(ws + OFF_BAR); unsigned nbar = 0;

    { const int nitems = 64 + p.ntiles_w + 256;
      for (int it = bid; it < nitems; it += nb) {
          if (it < 64) s5_tables(wave_s, p, it, lds);
          else if (it < 64 + p.ntiles_w) wtile(wave_s, p, it - 64, lds);
          else rms0_item(wave_s, p, it - 64 - p.ntiles_w);
      } }
    grid.sync();
    for (int g = bid; g < 64; g += nb) {
        Seg s = {(const bf16_t*)(ws + OFF_W1) + (size_t)g * 128 * 1024, 1024, 16, hn0 + g * 16, 65536, 1024};
        EpiSloc e = {(float*)(ws + OFF_SLOC) + (size_t)g * 256 * 128};
        gemm_tile(wave_s, lds, s, 16, nul, 0, e);
    }
    gbar(wave_s, bar, (unsigned)nb * (++nbar));
    for (int t = bid; t < 256; t += nb) {
        const int g = t >> 2, i = 3 - (t & 3);
        bf16_t* sprev = (bf16_t*)(ws + OFF_SPREV) + (size_t)t * 256 * 128;
        {
            const int lane_ = get_tid(wave_s) & 63, w_ = wave_s;
            const f32x2 a = ((const f32x2*)(ws + OFF_A64))[g * 64 + lane_];
            const float* sl = (const float*)(ws + OFF_SLOC) + (size_t)g * 256 * 128 + (size_t)(w_ * 32) * 128;
            float xr[32], xi[32];
#pragma unroll
            for (int j = 0; j < 32; ++j) { xr[j] = sl[j * 128 + lane_]; xi[j] = sl[j * 128 + 64 + lane_]; }
            float sr = 0.f, si = 0.f;
#pragma unroll
            for (int j = 0; j < 32; ++j) { const float nr = a[0] * sr - a[1] * si + xr[j], ni = a[0] * si + a[1] * sr + xi[j]; sr = nr; si = ni; }
            f32x2* carry = (f32x2*)lds;
            { f32x2 c; c[0] = sr; c[1] = si; carry[w_ * 64 + lane_] = c; }
            float pr = a[0], pi = a[1];
#pragma unroll
            for (int q = 0; q < 5; ++q) { const float nr = pr * pr - pi * pi, ni = 2.f * pr * pi; pr = nr; pi = ni; }
            __syncthreads();
#pragma unroll
            for (int j = 0; j < 32; ++j) { xr[j] = __builtin_nontemporal_load(sl + j * 128 + lane_); xi[j] = __builtin_nontemporal_load(sl + j * 128 + 64 + lane_); }
            sr = 0.f; si = 0.f;
            for (int v = 0; v < w_; ++v) { const f32x2 c = carry[v * 64 + lane_]; const float nr = pr * sr - pi * si + c[0], ni = pr * si + pi * sr + c[1]; sr = nr; si = ni; }
            bf16_t* sp = sprev + (size_t)(w_ * 32) * 128;
#pragma unroll
            for (int j = 0; j < 32; ++j) {
                sp[j * 128 + lane_] = (bf16_t)(pk_bf16(sr, 0.f) & 0xffffu); sp[j * 128 + 64 + lane_] = (bf16_t)(pk_bf16(si, 0.f) & 0xffffu);
                const float nr = a[0] * sr - a[1] * si + xr[j], ni = a[0] * si + a[1] * sr + xi[j]; sr = nr; si = ni;
            }
            __threadfence();
        }
        __syncthreads();
        Seg s0 = {(const bf16_t*)(ws + OFF_KT) + (size_t)g * 127 * 256 + 63 * 256 + (size_t)(i * 256) * 16, 16, -256, hn0 + g * 16, 65536, 1024};
        Seg s1 = {(const bf16_t*)(ws + OFF_W3) + (size_t)g * 1024 * 128 + (size_t)(i * 256) * 128, 128, 16, sprev, 128, 16};
        EpiS5 e = {hn0, p.ssm_d, (bf16_t*)(ws + OFF_Z), g, i * 256};
        gemm_tile(wave_s, lds, s0, 4 * (i + 1), s1, 2, e);
    }
    gbar(wave_s, bar, (unsigned)nb * (++nbar));
    for (int t = bid; t < 8 * 64; t += nb) {
        const int nt = t & 7, mt = t >> 3;
        Seg s = {(const bf16_t*)(ws + OFF_WGLU) + (size_t)nt * 256 * DM, DM, 16, (const bf16_t*)(ws + OFF_Z) + (size_t)mt * 256 * DM, DM, 16};
        EpiGlu e = {p.x, p.out, hb, ssq0, nt * 256, mt * 256};
        gemm_tile(wave_s, lds, s, 16, nul, 0, e);
    }
    gbar(wave_s, bar, (unsigned)nb * (++nbar));
#pragma unroll
    for (int layer = 0; layer < 2; ++layer) {
        if (layer == 1) {
            for (int t = bid; t < 12 * 64; t += nb) {
                const int nt = t % 12, mt = t / 12;
                Seg s = {(const bf16_t*)(ws + OFF_WKVQ) + (size_t)nt * 256 * DM, DM, 16, hb + (size_t)mt * 256 * DM, DM, 16};
                EpiKvq e = {ssq1, 8, ws, nt * 256, mt * 256};
                gemm_tile(wave_s, lds, s, 16, nul, 0, e);
            }
            gbar(wave_s, bar, (unsigned)nb * (++nbar));
            {
                float a1 = 0.f, a2 = 0.f;
                for (int i = 0; i < 64; ++i) { a1 += p.lq1[i] * p.lk1[i]; a2 += p.lq2[i] * p.lk2[i]; }
                const float lam = expf(a1) - expf(a2) + LAM_INIT;
                for (int rep = 0; rep < REP_ATTN; ++rep)
                for (int it = bid; it < 1024; it += nb) {
                    const int head = it & 7, r = it >> 3, rnd = r >> 5, j = r & 31;
                    const int qb = (rnd == 0) ? 127 - j : (rnd == 1) ? 64 + j : (rnd == 2) ? 63 - j : j;
                    attn_item(wave_s, p, head, qb, lam, lds);
                }
            }
            gbar(wave_s, bar, (unsigned)nb * (++nbar));
            for (int t = bid; t < 4 * 64; t += nb) {
                const int nt = t & 3, mt = t >> 2;
                Seg s = {(const bf16_t*)(ws + OFF_WO) + (size_t)nt * 256 * DM, DM, 16, (const bf16_t*)(ws + OFF_ON) + (size_t)mt * 256 * DM, DM, 16};
                EpiRes e = {p.out, hb, ssq2, nt * 256, mt * 256};
                gemm_tile(wave_s, lds, s, 16, nul, 0, e);
            }
            gbar(wave_s, bar, (unsigned)nb * (++nbar));
        }
        {
            const bf16_t* wup = (const bf16_t*)(ws + (layer ? OFF_WUP1 : OFF_WUP0));
            const float* sq = layer ? ssq2 : ssq0; const int npart = layer ? 8 : 16;
            for (int rep = 0; rep < REP_UP; ++rep)
            for (int t = bid; t < 22 * 64; t += nb) {
                const int nt = t % 22, mt = t / 22;
                Seg s = {wup + (size_t)nt * 256 * DM, DM, 16, hb + (size_t)mt * 256 * DM, DM, 16};
                EpiUp e = {sq, npart, (bf16_t*)(ws + OFF_ACT), nt * 256, mt * 256};
                gemm_tile(wave_s, lds, s, 16, nul, 0, e);
            }
        }
        gbar(wave_s, bar, (unsigned)nb * (++nbar));
        {
            const bf16_t* wdn = (const bf16_t*)(ws + (layer ? OFF_WDN1 : OFF_WDN0));
            for (int t = bid; t < 4 * 64; t += nb) {
                const int nt = t & 3, mt = t >> 2;
                Seg s = {wdn + (size_t)nt * 256 * FFN, FFN, 16, (const bf16_t*)(ws + OFF_ACT) + (size_t)mt * 256 * FFN, FFN, 16};
                EpiRes e = {p.out, layer ? (bf16_t*)nullptr : hb, layer ? ssq3 : ssq1, nt * 256, mt * 256};
                gemm_tile(wave_s, lds, s, FFN / 64, nul, 0, e);
            }
        }
        gbar(wave_s, bar, (unsigned)nb * (++nbar));
    }
    {
        const int lane = get_tid(wave_s) & 63, wid = wave_s;
        for (int row = bid * 8 + wid; row < L_SEQ; row += nb * 8) {
            float s = 0.f;
            for (int i = 0; i < 8; ++i) s += ssq3[(size_t)i * L_SEQ + row];
            const float rs = rsqrtf(s * (1.0f / DM) + EPSV);
#pragma unroll
            for (int i = 0; i < 4; ++i) { const size_t off = (size_t)row * DM + lane * 4 + 256 * i;
                f32x4 v = *(const f32x4*)(p.out + off); const f32x4 g = *(const f32x4*)(p.final_g + lane * 4 + 256 * i);
                v[0] *= rs * g[0]; v[1] *= rs * g[1]; v[2] *= rs * g[2]; v[3] *= rs * g[3]; *(f32x4*)(p.out + off) = v; }
        }
    }
}

static void add_job(Params& P, int& nt, const float* src, bf16_t* dst, const float* gain, int K, int N, int ld, int col0, int mode, int rowoff, float scale) {
    WJob& J = P.jobs[P.njobs++];
    J.src = src; J.dst = dst; J.gain = gain; J.K = K; J.N = N; J.ldsrc = ld; J.col0 = col0; J.mode = mode; J.rowoff = rowoff; J.scale = scale; J.tile0 = nt; J.ntn = N / 64; J.pad = 0;
    nt += (K / 64) * (N / 64);
}

extern "C" void kernel_launch(void* const* d_in, const int* in_sizes, int n_in, void* d_out, int out_size, void* d_ws, size_t ws_size, hipStream_t stream) {
    Params P; memset(&P, 0, sizeof(P));
    P.x = (const float*)d_in[0]; P.norm_mix_g = (const float*)d_in[1]; P.norm_ffn_g = (const float*)d_in[2];
    P.ffn_w1 = (const float*)d_in[3]; P.ffn_w3 = (const float*)d_in[4]; P.ffn_w2 = (const float*)d_in[5];
    P.lam_re = (const float*)d_in[6]; P.lam_im = (const float*)d_in[7]; P.log_dt = (const float*)d_in[8];
    P.b_re = (const float*)d_in[9]; P.b_im = (const float*)d_in[10]; P.c_re = (const float*)d_in[11]; P.c_im = (const float*)d_in[12];
    P.ssm_d = (const float*)d_in[13]; P.w_glu = (const float*)d_in[14]; P.kv_norm_g = (const float*)d_in[15]; P.w_kv = (const float*)d_in[16];
    P.w_q = (const float*)d_in[17]; P.lq1 = (const float*)d_in[18]; P.lk1 = (const float*)d_in[19]; P.lq2 = (const float*)d_in[20]; P.lk2 = (const float*)d_in[21];
    P.subln_g = (const float*)d_in[22]; P.w_o = (const float*)d_in[23]; P.final_g = (const float*)d_in[24];
    P.out = (float*)d_out; P.ws = (char*)d_ws;
    char* ws = (char*)d_ws; int nt = 0;
    const size_t FW = (size_t)DM * FFN;
    add_job(P, nt, P.w_glu, (bf16_t*)(ws + OFF_WGLU), nullptr, DM, 1024, 2048, 0, 1, 0, 1.0f);
    add_job(P, nt, P.w_glu, (bf16_t*)(ws + OFF_WGLU), nullptr, DM, 1024, 2048, 1024, 2, 0, 1.0f);
    add_job(P, nt, P.ffn_w1, (bf16_t*)(ws + OFF_WUP0), P.norm_ffn_g, DM, FFN, FFN, 0, 1, 0, 1.0f);
    add_job(P, nt, P.ffn_w3, (bf16_t*)(ws + OFF_WUP0), P.norm_ffn_g, DM, FFN, FFN, 0, 2, 0, 1.0f);
    add_job(P, nt, P.ffn_w2, (bf16_t*)(ws + OFF_WDN0), nullptr, FFN, DM, DM, 0, 0, 0, 1.0f);
    add_job(P, nt, P.w_kv, (bf16_t*)(ws + OFF_WKVQ), P.kv_norm_g, DM, 2048, 2048, 0, 0, 0, 1.0f);
    add_job(P, nt, P.w_q, (bf16_t*)(ws + OFF_WKVQ), P.norm_mix_g + DM, DM, 1024, 1024, 0, 0, 2048, QSCALE);
    add_job(P, nt, P.w_o, (bf16_t*)(ws + OFF_WO), nullptr, DM, DM, DM, 0, 0, 0, 1.0f);
    add_job(P, nt, P.ffn_w1 + FW, (bf16_t*)(ws + OFF_WUP1), P.norm_ffn_g + DM, DM, FFN, FFN, 0, 1, 0, 1.0f);
    add_job(P, nt, P.ffn_w3 + FW, (bf16_t*)(ws + OFF_WUP1), P.norm_ffn_g + DM, DM, FFN, FFN, 0, 2, 0, 1.0f);
    add_job(P, nt, P.ffn_w2 + FW, (bf16_t*)(ws + OFF_WDN1), nullptr, FFN, DM, DM, 0, 0, 0, 1.0f);
    P.ntiles_w = nt;
    static int grid_blocks = 0;
    if (!grid_blocks) {
        int dev = 0, cus = 0, per_cu = 0;
        hipGetDevice(&dev);
        hipDeviceGetAttribute(&cus, hipDeviceAttributeMultiprocessorCount, dev);
        hipOccupancyMaxActiveBlocksPerMultiprocessor(&per_cu, mega, NTHREADS, 0);
        if (per_cu < 1) per_cu = 1;
        grid_blocks = cus * 1;
    }
    hipMemsetAsync(ws + OFF_BAR, 0, 256, stream);
    void* args[] = {&P};
    hipError_t e = hipLaunchCooperativeKernel((void*)mega, dim3(grid_blocks), dim3(NTHREADS), args, 0, stream);
    if (e != hipSuccess) fprintf(stderr, "cooperative launch failed: %s (grid %d)\n", hipGetErrorString(e), grid_blocks);
}
```

```cpp
#include <hip/hip_runtime.h>
#include <hip/hip_cooperative_groups.h>
#include <stdint.h>
#include <string.h>
#include <stdio.h>
namespace cg = cooperative_groups;

typedef unsigned short bf16_t;
typedef short bf16x8 __attribute__((ext_vector_type(8)));
typedef float f32x16 __attribute__((ext_vector_type(16)));
typedef float f32x4 __attribute__((ext_vector_type(4)));
typedef float f32x2 __attribute__((ext_vector_type(2)));
typedef unsigned u32x4 __attribute__((ext_vector_type(4)));
typedef unsigned u32x2 __attribute__((ext_vector_type(2)));

#define L_SEQ 16384
#define DM 1024
#define FFN 2816
#define NTHREADS 512
#ifndef REP_ATTN
#define REP_ATTN 1
#endif
#ifndef REP_UP
#define REP_UP 1
#endif
#define LDS_BYTES 131072
#define EPSV 1e-6f
#define LAM_INIT 0.35550906759096927f
#define QSCALE 0.18033688011112042f

static constexpr size_t MiB = 1024ull * 1024ull;
static constexpr size_t OFF_WGLU = 0;
static constexpr size_t OFF_WUP0 = 4 * MiB;
static constexpr size_t OFF_WDN0 = 15 * MiB;
static constexpr size_t OFF_WKVQ = 20 * MiB + MiB / 2;
static constexpr size_t OFF_WO = 26 * MiB + MiB / 2;
static constexpr size_t OFF_WUP1 = 28 * MiB + MiB / 2;
static constexpr size_t OFF_WDN1 = 39 * MiB + MiB / 2;
static constexpr size_t OFF_SSQ = 45 * MiB;
static constexpr size_t OFF_A64 = 49 * MiB;
static constexpr size_t OFF_BAR = 49 * MiB + MiB / 2;
static constexpr size_t OFF_A = 50 * MiB;
static constexpr size_t OFF_HN0 = OFF_A;
static constexpr size_t OFF_Z = OFF_A + 32 * MiB;
static constexpr size_t OFF_ACT = OFF_A;
static constexpr size_t OFF_K1 = OFF_A;
static constexpr size_t OFF_K2 = OFF_A + 16 * MiB;
static constexpr size_t OFF_VT = OFF_A + 32 * MiB;
static constexpr size_t OFF_Q1 = OFF_A + 64 * MiB;
static constexpr size_t OFF_Q2 = OFF_A + 80 * MiB;
static constexpr size_t OFF_B = 146 * MiB;
static constexpr size_t OFF_KT = OFF_B;
static constexpr size_t OFF_W1 = OFF_B + 4 * MiB;
static constexpr size_t OFF_W3 = OFF_B + 20 * MiB;
static constexpr size_t OFF_SLOC = OFF_B + 36 * MiB;
static constexpr size_t OFF_SPREV = OFF_B + 44 * MiB;
static constexpr size_t OFF_HB = OFF_B;
static constexpr size_t OFF_ON = OFF_B + 32 * MiB;

struct WJob { const float* src; bf16_t* dst; const float* gain; int K; int N; int ldsrc; int col0; int mode; int rowoff; float scale; int tile0; int ntn; int pad; };

struct Params {
    const float *x, *norm_mix_g, *norm_ffn_g, *ffn_w1, *ffn_w3, *ffn_w2;
    const float *lam_re, *lam_im, *log_dt, *b_re, *b_im, *c_re, *c_im, *ssm_d, *w_glu;
    const float *kv_norm_g, *w_kv, *w_q, *lq1, *lk1, *lq2, *lk2, *subln_g, *w_o, *final_g;
    float* out;
    char* ws;
    WJob jobs[12];
    int njobs; int ntiles_w;
};

__device__ __forceinline__ int get_tid(int wave_s) { int t = wave_s * 64 + (int)__builtin_amdgcn_mbcnt_hi(~0u, __builtin_amdgcn_mbcnt_lo(~0u, 0u)); asm volatile("" : "+v"(t)); return t; }
__device__ __forceinline__ unsigned pk_bf16(float lo, float hi) { unsigned r; asm("v_cvt_pk_bf16_f32 %0, %1, %2" : "=v"(r) : "v"(lo), "v"(hi)); return r; }
__device__ __forceinline__ float bf_lo(unsigned u) { return __uint_as_float(u << 16); }
__device__ __forceinline__ float bf_hi(unsigned u) { return __uint_as_float(u & 0xffff0000u); }
__device__ __forceinline__ float fast_rcp(float x) { return __builtin_amdgcn_rcpf(x); }
__device__ __forceinline__ float fast_exp2(float x) { return __builtin_amdgcn_exp2f(x); }
__device__ __forceinline__ float sigmoidf_(float x) { return fast_rcp(1.0f + fast_exp2(-1.4426950408889634f * x)); }
__device__ __forceinline__ float gelu_tanh(float x) {
    const float u = 0.7978845608028654f * x * (1.0f + 0.044715f * x * x);
    return x * fast_rcp(1.0f + fast_exp2(-2.8853900817779268f * u));
}

struct Seg { const bf16_t* W; long wrs; long wkhi; const bf16_t* X; long xrs; long xkhi; };

struct TileCtx { int wn, wm, lane; };

template <class Epi>
__device__ __forceinline__ void gemm_tile(const int wave_s, char* lds, const Seg s0, const int nk0_, const Seg s1, const int nk1_, Epi& epi) {
    int tid = get_tid(wave_s);
    const int lane = tid & 63;
    const int wn = wave_s >> 2, wm = wave_s & 3;
    const int lr = lane & 31, h = lane >> 5;
    const int nk0 = nk0_ * 2, nk1 = nk1_ * 2, nk = nk0 + nk1;
    const int cch = (lane & 3) ^ ((lane >> 4) & 3);
    const int row0 = wave_s * 32 + (lane >> 2);
    f32x16 acc[4][2];
#pragma unroll
    for (int a = 0; a < 4; ++a)
#pragma unroll
        for (int b = 0; b < 2; ++b)
#pragma unroll
            for (int r = 0; r < 16; ++r) acc[a][b][r] = 0.f;
    auto issue = [&](int t) {
        const bool first = t < nk0;
        const bf16_t* W = first ? s0.W : s1.W; const bf16_t* X = first ? s0.X : s1.X;
        const long wrs = first ? s0.wrs : s1.wrs, xrs = first ? s0.xrs : s1.xrs;
        const long wkhi = first ? s0.wkhi : s1.wkhi, xkhi = first ? s0.xkhi : s1.xkhi;
        const int kt = first ? t : t - nk0;
        const long kc = kt * 2 + (cch >> 1);
        const bf16_t* wp = W + (long)row0 * wrs + kc * wkhi + (cch & 1) * 8;
        const bf16_t* xp = X + (long)row0 * xrs + kc * xkhi + (cch & 1) * 8;
        char* st = lds + (t & 3) * 32768 + wave_s * 2048;
        __builtin_amdgcn_global_load_lds((const unsigned*)wp, (__attribute__((address_space(3))) unsigned*)(st), 16, 0, 0);
        __builtin_amdgcn_global_load_lds((const unsigned*)(wp + 16 * wrs), (__attribute__((address_space(3))) unsigned*)(st + 1024), 16, 0, 0);
        __builtin_amdgcn_global_load_lds((const unsigned*)xp, (__attribute__((address_space(3))) unsigned*)(st + 16384), 16, 0, 0);
        __builtin_amdgcn_global_load_lds((const unsigned*)(xp + 16 * xrs), (__attribute__((address_space(3))) unsigned*)(st + 16384 + 1024), 16, 0, 0);
    };
    const int sw = (lr >> 2) & 3;
    const int aoff = (wn * 128 + lr) * 64, boff = 16384 + (wm * 64 + lr) * 64;
    const int ch0 = ((0 + h) ^ sw) << 4, ch1 = ((2 + h) ^ sw) << 4;
    bf16x8 a0[4], b0[2], a1[4], b1[2];
    asm volatile("s_waitcnt vmcnt(0)" ::: "memory");
    issue(0); issue(1); issue(2); issue(3);
    asm volatile("s_waitcnt vmcnt(12)" ::: "memory");
    __builtin_amdgcn_s_barrier(); asm volatile("" ::: "memory");
#pragma unroll
    for (int nb = 0; nb < 4; ++nb) a0[nb] = *(const bf16x8*)(lds + aoff + nb * 2048 + ch0);
#pragma unroll
    for (int mb = 0; mb < 2; ++mb) b0[mb] = *(const bf16x8*)(lds + boff + mb * 2048 + ch0);
    for (int t = 0; t < nk; ++t) {
        const char* st = lds + (t & 3) * 32768;
#pragma unroll
        for (int nb = 0; nb < 4; ++nb) a1[nb] = *(const bf16x8*)(st + aoff + nb * 2048 + ch1);
#pragma unroll
        for (int mb = 0; mb < 2; ++mb) b1[mb] = *(const bf16x8*)(st + boff + mb * 2048 + ch1);
#pragma unroll
        for (int nb = 0; nb < 4; ++nb)
#pragma unroll
            for (int mb = 0; mb < 2; ++mb) acc[nb][mb] = __builtin_amdgcn_mfma_f32_32x32x16_bf16(a0[nb], b0[mb], acc[nb][mb], 0, 0, 0);
        const int rem = nk - 1 - t;
        if (rem >= 3) asm volatile("s_waitcnt vmcnt(8)" ::: "memory");
        else if (rem == 2) asm volatile("s_waitcnt vmcnt(4)" ::: "memory");
        else asm volatile("s_waitcnt vmcnt(0)" ::: "memory");
        asm volatile("s_waitcnt lgkmcnt(0)" ::: "memory");
        __builtin_amdgcn_s_barrier(); asm volatile("" ::: "memory");
        if (t + 4 < nk) issue(t + 4);
        if (t + 1 < nk) {
            const char* sn = lds + ((t + 1) & 3) * 32768;
#pragma unroll
            for (int nb = 0; nb < 4; ++nb) a0[nb] = *(const bf16x8*)(sn + aoff + nb * 2048 + ch0);
#pragma unroll
            for (int mb = 0; mb < 2; ++mb) b0[mb] = *(const bf16x8*)(sn + boff + mb * 2048 + ch0);
        }
#pragma unroll
        for (int nb = 0; nb < 4; ++nb)
#pragma unroll
            for (int mb = 0; mb < 2; ++mb) acc[nb][mb] = __builtin_amdgcn_mfma_f32_32x32x16_bf16(a1[nb], b1[mb], acc[nb][mb], 0, 0, 0);
    }
    TileCtx c; c.wn = wn; c.wm = wm; c.lane = lane;
    epi(acc, c);
}

__device__ __forceinline__ float rstd_from(const float* ssq, int npart, int token) {
    float s = 0.f;
    for (int i = 0; i < npart; ++i) s += ssq[(size_t)i * L_SEQ + token];
    return rsqrtf(s * (1.0f / DM) + EPSV);
}

struct EpiSloc {
    float* dst;
    __device__ __forceinline__ void operator()(f32x16 (&acc)[4][2], const TileCtx& c) const {
        if (c.wn != 0) return;
        const int lr = c.lane & 31, h = c.lane >> 5;
#pragma unroll
        for (int mb = 0; mb < 2; ++mb) { const int m = c.wm * 64 + mb * 32 + lr;
#pragma unroll
            for (int nb = 0; nb < 4; ++nb)
#pragma unroll
                for (int rq = 0; rq < 4; ++rq) { const int n = nb * 32 + rq * 8 + 4 * h;
                    f32x4 v = {acc[nb][mb][4 * rq], acc[nb][mb][4 * rq + 1], acc[nb][mb][4 * rq + 2], acc[nb][mb][4 * rq + 3]};
                    *(f32x4*)(dst + (size_t)m * 128 + n) = v; } }
    }
};

struct EpiS5 {
    const bf16_t* hn0; const float* dskip; bf16_t* z; int g; int n0;
    __device__ __forceinline__ void operator()(f32x16 (&acc)[4][2], const TileCtx& c) const {
        const int lr = c.lane & 31, h = c.lane >> 5;
#pragma unroll
        for (int mb = 0; mb < 2; ++mb) { const int j = c.wm * 64 + mb * 32 + lr;
            u32x2 uu[16];
#pragma unroll
            for (int q = 0; q < 16; ++q) { const int n = n0 + c.wn * 128 + (q >> 2) * 32 + (q & 3) * 8 + 4 * h; uu[q] = *(const u32x2*)(hn0 + (size_t)(j * 64 + (n >> 4)) * DM + g * 16 + (n & 15)); }
            asm volatile("" ::: "memory");
#pragma unroll
            for (int q = 0; q < 16; ++q) { const int nb = q >> 2, rq = q & 3; const int n = n0 + c.wn * 128 + nb * 32 + rq * 8 + 4 * h; const int t = n >> 4, cc = n & 15;
                const size_t off = (size_t)(j * 64 + t) * DM + g * 16 + cc; const f32x4 d4 = *(const f32x4*)(dskip + g * 16 + cc);
                const float y0 = acc[nb][mb][4 * rq] + d4[0] * bf_lo(uu[q][0]), y1 = acc[nb][mb][4 * rq + 1] + d4[1] * bf_hi(uu[q][0]);
                const float y2 = acc[nb][mb][4 * rq + 2] + d4[2] * bf_lo(uu[q][1]), y3 = acc[nb][mb][4 * rq + 3] + d4[3] * bf_hi(uu[q][1]);
                u32x2 o; o[0] = pk_bf16(gelu_tanh(y0), gelu_tanh(y1)); o[1] = pk_bf16(gelu_tanh(y2), gelu_tanh(y3));
                *(u32x2*)(z + off) = o; }
            asm volatile("" ::: "memory"); }
    }
};

struct EpiGlu {
    const float* x; float* out; bf16_t* hb; float* ssq; int n0, m0;
    __device__ __forceinline__ void operator()(f32x16 (&acc)[4][2], const TileCtx& c) const {
        const int lr = c.lane & 31, h = c.lane >> 5;
#pragma unroll
        for (int mb = 0; mb < 2; ++mb) { const int m = m0 + c.wm * 64 + mb * 32 + lr; float s = 0.f;
            const size_t rowoff = (size_t)m * DM + ((n0 + c.wn * 128) >> 1) + 4 * h;
            f32x4 xv[8];
#pragma unroll
            for (int q = 0; q < 8; ++q) xv[q] = *(const f32x4*)(x + rowoff + (q >> 1) * 16 + (q & 1) * 8);
            asm volatile("" ::: "memory");
#pragma unroll
            for (int q = 0; q < 8; ++q) { const int nb = q >> 1, rg = q & 1; const size_t off = rowoff + nb * 16 + rg * 8; f32x4 o;
#pragma unroll
                for (int e = 0; e < 4; ++e) { o[e] = xv[q][e] + acc[nb][mb][rg * 8 + e] * sigmoidf_(acc[nb][mb][rg * 8 + 4 + e]); s += o[e] * o[e]; }
                *(f32x4*)(out + off) = o; u32x2 b; b[0] = pk_bf16(o[0], o[1]); b[1] = pk_bf16(o[2], o[3]); *(u32x2*)(hb + off) = b; }
            asm volatile("" ::: "memory");
            s += __shfl_xor(s, 32);
            if (h == 0) ssq[(size_t)((n0 >> 8) * 2 + c.wn) * L_SEQ + m] = s; }
    }
};

struct EpiUp {
    const float* ssq; int npart; bf16_t* act; int n0, m0;
    __device__ __forceinline__ void operator()(f32x16 (&acc)[4][2], const TileCtx& c) const {
        const int lr = c.lane & 31, h = c.lane >> 5;
#pragma unroll
        for (int mb = 0; mb < 2; ++mb) { const int m = m0 + c.wm * 64 + mb * 32 + lr; const float rs = rstd_from(ssq, npart, m);
#pragma unroll
            for (int nb = 0; nb < 4; ++nb)
#pragma unroll
                for (int rg = 0; rg < 2; ++rg) { const int f = ((n0 + c.wn * 128 + nb * 32) >> 1) + rg * 8 + 4 * h; float o[4];
#pragma unroll
                    for (int e = 0; e < 4; ++e) { const float a = acc[nb][mb][rg * 8 + e] * rs, b = acc[nb][mb][rg * 8 + 4 + e] * rs; o[e] = a * sigmoidf_(a) * b; }
                    u32x2 bb; bb[0] = pk_bf16(o[0], o[1]); bb[1] = pk_bf16(o[2], o[3]); *(u32x2*)(act + (size_t)m * FFN + f) = bb; } }
    }
};

struct EpiRes {
    float* out; bf16_t* hb; float* ssq; int n0, m0;
    __device__ __forceinline__ void operator()(f32x16 (&acc)[4][2], const TileCtx& c) const {
        const int lr = c.lane & 31, h = c.lane >> 5;
#pragma unroll
        for (int mb = 0; mb < 2; ++mb) { const int m = m0 + c.wm * 64 + mb * 32 + lr; float s = 0.f;
            const size_t rowoff = (size_t)m * DM + n0 + c.wn * 128 + 4 * h;
#pragma unroll
            for (int np = 0; np < 2; ++np) {
                f32x4 o[8];
#pragma unroll
                for (int q = 0; q < 8; ++q) o[q] = *(const f32x4*)(out + rowoff + (np * 2 + (q >> 2)) * 32 + (q & 3) * 8);
                asm volatile("" ::: "memory");
#pragma unroll
                for (int q = 0; q < 8; ++q) { const int nb = np * 2 + (q >> 2), rq = q & 3; const size_t off = rowoff + nb * 32 + rq * 8;
#pragma unroll
                    for (int e = 0; e < 4; ++e) { o[q][e] += acc[nb][mb][4 * rq + e]; s += o[q][e] * o[q][e]; }
                    *(f32x4*)(out + off) = o[q];
                    if (hb) { u32x2 b; b[0] = pk_bf16(o[q][0], o[q][1]); b[1] = pk_bf16(o[q][2], o[q][3]); *(u32x2*)(hb + off) = b; } }
                asm volatile("" ::: "memory");
            }
            s += __shfl_xor(s, 32);
            if (h == 0) ssq[(size_t)((n0 >> 8) * 2 + c.wn) * L_SEQ + m] = s; }
    }
};

struct EpiKvq {
    const float* ssq; int npart; char* ws; int n0, m0;
    __device__ __forceinline__ void operator()(f32x16 (&acc)[4][2], const TileCtx& c) const {
        const int lr = c.lane & 31, h = c.lane >> 5;
        const bool isV = (n0 >= 1024 && n0 < 2048);
#pragma unroll
        for (int mb = 0; mb < 2; ++mb) { const int m = m0 + c.wm * 64 + mb * 32 + lr; const float rs = rstd_from(ssq, npart, m);
            if (isV) {
                const int mp = (m & ~12) | ((m & 4) << 1) | ((m & 8) >> 1);
                bf16_t* vt = (bf16_t*)(ws + OFF_VT);
#pragma unroll
                for (int nb = 0; nb < 4; ++nb)
#pragma unroll
                    for (int r = 0; r < 16; ++r) { const int nl = n0 - 1024 + c.wn * 128 + nb * 32 + (r & 3) + 8 * (r >> 2) + 4 * h;
                        vt[(size_t)nl * L_SEQ + mp] = (bf16_t)(pk_bf16(acc[nb][mb][r] * rs, 0.f) & 0xffffu); }
            } else {
                size_t base; int nl;
                if (n0 < 512) { base = OFF_K1; nl = n0; } else if (n0 < 1024) { base = OFF_K2; nl = n0 - 512; } else if (n0 < 2560) { base = OFF_Q1; nl = n0 - 2048; } else { base = OFF_Q2; nl = n0 - 2560; }
                bf16_t* dst = (bf16_t*)(ws + base);
                float cs[4], sn[4];
#pragma unroll
                for (int e = 0; e < 4; ++e) { const int i = 4 * h + e;
                    const float invf = (i == 0) ? 1.0f : (i == 1) ? 0.19391188f : (i == 2) ? 0.037601817f : (i == 3) ? 0.0072914392f : (i == 4) ? 0.0014142136f : (i == 5) ? 0.00027423282f : (i == 6) ? 5.3176997e-05f : 1.0311653e-05f;
                    const float ang = (float)m * invf; double rev = (double)ang * 0.15915494309189535; rev -= rint(rev); const float fr = (float)rev;
                    cs[e] = __builtin_amdgcn_cosf(fr); sn[e] = __builtin_amdgcn_sinf(fr); }
#pragma unroll
                for (int nb = 0; nb < 4; ++nb) {
                    const int nn = nl + c.wn * 128 + nb * 32; const int head = nn >> 6, d0 = nn & 63;
                    float v[16];
#pragma unroll
                    for (int r = 0; r < 16; ++r) v[r] = acc[nb][mb][r] * rs;
                    if (d0 == 0) {
#pragma unroll
                        for (int e = 0; e < 4; ++e) { const float x1 = v[e], x2 = v[4 + e]; v[e] = x1 * cs[e] - x2 * sn[e]; v[4 + e] = x2 * cs[e] + x1 * sn[e]; }
                    }
#pragma unroll
                    for (int rq = 0; rq < 4; ++rq) { u32x2 b; b[0] = pk_bf16(v[4 * rq], v[4 * rq + 1]); b[1] = pk_bf16(v[4 * rq + 2], v[4 * rq + 3]);
                        *(u32x2*)(dst + ((size_t)head * L_SEQ + m) * 64 + d0 + rq * 8 + 4 * h) = b; }
                }
            } }
    }
};

__device__ __forceinline__ void s5_tables(const int wave_s, const Params& p, int g, char* lds) {
    f32x2* apow = (f32x2*)lds;
    f32x2* bb = apow + 65 * 64;
    f32x2* cc = bb + 1024;
    f32x2* zf = cc + 1024;
    int tid = get_tid(wave_s); asm volatile("" : "+v"(tid));
    const float dt = expf(p.log_dt[g]);
    for (int e = tid; e < 65 * 64; e += NTHREADS) {
        const int lag = e >> 6, pp = e & 63;
        const float lr = p.lam_re[g * 64 + pp], li = p.lam_im[g * 64 + pp];
        const float mag = expf(lr * dt * (float)lag);
        double rev = (double)li * (double)dt * (double)lag * 0.15915494309189535; rev -= rint(rev);
        const float fr = (float)rev;
        f32x2 v; v[0] = mag * __builtin_amdgcn_cosf(fr); v[1] = mag * __builtin_amdgcn_sinf(fr); apow[e] = v;
    }
    if (tid < 64) {
        const float lr = p.lam_re[g * 64 + tid], li = p.lam_im[g * 64 + tid];
        const float em1 = expm1f(lr * dt);
        double rev = (double)li * (double)dt * 0.15915494309189535; const double rh = rev * 0.5; rev -= rint(rev);
        const double rh2 = rh - rint(rh);
        const float cth = __builtin_amdgcn_cosf((float)rev), sth = __builtin_amdgcn_sinf((float)rev), shalf = __builtin_amdgcn_sinf((float)rh2);
        const float nr = em1 * cth - 2.0f * shalf * shalf, ni = (1.0f + em1) * sth;
        const float den = lr * lr + li * li;
        f32x2 f; f[0] = (nr * lr + ni * li) / den; f[1] = (ni * lr - nr * li) / den; zf[tid] = f;
    }
    __syncthreads();
    for (int e = tid; e < 1024; e += NTHREADS) {
        const int pp = e >> 4;
        const float br = p.b_re[(size_t)g * 1024 + e], bi = p.b_im[(size_t)g * 1024 + e];
        const f32x2 f = zf[pp]; f32x2 v; v[0] = f[0] * br - f[1] * bi; v[1] = f[0] * bi + f[1] * br; bb[e] = v;
        f32x2 cv; cv[0] = p.c_re[(size_t)g * 1024 + e]; cv[1] = p.c_im[(size_t)g * 1024 + e]; cc[e] = cv;
    }
    __syncthreads();
    bf16_t* kt = (bf16_t*)(p.ws + OFF_KT) + (size_t)g * 127 * 256;
    bf16_t* w1 = (bf16_t*)(p.ws + OFF_W1) + (size_t)g * 128 * 1024;
    bf16_t* w3 = (bf16_t*)(p.ws + OFF_W3) + (size_t)g * 1024 * 128;
    {
        const int cp = tid & 255, c = cp >> 4, c2 = cp & 15, half = tid >> 8;
        float acc[32];
#pragma unroll
        for (int l = 0; l < 32; ++l) acc[l] = 0.f;
        for (int pp = 0; pp < 64; ++pp) {
            const f32x2 cv = cc[c * 64 + pp], bv = bb[pp * 16 + c2];
            const float cbr = cv[0] * bv[0] - cv[1] * bv[1], cbi = cv[0] * bv[1] + cv[1] * bv[0];
#pragma unroll
            for (int l = 0; l < 32; ++l) { const f32x2 a = apow[(half * 32 + l) * 64 + pp]; acc[l] += cbr * a[0] - cbi * a[1]; }
        }
#pragma unroll
        for (int l = 0; l < 32; ++l) kt[(size_t)(63 + half * 32 + l) * 256 + cp] = (bf16_t)(pk_bf16(acc[l], 0.f) & 0xffffu);
        for (int e = tid; e < 63 * 256 / 8; e += NTHREADS) { u32x4 zz = {0u, 0u, 0u, 0u}; *(u32x4*)(kt + e * 8) = zz; }
    }
    for (int q = tid; q < 128 * 128; q += NTHREADS) {
        const int pq = q >> 7, kc = q & 127, tau = kc >> 1, c0 = (kc & 1) * 8, pp = pq & 63, im = pq >> 6;
        const f32x2 a = apow[(63 - tau) * 64 + pp]; float v[8];
#pragma unroll
        for (int e = 0; e < 8; ++e) { const f32x2 b = bb[pp * 16 + c0 + e]; v[e] = im ? (a[0] * b[1] + a[1] * b[0]) : (a[0] * b[0] - a[1] * b[1]); }
        u32x4 o; o[0] = pk_bf16(v[0], v[1]); o[1] = pk_bf16(v[2], v[3]); o[2] = pk_bf16(v[4], v[5]); o[3] = pk_bf16(v[6], v[7]);
        *(u32x4*)(w1 + (size_t)pq * 1024 + kc * 8) = o;
    }
    for (int q = tid; q < 1024 * 16; q += NTHREADS) {
        const int n = q >> 4, p0 = (q & 15) * 8, t = n >> 4, c = n & 15, im = p0 >> 6; float v[8];
#pragma unroll
        for (int e = 0; e < 8; ++e) { const int pp = (p0 + e) & 63; const f32x2 a = apow[(t + 1) * 64 + pp]; const f32x2 cv = cc[c * 64 + pp];
            v[e] = im ? -(cv[0] * a[1] + cv[1] * a[0]) : (cv[0] * a[0] - cv[1] * a[1]); }
        u32x4 o; o[0] = pk_bf16(v[0], v[1]); o[1] = pk_bf16(v[2], v[3]); o[2] = pk_bf16(v[4], v[5]); o[3] = pk_bf16(v[6], v[7]);
        *(u32x4*)(w3 + (size_t)n * 128 + p0) = o;
    }
    if (tid < 64) ((f32x2*)(p.ws + OFF_A64))[g * 64 + tid] = apow[64 * 64 + tid];
    __syncthreads();
}

__device__ __forceinline__ void wtile(const int wave_s, const Params& p, int t, char* lds) {
    int j = 0;
    for (int i = 1; i < p.njobs; ++i) if (t >= p.jobs[i].tile0) j = i;
    const WJob& J = p.jobs[j];
    const int lt = t - J.tile0, kt = lt / J.ntn, nt = lt - kt * J.ntn;
    const int k0 = kt * 64, nl0 = nt * 64;
    float* T = (float*)lds;
    int tid = get_tid(wave_s); asm volatile("" : "+v"(tid));
#pragma unroll
    for (int i = 0; i < 2; ++i) { const int kk = i * 32 + (tid >> 4), n4 = (tid & 15) * 4;
        f32x4 v = *(const f32x4*)(J.src + (size_t)(k0 + kk) * J.ldsrc + J.col0 + nl0 + n4);
        float sc = J.scale; if (J.gain) sc *= J.gain[k0 + kk];
        T[kk * 65 + n4] = v[0] * sc; T[kk * 65 + n4 + 1] = v[1] * sc; T[kk * 65 + n4 + 2] = v[2] * sc; T[kk * 65 + n4 + 3] = v[3] * sc; }
    __syncthreads();
    { const int nn = tid >> 3, kc = (tid & 7) * 8; float v[8];
#pragma unroll
        for (int e = 0; e < 8; ++e) v[e] = T[(kc + e) * 65 + nn];
        const int n = nl0 + nn; int row = (J.mode == 0) ? n : ((n >> 3) * 16 + (n & 7) + (J.mode == 2 ? 8 : 0)); row += J.rowoff;
        u32x4 o; o[0] = pk_bf16(v[0], v[1]); o[1] = pk_bf16(v[2], v[3]); o[2] = pk_bf16(v[4], v[5]); o[3] = pk_bf16(v[6], v[7]);
        *(u32x4*)(J.dst + (size_t)row * J.K + k0 + kc) = o; }
    __syncthreads();
}

__device__ __forceinline__ void rms0_item(const int wave_s, const Params& p, int item) {
    const int lane = get_tid(wave_s) & 63, wid = wave_s;
    bf16_t* hn0 = (bf16_t*)(p.ws + OFF_HN0);
    for (int r = 0; r < 8; ++r) {
        const int row = item * 64 + wid * 8 + r;
        f32x4 v[4]; float s = 0.f;
#pragma unroll
        for (int i = 0; i < 4; ++i) { v[i] = *(const f32x4*)(p.x + (size_t)row * DM + lane * 4 + 256 * i); s += v[i][0] * v[i][0] + v[i][1] * v[i][1] + v[i][2] * v[i][2] + v[i][3] * v[i][3]; }
#pragma unroll
        for (int o = 32; o >= 1; o >>= 1) s += __shfl_xor(s, o);
        const float rs = rsqrtf(s * (1.0f / DM) + EPSV);
#pragma unroll
        for (int i = 0; i < 4; ++i) { const f32x4 g = *(const f32x4*)(p.norm_mix_g + lane * 4 + 256 * i);
            u32x2 o; o[0] = pk_bf16(v[i][0] * rs * g[0], v[i][1] * rs * g[1]); o[1] = pk_bf16(v[i][2] * rs * g[2], v[i][3] * rs * g[3]);
            *(u32x2*)(hn0 + (size_t)row * DM + lane * 4 + 256 * i) = o; }
    }
}

__device__ __forceinline__ void attn_item(const int wave_s, const Params& p, int head, int qb, float lam, char* lds) {
    int tid = get_tid(wave_s); asm volatile("" : "+v"(tid));
    const int lane = tid & 63, wid = tid >> 6;
    const int mp = wid >> 2, g = wid & 3;
    const int lr = lane & 31, h = lane >> 5, sw = (lane >> 1) & 7;
    const bf16_t* K1 = (const bf16_t*)(p.ws + OFF_K1) + (size_t)head * L_SEQ * 64;
    const bf16_t* K2 = (const bf16_t*)(p.ws + OFF_K2) + (size_t)head * L_SEQ * 64;
    const bf16_t* VT = (const bf16_t*)(p.ws + OFF_VT) + (size_t)head * 128 * L_SEQ;
    const bf16_t* Q = (const bf16_t*)(p.ws + (mp ? OFF_Q2 : OFF_Q1)) + (size_t)head * L_SEQ * 64;
    const int q0 = qb * 128 + g * 32;
    bf16x8 qf[4];
#pragma unroll
    for (int s = 0; s < 4; ++s) qf[s] = *(const bf16x8*)(Q + (size_t)(q0 + lr) * 64 + 16 * s + 8 * h);
    const int nkt = 2 * qb + 2;
    const int my_last = 2 * qb + (g >> 1);
    f32x16 O[4];
#pragma unroll
    for (int e = 0; e < 4; ++e)
#pragma unroll
        for (int r = 0; r < 16; ++r) O[e][r] = 0.f;
    float m_run = -1e30f, l_run = 0.f;
    const int r0 = tid >> 3, c8 = tid & 7;
    const int kofs = r0 * 128 + ((c8 ^ ((r0 >> 1) & 7)) << 4);
    u32x4 sk1, sk2, sv0, sv1;
    auto gload = [&](int kt) {
        sk1 = *(const u32x4*)(K1 + (size_t)(kt * 64 + r0) * 64 + c8 * 8);
        sk2 = *(const u32x4*)(K2 + (size_t)(kt * 64 + r0) * 64 + c8 * 8);
        sv0 = *(const u32x4*)(VT + (size_t)r0 * L_SEQ + kt * 64 + c8 * 8);
        sv1 = *(const u32x4*)(VT + (size_t)(r0 + 64) * L_SEQ + kt * 64 + c8 * 8);
    };
    auto lstore = [&](int buf) {
        char* b = lds + buf * 32768 + kofs;
        *(u32x4*)(b) = sk1; *(u32x4*)(b + 8192) = sk2; *(u32x4*)(b + 16384) = sv0; *(u32x4*)(b + 16384 + 8192) = sv1;
    };
    gload(0); lstore(0); __syncthreads();
    for (int kt = 0; kt < nkt; ++kt) {
        if (kt + 1 < nkt) gload(kt + 1);
        if (kt <= my_last) {
            const char* kb_ = lds + (kt & 1) * 32768 + mp * 8192 + lr * 128;
            const char* vb_ = lds + (kt & 1) * 32768 + 16384 + lr * 128;
            f32x16 S[2];
#pragma unroll
            for (int kb = 0; kb < 2; ++kb) {
#pragma unroll
                for (int r = 0; r < 16; ++r) S[kb][r] = 0.f;
#pragma unroll
                for (int s = 0; s < 4; ++s) { const bf16x8 kf = *(const bf16x8*)(kb_ + kb * 4096 + (((2 * s + h) ^ sw) << 4));
                    S[kb] = __builtin_amdgcn_mfma_f32_32x32x16_bf16(kf, qf[s], S[kb], 0, 0, 0); }
            }
            float mt = S[0][0];
#pragma unroll
            for (int r = 1; r < 16; ++r) mt = fmaxf(mt, S[0][r]);
#pragma unroll
            for (int r = 0; r < 16; ++r) mt = fmaxf(mt, S[1][r]);
            mt = fmaxf(mt, __shfl_xor(mt, 32));
            const bool need = mt > m_run + 8.0f;
            if (__any(need)) {
                const float mnew = need ? mt : m_run;
                const float alpha = fast_exp2(m_run - mnew);
                m_run = mnew; l_run *= alpha;
#pragma unroll
                for (int e = 0; e < 4; ++e)
#pragma unroll
                    for (int r = 0; r < 16; ++r) O[e][r] *= alpha;
            }
            float ls = 0.f;
            bf16x8 pf[2][2];
#pragma unroll
            for (int kb = 0; kb < 2; ++kb)
#pragma unroll
                for (int s = 0; s < 2; ++s) { float e_[8];
#pragma unroll
                    for (int j = 0; j < 8; ++j) { e_[j] = fast_exp2(S[kb][8 * s + j] - m_run); ls += e_[j]; }
                    u32x4 pk; pk[0] = pk_bf16(e_[0], e_[1]); pk[1] = pk_bf16(e_[2], e_[3]); pk[2] = pk_bf16(e_[4], e_[5]); pk[3] = pk_bf16(e_[6], e_[7]);
                    pf[kb][s] = __builtin_bit_cast(bf16x8, pk); }
            l_run += ls;
#pragma unroll
            for (int kb = 0; kb < 2; ++kb)
#pragma unroll
                for (int s = 0; s < 2; ++s)
#pragma unroll
                    for (int e = 0; e < 4; ++e) { const bf16x8 vf = *(const bf16x8*)(vb_ + e * 4096 + (((4 * kb + 2 * s + h) ^ sw) << 4));
                        O[e] = __builtin_amdgcn_mfma_f32_32x32x16_bf16(vf, pf[kb][s], O[e], 0, 0, 0); }
        }
        if (kt + 1 < nkt) lstore((kt + 1) & 1);
        __syncthreads();
    }
    const float lt = l_run + __shfl_xor(l_run, 32);
    const float inv = fast_rcp(lt) * (mp ? lam : 1.0f);
    float* ex = (float*)lds;
    if (mp == 1) {
#pragma unroll
        for (int e = 0; e < 4; ++e)
#pragma unroll
            for (int r = 0; r < 16; ++r) ex[((g * 4 + e) * 16 + r) * 64 + lane] = O[e][r] * inv;
    }
    __syncthreads();
    if (mp == 0) {
        float ss = 0.f;
#pragma unroll
        for (int e = 0; e < 4; ++e)
#pragma unroll
            for (int r = 0; r < 16; ++r) { const float o = O[e][r] * inv - ex[((g * 4 + e) * 16 + r) * 64 + lane]; O[e][r] = o; ss += o * o; }
        ss += __shfl_xor(ss, 32);
        const float rs = rsqrtf(ss * (1.0f / 128.0f) + EPSV) * (1.0f - LAM_INIT);
        bf16_t* on = (bf16_t*)(p.ws + OFF_ON) + (size_t)(q0 + lr) * DM + head * 128;
#pragma unroll
        for (int e = 0; e < 4; ++e)
#pragma unroll
            for (int rq = 0; rq < 4; ++rq) { const int ee = e * 32 + rq * 8 + 4 * h; const f32x4 gg = *(const f32x4*)(p.subln_g + ee);
                u32x2 b; b[0] = pk_bf16(O[e][4 * rq] * rs * gg[0], O[e][4 * rq + 1] * rs * gg[1]); b[1] = pk_bf16(O[e][4 * rq + 2] * rs * gg[2], O[e][4 * rq + 3] * rs * gg[3]);
                *(u32x2*)(on + ee) = b; }
    }
    __syncthreads();
}


__device__ __forceinline__ void gbar(const int wave_s, unsigned* ctr, unsigned target) {
    __syncthreads();
    if (get_tid(wave_s) == 0) {
        __builtin_amdgcn_fence(__ATOMIC_RELEASE, "agent");
        asm volatile("s_waitcnt vmcnt(0)" ::: "memory");
        __hip_atomic_fetch_add(ctr, 1u, __ATOMIC_RELAXED, __HIP_MEMORY_SCOPE_AGENT);
        while (__hip_atomic_load(ctr, __ATOMIC_RELAXED, __HIP_MEMORY_SCOPE_AGENT) < target) __builtin_amdgcn_s_sleep(2);
        __builtin_amdgcn_fence(__ATOMIC_ACQUIRE, "agent");
        asm volatile("s_waitcnt vmcnt(0)" ::: "memory");
    }
    __syncthreads();
}


__device__ __forceinline__ bool tile_map(int r, int bid, int nb, int NT, int& nt, int& mt) {
    if (nb == 256) {
        const int x = bid & 7, li = bid >> 3, q = li + 32 * r;
        if (q >= 8 * NT) return false;
        const int mi = q & 3, rest = q >> 2, mg = rest / NT;
        nt = rest - mg * NT; mt = x * 8 + mg * 4 + mi; return true;
    }
    const int t = bid + r * nb; if (t >= NT * 64) return false;
    nt = t % NT; mt = t / NT; return true;
}

__global__ void __launch_bounds__(NTHREADS) mega(const Params p) {
    __shared__ __attribute__((aligned(16))) char lds[LDS_BYTES];
    cg::grid_group grid = cg::this_grid();
    const int wave_s = __builtin_amdgcn_readfirstlane((int)(threadIdx.x >> 6));
    const int nb = gridDim.x, bid = blockIdx.x;
    char* ws = p.ws;
    bf16_t* hn0 = (bf16_t*)(ws + OFF_HN0);
    bf16_t* hb = (bf16_t*)(ws + OFF_HB);
    float* ssq0 = (float*)(ws + OFF_SSQ);
    float* ssq1 = ssq0 + 16 * L_SEQ; float* ssq2 = ssq1 + 16 * L_SEQ; float* ssq3 = ssq2 + 16 * L_SEQ;
    const Seg nul = {nullptr, 0, 0, nullptr, 0, 0};
    unsigned* bar = (unsigned*)(ws + OFF_BAR); unsigned nbar = 0;

    { const int nitems = 64 + p.ntiles_w + 256;
      for (int it = bid; it < nitems; it += nb) {
          if (it < 64) s5_tables(wave_s, p, it, lds);
          else if (it < 64 + p.ntiles_w) wtile(wave_s, p, it - 64, lds);
          else rms0_item(wave_s, p, it - 64 - p.ntiles_w);
      } }
    grid.sync();
    for (int g = bid; g < 64; g += nb) {
        Seg s = {(const bf16_t*)(ws + OFF_W1) + (size_t)g * 128 * 1024, 1024, 16, hn0 + g * 16, 65536, 1024};
        EpiSloc e = {(float*)(ws + OFF_SLOC) + (size_t)g * 256 * 128};
        gemm_tile(wave_s, lds, s, 16, nul, 0, e);
    }
    gbar(wave_s, bar, (unsigned)nb * (++nbar));
    for (int t0 = bid; t0 < 256; t0 += nb) {
        const int t = (nb == 256) ? ((t0 & 7) * 32 + (t0 >> 3)) : t0;
        const int g = t >> 2, i = 3 - (t & 3);
        bf16_t* sprev = (bf16_t*)(ws + OFF_SPREV) + (size_t)t * 256 * 128;
        {
            const int lane_ = get_tid(wave_s) & 63, w_ = wave_s;
            const f32x2 a = ((const f32x2*)(ws + OFF_A64))[g * 64 + lane_];
            const float* sl = (const float*)(ws + OFF_SLOC) + (size_t)g * 256 * 128 + (size_t)(w_ * 32) * 128;
            float xr[32], xi[32];
#pragma unroll
            for (int j = 0; j < 32; ++j) { xr[j] = sl[j * 128 + lane_]; xi[j] = sl[j * 128 + 64 + lane_]; }
            float sr = 0.f, si = 0.f;
#pragma unroll
            for (int j = 0; j < 32; ++j) { const float nr = a[0] * sr - a[1] * si + xr[j], ni = a[0] * si + a[1] * sr + xi[j]; sr = nr; si = ni; }
            f32x2* carry = (f32x2*)lds;
            { f32x2 c; c[0] = sr; c[1] = si; carry[w_ * 64 + lane_] = c; }
            float pr = a[0], pi = a[1];
#pragma unroll
            for (int q = 0; q < 5; ++q) { const float nr = pr * pr - pi * pi, ni = 2.f * pr * pi; pr = nr; pi = ni; }
            __syncthreads();
#pragma unroll
            for (int j = 0; j < 32; ++j) { xr[j] = __builtin_nontemporal_load(sl + j * 128 + lane_); xi[j] = __builtin_nontemporal_load(sl + j * 128 + 64 + lane_); }
            sr = 0.f; si = 0.f;
            for (int v = 0; v < w_; ++v) { const f32x2 c = carry[v * 64 + lane_]; const float nr = pr * sr - pi * si + c[0], ni = pr * si + pi * sr + c[1]; sr = nr; si = ni; }
            bf16_t* sp = sprev + (size_t)(w_ * 32) * 128;
#pragma unroll
            for (int j = 0; j < 32; ++j) {
                sp[j * 128 + lane_] = (bf16_t)(pk_bf16(sr, 0.f) & 0xffffu); sp[j * 128 + 64 + lane_] = (bf16_t)(pk_bf16(si, 0.f) & 0xffffu);
                const float nr = a[0] * sr - a[1] * si + xr[j], ni = a[0] * si + a[1] * sr + xi[j]; sr = nr; si = ni;
            }
            __threadfence();
        }
        __syncthreads();
        Seg s0 = {(const bf16_t*)(ws + OFF_KT) + (size_t)g * 127 * 256 + 63 * 256 + (size_t)(i * 256) * 16, 16, -256, hn0 + g * 16, 65536, 1024};
        Seg s1 = {(const bf16_t*)(ws + OFF_W3) + (size_t)g * 1024 * 128 + (size_t)(i * 256) * 128, 128, 16, sprev, 128, 16};
        EpiS5 e = {hn0, p.ssm_d, (bf16_t*)(ws + OFF_Z), g, i * 256};
        gemm_tile(wave_s, lds, s0, 4 * (i + 1), s1, 2, e);
    }
    gbar(wave_s, bar, (unsigned)nb * (++nbar));
    for (int r = 0, nt, mt; tile_map(r, bid, nb, 8, nt, mt); ++r) {
        Seg s = {(const bf16_t*)(ws + OFF_WGLU) + (size_t)nt * 256 * DM, DM, 16, (const bf16_t*)(ws + OFF_Z) + (size_t)mt * 256 * DM, DM, 16};
        EpiGlu e = {p.x, p.out, hb, ssq0, nt * 256, mt * 256};
        gemm_tile(wave_s, lds, s, 16, nul, 0, e);
    }
    gbar(wave_s, bar, (unsigned)nb * (++nbar));
#pragma unroll
    for (int layer = 0; layer < 2; ++layer) {
        if (layer == 1) {
            for (int r = 0, nt, mt; tile_map(r, bid, nb, 12, nt, mt); ++r) {
                Seg s = {(const bf16_t*)(ws + OFF_WKVQ) + (size_t)nt * 256 * DM, DM, 16, hb + (size_t)mt * 256 * DM, DM, 16};
                EpiKvq e = {ssq1, 8, ws, nt * 256, mt * 256};
                gemm_tile(wave_s, lds, s, 16, nul, 0, e);
            }
            gbar(wave_s, bar, (unsigned)nb * (++nbar));
            {
                float a1 = 0.f, a2 = 0.f;
                for (int i = 0; i < 64; ++i) { a1 += p.lq1[i] * p.lk1[i]; a2 += p.lq2[i] * p.lk2[i]; }
                const float lam = expf(a1) - expf(a2) + LAM_INIT;
                for (int rep = 0; rep < REP_ATTN; ++rep)
                for (int it = bid; it < 1024; it += nb) {
                    const int head = it & 7, r = it >> 3, rnd = r >> 5, j = r & 31;
                    const int qb = (rnd == 0) ? 127 - j : (rnd == 1) ? 64 + j : (rnd == 2) ? 63 - j : j;
                    attn_item(wave_s, p, head, qb, lam, lds);
                }
            }
            gbar(wave_s, bar, (unsigned)nb * (++nbar));
            for (int r = 0, nt, mt; tile_map(r, bid, nb, 4, nt, mt); ++r) {
                Seg s = {(const bf16_t*)(ws + OFF_WO) + (size_t)nt * 256 * DM, DM, 16, (const bf16_t*)(ws + OFF_ON) + (size_t)mt * 256 * DM, DM, 16};
                EpiRes e = {p.out, hb, ssq2, nt * 256, mt * 256};
                gemm_tile(wave_s, lds, s, 16, nul, 0, e);
            }
            gbar(wave_s, bar, (unsigned)nb * (++nbar));
        }
        {
            const bf16_t* wup = (const bf16_t*)(ws + (layer ? OFF_WUP1 : OFF_WUP0));
            const float* sq = layer ? ssq2 : ssq0; const int npart = layer ? 8 : 16;
            for (int rep = 0; rep < REP_UP; ++rep)
            for (int r = 0, nt, mt; tile_map(r, bid, nb, 22, nt, mt); ++r) {
                Seg s = {wup + (size_t)nt * 256 * DM, DM, 16, hb + (size_t)mt * 256 * DM, DM, 16};
                EpiUp e = {sq, npart, (bf16_t*)(ws + OFF_ACT), nt * 256, mt * 256};
                gemm_tile(wave_s, lds, s, 16, nul, 0, e);
            }
        }
        gbar(wave_s, bar, (unsigned)nb * (++nbar));
        {
            const bf16_t* wdn = (const bf16_t*)(ws + (layer ? OFF_WDN1 : OFF_WDN0));
            for (int r = 0, nt, mt; tile_map(r, bid, nb, 4, nt, mt); ++r) {
                Seg s = {wdn + (size_t)nt * 256 * FFN, FFN, 16, (const bf16_t*)(ws + OFF_ACT) + (size_t)mt * 256 * FFN, FFN, 16};
                EpiRes e = {p.out, layer ? (bf16_t*)nullptr : hb, layer ? ssq3 : ssq1, nt * 256, mt * 256};
                gemm_tile(wave_s, lds, s, FFN / 64, nul, 0, e);
            }
        }
        gbar(wave_s, bar, (unsigned)nb * (++nbar));
    }
    {
        const int lane = get_tid(wave_s) & 63, wid = wave_s;
        for (int row = bid * 8 + wid; row < L_SEQ; row += nb * 8) {
            float s = 0.f;
            for (int i = 0; i < 8; ++i) s += ssq3[(size_t)i * L_SEQ + row];
            const float rs = rsqrtf(s * (1.0f / DM) + EPSV);
#pragma unroll
            for (int i = 0; i < 4; ++i) { const size_t off = (size_t)row * DM + lane * 4 + 256 * i;
                f32x4 v = *(const f32x4*)(p.out + off); const f32x4 g = *(const f32x4*)(p.final_g + lane * 4 + 256 * i);
                v[0] *= rs * g[0]; v[1] *= rs * g[1]; v[2] *= rs * g[2]; v[3] *= rs * g[3]; *(f32x4*)(p.out + off) = v; }
        }
    }
}

static void add_job(Params& P, int& nt, const float* src, bf16_t* dst, const float* gain, int K, int N, int ld, int col0, int mode, int rowoff, float scale) {
    WJob& J = P.jobs[P.njobs++];
    J.src = src; J.dst = dst; J.gain = gain; J.K = K; J.N = N; J.ldsrc = ld; J.col0 = col0; J.mode = mode; J.rowoff = rowoff; J.scale = scale; J.tile0 = nt; J.ntn = N / 64; J.pad = 0;
    nt += (K / 64) * (N / 64);
}

extern "C" void kernel_launch(void* const* d_in, const int* in_sizes, int n_in, void* d_out, int out_size, void* d_ws, size_t ws_size, hipStream_t stream) {
    Params P; memset(&P, 0, sizeof(P));
    P.x = (const float*)d_in[0]; P.norm_mix_g = (const float*)d_in[1]; P.norm_ffn_g = (const float*)d_in[2];
    P.ffn_w1 = (const float*)d_in[3]; P.ffn_w3 = (const float*)d_in[4]; P.ffn_w2 = (const float*)d_in[5];
    P.lam_re = (const float*)d_in[6]; P.lam_im = (const float*)d_in[7]; P.log_dt = (const float*)d_in[8];
    P.b_re = (const float*)d_in[9]; P.b_im = (const float*)d_in[10]; P.c_re = (const float*)d_in[11]; P.c_im = (const float*)d_in[12];
    P.ssm_d = (const float*)d_in[13]; P.w_glu = (const float*)d_in[14]; P.kv_norm_g = (const float*)d_in[15]; P.w_kv = (const float*)d_in[16];
    P.w_q = (const float*)d_in[17]; P.lq1 = (const float*)d_in[18]; P.lk1 = (const float*)d_in[19]; P.lq2 = (const float*)d_in[20]; P.lk2 = (const float*)d_in[21];
    P.subln_g = (const float*)d_in[22]; P.w_o = (const float*)d_in[23]; P.final_g = (const float*)d_in[24];
    P.out = (float*)d_out; P.ws = (char*)d_ws;
    char* ws = (char*)d_ws; int nt = 0;
    const size_t FW = (size_t)DM * FFN;
    add_job(P, nt, P.w_glu, (bf16_t*)(ws + OFF_WGLU), nullptr, DM, 1024, 2048, 0, 1, 0, 1.0f);
    add_job(P, nt, P.w_glu, (bf16_t*)(ws + OFF_WGLU), nullptr, DM, 1024, 2048, 1024, 2, 0, 1.0f);
    add_job(P, nt, P.ffn_w1, (bf16_t*)(ws + OFF_WUP0), P.norm_ffn_g, DM, FFN, FFN, 0, 1, 0, 1.0f);
    add_job(P, nt, P.ffn_w3, (bf16_t*)(ws + OFF_WUP0), P.norm_ffn_g, DM, FFN, FFN, 0, 2, 0, 1.0f);
    add_job(P, nt, P.ffn_w2, (bf16_t*)(ws + OFF_WDN0), nullptr, FFN, DM, DM, 0, 0, 0, 1.0f);
    add_job(P, nt, P.w_kv, (bf16_t*)(ws + OFF_WKVQ), P.kv_norm_g, DM, 2048, 2048, 0, 0, 0, 1.0f);
    add_job(P, nt, P.w_q, (bf16_t*)(ws + OFF_WKVQ), P.norm_mix_g + DM, DM, 1024, 1024, 0, 0, 2048, QSCALE);
    add_job(P, nt, P.w_o, (bf16_t*)(ws + OFF_WO), nullptr, DM, DM, DM, 0, 0, 0, 1.0f);
    add_job(P, nt, P.ffn_w1 + FW, (bf16_t*)(ws + OFF_WUP1), P.norm_ffn_g + DM, DM, FFN, FFN, 0, 1, 0, 1.0f);
    add_job(P, nt, P.ffn_w3 + FW, (bf16_t*)(ws + OFF_WUP1), P.norm_ffn_g + DM, DM, FFN, FFN, 0, 2, 0, 1.0f);
    add_job(P, nt, P.ffn_w2 + FW, (bf16_t*)(ws + OFF_WDN1), nullptr, FFN, DM, DM, 0, 0, 0, 1.0f);
    P.ntiles_w = nt;
    static int grid_blocks = 0;
    if (!grid_blocks) {
        int dev = 0, cus = 0, per_cu = 0;
        hipGetDevice(&dev);
        hipDeviceGetAttribute(&cus, hipDeviceAttributeMultiprocessorCount, dev);
        hipOccupancyMaxActiveBlocksPerMultiprocessor(&per_cu, mega, NTHREADS, 0);
        if (per_cu < 1) per_cu = 1;
        grid_blocks = cus * 1;
    }
    hipMemsetAsync(ws + OFF_BAR, 0, 256, stream);
    void* args[] = {&P};
    hipError_t e = hipLaunchCooperativeKernel((void*)mega, dim3(grid_blocks), dim3(NTHREADS), args, 0, stream);
    if (e != hipSuccess) fprintf(stderr, "cooperative launch failed: %s (grid %d)\n", hipGetErrorString(e), grid_blocks);
}
```

```cpp
#include <hip/hip_runtime.h>
#include <hip/hip_cooperative_groups.h>
#include <stdint.h>
#include <string.h>
#include <stdio.h>
namespace cg = cooperative_groups;

typedef unsigned short bf16_t;
typedef short bf16x8 __attribute__((ext_vector_type(8)));
typedef float f32x16 __attribute__((ext_vector_type(16)));
typedef float f32x4 __attribute__((ext_vector_type(4)));
typedef float f32x2 __attribute__((ext_vector_type(2)));
typedef unsigned u32x4 __attribute__((ext_vector_type(4)));
typedef unsigned u32x2 __attribute__((ext_vector_type(2)));

#define L_SEQ 16384
#define DM 1024
#define FFN 2816
#define NTHREADS 512
#ifndef REP_ATTN
#define REP_ATTN 1
#endif
#ifndef REP_UP
#define REP_UP 1
#endif
#define REP_GLU 1
#define REP_KVQ 1
#define REP_S5 1
#define REP_SLOC 1
#define REP_PREP 1
#define LDS_BYTES 131072
#define EPSV 1e-6f
#define LAM_INIT 0.35550906759096927f
#define QSCALE 0.18033688011112042f

static constexpr size_t MiB = 1024ull * 1024ull;
static constexpr size_t OFF_WGLU = 0;
static constexpr size_t OFF_WUP0 = 4 * MiB;
static constexpr size_t OFF_WDN0 = 15 * MiB;
static constexpr size_t OFF_WKVQ = 20 * MiB + MiB / 2;
static constexpr size_t OFF_WO = 26 * MiB + MiB / 2;
static constexpr size_t OFF_WUP1 = 28 * MiB + MiB / 2;
static constexpr size_t OFF_WDN1 = 39 * MiB + MiB / 2;
static constexpr size_t OFF_SSQ = 45 * MiB;
static constexpr size_t OFF_A64 = 49 * MiB;
static constexpr size_t OFF_BAR = 49 * MiB + MiB / 2;
static constexpr size_t OFF_A = 50 * MiB;
static constexpr size_t OFF_HN0 = OFF_A;
static constexpr size_t OFF_Z = OFF_A + 32 * MiB;
static constexpr size_t OFF_ACT = OFF_A;
static constexpr size_t OFF_K1 = OFF_A;
static constexpr size_t OFF_K2 = OFF_A + 16 * MiB;
static constexpr size_t OFF_VT = OFF_A + 32 * MiB;
static constexpr size_t OFF_Q1 = OFF_A + 64 * MiB;
static constexpr size_t OFF_Q2 = OFF_A + 80 * MiB;
static constexpr size_t OFF_B = 146 * MiB;
static constexpr size_t OFF_KT = OFF_B;
static constexpr size_t OFF_W1 = OFF_B + 4 * MiB;
static constexpr size_t OFF_W3 = OFF_B + 20 * MiB;
static constexpr size_t OFF_SLOC = OFF_B + 36 * MiB;
static constexpr size_t OFF_SPREV = OFF_B + 44 * MiB;
static constexpr size_t OFF_HB = OFF_B;
static constexpr size_t OFF_ON = OFF_B + 32 * MiB;

struct WJob { const float* src; bf16_t* dst; const float* gain; int K; int N; int ldsrc; int col0; int mode; int rowoff; float scale; int tile0; int ntn; int pad; };

struct Params {
    const float *x, *norm_mix_g, *norm_ffn_g, *ffn_w1, *ffn_w3, *ffn_w2;
    const float *lam_re, *lam_im, *log_dt, *b_re, *b_im, *c_re, *c_im, *ssm_d, *w_glu;
    const float *kv_norm_g, *w_kv, *w_q, *lq1, *lk1, *lq2, *lk2, *subln_g, *w_o, *final_g;
    float* out;
    char* ws;
    WJob jobs[12];
    int njobs; int ntiles_w;
};

__device__ __forceinline__ int get_tid(int wave_s) { int t = wave_s * 64 + (int)__builtin_amdgcn_mbcnt_hi(~0u, __builtin_amdgcn_mbcnt_lo(~0u, 0u)); asm volatile("" : "+v"(t)); return t; }
__device__ __forceinline__ unsigned pk_bf16(float lo, float hi) { unsigned r; asm("v_cvt_pk_bf16_f32 %0, %1, %2" : "=v"(r) : "v"(lo), "v"(hi)); return r; }
__device__ __forceinline__ float bf_lo(unsigned u) { return __uint_as_float(u << 16); }
__device__ __forceinline__ float bf_hi(unsigned u) { return __uint_as_float(u & 0xffff0000u); }
__device__ __forceinline__ float fast_rcp(float x) { return __builtin_amdgcn_rcpf(x); }
__device__ __forceinline__ float fast_exp2(float x) { return __builtin_amdgcn_exp2f(x); }
__device__ __forceinline__ float sigmoidf_(float x) { return fast_rcp(1.0f + fast_exp2(-1.4426950408889634f * x)); }
__device__ __forceinline__ float gelu_tanh(float x) {
    const float u = 0.7978845608028654f * x * (1.0f + 0.044715f * x * x);
    return x * fast_rcp(1.0f + fast_exp2(-2.8853900817779268f * u));
}

struct Seg { const bf16_t* W; long wrs; long wkhi; const bf16_t* X; long xrs; long xkhi; };

struct TileCtx { int wn, wm, lane; };

template <class Epi>
__device__ __forceinline__ void gemm_tile(const int wave_s, char* lds, const Seg s0, const int nk0_, const Seg s1, const int nk1_, Epi& epi) {
    int tid = get_tid(wave_s);
    const int lane = tid & 63;
    const int wn = wave_s >> 2, wm = wave_s & 3;
    const int lr = lane & 31, h = lane >> 5;
    const int nk0 = nk0_ * 2, nk1 = nk1_ * 2, nk = nk0 + nk1;
    const int cch = (lane & 3) ^ ((lane >> 4) & 3);
    const int row0 = wave_s * 32 + (lane >> 2);
    f32x16 acc[4][2];
#pragma unroll
    for (int a = 0; a < 4; ++a)
#pragma unroll
        for (int b = 0; b < 2; ++b)
#pragma unroll
            for (int r = 0; r < 16; ++r) acc[a][b][r] = 0.f;
    auto issue = [&](int t) {
        const bool first = t < nk0;
        const bf16_t* W = first ? s0.W : s1.W; const bf16_t* X = first ? s0.X : s1.X;
        const long wrs = first ? s0.wrs : s1.wrs, xrs = first ? s0.xrs : s1.xrs;
        const long wkhi = first ? s0.wkhi : s1.wkhi, xkhi = first ? s0.xkhi : s1.xkhi;
        const int kt = first ? t : t - nk0;
        const long kc = kt * 2 + (cch >> 1);
        const bf16_t* wp = W + (long)row0 * wrs + kc * wkhi + (cch & 1) * 8;
        const bf16_t* xp = X + (long)row0 * xrs + kc * xkhi + (cch & 1) * 8;
        char* st = lds + (t & 3) * 32768 + wave_s * 2048;
        __builtin_amdgcn_global_load_lds((const unsigned*)wp, (__attribute__((address_space(3))) unsigned*)(st), 16, 0, 0);
        __builtin_amdgcn_global_load_lds((const unsigned*)(wp + 16 * wrs), (__attribute__((address_space(3))) unsigned*)(st + 1024), 16, 0, 0);
        __builtin_amdgcn_global_load_lds((const unsigned*)xp, (__attribute__((address_space(3))) unsigned*)(st + 16384), 16, 0, 0);
        __builtin_amdgcn_global_load_lds((const unsigned*)(xp + 16 * xrs), (__attribute__((address_space(3))) unsigned*)(st + 16384 + 1024), 16, 0, 0);
    };
    const int sw = (lr >> 2) & 3;
    const int aoff = (wn * 128 + lr) * 64, boff = 16384 + (wm * 64 + lr) * 64;
    const int ch0 = ((0 + h) ^ sw) << 4, ch1 = ((2 + h) ^ sw) << 4;
    bf16x8 a0[4], b0[2], a1[4], b1[2];
    epi.pre(wm, lane, wn);
    issue(0); issue(1); issue(2); issue(3);
    asm volatile("s_waitcnt vmcnt(12)" ::: "memory");
    __builtin_amdgcn_s_barrier(); asm volatile("" ::: "memory");
#pragma unroll
    for (int nb = 0; nb < 4; ++nb) a0[nb] = *(const bf16x8*)(lds + aoff + nb * 2048 + ch0);
#pragma unroll
    for (int mb = 0; mb < 2; ++mb) b0[mb] = *(const bf16x8*)(lds + boff + mb * 2048 + ch0);
    for (int t = 0; t < nk; ++t) {
        const char* st = lds + (t & 3) * 32768;
#pragma unroll
        for (int nb = 0; nb < 4; ++nb) a1[nb] = *(const bf16x8*)(st + aoff + nb * 2048 + ch1);
#pragma unroll
        for (int mb = 0; mb < 2; ++mb) b1[mb] = *(const bf16x8*)(st + boff + mb * 2048 + ch1);
#pragma unroll
        for (int nb = 0; nb < 4; ++nb)
#pragma unroll
            for (int mb = 0; mb < 2; ++mb) acc[nb][mb] = __builtin_amdgcn_mfma_f32_32x32x16_bf16(a0[nb], b0[mb], acc[nb][mb], 0, 0, 0);
        const int rem = nk - 1 - t;
        if (rem >= 3) asm volatile("s_waitcnt vmcnt(8)" ::: "memory");
        else if (rem == 2) asm volatile("s_waitcnt vmcnt(4)" ::: "memory");
        else asm volatile("s_waitcnt vmcnt(0)" ::: "memory");
        asm volatile("s_waitcnt lgkmcnt(0)" ::: "memory");
        __builtin_amdgcn_s_barrier(); asm volatile("" ::: "memory");
        if (t + 4 < nk) issue(t + 4);
        if (t + 1 < nk) {
            const char* sn = lds + ((t + 1) & 3) * 32768;
#pragma unroll
            for (int nb = 0; nb < 4; ++nb) a0[nb] = *(const bf16x8*)(sn + aoff + nb * 2048 + ch0);
#pragma unroll
            for (int mb = 0; mb < 2; ++mb) b0[mb] = *(const bf16x8*)(sn + boff + mb * 2048 + ch0);
        }
#pragma unroll
        for (int nb = 0; nb < 4; ++nb)
#pragma unroll
            for (int mb = 0; mb < 2; ++mb) acc[nb][mb] = __builtin_amdgcn_mfma_f32_32x32x16_bf16(a1[nb], b1[mb], acc[nb][mb], 0, 0, 0);
    }
    TileCtx c; c.wn = wn; c.wm = wm; c.lane = lane;
    epi(acc, c);
}

template <int NPART>
__device__ __forceinline__ float rstd_from(const float* ssq, int token) {
    float v[NPART];
#pragma unroll
    for (int i = 0; i < NPART; ++i) v[i] = ssq[(size_t)i * L_SEQ + token];
    float s = 0.f;
#pragma unroll
    for (int i = 0; i < NPART; ++i) s += v[i];
    return rsqrtf(s * (1.0f / DM) + EPSV);
}

struct EpiSloc {
    float* dst;
    __device__ __forceinline__ void pre(int, int, int) {}
    __device__ __forceinline__ void operator()(f32x16 (&acc)[4][2], const TileCtx& c) const {
        if (c.wn != 0) return;
        const int lr = c.lane & 31, h = c.lane >> 5;
#pragma unroll
        for (int mb = 0; mb < 2; ++mb) { const int m = c.wm * 64 + mb * 32 + lr;
#pragma unroll
            for (int nb = 0; nb < 4; ++nb)
#pragma unroll
                for (int rq = 0; rq < 4; ++rq) { const int n = nb * 32 + rq * 8 + 4 * h;
                    f32x4 v = {acc[nb][mb][4 * rq], acc[nb][mb][4 * rq + 1], acc[nb][mb][4 * rq + 2], acc[nb][mb][4 * rq + 3]};
                    *(f32x4*)(dst + (size_t)m * 128 + n) = v; } }
    }
};

struct EpiS5 {
    const bf16_t* hn0; const float* dskip; bf16_t* z; int g; int n0;
    __device__ __forceinline__ void pre(int, int, int) {}
    __device__ __forceinline__ void operator()(f32x16 (&acc)[4][2], const TileCtx& c) const {
        const int lr = c.lane & 31, h = c.lane >> 5;
#pragma unroll
        for (int mb = 0; mb < 2; ++mb) { const int j = c.wm * 64 + mb * 32 + lr;
            u32x2 uu[16];
#pragma unroll
            for (int q = 0; q < 16; ++q) { const int n = n0 + c.wn * 128 + (q >> 2) * 32 + (q & 3) * 8 + 4 * h; uu[q] = *(const u32x2*)(hn0 + (size_t)(j * 64 + (n >> 4)) * DM + g * 16 + (n & 15)); }
            asm volatile("" ::: "memory");
#pragma unroll
            for (int q = 0; q < 16; ++q) { const int nb = q >> 2, rq = q & 3; const int n = n0 + c.wn * 128 + nb * 32 + rq * 8 + 4 * h; const int t = n >> 4, cc = n & 15;
                const size_t off = (size_t)(j * 64 + t) * DM + g * 16 + cc; const f32x4 d4 = *(const f32x4*)(dskip + g * 16 + cc);
                const float y0 = acc[nb][mb][4 * rq] + d4[0] * bf_lo(uu[q][0]), y1 = acc[nb][mb][4 * rq + 1] + d4[1] * bf_hi(uu[q][0]);
                const float y2 = acc[nb][mb][4 * rq + 2] + d4[2] * bf_lo(uu[q][1]), y3 = acc[nb][mb][4 * rq + 3] + d4[3] * bf_hi(uu[q][1]);
                u32x2 o; o[0] = pk_bf16(gelu_tanh(y0), gelu_tanh(y1)); o[1] = pk_bf16(gelu_tanh(y2), gelu_tanh(y3));
                *(u32x2*)(z + off) = o; }
            asm volatile("" ::: "memory"); }
    }
};

struct EpiGlu {
    const float* x; float* out; bf16_t* hb; float* ssq; int n0, m0;
    __device__ __forceinline__ void pre(int, int, int) {}
    __device__ __forceinline__ void operator()(f32x16 (&acc)[4][2], const TileCtx& c) const {
        const int lr = c.lane & 31, h = c.lane >> 5;
#pragma unroll
        for (int mb = 0; mb < 2; ++mb) { const int m = m0 + c.wm * 64 + mb * 32 + lr; float s = 0.f;
            const size_t rowoff = (size_t)m * DM + ((n0 + c.wn * 128) >> 1) + 4 * h;
            f32x4 xv[8];
#pragma unroll
            for (int q = 0; q < 8; ++q) xv[q] = *(const f32x4*)(x + rowoff + (q >> 1) * 16 + (q & 1) * 8);
            asm volatile("" ::: "memory");
#pragma unroll
            for (int q = 0; q < 8; ++q) { const int nb = q >> 1, rg = q & 1; const size_t off = rowoff + nb * 16 + rg * 8; f32x4 o;
#pragma unroll
                for (int e = 0; e < 4; ++e) { o[e] = xv[q][e] + acc[nb][mb][rg * 8 + e] * sigmoidf_(acc[nb][mb][rg * 8 + 4 + e]); s += o[e] * o[e]; }
                *(f32x4*)(out + off) = o; u32x2 b; b[0] = pk_bf16(o[0], o[1]); b[1] = pk_bf16(o[2], o[3]); *(u32x2*)(hb + off) = b; }
            asm volatile("" ::: "memory");
            s += __shfl_xor(s, 32);
            if (h == 0) ssq[(size_t)((n0 >> 8) * 2 + c.wn) * L_SEQ + m] = s; }
    }
};

template <int NPART> struct EpiUp {
    const float* ssq; bf16_t* act; int n0, m0; float rsv[2];
    __device__ __forceinline__ void pre(int wm, int lane, int) {
#pragma unroll
        for (int mb = 0; mb < 2; ++mb) rsv[mb] = rstd_from<NPART>(ssq, m0 + wm * 64 + mb * 32 + (lane & 31)); }
    __device__ __forceinline__ void operator()(f32x16 (&acc)[4][2], const TileCtx& c) const {
        const int lr = c.lane & 31, h = c.lane >> 5;
#pragma unroll
        for (int mb = 0; mb < 2; ++mb) { const int m = m0 + c.wm * 64 + mb * 32 + lr; const float rs = rsv[mb];
#pragma unroll
            for (int nb = 0; nb < 4; ++nb)
#pragma unroll
                for (int rg = 0; rg < 2; ++rg) { const int f = ((n0 + c.wn * 128 + nb * 32) >> 1) + rg * 8 + 4 * h; float o[4];
#pragma unroll
                    for (int e = 0; e < 4; ++e) { const float a = acc[nb][mb][rg * 8 + e] * rs, b = acc[nb][mb][rg * 8 + 4 + e] * rs; o[e] = a * sigmoidf_(a) * b; }
                    u32x2 bb; bb[0] = pk_bf16(o[0], o[1]); bb[1] = pk_bf16(o[2], o[3]); *(u32x2*)(act + (size_t)m * FFN + f) = bb; } }
    }
};

struct EpiRes {
    float* out; bf16_t* hb; float* ssq; int n0, m0;
    __device__ __forceinline__ void pre(int, int, int) {}
    __device__ __forceinline__ void operator()(f32x16 (&acc)[4][2], const TileCtx& c) const {
        const int lr = c.lane & 31, h = c.lane >> 5;
#pragma unroll
        for (int mb = 0; mb < 2; ++mb) { const int m = m0 + c.wm * 64 + mb * 32 + lr; float s = 0.f;
            const size_t rowoff = (size_t)m * DM + n0 + c.wn * 128 + 4 * h;
#pragma unroll
            for (int np = 0; np < 2; ++np) {
                f32x4 o[8];
#pragma unroll
                for (int q = 0; q < 8; ++q) o[q] = *(const f32x4*)(out + rowoff + (np * 2 + (q >> 2)) * 32 + (q & 3) * 8);
                asm volatile("" ::: "memory");
#pragma unroll
                for (int q = 0; q < 8; ++q) { const int nb = np * 2 + (q >> 2), rq = q & 3; const size_t off = rowoff + nb * 32 + rq * 8;
#pragma unroll
                    for (int e = 0; e < 4; ++e) { o[q][e] += acc[nb][mb][4 * rq + e]; s += o[q][e] * o[q][e]; }
                    *(f32x4*)(out + off) = o[q];
                    if (hb) { u32x2 b; b[0] = pk_bf16(o[q][0], o[q][1]); b[1] = pk_bf16(o[q][2], o[q][3]); *(u32x2*)(hb + off) = b; } }
                asm volatile("" ::: "memory");
            }
            s += __shfl_xor(s, 32);
            if (h == 0) ssq[(size_t)((n0 >> 8) * 2 + c.wn) * L_SEQ + m] = s; }
    }
};

struct EpiKvq {
    const float* ssq; char* ws; int n0, m0; float rsv[2];
    __device__ __forceinline__ void pre(int wm, int lane, int) {
#pragma unroll
        for (int mb = 0; mb < 2; ++mb) rsv[mb] = rstd_from<8>(ssq, m0 + wm * 64 + mb * 32 + (lane & 31)); }
    __device__ __forceinline__ void operator()(f32x16 (&acc)[4][2], const TileCtx& c) const {
        const int lr = c.lane & 31, h = c.lane >> 5;
        const bool isV = (n0 >= 1024 && n0 < 2048);
#pragma unroll
        for (int mb = 0; mb < 2; ++mb) { const int m = m0 + c.wm * 64 + mb * 32 + lr; const float rs = rsv[mb];
            if (isV) {
                const int mp = (m & ~12) | ((m & 4) << 1) | ((m & 8) >> 1);
                bf16_t* vt = (bf16_t*)(ws + OFF_VT);
#pragma unroll
                for (int nb = 0; nb < 4; ++nb)
#pragma unroll
                    for (int r = 0; r < 16; ++r) { const int nl = n0 - 1024 + c.wn * 128 + nb * 32 + (r & 3) + 8 * (r >> 2) + 4 * h;
                        vt[(size_t)nl * L_SEQ + mp] = (bf16_t)(pk_bf16(acc[nb][mb][r] * rs, 0.f) & 0xffffu); }
            } else {
                size_t base; int nl;
                if (n0 < 512) { base = OFF_K1; nl = n0; } else if (n0 < 1024) { base = OFF_K2; nl = n0 - 512; } else if (n0 < 2560) { base = OFF_Q1; nl = n0 - 2048; } else { base = OFF_Q2; nl = n0 - 2560; }
                bf16_t* dst = (bf16_t*)(ws + base);
                float cs[4], sn[4];
#pragma unroll
                for (int e = 0; e < 4; ++e) { const int i = 4 * h + e;
                    const float invf = (i == 0) ? 1.0f : (i == 1) ? 0.19391188f : (i == 2) ? 0.037601817f : (i == 3) ? 0.0072914392f : (i == 4) ? 0.0014142136f : (i == 5) ? 0.00027423282f : (i == 6) ? 5.3176997e-05f : 1.0311653e-05f;
                    const float ang = (float)m * invf; double rev = (double)ang * 0.15915494309189535; rev -= rint(rev); const float fr = (float)rev;
                    cs[e] = __builtin_amdgcn_cosf(fr); sn[e] = __builtin_amdgcn_sinf(fr); }
#pragma unroll
                for (int nb = 0; nb < 4; ++nb) {
                    const int nn = nl + c.wn * 128 + nb * 32; const int head = nn >> 6, d0 = nn & 63;
                    float v[16];
#pragma unroll
                    for (int r = 0; r < 16; ++r) v[r] = acc[nb][mb][r] * rs;
                    if (d0 == 0) {
#pragma unroll
                        for (int e = 0; e < 4; ++e) { const float x1 = v[e], x2 = v[4 + e]; v[e] = x1 * cs[e] - x2 * sn[e]; v[4 + e] = x2 * cs[e] + x1 * sn[e]; }
                    }
#pragma unroll
                    for (int rq = 0; rq < 4; ++rq) { u32x2 b; b[0] = pk_bf16(v[4 * rq], v[4 * rq + 1]); b[1] = pk_bf16(v[4 * rq + 2], v[4 * rq + 3]);
                        *(u32x2*)(dst + ((size_t)head * L_SEQ + m) * 64 + d0 + rq * 8 + 4 * h) = b; }
                }
            } }
    }
};

__device__ __forceinline__ void s5_tables(const int wave_s, const Params& p, int g, char* lds) {
    f32x2* apow = (f32x2*)lds;
    f32x2* bb = apow + 65 * 64;
    f32x2* cc = bb + 1024;
    f32x2* zf = cc + 1024;
    int tid = get_tid(wave_s); asm volatile("" : "+v"(tid));
    const float dt = expf(p.log_dt[g]);
    for (int e = tid; e < 65 * 64; e += NTHREADS) {
        const int lag = e >> 6, pp = e & 63;
        const float lr = p.lam_re[g * 64 + pp], li = p.lam_im[g * 64 + pp];
        const float mag = expf(lr * dt * (float)lag);
        double rev = (double)li * (double)dt * (double)lag * 0.15915494309189535; rev -= rint(rev);
        const float fr = (float)rev;
        f32x2 v; v[0] = mag * __builtin_amdgcn_cosf(fr); v[1] = mag * __builtin_amdgcn_sinf(fr); apow[e] = v;
    }
    if (tid < 64) {
        const float lr = p.lam_re[g * 64 + tid], li = p.lam_im[g * 64 + tid];
        const float em1 = expm1f(lr * dt);
        double rev = (double)li * (double)dt * 0.15915494309189535; const double rh = rev * 0.5; rev -= rint(rev);
        const double rh2 = rh - rint(rh);
        const float cth = __builtin_amdgcn_cosf((float)rev), sth = __builtin_amdgcn_sinf((float)rev), shalf = __builtin_amdgcn_sinf((float)rh2);
        const float nr = em1 * cth - 2.0f * shalf * shalf, ni = (1.0f + em1) * sth;
        const float den = lr * lr + li * li;
        f32x2 f; f[0] = (nr * lr + ni * li) / den; f[1] = (ni * lr - nr * li) / den; zf[tid] = f;
    }
    __syncthreads();
    for (int e = tid; e < 1024; e += NTHREADS) {
        const int pp = e >> 4;
        const float br = p.b_re[(size_t)g * 1024 + e], bi = p.b_im[(size_t)g * 1024 + e];
        const f32x2 f = zf[pp]; f32x2 v; v[0] = f[0] * br - f[1] * bi; v[1] = f[0] * bi + f[1] * br; bb[e] = v;
        f32x2 cv; cv[0] = p.c_re[(size_t)g * 1024 + e]; cv[1] = p.c_im[(size_t)g * 1024 + e]; cc[e] = cv;
    }
    __syncthreads();
    bf16_t* kt = (bf16_t*)(p.ws + OFF_KT) + (size_t)g * 127 * 256;
    bf16_t* w1 = (bf16_t*)(p.ws + OFF_W1) + (size_t)g * 128 * 1024;
    bf16_t* w3 = (bf16_t*)(p.ws + OFF_W3) + (size_t)g * 1024 * 128;
    {
        const int cp = tid & 255, c = cp >> 4, c2 = cp & 15, half = tid >> 8;
        float acc[32];
#pragma unroll
        for (int l = 0; l < 32; ++l) acc[l] = 0.f;
        for (int pp = 0; pp < 64; ++pp) {
            const f32x2 cv = cc[c * 64 + pp], bv = bb[pp * 16 + c2];
            const float cbr = cv[0] * bv[0] - cv[1] * bv[1], cbi = cv[0] * bv[1] + cv[1] * bv[0];
#pragma unroll
            for (int l = 0; l < 32; ++l) { const f32x2 a = apow[(half * 32 + l) * 64 + pp]; acc[l] += cbr * a[0] - cbi * a[1]; }
        }
#pragma unroll
        for (int l = 0; l < 32; ++l) kt[(size_t)(63 + half * 32 + l) * 256 + cp] = (bf16_t)(pk_bf16(acc[l], 0.f) & 0xffffu);
        for (int e = tid; e < 63 * 256 / 8; e += NTHREADS) { u32x4 zz = {0u, 0u, 0u, 0u}; *(u32x4*)(kt + e * 8) = zz; }
    }
    for (int q = tid; q < 128 * 128; q += NTHREADS) {
        const int pq = q >> 7, kc = q & 127, tau = kc >> 1, c0 = (kc & 1) * 8, pp = pq & 63, im = pq >> 6;
        const f32x2 a = apow[(63 - tau) * 64 + pp]; float v[8];
#pragma unroll
        for (int e = 0; e < 8; ++e) { const f32x2 b = bb[pp * 16 + c0 + e]; v[e] = im ? (a[0] * b[1] + a[1] * b[0]) : (a[0] * b[0] - a[1] * b[1]); }
        u32x4 o; o[0] = pk_bf16(v[0], v[1]); o[1] = pk_bf16(v[2], v[3]); o[2] = pk_bf16(v[4], v[5]); o[3] = pk_bf16(v[6], v[7]);
        *(u32x4*)(w1 + (size_t)pq * 1024 + kc * 8) = o;
    }
    for (int q = tid; q < 1024 * 16; q += NTHREADS) {
        const int n = q >> 4, p0 = (q & 15) * 8, t = n >> 4, c = n & 15, im = p0 >> 6; float v[8];
#pragma unroll
        for (int e = 0; e < 8; ++e) { const int pp = (p0 + e) & 63; const f32x2 a = apow[(t + 1) * 64 + pp]; const f32x2 cv = cc[c * 64 + pp];
            v[e] = im ? -(cv[0] * a[1] + cv[1] * a[0]) : (cv[0] * a[0] - cv[1] * a[1]); }
        u32x4 o; o[0] = pk_bf16(v[0], v[1]); o[1] = pk_bf16(v[2], v[3]); o[2] = pk_bf16(v[4], v[5]); o[3] = pk_bf16(v[6], v[7]);
        *(u32x4*)(w3 + (size_t)n * 128 + p0) = o;
    }
    if (tid < 64) ((f32x2*)(p.ws + OFF_A64))[g * 64 + tid] = apow[64 * 64 + tid];
    __syncthreads();
}

__device__ __forceinline__ void wtile(const int wave_s, const Params& p, int t, char* lds) {
    int j = 0;
    for (int i = 1; i < p.njobs; ++i) if (t >= p.jobs[i].tile0) j = i;
    const WJob& J = p.jobs[j];
    const int lt = t - J.tile0, kt = lt / J.ntn, nt = lt - kt * J.ntn;
    const int k0 = kt * 64, nl0 = nt * 64;
    float* T = (float*)lds;
    int tid = get_tid(wave_s); asm volatile("" : "+v"(tid));
#pragma unroll
    for (int i = 0; i < 2; ++i) { const int kk = i * 32 + (tid >> 4), n4 = (tid & 15) * 4;
        f32x4 v = *(const f32x4*)(J.src + (size_t)(k0 + kk) * J.ldsrc + J.col0 + nl0 + n4);
        float sc = J.scale; if (J.gain) sc *= J.gain[k0 + kk];
        T[kk * 65 + n4] = v[0] * sc; T[kk * 65 + n4 + 1] = v[1] * sc; T[kk * 65 + n4 + 2] = v[2] * sc; T[kk * 65 + n4 + 3] = v[3] * sc; }
    __syncthreads();
    { const int nn = tid >> 3, kc = (tid & 7) * 8; float v[8];
#pragma unroll
        for (int e = 0; e < 8; ++e) v[e] = T[(kc + e) * 65 + nn];
        const int n = nl0 + nn; int row = (J.mode == 0) ? n : ((n >> 3) * 16 + (n & 7) + (J.mode == 2 ? 8 : 0)); row += J.rowoff;
        u32x4 o; o[0] = pk_bf16(v[0], v[1]); o[1] = pk_bf16(v[2], v[3]); o[2] = pk_bf16(v[4], v[5]); o[3] = pk_bf16(v[6], v[7]);
        *(u32x4*)(J.dst + (size_t)row * J.K + k0 + kc) = o; }
    __syncthreads();
}

__device__ __forceinline__ void rms0_item(const int wave_s, const Params& p, int item) {
    const int lane = get_tid(wave_s) & 63, wid = wave_s;
    bf16_t* hn0 = (bf16_t*)(p.ws + OFF_HN0);
    for (int r = 0; r < 8; ++r) {
        const int row = item * 64 + wid * 8 + r;
        f32x4 v[4]; float s = 0.f;
#pragma unroll
        for (int i = 0; i < 4; ++i) { v[i] = *(const f32x4*)(p.x + (size_t)row * DM + lane * 4 + 256 * i); s += v[i][0] * v[i][0] + v[i][1] * v[i][1] + v[i][2] * v[i][2] + v[i][3] * v[i][3]; }
#pragma unroll
        for (int o = 32; o >= 1; o >>= 1) s += __shfl_xor(s, o);
        const float rs = rsqrtf(s * (1.0f / DM) + EPSV);
#pragma unroll
        for (int i = 0; i < 4; ++i) { const f32x4 g = *(const f32x4*)(p.norm_mix_g + lane * 4 + 256 * i);
            u32x2 o; o[0] = pk_bf16(v[i][0] * rs * g[0], v[i][1] * rs * g[1]); o[1] = pk_bf16(v[i][2] * rs * g[2], v[i][3] * rs * g[3]);
            *(u32x2*)(hn0 + (size_t)row * DM + lane * 4 + 256 * i) = o; }
    }
}

__device__ __forceinline__ void attn_item(const int wave_s, const Params& p, int head, int qb, float lam, char* lds) {
    int tid = get_tid(wave_s); asm volatile("" : "+v"(tid));
    const int lane = tid & 63, wid = tid >> 6;
    const int mp = wid >> 2, g = wid & 3;
    const int lr = lane & 31, h = lane >> 5, sw = (lane >> 1) & 7;
    const bf16_t* K1 = (const bf16_t*)(p.ws + OFF_K1) + (size_t)head * L_SEQ * 64;
    const bf16_t* K2 = (const bf16_t*)(p.ws + OFF_K2) + (size_t)head * L_SEQ * 64;
    const bf16_t* VT = (const bf16_t*)(p.ws + OFF_VT) + (size_t)head * 128 * L_SEQ;
    const bf16_t* Q = (const bf16_t*)(p.ws + (mp ? OFF_Q2 : OFF_Q1)) + (size_t)head * L_SEQ * 64;
    const int q0 = qb * 128 + g * 32;
    bf16x8 qf[4];
#pragma unroll
    for (int s = 0; s < 4; ++s) qf[s] = *(const bf16x8*)(Q + (size_t)(q0 + lr) * 64 + 16 * s + 8 * h);
    const int nkt = 2 * qb + 2;
    const int my_last = 2 * qb + (g >> 1);
    f32x16 O[4];
#pragma unroll
    for (int e = 0; e < 4; ++e)
#pragma unroll
        for (int r = 0; r < 16; ++r) O[e][r] = 0.f;
    float m_run = -1e30f, l_run = 0.f;
    const int lrow = lane >> 3;
    const int ck = (lane & 7) ^ (((wave_s & 1) * 4 + (lane >> 4)) & 7);
    const int cv0 = (lane & 7) ^ (lane >> 4), cv1 = (lane & 7) ^ (4 + (lane >> 4));
    const bf16_t* k1p = K1 + (size_t)(wave_s * 8 + lrow) * 64 + ck * 8;
    const bf16_t* k2p = K2 + (size_t)(wave_s * 8 + lrow) * 64 + ck * 8;
    const bf16_t* v0p = VT + (size_t)(wave_s * 16 + lrow) * L_SEQ + cv0 * 8;
    const bf16_t* v1p = VT + (size_t)(wave_s * 16 + 8 + lrow) * L_SEQ + cv1 * 8;
    auto issue = [&](int kt) {
        char* st = lds + (kt & 3) * 32768;
        __builtin_amdgcn_global_load_lds((const unsigned*)(k1p + (size_t)kt * 4096), (__attribute__((address_space(3))) unsigned*)(st + wave_s * 1024), 16, 0, 0);
        __builtin_amdgcn_global_load_lds((const unsigned*)(k2p + (size_t)kt * 4096), (__attribute__((address_space(3))) unsigned*)(st + 8192 + wave_s * 1024), 16, 0, 0);
        __builtin_amdgcn_global_load_lds((const unsigned*)(v0p + kt * 64), (__attribute__((address_space(3))) unsigned*)(st + 16384 + wave_s * 2048), 16, 0, 0);
        __builtin_amdgcn_global_load_lds((const unsigned*)(v1p + kt * 64), (__attribute__((address_space(3))) unsigned*)(st + 16384 + wave_s * 2048 + 1024), 16, 0, 0);
    };
    issue(0); issue(1);
    if (nkt > 2) issue(2);
    if (nkt > 2) asm volatile("s_waitcnt vmcnt(8)" ::: "memory");
    else asm volatile("s_waitcnt vmcnt(4)" ::: "memory");
    __builtin_amdgcn_s_barrier(); asm volatile("" ::: "memory");
    const int koff_ = mp * 8192 + lr * 128, voff_ = 16384 + lr * 128;
    int chk[4], chv[4];
#pragma unroll
    for (int s = 0; s < 4; ++s) { chk[s] = ((2 * s + h) ^ sw) << 4; chv[s] = chk[s]; }
    bf16x8 kf[8], vf[8];
#pragma unroll
    for (int i = 0; i < 8; ++i) kf[i] = *(const bf16x8*)(lds + koff_ + (i >> 2) * 4096 + chk[i & 3]);
    for (int kt = 0; kt < nkt; ++kt) {
        const bool active = kt <= my_last;
        const char* stg = lds + (kt & 3) * 32768;
        f32x16 S[2];
        bf16x8 pf[2][2];
        if (active) {
#pragma unroll
            for (int kb = 0; kb < 2; ++kb) {
#pragma unroll
                for (int r = 0; r < 16; ++r) S[kb][r] = 0.f;
#pragma unroll
                for (int s = 0; s < 4; ++s) S[kb] = __builtin_amdgcn_mfma_f32_32x32x16_bf16(kf[kb * 4 + s], qf[s], S[kb], 0, 0, 0);
            }
#pragma unroll
            for (int i = 0; i < 8; ++i) vf[i] = *(const bf16x8*)(stg + voff_ + (i & 3) * 4096 + chv[i >> 2]);
            __builtin_amdgcn_sched_barrier(0);
            float mt = S[0][0];
#pragma unroll
            for (int r = 1; r < 16; ++r) mt = fmaxf(mt, S[0][r]);
#pragma unroll
            for (int r = 0; r < 16; ++r) mt = fmaxf(mt, S[1][r]);
            mt = fmaxf(mt, __shfl_xor(mt, 32));
            const bool need = mt > m_run + 8.0f;
            if (__any(need)) {
                const float mnew = need ? mt : m_run;
                const float alpha = fast_exp2(m_run - mnew);
                m_run = mnew; l_run *= alpha;
#pragma unroll
                for (int e = 0; e < 4; ++e)
#pragma unroll
                    for (int r = 0; r < 16; ++r) O[e][r] *= alpha;
            }
            float ls = 0.f;
#pragma unroll
            for (int kb = 0; kb < 2; ++kb)
#pragma unroll
                for (int s = 0; s < 2; ++s) { float e_[8];
#pragma unroll
                    for (int j = 0; j < 8; ++j) { e_[j] = fast_exp2(S[kb][8 * s + j] - m_run); ls += e_[j]; }
                    u32x4 pk; pk[0] = pk_bf16(e_[0], e_[1]); pk[1] = pk_bf16(e_[2], e_[3]); pk[2] = pk_bf16(e_[4], e_[5]); pk[3] = pk_bf16(e_[6], e_[7]);
                    pf[kb][s] = __builtin_bit_cast(bf16x8, pk); }
            l_run += ls;
        }
        const int rem = nkt - 1 - kt;
        if (rem >= 2) asm volatile("s_waitcnt vmcnt(4)" ::: "memory");
        else asm volatile("s_waitcnt vmcnt(0)" ::: "memory");
        __builtin_amdgcn_s_barrier(); asm volatile("" ::: "memory");
        if (kt + 3 < nkt) issue(kt + 3);
        if (kt + 1 <= my_last) {
            const char* sn = lds + ((kt + 1) & 3) * 32768;
#pragma unroll
            for (int i = 0; i < 8; ++i) kf[i] = *(const bf16x8*)(sn + koff_ + (i >> 2) * 4096 + chk[i & 3]);
        }
        __builtin_amdgcn_sched_barrier(0);
        if (active) {
#pragma unroll
            for (int i = 0; i < 8; ++i) O[i & 3] = __builtin_amdgcn_mfma_f32_32x32x16_bf16(vf[i], pf[0][i >> 2], O[i & 3], 0, 0, 0);
#pragma unroll
            for (int i = 0; i < 8; ++i) vf[i] = *(const bf16x8*)(stg + voff_ + (i & 3) * 4096 + (((4 + 2 * (i >> 2) + h) ^ sw) << 4));
#pragma unroll
            for (int i = 0; i < 8; ++i) O[i & 3] = __builtin_amdgcn_mfma_f32_32x32x16_bf16(vf[i], pf[1][i >> 2], O[i & 3], 0, 0, 0);
        }
    }
    __syncthreads();
    const float lt = l_run + __shfl_xor(l_run, 32);
    const float inv = fast_rcp(lt) * (mp ? lam : 1.0f);
    float* ex = (float*)lds;
    if (mp == 1) {
#pragma unroll
        for (int e = 0; e < 4; ++e)
#pragma unroll
            for (int r = 0; r < 16; ++r) ex[((g * 4 + e) * 16 + r) * 64 + lane] = O[e][r] * inv;
    }
    __syncthreads();
    if (mp == 0) {
        float ss = 0.f;
#pragma unroll
        for (int e = 0; e < 4; ++e)
#pragma unroll
            for (int r = 0; r < 16; ++r) { const float o = O[e][r] * inv - ex[((g * 4 + e) * 16 + r) * 64 + lane]; O[e][r] = o; ss += o * o; }
        ss += __shfl_xor(ss, 32);
        const float rs = rsqrtf(ss * (1.0f / 128.0f) + EPSV) * (1.0f - LAM_INIT);
        bf16_t* on = (bf16_t*)(p.ws + OFF_ON) + (size_t)(q0 + lr) * DM + head * 128;
#pragma unroll
        for (int e = 0; e < 4; ++e)
#pragma unroll
            for (int rq = 0; rq < 4; ++rq) { const int ee = e * 32 + rq * 8 + 4 * h; const f32x4 gg = *(const f32x4*)(p.subln_g + ee);
                u32x2 b; b[0] = pk_bf16(O[e][4 * rq] * rs * gg[0], O[e][4 * rq + 1] * rs * gg[1]); b[1] = pk_bf16(O[e][4 * rq + 2] * rs * gg[2], O[e][4 * rq + 3] * rs * gg[3]);
                *(u32x2*)(on + ee) = b; }
    }
    __syncthreads();
}


__device__ __forceinline__ void gbar(const int wave_s, unsigned* ctr, unsigned target) {
    __syncthreads();
    if (get_tid(wave_s) == 0) {
        __builtin_amdgcn_fence(__ATOMIC_RELEASE, "agent");
        asm volatile("s_waitcnt vmcnt(0)" ::: "memory");
        __hip_atomic_fetch_add(ctr, 1u, __ATOMIC_RELAXED, __HIP_MEMORY_SCOPE_AGENT);
        while (__hip_atomic_load(ctr, __ATOMIC_RELAXED, __HIP_MEMORY_SCOPE_AGENT) < target) __builtin_amdgcn_s_sleep(2);
        __builtin_amdgcn_fence(__ATOMIC_ACQUIRE, "agent");
        asm volatile("s_waitcnt vmcnt(0)" ::: "memory");
    }
    __syncthreads();
}


__device__ __forceinline__ bool tile_map(int r, int bid, int nb, int NT, int& nt, int& mt) {
    if (nb == 256) {
        const int x = bid & 7, li = bid >> 3, q = li + 32 * r;
        if (q >= 8 * NT) return false;
        const int mi = q & 3, rest = q >> 2, mg = rest / NT;
        nt = rest - mg * NT; mt = x * 8 + mg * 4 + mi; return true;
    }
    const int t = bid + r * nb; if (t >= NT * 64) return false;
    nt = t % NT; mt = t / NT; return true;
}

__global__ void __launch_bounds__(NTHREADS) mega(const Params p) {
    __shared__ __attribute__((aligned(16))) char lds[LDS_BYTES];
    cg::grid_group grid = cg::this_grid();
    const int wave_s = __builtin_amdgcn_readfirstlane((int)(threadIdx.x >> 6));
    const int nb = gridDim.x, bid = blockIdx.x;
    char* ws = p.ws;
    bf16_t* hn0 = (bf16_t*)(ws + OFF_HN0);
    bf16_t* hb = (bf16_t*)(ws + OFF_HB);
    float* ssq0 = (float*)(ws + OFF_SSQ);
    float* ssq1 = ssq0 + 16 * L_SEQ; float* ssq2 = ssq1 + 16 * L_SEQ; float* ssq3 = ssq2 + 16 * L_SEQ;
    const Seg nul = {nullptr, 0, 0, nullptr, 0, 0};
    unsigned* bar = (unsigned*)(ws + OFF_BAR); unsigned nbar = 0;

    { const int nitems = 64 + p.ntiles_w + 256;
      for (int rep = 0; rep < REP_PREP; ++rep)
      for (int it = bid; it < nitems; it += nb) {
          if (it < 64) s5_tables(wave_s, p, it, lds);
          else if (it < 64 + p.ntiles_w) wtile(wave_s, p, it - 64, lds);
          else rms0_item(wave_s, p, it - 64 - p.ntiles_w);
      } }
    grid.sync();
    for (int rep = 0; rep < REP_SLOC; ++rep)
    for (int g = bid; g < 64; g += nb) {
        Seg s = {(const bf16_t*)(ws + OFF_W1) + (size_t)g * 128 * 1024, 1024, 16, hn0 + g * 16, 65536, 1024};
        EpiSloc e = {(float*)(ws + OFF_SLOC) + (size_t)g * 256 * 128};
        gemm_tile(wave_s, lds, s, 16, nul, 0, e);
    }
    gbar(wave_s, bar, (unsigned)nb * (++nbar));
    for (int rep = 0; rep < REP_S5; ++rep)
    for (int t0 = bid; t0 < 256; t0 += nb) {
        const int t = (nb == 256) ? ((t0 & 7) * 32 + (t0 >> 3)) : t0;
        const int g = t >> 2, i = 3 - (t & 3);
        bf16_t* sprev = (bf16_t*)(ws + OFF_SPREV) + (size_t)t * 256 * 128;
        {
            const int lane_ = get_tid(wave_s) & 63, w_ = wave_s;
            const f32x2 a = ((const f32x2*)(ws + OFF_A64))[g * 64 + lane_];
            const float* sl = (const float*)(ws + OFF_SLOC) + (size_t)g * 256 * 128 + (size_t)(w_ * 32) * 128;
            float xr[32], xi[32];
#pragma unroll
            for (int j = 0; j < 32; ++j) { xr[j] = sl[j * 128 + lane_]; xi[j] = sl[j * 128 + 64 + lane_]; }
            float sr = 0.f, si = 0.f;
#pragma unroll
            for (int j = 0; j < 32; ++j) { const float nr = a[0] * sr - a[1] * si + xr[j], ni = a[0] * si + a[1] * sr + xi[j]; sr = nr; si = ni; }
            f32x2* carry = (f32x2*)lds;
            { f32x2 c; c[0] = sr; c[1] = si; carry[w_ * 64 + lane_] = c; }
            float pr = a[0], pi = a[1];
#pragma unroll
            for (int q = 0; q < 5; ++q) { const float nr = pr * pr - pi * pi, ni = 2.f * pr * pi; pr = nr; pi = ni; }
            __syncthreads();
#pragma unroll
            for (int j = 0; j < 32; ++j) { xr[j] = __builtin_nontemporal_load(sl + j * 128 + lane_); xi[j] = __builtin_nontemporal_load(sl + j * 128 + 64 + lane_); }
            sr = 0.f; si = 0.f;
            for (int v = 0; v < w_; ++v) { const f32x2 c = carry[v * 64 + lane_]; const float nr = pr * sr - pi * si + c[0], ni = pr * si + pi * sr + c[1]; sr = nr; si = ni; }
            bf16_t* sp = sprev + (size_t)(w_ * 32) * 128;
#pragma unroll
            for (int j = 0; j < 32; ++j) {
                sp[j * 128 + lane_] = (bf16_t)(pk_bf16(sr, 0.f) & 0xffffu); sp[j * 128 + 64 + lane_] = (bf16_t)(pk_bf16(si, 0.f) & 0xffffu);
                const float nr = a[0] * sr - a[1] * si + xr[j], ni = a[0] * si + a[1] * sr + xi[j]; sr = nr; si = ni;
            }
            __threadfence();
        }
        __syncthreads();
        Seg s0 = {(const bf16_t*)(ws + OFF_KT) + (size_t)g * 127 * 256 + 63 * 256 + (size_t)(i * 256) * 16, 16, -256, hn0 + g * 16, 65536, 1024};
        Seg s1 = {(const bf16_t*)(ws + OFF_W3) + (size_t)g * 1024 * 128 + (size_t)(i * 256) * 128, 128, 16, sprev, 128, 16};
        EpiS5 e = {hn0, p.ssm_d, (bf16_t*)(ws + OFF_Z), g, i * 256};
        gemm_tile(wave_s, lds, s0, 4 * (i + 1), s1, 2, e);
    }
    gbar(wave_s, bar, (unsigned)nb * (++nbar));
    for (int rep = 0; rep < REP_GLU; ++rep)
    for (int r = 0, nt, mt; tile_map(r, bid, nb, 8, nt, mt); ++r) {
        Seg s = {(const bf16_t*)(ws + OFF_WGLU) + (size_t)nt * 256 * DM, DM, 16, (const bf16_t*)(ws + OFF_Z) + (size_t)mt * 256 * DM, DM, 16};
        EpiGlu e = {p.x, p.out, hb, ssq0, nt * 256, mt * 256};
        gemm_tile(wave_s, lds, s, 16, nul, 0, e);
    }
    gbar(wave_s, bar, (unsigned)nb * (++nbar));
#pragma unroll
    for (int layer = 0; layer < 2; ++layer) {
        if (layer == 1) {
            for (int rep = 0; rep < REP_KVQ; ++rep)
            for (int r = 0, nt, mt; tile_map(r, bid, nb, 12, nt, mt); ++r) {
                Seg s = {(const bf16_t*)(ws + OFF_WKVQ) + (size_t)nt * 256 * DM, DM, 16, hb + (size_t)mt * 256 * DM, DM, 16};
                EpiKvq e = {ssq1, ws, nt * 256, mt * 256, {0.f, 0.f}};
                gemm_tile(wave_s, lds, s, 16, nul, 0, e);
            }
            gbar(wave_s, bar, (unsigned)nb * (++nbar));
            {
                float a1 = 0.f, a2 = 0.f;
                for (int i = 0; i < 64; ++i) { a1 += p.lq1[i] * p.lk1[i]; a2 += p.lq2[i] * p.lk2[i]; }
                const float lam = expf(a1) - expf(a2) + LAM_INIT;
                for (int rep = 0; rep < REP_ATTN; ++rep)
                for (int it = bid; it < 1024; it += nb) {
                    const int head = it & 7, r = it >> 3, rnd = r >> 5, j = r & 31;
                    const int qb = (rnd == 0) ? 127 - j : (rnd == 1) ? 64 + j : (rnd == 2) ? 63 - j : j;
                    attn_item(wave_s, p, head, qb, lam, lds);
                }
            }
            gbar(wave_s, bar, (unsigned)nb * (++nbar));
            for (int r = 0, nt, mt; tile_map(r, bid, nb, 4, nt, mt); ++r) {
                Seg s = {(const bf16_t*)(ws + OFF_WO) + (size_t)nt * 256 * DM, DM, 16, (const bf16_t*)(ws + OFF_ON) + (size_t)mt * 256 * DM, DM, 16};
                EpiRes e = {p.out, hb, ssq2, nt * 256, mt * 256};
                gemm_tile(wave_s, lds, s, 16, nul, 0, e);
            }
            gbar(wave_s, bar, (unsigned)nb * (++nbar));
        }
        {
            const bf16_t* wup = (const bf16_t*)(ws + (layer ? OFF_WUP1 : OFF_WUP0));
            for (int rep = 0; rep < REP_UP; ++rep)
            for (int r = 0, nt, mt; tile_map(r, bid, nb, 22, nt, mt); ++r) {
                Seg s = {wup + (size_t)nt * 256 * DM, DM, 16, hb + (size_t)mt * 256 * DM, DM, 16};
                if (layer == 0) { EpiUp<16> e = {ssq0, (bf16_t*)(ws + OFF_ACT), nt * 256, mt * 256, {0.f, 0.f}}; gemm_tile(wave_s, lds, s, 16, nul, 0, e); }
                else { EpiUp<8> e = {ssq2, (bf16_t*)(ws + OFF_ACT), nt * 256, mt * 256, {0.f, 0.f}}; gemm_tile(wave_s, lds, s, 16, nul, 0, e); }
            }
        }
        gbar(wave_s, bar, (unsigned)nb * (++nbar));
        {
            const bf16_t* wdn = (const bf16_t*)(ws + (layer ? OFF_WDN1 : OFF_WDN0));
            for (int r = 0, nt, mt; tile_map(r, bid, nb, 4, nt, mt); ++r) {
                Seg s = {wdn + (size_t)nt * 256 * FFN, FFN, 16, (const bf16_t*)(ws + OFF_ACT) + (size_t)mt * 256 * FFN, FFN, 16};
                EpiRes e = {p.out, layer ? (bf16_t*)nullptr : hb, layer ? ssq3 : ssq1, nt * 256, mt * 256};
                gemm_tile(wave_s, lds, s, FFN / 64, nul, 0, e);
            }
        }
        gbar(wave_s, bar, (unsigned)nb * (++nbar));
    }
    {
        const int lane = get_tid(wave_s) & 63, wid = wave_s;
        for (int row = bid * 8 + wid; row < L_SEQ; row += nb * 8) {
            float s = 0.f;
            for (int i = 0; i < 8; ++i) s += ssq3[(size_t)i * L_SEQ + row];
            const float rs = rsqrtf(s * (1.0f / DM) + EPSV);
#pragma unroll
            for (int i = 0; i < 4; ++i) { const size_t off = (size_t)row * DM + lane * 4 + 256 * i;
                f32x4 v = *(const f32x4*)(p.out + off); const f32x4 g = *(const f32x4*)(p.final_g + lane * 4 + 256 * i);
                v[0] *= rs * g[0]; v[1] *= rs * g[1]; v[2] *= rs * g[2]; v[3] *= rs * g[3]; *(f32x4*)(p.out + off) = v; }
        }
    }
}

static void add_job(Params& P, int& nt, const float* src, bf16_t* dst, const float* gain, int K, int N, int ld, int col0, int mode, int rowoff, float scale) {
    WJob& J = P.jobs[P.njobs++];
    J.src = src; J.dst = dst; J.gain = gain; J.K = K; J.N = N; J.ldsrc = ld; J.col0 = col0; J.mode = mode; J.rowoff = rowoff; J.scale = scale; J.tile0 = nt; J.ntn = N / 64; J.pad = 0;
    nt += (K / 64) * (N / 64);
}

extern "C" void kernel_launch(void* const* d_in, const int* in_sizes, int n_in, void* d_out, int out_size, void* d_ws, size_t ws_size, hipStream_t stream) {
    Params P; memset(&P, 0, sizeof(P));
    P.x = (const float*)d_in[0]; P.norm_mix_g = (const float*)d_in[1]; P.norm_ffn_g = (const float*)d_in[2];
    P.ffn_w1 = (const float*)d_in[3]; P.ffn_w3 = (const float*)d_in[4]; P.ffn_w2 = (const float*)d_in[5];
    P.lam_re = (const float*)d_in[6]; P.lam_im = (const float*)d_in[7]; P.log_dt = (const float*)d_in[8];
    P.b_re = (const float*)d_in[9]; P.b_im = (const float*)d_in[10]; P.c_re = (const float*)d_in[11]; P.c_im = (const float*)d_in[12];
    P.ssm_d = (const float*)d_in[13]; P.w_glu = (const float*)d_in[14]; P.kv_norm_g = (const float*)d_in[15]; P.w_kv = (const float*)d_in[16];
    P.w_q = (const float*)d_in[17]; P.lq1 = (const float*)d_in[18]; P.lk1 = (const float*)d_in[19]; P.lq2 = (const float*)d_in[20]; P.lk2 = (const float*)d_in[21];
    P.subln_g = (const float*)d_in[22]; P.w_o = (const float*)d_in[23]; P.final_g = (const float*)d_in[24];
    P.out = (float*)d_out; P.ws = (char*)d_ws;
    char* ws = (char*)d_ws; int nt = 0;
    const size_t FW = (size_t)DM * FFN;
    add_job(P, nt, P.w_glu, (bf16_t*)(ws + OFF_WGLU), nullptr, DM, 1024, 2048, 0, 1, 0, 1.0f);
    add_job(P, nt, P.w_glu, (bf16_t*)(ws + OFF_WGLU), nullptr, DM, 1024, 2048, 1024, 2, 0, 1.0f);
    add_job(P, nt, P.ffn_w1, (bf16_t*)(ws + OFF_WUP0), P.norm_ffn_g, DM, FFN, FFN, 0, 1, 0, 1.0f);
    add_job(P, nt, P.ffn_w3, (bf16_t*)(ws + OFF_WUP0), P.norm_ffn_g, DM, FFN, FFN, 0, 2, 0, 1.0f);
    add_job(P, nt, P.ffn_w2, (bf16_t*)(ws + OFF_WDN0), nullptr, FFN, DM, DM, 0, 0, 0, 1.0f);
    add_job(P, nt, P.w_kv, (bf16_t*)(ws + OFF_WKVQ), P.kv_norm_g, DM, 2048, 2048, 0, 0, 0, 1.0f);
    add_job(P, nt, P.w_q, (bf16_t*)(ws + OFF_WKVQ), P.norm_mix_g + DM, DM, 1024, 1024, 0, 0, 2048, QSCALE);
    add_job(P, nt, P.w_o, (bf16_t*)(ws + OFF_WO), nullptr, DM, DM, DM, 0, 0, 0, 1.0f);
    add_job(P, nt, P.ffn_w1 + FW, (bf16_t*)(ws + OFF_WUP1), P.norm_ffn_g + DM, DM, FFN, FFN, 0, 1, 0, 1.0f);
    add_job(P, nt, P.ffn_w3 + FW, (bf16_t*)(ws + OFF_WUP1), P.norm_ffn_g + DM, DM, FFN, FFN, 0, 2, 0, 1.0f);
    add_job(P, nt, P.ffn_w2 + FW, (bf16_t*)(ws + OFF_WDN1), nullptr, FFN, DM, DM, 0, 0, 0, 1.0f);
    P.ntiles_w = nt;
    static int grid_blocks = 0;
    if (!grid_blocks) {
        int dev = 0, cus = 0, per_cu = 0;
        hipGetDevice(&dev);
        hipDeviceGetAttribute(&cus, hipDeviceAttributeMultiprocessorCount, dev);
        hipOccupancyMaxActiveBlocksPerMultiprocessor(&per_cu, mega, NTHREADS, 0);
        if (per_cu < 1) per_cu = 1;
        grid_blocks = cus * 1;
    }
    hipMemsetAsync(ws + OFF_BAR, 0, 256, stream);
    void* args[] = {&P};
    hipError_t e = hipLaunchCooperativeKernel((void*)mega, dim3(grid_blocks), dim3(NTHREADS), args, 0, stream);
    if (e != hipSuccess) fprintf(stderr, "cooperative launch failed: %s (grid %d)\n", hipGetErrorString(e), grid_blocks);
}
```

```cpp
#include <hip/hip_runtime.h>
#include <hip/hip_cooperative_groups.h>
#include <stdint.h>
#include <string.h>
#include <stdio.h>
namespace cg = cooperative_groups;

typedef unsigned short bf16_t;
typedef short bf16x8 __attribute__((ext_vector_type(8)));
typedef float f32x16 __attribute__((ext_vector_type(16)));
typedef float f32x4 __attribute__((ext_vector_type(4)));
typedef float f32x2 __attribute__((ext_vector_type(2)));
typedef unsigned u32x4 __attribute__((ext_vector_type(4)));
typedef unsigned u32x2 __attribute__((ext_vector_type(2)));

#define L_SEQ 16384
#define DM 1024
#define FFN 2816
#define NTHREADS 512
#ifndef REP_ATTN
#define REP_ATTN 1
#endif
#ifndef REP_UP
#define REP_UP 1
#endif
#define REP_GLU 1
#define REP_KVQ 1
#define REP_S5 1
#define REP_SLOC 1
#define REP_PREP 1
#define LDS_BYTES 139264
#define EPSV 1e-6f
#define LAM_INIT 0.35550906759096927f
#define QSCALE 0.18033688011112042f

static constexpr size_t MiB = 1024ull * 1024ull;
static constexpr size_t OFF_WGLU = 0;
static constexpr size_t OFF_WUP0 = 4 * MiB;
static constexpr size_t OFF_WDN0 = 15 * MiB;
static constexpr size_t OFF_WKVQ = 20 * MiB + MiB / 2;
static constexpr size_t OFF_WO = 26 * MiB + MiB / 2;
static constexpr size_t OFF_WUP1 = 28 * MiB + MiB / 2;
static constexpr size_t OFF_WDN1 = 39 * MiB + MiB / 2;
static constexpr size_t OFF_SSQ = 45 * MiB;
static constexpr size_t OFF_A64 = 49 * MiB;
static constexpr size_t OFF_BAR = 49 * MiB + MiB / 2;
static constexpr size_t OFF_A = 50 * MiB;
static constexpr size_t OFF_HN0 = OFF_A;
static constexpr size_t OFF_Z = OFF_A + 32 * MiB;
static constexpr size_t OFF_ACT = OFF_A;
static constexpr size_t OFF_K1 = OFF_A;
static constexpr size_t OFF_K2 = OFF_A + 16 * MiB;
static constexpr size_t OFF_VT = OFF_A + 32 * MiB;
static constexpr size_t OFF_Q1 = OFF_A + 64 * MiB;
static constexpr size_t OFF_Q2 = OFF_A + 80 * MiB;
static constexpr size_t OFF_B = 146 * MiB;
static constexpr size_t OFF_KT = OFF_B;
static constexpr size_t OFF_W1 = OFF_B + 4 * MiB;
static constexpr size_t OFF_W3 = OFF_B + 20 * MiB;
static constexpr size_t OFF_SLOC = OFF_B + 36 * MiB;
static constexpr size_t OFF_SPREV = OFF_B + 44 * MiB;
static constexpr size_t OFF_HB = OFF_B;
static constexpr size_t OFF_ON = OFF_B + 32 * MiB;

struct WJob { const float* src; bf16_t* dst; const float* gain; int K; int N; int ldsrc; int col0; int mode; int rowoff; float scale; int tile0; int ntn; int pad; };

struct Params {
    const float *x, *norm_mix_g, *norm_ffn_g, *ffn_w1, *ffn_w3, *ffn_w2;
    const float *lam_re, *lam_im, *log_dt, *b_re, *b_im, *c_re, *c_im, *ssm_d, *w_glu;
    const float *kv_norm_g, *w_kv, *w_q, *lq1, *lk1, *lq2, *lk2, *subln_g, *w_o, *final_g;
    float* out;
    char* ws;
    WJob jobs[12];
    int njobs; int ntiles_w;
};

__device__ __forceinline__ int get_tid(int wave_s) { int t = wave_s * 64 + (int)__builtin_amdgcn_mbcnt_hi(~0u, __builtin_amdgcn_mbcnt_lo(~0u, 0u)); asm volatile("" : "+v"(t)); return t; }
__device__ __forceinline__ unsigned pk_bf16(float lo, float hi) { unsigned r; asm("v_cvt_pk_bf16_f32 %0, %1, %2" : "=v"(r) : "v"(lo), "v"(hi)); return r; }
__device__ __forceinline__ float bf_lo(unsigned u) { return __uint_as_float(u << 16); }
__device__ __forceinline__ float bf_hi(unsigned u) { return __uint_as_float(u & 0xffff0000u); }
__device__ __forceinline__ float fast_rcp(float x) { return __builtin_amdgcn_rcpf(x); }
__device__ __forceinline__ float fast_exp2(float x) { return __builtin_amdgcn_exp2f(x); }
__device__ __forceinline__ float sigmoidf_(float x) { return fast_rcp(1.0f + fast_exp2(-1.4426950408889634f * x)); }
__device__ __forceinline__ float gelu_tanh(float x) {
    const float u = 0.7978845608028654f * x * (1.0f + 0.044715f * x * x);
    return x * fast_rcp(1.0f + fast_exp2(-2.8853900817779268f * u));
}

struct Seg { const bf16_t* W; long wrs; long wkhi; const bf16_t* X; long xrs; long xkhi; };

struct TileCtx { int wn, wm, lane; };

template <class Epi>
__device__ __forceinline__ void gemm_tile(const int wave_s, char* lds, const Seg s0, const int nk0_, const Seg s1, const int nk1_, Epi& epi) {
    int tid = get_tid(wave_s);
    const int lane = tid & 63;
    const int wn = wave_s >> 2, wm = wave_s & 3;
    const int lr = lane & 31, h = lane >> 5;
    const int nk0 = nk0_ * 2, nk1 = nk1_ * 2, nk = nk0 + nk1;
    const int cch = (lane & 3) ^ ((lane >> 4) & 3);
    const int row0 = wave_s * 32 + (lane >> 2);
    f32x16 acc[4][2];
#pragma unroll
    for (int a = 0; a < 4; ++a)
#pragma unroll
        for (int b = 0; b < 2; ++b)
#pragma unroll
            for (int r = 0; r < 16; ++r) acc[a][b][r] = 0.f;
    auto issue = [&](int t) {
        const bool first = t < nk0;
        const bf16_t* W = first ? s0.W : s1.W; const bf16_t* X = first ? s0.X : s1.X;
        const long wrs = first ? s0.wrs : s1.wrs, xrs = first ? s0.xrs : s1.xrs;
        const long wkhi = first ? s0.wkhi : s1.wkhi, xkhi = first ? s0.xkhi : s1.xkhi;
        const int kt = first ? t : t - nk0;
        const long kc = kt * 2 + (cch >> 1);
        const bf16_t* wp = W + (long)row0 * wrs + kc * wkhi + (cch & 1) * 8;
        const bf16_t* xp = X + (long)row0 * xrs + kc * xkhi + (cch & 1) * 8;
        char* st = lds + (t & 3) * 32768 + wave_s * 2048;
        __builtin_amdgcn_global_load_lds((const unsigned*)wp, (__attribute__((address_space(3))) unsigned*)(st), 16, 0, 0);
        __builtin_amdgcn_global_load_lds((const unsigned*)(wp + 16 * wrs), (__attribute__((address_space(3))) unsigned*)(st + 1024), 16, 0, 0);
        __builtin_amdgcn_global_load_lds((const unsigned*)xp, (__attribute__((address_space(3))) unsigned*)(st + 16384), 16, 0, 0);
        __builtin_amdgcn_global_load_lds((const unsigned*)(xp + 16 * xrs), (__attribute__((address_space(3))) unsigned*)(st + 16384 + 1024), 16, 0, 0);
    };
    const int sw = (lr >> 2) & 3;
    const int aoff = (wn * 128 + lr) * 64, boff = 16384 + (wm * 64 + lr) * 64;
    const int ch0 = ((0 + h) ^ sw) << 4, ch1 = ((2 + h) ^ sw) << 4;
    bf16x8 a0[4], b0[2], a1[4], b1[2];
    epi.pre(wm, lane, wn);
    issue(0); issue(1); issue(2); issue(3);
    asm volatile("s_waitcnt vmcnt(12)" ::: "memory");
    __builtin_amdgcn_s_barrier(); asm volatile("" ::: "memory");
#pragma unroll
    for (int nb = 0; nb < 4; ++nb) a0[nb] = *(const bf16x8*)(lds + aoff + nb * 2048 + ch0);
#pragma unroll
    for (int mb = 0; mb < 2; ++mb) b0[mb] = *(const bf16x8*)(lds + boff + mb * 2048 + ch0);
    for (int t = 0; t < nk; ++t) {
        const char* st = lds + (t & 3) * 32768;
#pragma unroll
        for (int nb = 0; nb < 4; ++nb) a1[nb] = *(const bf16x8*)(st + aoff + nb * 2048 + ch1);
#pragma unroll
        for (int mb = 0; mb < 2; ++mb) b1[mb] = *(const bf16x8*)(st + boff + mb * 2048 + ch1);
#pragma unroll
        for (int nb = 0; nb < 4; ++nb)
#pragma unroll
            for (int mb = 0; mb < 2; ++mb) acc[nb][mb] = __builtin_amdgcn_mfma_f32_32x32x16_bf16(a0[nb], b0[mb], acc[nb][mb], 0, 0, 0);
        const int rem = nk - 1 - t;
        if (rem >= 3) asm volatile("s_waitcnt vmcnt(8)" ::: "memory");
        else if (rem == 2) asm volatile("s_waitcnt vmcnt(4)" ::: "memory");
        else asm volatile("s_waitcnt vmcnt(0)" ::: "memory");
        asm volatile("s_waitcnt lgkmcnt(0)" ::: "memory");
        __builtin_amdgcn_s_barrier(); asm volatile("" ::: "memory");
        if (t + 4 < nk) issue(t + 4);
        if (t + 1 < nk) {
            const char* sn = lds + ((t + 1) & 3) * 32768;
#pragma unroll
            for (int nb = 0; nb < 4; ++nb) a0[nb] = *(const bf16x8*)(sn + aoff + nb * 2048 + ch0);
#pragma unroll
            for (int mb = 0; mb < 2; ++mb) b0[mb] = *(const bf16x8*)(sn + boff + mb * 2048 + ch0);
        }
#pragma unroll
        for (int nb = 0; nb < 4; ++nb)
#pragma unroll
            for (int mb = 0; mb < 2; ++mb) acc[nb][mb] = __builtin_amdgcn_mfma_f32_32x32x16_bf16(a1[nb], b1[mb], acc[nb][mb], 0, 0, 0);
    }
    TileCtx c; c.wn = wn; c.wm = wm; c.lane = lane;
    epi(acc, c);
}

template <int NPART>
__device__ __forceinline__ float rstd_from(const float* ssq, int token) {
    float v[NPART];
#pragma unroll
    for (int i = 0; i < NPART; ++i) v[i] = ssq[(size_t)i * L_SEQ + token];
    float s = 0.f;
#pragma unroll
    for (int i = 0; i < NPART; ++i) s += v[i];
    return rsqrtf(s * (1.0f / DM) + EPSV);
}

struct EpiSloc {
    float* dst;
    __device__ __forceinline__ void pre(int, int, int) {}
    __device__ __forceinline__ void operator()(f32x16 (&acc)[4][2], const TileCtx& c) const {
        if (c.wn != 0) return;
        const int lr = c.lane & 31, h = c.lane >> 5;
#pragma unroll
        for (int mb = 0; mb < 2; ++mb) { const int m = c.wm * 64 + mb * 32 + lr;
#pragma unroll
            for (int nb = 0; nb < 4; ++nb)
#pragma unroll
                for (int rq = 0; rq < 4; ++rq) { const int n = nb * 32 + rq * 8 + 4 * h;
                    f32x4 v = {acc[nb][mb][4 * rq], acc[nb][mb][4 * rq + 1], acc[nb][mb][4 * rq + 2], acc[nb][mb][4 * rq + 3]};
                    *(f32x4*)(dst + m * 132 + n) = v; } }
    }
};

struct EpiS5 {
    const bf16_t* hn0; const float* dskip; bf16_t* z; int g; int n0;
    __device__ __forceinline__ void pre(int, int, int) {}
    __device__ __forceinline__ void operator()(f32x16 (&acc)[4][2], const TileCtx& c) const {
        const int lr = c.lane & 31, h = c.lane >> 5;
#pragma unroll
        for (int mb = 0; mb < 2; ++mb) { const int j = c.wm * 64 + mb * 32 + lr;
            u32x2 uu[16];
#pragma unroll
            for (int q = 0; q < 16; ++q) { const int n = n0 + c.wn * 128 + (q >> 2) * 32 + (q & 3) * 8 + 4 * h; uu[q] = *(const u32x2*)(hn0 + (size_t)g * 262144 + (size_t)j * 1024 + n); }
            asm volatile("" ::: "memory");
#pragma unroll
            for (int q = 0; q < 16; ++q) { const int nb = q >> 2, rq = q & 3; const int n = n0 + c.wn * 128 + nb * 32 + rq * 8 + 4 * h; const int t = n >> 4, cc = n & 15;
                const size_t off = (size_t)g * 262144 + (size_t)(j * 64 + t) * 16 + cc; const f32x4 d4 = *(const f32x4*)(dskip + g * 16 + cc);
                const float y0 = acc[nb][mb][4 * rq] + d4[0] * bf_lo(uu[q][0]), y1 = acc[nb][mb][4 * rq + 1] + d4[1] * bf_hi(uu[q][0]);
                const float y2 = acc[nb][mb][4 * rq + 2] + d4[2] * bf_lo(uu[q][1]), y3 = acc[nb][mb][4 * rq + 3] + d4[3] * bf_hi(uu[q][1]);
                u32x2 o; o[0] = pk_bf16(gelu_tanh(y0), gelu_tanh(y1)); o[1] = pk_bf16(gelu_tanh(y2), gelu_tanh(y3));
                *(u32x2*)(z + off) = o; }
            asm volatile("" ::: "memory"); }
    }
};

struct EpiGlu {
    const float* x; float* out; bf16_t* hb; float* ssq; int n0, m0;
    __device__ __forceinline__ void pre(int, int, int) {}
    __device__ __forceinline__ void operator()(f32x16 (&acc)[4][2], const TileCtx& c) const {
        const int lr = c.lane & 31, h = c.lane >> 5;
#pragma unroll
        for (int mb = 0; mb < 2; ++mb) { const int m = m0 + c.wm * 64 + mb * 32 + lr; float s = 0.f;
            const size_t rowoff = (size_t)m * DM + ((n0 + c.wn * 128) >> 1) + 4 * h;
            f32x4 xv[8];
#pragma unroll
            for (int q = 0; q < 8; ++q) xv[q] = *(const f32x4*)(x + rowoff + (q >> 1) * 16 + (q & 1) * 8);
            asm volatile("" ::: "memory");
#pragma unroll
            for (int q = 0; q < 8; ++q) { const int nb = q >> 1, rg = q & 1; const size_t off = rowoff + nb * 16 + rg * 8; f32x4 o;
#pragma unroll
                for (int e = 0; e < 4; ++e) { o[e] = xv[q][e] + acc[nb][mb][rg * 8 + e] * sigmoidf_(acc[nb][mb][rg * 8 + 4 + e]); s += o[e] * o[e]; }
                *(f32x4*)(out + off) = o; u32x2 b; b[0] = pk_bf16(o[0], o[1]); b[1] = pk_bf16(o[2], o[3]); *(u32x2*)(hb + off) = b; }
            asm volatile("" ::: "memory");
            s += __shfl_xor(s, 32);
            if (h == 0) ssq[(size_t)((n0 >> 8) * 2 + c.wn) * L_SEQ + m] = s; }
    }
};

template <int NPART> struct EpiUp {
    const float* ssq; bf16_t* act; int n0, m0; float rsv[2];
    __device__ __forceinline__ void pre(int wm, int lane, int) {
#pragma unroll
        for (int mb = 0; mb < 2; ++mb) rsv[mb] = rstd_from<NPART>(ssq, m0 + wm * 64 + mb * 32 + (lane & 31)); }
    __device__ __forceinline__ void operator()(f32x16 (&acc)[4][2], const TileCtx& c) const {
        const int lr = c.lane & 31, h = c.lane >> 5;
#pragma unroll
        for (int mb = 0; mb < 2; ++mb) { const int m = m0 + c.wm * 64 + mb * 32 + lr; const float rs = rsv[mb];
#pragma unroll
            for (int nb = 0; nb < 4; ++nb)
#pragma unroll
                for (int rg = 0; rg < 2; ++rg) { const int f = ((n0 + c.wn * 128 + nb * 32) >> 1) + rg * 8 + 4 * h; float o[4];
#pragma unroll
                    for (int e = 0; e < 4; ++e) { const float a = acc[nb][mb][rg * 8 + e] * rs, b = acc[nb][mb][rg * 8 + 4 + e] * rs; o[e] = a * sigmoidf_(a) * b; }
                    u32x2 bb; bb[0] = pk_bf16(o[0], o[1]); bb[1] = pk_bf16(o[2], o[3]); *(u32x2*)(act + (size_t)m * FFN + f) = bb; } }
    }
};

struct EpiRes {
    float* out; bf16_t* hb; float* ssq; int n0, m0;
    __device__ __forceinline__ void pre(int, int, int) {}
    __device__ __forceinline__ void operator()(f32x16 (&acc)[4][2], const TileCtx& c) const {
        const int lr = c.lane & 31, h = c.lane >> 5;
#pragma unroll
        for (int mb = 0; mb < 2; ++mb) { const int m = m0 + c.wm * 64 + mb * 32 + lr; float s = 0.f;
            const size_t rowoff = (size_t)m * DM + n0 + c.wn * 128 + 4 * h;
#pragma unroll
            for (int np = 0; np < 2; ++np) {
                f32x4 o[8];
#pragma unroll
                for (int q = 0; q < 8; ++q) o[q] = *(const f32x4*)(out + rowoff + (np * 2 + (q >> 2)) * 32 + (q & 3) * 8);
                asm volatile("" ::: "memory");
#pragma unroll
                for (int q = 0; q < 8; ++q) { const int nb = np * 2 + (q >> 2), rq = q & 3; const size_t off = rowoff + nb * 32 + rq * 8;
#pragma unroll
                    for (int e = 0; e < 4; ++e) { o[q][e] += acc[nb][mb][4 * rq + e]; s += o[q][e] * o[q][e]; }
                    *(f32x4*)(out + off) = o[q];
                    if (hb) { u32x2 b; b[0] = pk_bf16(o[q][0], o[q][1]); b[1] = pk_bf16(o[q][2], o[q][3]); *(u32x2*)(hb + off) = b; } }
                asm volatile("" ::: "memory");
            }
            s += __shfl_xor(s, 32);
            if (h == 0) ssq[(size_t)((n0 >> 8) * 2 + c.wn) * L_SEQ + m] = s; }
    }
};

struct EpiKvq {
    const float* ssq; char* ws; int n0, m0; float rsv[2];
    __device__ __forceinline__ void pre(int wm, int lane, int) {
#pragma unroll
        for (int mb = 0; mb < 2; ++mb) rsv[mb] = rstd_from<8>(ssq, m0 + wm * 64 + mb * 32 + (lane & 31)); }
    __device__ __forceinline__ void operator()(f32x16 (&acc)[4][2], const TileCtx& c) const {
        const int lr = c.lane & 31, h = c.lane >> 5;
        const bool isV = (n0 >= 1024 && n0 < 2048);
#pragma unroll
        for (int mb = 0; mb < 2; ++mb) { const int m = m0 + c.wm * 64 + mb * 32 + lr; const float rs = rsv[mb];
            if (isV) {
                const int mp = (m & ~12) | ((m & 4) << 1) | ((m & 8) >> 1);
                bf16_t* vt = (bf16_t*)(ws + OFF_VT);
#pragma unroll
                for (int nb = 0; nb < 4; ++nb)
#pragma unroll
                    for (int r = 0; r < 16; ++r) { const int nl = n0 - 1024 + c.wn * 128 + nb * 32 + (r & 3) + 8 * (r >> 2) + 4 * h;
                        vt[(size_t)nl * L_SEQ + mp] = (bf16_t)(pk_bf16(acc[nb][mb][r] * rs, 0.f) & 0xffffu); }
            } else {
                size_t base; int nl;
                if (n0 < 512) { base = OFF_K1; nl = n0; } else if (n0 < 1024) { base = OFF_K2; nl = n0 - 512; } else if (n0 < 2560) { base = OFF_Q1; nl = n0 - 2048; } else { base = OFF_Q2; nl = n0 - 2560; }
                bf16_t* dst = (bf16_t*)(ws + base);
                float cs[4], sn[4];
#pragma unroll
                for (int e = 0; e < 4; ++e) { const int i = 4 * h + e;
                    const float invf = (i == 0) ? 1.0f : (i == 1) ? 0.19391188f : (i == 2) ? 0.037601817f : (i == 3) ? 0.0072914392f : (i == 4) ? 0.0014142136f : (i == 5) ? 0.00027423282f : (i == 6) ? 5.3176997e-05f : 1.0311653e-05f;
                    const float ang = (float)m * invf; double rev = (double)ang * 0.15915494309189535; rev -= rint(rev); const float fr = (float)rev;
                    cs[e] = __builtin_amdgcn_cosf(fr); sn[e] = __builtin_amdgcn_sinf(fr); }
#pragma unroll
                for (int nb = 0; nb < 4; ++nb) {
                    const int nn = nl + c.wn * 128 + nb * 32; const int head = nn >> 6, d0 = nn & 63;
                    float v[16];
#pragma unroll
                    for (int r = 0; r < 16; ++r) v[r] = acc[nb][mb][r] * rs;
                    if (d0 == 0) {
#pragma unroll
                        for (int e = 0; e < 4; ++e) { const float x1 = v[e], x2 = v[4 + e]; v[e] = x1 * cs[e] - x2 * sn[e]; v[4 + e] = x2 * cs[e] + x1 * sn[e]; }
                    }
#pragma unroll
                    for (int rq = 0; rq < 4; ++rq) { u32x2 b; b[0] = pk_bf16(v[4 * rq], v[4 * rq + 1]); b[1] = pk_bf16(v[4 * rq + 2], v[4 * rq + 3]);
                        *(u32x2*)(dst + ((size_t)head * L_SEQ + m) * 64 + d0 + rq * 8 + 4 * h) = b; }
                }
            } }
    }
};

__device__ __forceinline__ void s5_tables(const int wave_s, const Params& p, int g, char* lds) {
    f32x2* apow = (f32x2*)lds;
    f32x2* bb = apow + 65 * 64;
    f32x2* cc = bb + 1024;
    f32x2* zf = cc + 1024;
    int tid = get_tid(wave_s); asm volatile("" : "+v"(tid));
    const float dt = expf(p.log_dt[g]);
    for (int e = tid; e < 65 * 64; e += NTHREADS) {
        const int lag = e >> 6, pp = e & 63;
        const float lr = p.lam_re[g * 64 + pp], li = p.lam_im[g * 64 + pp];
        const float mag = expf(lr * dt * (float)lag);
        double rev = (double)li * (double)dt * (double)lag * 0.15915494309189535; rev -= rint(rev);
        const float fr = (float)rev;
        f32x2 v; v[0] = mag * __builtin_amdgcn_cosf(fr); v[1] = mag * __builtin_amdgcn_sinf(fr); apow[e] = v;
    }
    if (tid < 64) {
        const float lr = p.lam_re[g * 64 + tid], li = p.lam_im[g * 64 + tid];
        const float em1 = expm1f(lr * dt);
        double rev = (double)li * (double)dt * 0.15915494309189535; const double rh = rev * 0.5; rev -= rint(rev);
        const double rh2 = rh - rint(rh);
        const float cth = __builtin_amdgcn_cosf((float)rev), sth = __builtin_amdgcn_sinf((float)rev), shalf = __builtin_amdgcn_sinf((float)rh2);
        const float nr = em1 * cth - 2.0f * shalf * shalf, ni = (1.0f + em1) * sth;
        const float den = lr * lr + li * li;
        f32x2 f; f[0] = (nr * lr + ni * li) / den; f[1] = (ni * lr - nr * li) / den; zf[tid] = f;
    }
    __syncthreads();
    for (int e = tid; e < 1024; e += NTHREADS) {
        const int pp = e >> 4;
        const float br = p.b_re[(size_t)g * 1024 + e], bi = p.b_im[(size_t)g * 1024 + e];
        const f32x2 f = zf[pp]; f32x2 v; v[0] = f[0] * br - f[1] * bi; v[1] = f[0] * bi + f[1] * br; bb[e] = v;
        f32x2 cv; cv[0] = p.c_re[(size_t)g * 1024 + e]; cv[1] = p.c_im[(size_t)g * 1024 + e]; cc[e] = cv;
    }
    __syncthreads();
    bf16_t* kt = (bf16_t*)(p.ws + OFF_KT) + (size_t)g * 127 * 256;
    bf16_t* w1 = (bf16_t*)(p.ws + OFF_W1) + (size_t)g * 128 * 1024;
    bf16_t* w3 = (bf16_t*)(p.ws + OFF_W3) + (size_t)g * 1024 * 128;
    {
        const int cp = tid & 255, c = cp >> 4, c2 = cp & 15, half = tid >> 8;
        float acc[32];
#pragma unroll
        for (int l = 0; l < 32; ++l) acc[l] = 0.f;
        for (int pp = 0; pp < 64; ++pp) {
            const f32x2 cv = cc[c * 64 + pp], bv = bb[pp * 16 + c2];
            const float cbr = cv[0] * bv[0] - cv[1] * bv[1], cbi = cv[0] * bv[1] + cv[1] * bv[0];
#pragma unroll
            for (int l = 0; l < 32; ++l) { const f32x2 a = apow[(half * 32 + l) * 64 + pp]; acc[l] += cbr * a[0] - cbi * a[1]; }
        }
#pragma unroll
        for (int l = 0; l < 32; ++l) kt[(size_t)(63 + half * 32 + l) * 256 + cp] = (bf16_t)(pk_bf16(acc[l], 0.f) & 0xffffu);
        for (int e = tid; e < 63 * 256 / 8; e += NTHREADS) { u32x4 zz = {0u, 0u, 0u, 0u}; *(u32x4*)(kt + e * 8) = zz; }
    }
    for (int q = tid; q < 128 * 128; q += NTHREADS) {
        const int pq = q >> 7, kc = q & 127, tau = kc >> 1, c0 = (kc & 1) * 8, pp = pq & 63, im = pq >> 6;
        const f32x2 a = apow[(63 - tau) * 64 + pp]; float v[8];
#pragma unroll
        for (int e = 0; e < 8; ++e) { const f32x2 b = bb[pp * 16 + c0 + e]; v[e] = im ? (a[0] * b[1] + a[1] * b[0]) : (a[0] * b[0] - a[1] * b[1]); }
        u32x4 o; o[0] = pk_bf16(v[0], v[1]); o[1] = pk_bf16(v[2], v[3]); o[2] = pk_bf16(v[4], v[5]); o[3] = pk_bf16(v[6], v[7]);
        *(u32x4*)(w1 + (size_t)pq * 1024 + kc * 8) = o;
    }
    for (int q = tid; q < 1024 * 16; q += NTHREADS) {
        const int n = q >> 4, p0 = (q & 15) * 8, t = n >> 4, c = n & 15, im = p0 >> 6; float v[8];
#pragma unroll
        for (int e = 0; e < 8; ++e) { const int pp = (p0 + e) & 63; const f32x2 a = apow[(t + 1) * 64 + pp]; const f32x2 cv = cc[c * 64 + pp];
            v[e] = im ? -(cv[0] * a[1] + cv[1] * a[0]) : (cv[0] * a[0] - cv[1] * a[1]); }
        u32x4 o; o[0] = pk_bf16(v[0], v[1]); o[1] = pk_bf16(v[2], v[3]); o[2] = pk_bf16(v[4], v[5]); o[3] = pk_bf16(v[6], v[7]);
        *(u32x4*)(w3 + (size_t)n * 128 + p0) = o;
    }
    if (tid < 64) ((f32x2*)(p.ws + OFF_A64))[g * 64 + tid] = apow[64 * 64 + tid];
    __syncthreads();
}

__device__ __forceinline__ void wtile(const int wave_s, const Params& p, int t, char* lds) {
    int j = 0;
    for (int i = 1; i < p.njobs; ++i) if (t >= p.jobs[i].tile0) j = i;
    const WJob& J = p.jobs[j];
    const int lt = t - J.tile0, kt = lt / J.ntn, nt = lt - kt * J.ntn;
    const int k0 = kt * 64, nl0 = nt * 256;
    float* T = (float*)lds;
    int tid = get_tid(wave_s); asm volatile("" : "+v"(tid));
    const int c4 = (tid & 63) * 4, kb = tid >> 6;
    f32x4 v[8];
#pragma unroll
    for (int i = 0; i < 8; ++i) v[i] = *(const f32x4*)(J.src + (size_t)(k0 + kb + 8 * i) * J.ldsrc + J.col0 + nl0 + c4);
#pragma unroll
    for (int i = 0; i < 8; ++i) { const int kk = kb + 8 * i; float sc = J.scale; if (J.gain) sc *= J.gain[k0 + kk];
        T[kk * 257 + c4] = v[i][0] * sc; T[kk * 257 + c4 + 1] = v[i][1] * sc; T[kk * 257 + c4 + 2] = v[i][2] * sc; T[kk * 257 + c4 + 3] = v[i][3] * sc; }
    __syncthreads();
    { const int nn = tid >> 1, kh = (tid & 1) * 32;
        const int n = nl0 + nn; int row = (J.mode == 0) ? n : ((n >> 3) * 16 + (n & 7) + (J.mode == 2 ? 8 : 0)); row += J.rowoff;
        bf16_t* d = J.dst + (size_t)row * J.K + k0 + kh;
#pragma unroll
        for (int q = 0; q < 4; ++q) { float w[8];
#pragma unroll
            for (int e = 0; e < 8; ++e) w[e] = T[(kh + q * 8 + e) * 257 + nn];
            u32x4 o; o[0] = pk_bf16(w[0], w[1]); o[1] = pk_bf16(w[2], w[3]); o[2] = pk_bf16(w[4], w[5]); o[3] = pk_bf16(w[6], w[7]);
            *(u32x4*)(d + q * 8) = o; } }
    __syncthreads();
}

__device__ __forceinline__ void rms0_item(const int wave_s, const Params& p, int item) {
    const int lane = get_tid(wave_s) & 63, wid = wave_s;
    bf16_t* hn0 = (bf16_t*)(p.ws + OFF_HN0);
    for (int r = 0; r < 8; ++r) {
        const int row = item * 64 + wid * 8 + r;
        f32x4 v[4]; float s = 0.f;
#pragma unroll
        for (int i = 0; i < 4; ++i) { v[i] = *(const f32x4*)(p.x + (size_t)row * DM + lane * 4 + 256 * i); s += v[i][0] * v[i][0] + v[i][1] * v[i][1] + v[i][2] * v[i][2] + v[i][3] * v[i][3]; }
#pragma unroll
        for (int o = 32; o >= 1; o >>= 1) s += __shfl_xor(s, o);
        const float rs = rsqrtf(s * (1.0f / DM) + EPSV);
#pragma unroll
        for (int i = 0; i < 4; ++i) { const f32x4 g = *(const f32x4*)(p.norm_mix_g + lane * 4 + 256 * i);
            u32x2 o; o[0] = pk_bf16(v[i][0] * rs * g[0], v[i][1] * rs * g[1]); o[1] = pk_bf16(v[i][2] * rs * g[2], v[i][3] * rs * g[3]);
            { const int col = lane * 4 + 256 * i; *(u32x2*)(hn0 + (size_t)(col >> 4) * 262144 + (size_t)(row >> 6) * 1024 + (row & 63) * 16 + (col & 15)) = o; } }
    }
}

__device__ __forceinline__ void attn_item(const int wave_s, const Params& p, int head, int qb, float lam, char* lds) {
    int tid = get_tid(wave_s); asm volatile("" : "+v"(tid));
    const int lane = tid & 63, wid = tid >> 6;
    const int mp = wid >> 2, g = wid & 3;
    const int lr = lane & 31, h = lane >> 5, sw = (lane >> 1) & 7;
    const bf16_t* K1 = (const bf16_t*)(p.ws + OFF_K1) + (size_t)head * L_SEQ * 64;
    const bf16_t* K2 = (const bf16_t*)(p.ws + OFF_K2) + (size_t)head * L_SEQ * 64;
    const bf16_t* VT = (const bf16_t*)(p.ws + OFF_VT) + (size_t)head * 128 * L_SEQ;
    const bf16_t* Q = (const bf16_t*)(p.ws + (mp ? OFF_Q2 : OFF_Q1)) + (size_t)head * L_SEQ * 64;
    const int q0 = qb * 128 + g * 32;
    bf16x8 qf[4];
#pragma unroll
    for (int s = 0; s < 4; ++s) qf[s] = *(const bf16x8*)(Q + (size_t)(q0 + lr) * 64 + 16 * s + 8 * h);
    const int nkt = 2 * qb + 2;
    const int my_last = 2 * qb + (g >> 1);
    f32x16 O[4];
#pragma unroll
    for (int e = 0; e < 4; ++e)
#pragma unroll
        for (int r = 0; r < 16; ++r) O[e][r] = 0.f;
    float m_run = -1e30f, l_run = 0.f;
    const int lrow = lane >> 3;
    const int ck = (lane & 7) ^ (((wave_s & 1) * 4 + (lane >> 4)) & 7);
    const int cv0 = (lane & 7) ^ (lane >> 4), cv1 = (lane & 7) ^ (4 + (lane >> 4));
    const bf16_t* k1p = K1 + (size_t)(wave_s * 8 + lrow) * 64 + ck * 8;
    const bf16_t* k2p = K2 + (size_t)(wave_s * 8 + lrow) * 64 + ck * 8;
    const bf16_t* v0p = VT + (size_t)(wave_s * 16 + lrow) * L_SEQ + cv0 * 8;
    const bf16_t* v1p = VT + (size_t)(wave_s * 16 + 8 + lrow) * L_SEQ + cv1 * 8;
    auto issue = [&](int kt) {
        char* st = lds + (kt & 3) * 32768;
        __builtin_amdgcn_global_load_lds((const unsigned*)(k1p + (size_t)kt * 4096), (__attribute__((address_space(3))) unsigned*)(st + wave_s * 1024), 16, 0, 0);
        __builtin_amdgcn_global_load_lds((const unsigned*)(k2p + (size_t)kt * 4096), (__attribute__((address_space(3))) unsigned*)(st + 8192 + wave_s * 1024), 16, 0, 0);
        __builtin_amdgcn_global_load_lds((const unsigned*)(v0p + kt * 64), (__attribute__((address_space(3))) unsigned*)(st + 16384 + wave_s * 2048), 16, 0, 0);
        __builtin_amdgcn_global_load_lds((const unsigned*)(v1p + kt * 64), (__attribute__((address_space(3))) unsigned*)(st + 16384 + wave_s * 2048 + 1024), 16, 0, 0);
    };
    issue(0); issue(1);
    if (nkt > 2) issue(2);
    if (nkt > 2) asm volatile("s_waitcnt vmcnt(8)" ::: "memory");
    else asm volatile("s_waitcnt vmcnt(4)" ::: "memory");
    __builtin_amdgcn_s_barrier(); asm volatile("" ::: "memory");
    const int koff_ = mp * 8192 + lr * 128, voff_ = 16384 + lr * 128;
    int chk[4], chv[4];
#pragma unroll
    for (int s = 0; s < 4; ++s) { chk[s] = ((2 * s + h) ^ sw) << 4; chv[s] = chk[s]; }
    bf16x8 kf[8], vf[8];
#pragma unroll
    for (int i = 0; i < 8; ++i) kf[i] = *(const bf16x8*)(lds + koff_ + (i >> 2) * 4096 + chk[i & 3]);
    for (int kt = 0; kt < nkt; ++kt) {
        const bool active = kt <= my_last;
        const char* stg = lds + (kt & 3) * 32768;
        f32x16 S[2];
        bf16x8 pf[2][2];
        if (active) {
#pragma unroll
            for (int kb = 0; kb < 2; ++kb) {
#pragma unroll
                for (int r = 0; r < 16; ++r) S[kb][r] = 0.f;
#pragma unroll
                for (int s = 0; s < 4; ++s) S[kb] = __builtin_amdgcn_mfma_f32_32x32x16_bf16(kf[kb * 4 + s], qf[s], S[kb], 0, 0, 0);
            }
#pragma unroll
            for (int i = 0; i < 8; ++i) vf[i] = *(const bf16x8*)(stg + voff_ + (i & 3) * 4096 + chv[i >> 2]);
            __builtin_amdgcn_sched_barrier(0);
            float mt = S[0][0];
#pragma unroll
            for (int r = 1; r < 16; ++r) mt = fmaxf(mt, S[0][r]);
#pragma unroll
            for (int r = 0; r < 16; ++r) mt = fmaxf(mt, S[1][r]);
            mt = fmaxf(mt, __shfl_xor(mt, 32));
            const bool need = mt > m_run + 8.0f;
            if (__any(need)) {
                const float mnew = need ? mt : m_run;
                const float alpha = fast_exp2(m_run - mnew);
                m_run = mnew; l_run *= alpha;
#pragma unroll
                for (int e = 0; e < 4; ++e)
#pragma unroll
                    for (int r = 0; r < 16; ++r) O[e][r] *= alpha;
            }
            float ls = 0.f;
#pragma unroll
            for (int kb = 0; kb < 2; ++kb)
#pragma unroll
                for (int s = 0; s < 2; ++s) { float e_[8];
#pragma unroll
                    for (int j = 0; j < 8; ++j) { e_[j] = fast_exp2(S[kb][8 * s + j] - m_run); ls += e_[j]; }
                    u32x4 pk; pk[0] = pk_bf16(e_[0], e_[1]); pk[1] = pk_bf16(e_[2], e_[3]); pk[2] = pk_bf16(e_[4], e_[5]); pk[3] = pk_bf16(e_[6], e_[7]);
                    pf[kb][s] = __builtin_bit_cast(bf16x8, pk); }
            l_run += ls;
        }
        const int rem = nkt - 1 - kt;
        if (rem >= 2) asm volatile("s_waitcnt vmcnt(4)" ::: "memory");
        else asm volatile("s_waitcnt vmcnt(0)" ::: "memory");
        __builtin_amdgcn_s_barrier(); asm volatile("" ::: "memory");
        if (kt + 3 < nkt) issue(kt + 3);
        if (kt + 1 <= my_last) {
            const char* sn = lds + ((kt + 1) & 3) * 32768;
#pragma unroll
            for (int i = 0; i < 8; ++i) kf[i] = *(const bf16x8*)(sn + koff_ + (i >> 2) * 4096 + chk[i & 3]);
        }
        __builtin_amdgcn_sched_barrier(0);
        if (active) {
#pragma unroll
            for (int i = 0; i < 8; ++i) O[i & 3] = __builtin_amdgcn_mfma_f32_32x32x16_bf16(vf[i], pf[0][i >> 2], O[i & 3], 0, 0, 0);
#pragma unroll
            for (int i = 0; i < 8; ++i) vf[i] = *(const bf16x8*)(stg + voff_ + (i & 3) * 4096 + (((4 + 2 * (i >> 2) + h) ^ sw) << 4));
#pragma unroll
            for (int i = 0; i < 8; ++i) O[i & 3] = __builtin_amdgcn_mfma_f32_32x32x16_bf16(vf[i], pf[1][i >> 2], O[i & 3], 0, 0, 0);
        }
    }
    __syncthreads();
    const float lt = l_run + __shfl_xor(l_run, 32);
    const float inv = fast_rcp(lt) * (mp ? lam : 1.0f);
    float* ex = (float*)lds;
    if (mp == 1) {
#pragma unroll
        for (int e = 0; e < 4; ++e)
#pragma unroll
            for (int r = 0; r < 16; ++r) ex[((g * 4 + e) * 16 + r) * 64 + lane] = O[e][r] * inv;
    }
    __syncthreads();
    if (mp == 0) {
        float ss = 0.f;
#pragma unroll
        for (int e = 0; e < 4; ++e)
#pragma unroll
            for (int r = 0; r < 16; ++r) { const float o = O[e][r] * inv - ex[((g * 4 + e) * 16 + r) * 64 + lane]; O[e][r] = o; ss += o * o; }
        ss += __shfl_xor(ss, 32);
        const float rs = rsqrtf(ss * (1.0f / 128.0f) + EPSV) * (1.0f - LAM_INIT);
        bf16_t* on = (bf16_t*)(p.ws + OFF_ON) + (size_t)(q0 + lr) * DM + head * 128;
#pragma unroll
        for (int e = 0; e < 4; ++e)
#pragma unroll
            for (int rq = 0; rq < 4; ++rq) { const int ee = e * 32 + rq * 8 + 4 * h; const f32x4 gg = *(const f32x4*)(p.subln_g + ee);
                u32x2 b; b[0] = pk_bf16(O[e][4 * rq] * rs * gg[0], O[e][4 * rq + 1] * rs * gg[1]); b[1] = pk_bf16(O[e][4 * rq + 2] * rs * gg[2], O[e][4 * rq + 3] * rs * gg[3]);
                *(u32x2*)(on + ee) = b; }
    }
    __syncthreads();
}


__device__ __forceinline__ void gbar(const int wave_s, unsigned* ctr, unsigned target) {
    __syncthreads();
    if (get_tid(wave_s) == 0) {
        __builtin_amdgcn_fence(__ATOMIC_RELEASE, "agent");
        asm volatile("s_waitcnt vmcnt(0)" ::: "memory");
        __hip_atomic_fetch_add(ctr, 1u, __ATOMIC_RELAXED, __HIP_MEMORY_SCOPE_AGENT);
        while (__hip_atomic_load(ctr, __ATOMIC_RELAXED, __HIP_MEMORY_SCOPE_AGENT) < target) __builtin_amdgcn_s_sleep(2);
        __builtin_amdgcn_fence(__ATOMIC_ACQUIRE, "agent");
        asm volatile("s_waitcnt vmcnt(0)" ::: "memory");
    }
    __syncthreads();
}


__device__ __forceinline__ bool tile_map(int r, int bid, int nb, int NT, int& nt, int& mt) {
    if (nb == 256) {
        const int x = bid & 7, li = bid >> 3, q = li + 32 * r;
        if (q >= 8 * NT) return false;
        const int mi = q & 3, rest = q >> 2, mg = rest / NT;
        nt = rest - mg * NT; mt = x * 8 + mg * 4 + mi; return true;
    }
    const int t = bid + r * nb; if (t >= NT * 64) return false;
    nt = t % NT; mt = t / NT; return true;
}

__global__ void __launch_bounds__(NTHREADS) mega(const Params p) {
    __shared__ __attribute__((aligned(16))) char lds[LDS_BYTES];
    cg::grid_group grid = cg::this_grid();
    const int wave_s = __builtin_amdgcn_readfirstlane((int)(threadIdx.x >> 6));
    const int nb = gridDim.x, bid = blockIdx.x;
    char* ws = p.ws;
    bf16_t* hn0 = (bf16_t*)(ws + OFF_HN0);
    bf16_t* hb = (bf16_t*)(ws + OFF_HB);
    float* ssq0 = (float*)(ws + OFF_SSQ);
    float* ssq1 = ssq0 + 16 * L_SEQ; float* ssq2 = ssq1 + 16 * L_SEQ; float* ssq3 = ssq2 + 16 * L_SEQ;
    const Seg nul = {nullptr, 0, 0, nullptr, 0, 0};
    unsigned* bar = (unsigned*)(ws + OFF_BAR); unsigned nbar = 0;

    { const int nwork = p.ntiles_w + 256;
      for (int rep = 0; rep < REP_PREP; ++rep) {
          if (nb >= 128) {
              if (bid < 64) s5_tables(wave_s, p, bid, lds);
              else for (int it = bid - 64; it < nwork; it += nb - 64) { if (it < p.ntiles_w) wtile(wave_s, p, it, lds); else rms0_item(wave_s, p, it - p.ntiles_w); }
          } else {
              for (int it = bid; it < 64 + nwork; it += nb) { if (it < 64) s5_tables(wave_s, p, it, lds); else if (it < 64 + p.ntiles_w) wtile(wave_s, p, it - 64, lds); else rms0_item(wave_s, p, it - 64 - p.ntiles_w); }
          }
      } }
    grid.sync();
    for (int rep = 0; rep < REP_SLOC; ++rep)
    for (int g = bid; g < 64; g += nb) {
        Seg s = {(const bf16_t*)(ws + OFF_W1) + (size_t)g * 128 * 1024, 1024, 16, hn0 + (size_t)g * 262144, 1024, 16};
        EpiSloc e = {(float*)lds};
        gemm_tile(wave_s, lds, s, 16, nul, 0, e);
        __syncthreads();
        {
            const int lane_ = get_tid(wave_s) & 63, w_ = wave_s;
            const f32x2 a = ((const f32x2*)(ws + OFF_A64))[g * 64 + lane_];
            const float* sl = (const float*)lds + (w_ * 32) * 132;
            float sr = 0.f, si = 0.f;
#pragma unroll
            for (int j = 0; j < 32; ++j) { const float xr = sl[j * 132 + lane_], xi = sl[j * 132 + 64 + lane_]; const float nr = a[0] * sr - a[1] * si + xr, ni = a[0] * si + a[1] * sr + xi; sr = nr; si = ni; }
            f32x2* carry = (f32x2*)(lds + 135168);
            { f32x2 c; c[0] = sr; c[1] = si; carry[w_ * 64 + lane_] = c; }
            float pr = a[0], pi = a[1];
#pragma unroll
            for (int q = 0; q < 5; ++q) { const float nr = pr * pr - pi * pi, ni = 2.f * pr * pi; pr = nr; pi = ni; }
            __syncthreads();
            sr = 0.f; si = 0.f;
            for (int v = 0; v < w_; ++v) { const f32x2 c = carry[v * 64 + lane_]; const float nr = pr * sr - pi * si + c[0], ni = pr * si + pi * sr + c[1]; sr = nr; si = ni; }
            bf16_t* sp = (bf16_t*)(ws + OFF_SPREV) + (size_t)g * 256 * 128 + (size_t)(w_ * 32) * 128;
#pragma unroll
            for (int j = 0; j < 32; ++j) {
                sp[j * 128 + lane_] = (bf16_t)(pk_bf16(sr, 0.f) & 0xffffu); sp[j * 128 + 64 + lane_] = (bf16_t)(pk_bf16(si, 0.f) & 0xffffu);
                const float xr = sl[j * 132 + lane_], xi = sl[j * 132 + 64 + lane_];
                const float nr = a[0] * sr - a[1] * si + xr, ni = a[0] * si + a[1] * sr + xi; sr = nr; si = ni;
            }
        }
        __syncthreads();
    }
    gbar(wave_s, bar, (unsigned)nb * (++nbar));
    for (int rep = 0; rep < REP_S5; ++rep)
    for (int t0 = bid; t0 < 256; t0 += nb) {
        const int t = (nb == 256) ? ((t0 & 7) * 32 + (t0 >> 3)) : t0;
        const int g = t >> 2, i = 3 - (t & 3);
        const bf16_t* sprev = (const bf16_t*)(ws + OFF_SPREV) + (size_t)g * 256 * 128;
        Seg s0 = {(const bf16_t*)(ws + OFF_KT) + (size_t)g * 127 * 256 + 63 * 256 + (size_t)(i * 256) * 16, 16, -256, hn0 + (size_t)g * 262144, 1024, 16};
        Seg s1 = {(const bf16_t*)(ws + OFF_W3) + (size_t)g * 1024 * 128 + (size_t)(i * 256) * 128, 128, 16, sprev, 128, 16};
        EpiS5 e = {hn0, p.ssm_d, (bf16_t*)(ws + OFF_Z), g, i * 256};
        gemm_tile(wave_s, lds, s0, 4 * (i + 1), s1, 2, e);
    }
    gbar(wave_s, bar, (unsigned)nb * (++nbar));
    for (int rep = 0; rep < REP_GLU; ++rep)
    for (int r = 0, nt, mt; tile_map(r, bid, nb, 8, nt, mt); ++r) {
        Seg s = {(const bf16_t*)(ws + OFF_WGLU) + (size_t)nt * 256 * DM, DM, 16, (const bf16_t*)(ws + OFF_Z) + (size_t)mt * 256 * 16, 16, 262144};
        EpiGlu e = {p.x, p.out, hb, ssq0, nt * 256, mt * 256};
        gemm_tile(wave_s, lds, s, 16, nul, 0, e);
    }
    gbar(wave_s, bar, (unsigned)nb * (++nbar));
#pragma unroll
    for (int layer = 0; layer < 2; ++layer) {
        if (layer == 1) {
            for (int rep = 0; rep < REP_KVQ; ++rep)
            for (int r = 0, nt, mt; tile_map(r, bid, nb, 12, nt, mt); ++r) {
                Seg s = {(const bf16_t*)(ws + OFF_WKVQ) + (size_t)nt * 256 * DM, DM, 16, hb + (size_t)mt * 256 * DM, DM, 16};
                EpiKvq e = {ssq1, ws, nt * 256, mt * 256, {0.f, 0.f}};
                gemm_tile(wave_s, lds, s, 16, nul, 0, e);
            }
            gbar(wave_s, bar, (unsigned)nb * (++nbar));
            {
                float a1 = 0.f, a2 = 0.f;
                for (int i = 0; i < 64; ++i) { a1 += p.lq1[i] * p.lk1[i]; a2 += p.lq2[i] * p.lk2[i]; }
                const float lam = expf(a1) - expf(a2) + LAM_INIT;
                for (int rep = 0; rep < REP_ATTN; ++rep)
                for (int it = bid; it < 1024; it += nb) {
                    const int head = it & 7, r = it >> 3, rnd = r >> 5, j = r & 31;
                    const int qb = (rnd == 0) ? 127 - j : (rnd == 1) ? 64 + j : (rnd == 2) ? 63 - j : j;
                    attn_item(wave_s, p, head, qb, lam, lds);
                }
            }
            gbar(wave_s, bar, (unsigned)nb * (++nbar));
            for (int r = 0, nt, mt; tile_map(r, bid, nb, 4, nt, mt); ++r) {
                Seg s = {(const bf16_t*)(ws + OFF_WO) + (size_t)nt * 256 * DM, DM, 16, (const bf16_t*)(ws + OFF_ON) + (size_t)mt * 256 * DM, DM, 16};
                EpiRes e = {p.out, hb, ssq2, nt * 256, mt * 256};
                gemm_tile(wave_s, lds, s, 16, nul, 0, e);
            }
            gbar(wave_s, bar, (unsigned)nb * (++nbar));
        }
        {
            const bf16_t* wup = (const bf16_t*)(ws + (layer ? OFF_WUP1 : OFF_WUP0));
            for (int rep = 0; rep < REP_UP; ++rep)
            for (int r = 0, nt, mt; tile_map(r, bid, nb, 22, nt, mt); ++r) {
                Seg s = {wup + (size_t)nt * 256 * DM, DM, 16, hb + (size_t)mt * 256 * DM, DM, 16};
                if (layer == 0) { EpiUp<16> e = {ssq0, (bf16_t*)(ws + OFF_ACT), nt * 256, mt * 256, {0.f, 0.f}}; gemm_tile(wave_s, lds, s, 16, nul, 0, e); }
                else { EpiUp<8> e = {ssq2, (bf16_t*)(ws + OFF_ACT), nt * 256, mt * 256, {0.f, 0.f}}; gemm_tile(wave_s, lds, s, 16, nul, 0, e); }
            }
        }
        gbar(wave_s, bar, (unsigned)nb * (++nbar));
        {
            const bf16_t* wdn = (const bf16_t*)(ws + (layer ? OFF_WDN1 : OFF_WDN0));
            for (int r = 0, nt, mt; tile_map(r, bid, nb, 4, nt, mt); ++r) {
                Seg s = {wdn + (size_t)nt * 256 * FFN, FFN, 16, (const bf16_t*)(ws + OFF_ACT) + (size_t)mt * 256 * FFN, FFN, 16};
                EpiRes e = {p.out, layer ? (bf16_t*)nullptr : hb, layer ? ssq3 : ssq1, nt * 256, mt * 256};
                gemm_tile(wave_s, lds, s, FFN / 64, nul, 0, e);
            }
        }
        gbar(wave_s, bar, (unsigned)nb * (++nbar));
    }
    {
        const int lane = get_tid(wave_s) & 63, wid = wave_s;
        for (int row = bid * 8 + wid; row < L_SEQ; row += nb * 8) {
            float s = 0.f;
            for (int i = 0; i < 8; ++i) s += ssq3[(size_t)i * L_SEQ + row];
            const float rs = rsqrtf(s * (1.0f / DM) + EPSV);
#pragma unroll
            for (int i = 0; i < 4; ++i) { const size_t off = (size_t)row * DM + lane * 4 + 256 * i;
                f32x4 v = *(const f32x4*)(p.out + off); const f32x4 g = *(const f32x4*)(p.final_g + lane * 4 + 256 * i);
                v[0] *= rs * g[0]; v[1] *= rs * g[1]; v[2] *= rs * g[2]; v[3] *= rs * g[3]; *(f32x4*)(p.out + off) = v; }
        }
    }
}

static void add_job(Params& P, int& nt, const float* src, bf16_t* dst, const float* gain, int K, int N, int ld, int col0, int mode, int rowoff, float scale) {
    WJob& J = P.jobs[P.njobs++];
    J.src = src; J.dst = dst; J.gain = gain; J.K = K; J.N = N; J.ldsrc = ld; J.col0 = col0; J.mode = mode; J.rowoff = rowoff; J.scale = scale; J.tile0 = nt; J.ntn = N / 256; J.pad = 0;
    nt += (K / 64) * (N / 256);
}

extern "C" void kernel_launch(void* const* d_in, const int* in_sizes, int n_in, void* d_out, int out_size, void* d_ws, size_t ws_size, hipStream_t stream) {
    Params P; memset(&P, 0, sizeof(P));
    P.x = (const float*)d_in[0]; P.norm_mix_g = (const float*)d_in[1]; P.norm_ffn_g = (const float*)d_in[2];
    P.ffn_w1 = (const float*)d_in[3]; P.ffn_w3 = (const float*)d_in[4]; P.ffn_w2 = (const float*)d_in[5];
    P.lam_re = (const float*)d_in[6]; P.lam_im = (const float*)d_in[7]; P.log_dt = (const float*)d_in[8];
    P.b_re = (const float*)d_in[9]; P.b_im = (const float*)d_in[10]; P.c_re = (const float*)d_in[11]; P.c_im = (const float*)d_in[12];
    P.ssm_d = (const float*)d_in[13]; P.w_glu = (const float*)d_in[14]; P.kv_norm_g = (const float*)d_in[15]; P.w_kv = (const float*)d_in[16];
    P.w_q = (const float*)d_in[17]; P.lq1 = (const float*)d_in[18]; P.lk1 = (const float*)d_in[19]; P.lq2 = (const float*)d_in[20]; P.lk2 = (const float*)d_in[21];
    P.subln_g = (const float*)d_in[22]; P.w_o = (const float*)d_in[23]; P.final_g = (const float*)d_in[24];
    P.out = (float*)d_out; P.ws = (char*)d_ws;
    char* ws = (char*)d_ws; int nt = 0;
    const size_t FW = (size_t)DM * FFN;
    add_job(P, nt, P.w_glu, (bf16_t*)(ws + OFF_WGLU), nullptr, DM, 1024, 2048, 0, 1, 0, 1.0f);
    add_job(P, nt, P.w_glu, (bf16_t*)(ws + OFF_WGLU), nullptr, DM, 1024, 2048, 1024, 2, 0, 1.0f);
    add_job(P, nt, P.ffn_w1, (bf16_t*)(ws + OFF_WUP0), P.norm_ffn_g, DM, FFN, FFN, 0, 1, 0, 1.0f);
    add_job(P, nt, P.ffn_w3, (bf16_t*)(ws + OFF_WUP0), P.norm_ffn_g, DM, FFN, FFN, 0, 2, 0, 1.0f);
    add_job(P, nt, P.ffn_w2, (bf16_t*)(ws + OFF_WDN0), nullptr, FFN, DM, DM, 0, 0, 0, 1.0f);
    add_job(P, nt, P.w_kv, (bf16_t*)(ws + OFF_WKVQ), P.kv_norm_g, DM, 2048, 2048, 0, 0, 0, 1.0f);
    add_job(P, nt, P.w_q, (bf16_t*)(ws + OFF_WKVQ), P.norm_mix_g + DM, DM, 1024, 1024, 0, 0, 2048, QSCALE);
    add_job(P, nt, P.w_o, (bf16_t*)(ws + OFF_WO), nullptr, DM, DM, DM, 0, 0, 0, 1.0f);
    add_job(P, nt, P.ffn_w1 + FW, (bf16_t*)(ws + OFF_WUP1), P.norm_ffn_g + DM, DM, FFN, FFN, 0, 1, 0, 1.0f);
    add_job(P, nt, P.ffn_w3 + FW, (bf16_t*)(ws + OFF_WUP1), P.norm_ffn_g + DM, DM, FFN, FFN, 0, 2, 0, 1.0f);
    add_job(P, nt, P.ffn_w2 + FW, (bf16_t*)(ws + OFF_WDN1), nullptr, FFN, DM, DM, 0, 0, 0, 1.0f);
    P.ntiles_w = nt;
    static int grid_blocks = 0;
    if (!grid_blocks) {
        int dev = 0, cus = 0, per_cu = 0;
        hipGetDevice(&dev);
        hipDeviceGetAttribute(&cus, hipDeviceAttributeMultiprocessorCount, dev);
        hipOccupancyMaxActiveBlocksPerMultiprocessor(&per_cu, mega, NTHREADS, 0);
        if (per_cu < 1) per_cu = 1;
        grid_blocks = cus * 1;
    }
    hipMemsetAsync(ws + OFF_BAR, 0, 256, stream);
    void* args[] = {&P};
    hipError_t e = hipLaunchCooperativeKernel((void*)mega, dim3(grid_blocks), dim3(NTHREADS), args, 0, stream);
    if (e != hipSuccess) fprintf(stderr, "cooperative launch failed: %s (grid %d)\n", hipGetErrorString(e), grid_blocks);
}
```

```cpp
#include <hip/hip_runtime.h>
#include <hip/hip_cooperative_groups.h>
#include <stdint.h>
#include <string.h>
#include <stdio.h>
namespace cg = cooperative_groups;

typedef unsigned short bf16_t;
typedef short bf16x8 __attribute__((ext_vector_type(8)));
typedef float f32x16 __attribute__((ext_vector_type(16)));
typedef float f32x4 __attribute__((ext_vector_type(4)));
typedef float f32x2 __attribute__((ext_vector_type(2)));
typedef unsigned u32x4 __attribute__((ext_vector_type(4)));
typedef unsigned u32x2 __attribute__((ext_vector_type(2)));

#define L_SEQ 16384
#define DM 1024
#define FFN 2816
#define NTHREADS 512
#ifndef REP_ATTN
#define REP_ATTN 1
#endif
#ifndef REP_UP
#define REP_UP 1
#endif
#define REP_GLU 1
#define REP_KVQ 1
#define REP_S5 1
#define REP_SLOC 1
#define REP_PREP 1
#define LDS_BYTES 139280
#define EPSV 1e-6f
#define LAM_INIT 0.35550906759096927f
#define QSCALE 0.18033688011112042f

static constexpr size_t MiB = 1024ull * 1024ull;
static constexpr size_t OFF_WGLU = 0;
static constexpr size_t OFF_WUP0 = 4 * MiB;
static constexpr size_t OFF_WDN0 = 15 * MiB;
static constexpr size_t OFF_WKVQ = 20 * MiB + MiB / 2;
static constexpr size_t OFF_WO = 26 * MiB + MiB / 2;
static constexpr size_t OFF_WUP1 = 28 * MiB + MiB / 2;
static constexpr size_t OFF_WDN1 = 39 * MiB + MiB / 2;
static constexpr size_t OFF_SSQ = 45 * MiB;
static constexpr size_t OFF_A64 = 49 * MiB;
static constexpr size_t OFF_BAR = 49 * MiB + MiB / 2;
static constexpr size_t OFF_A = 50 * MiB;
static constexpr size_t OFF_HN0 = OFF_A;
static constexpr size_t OFF_Z = OFF_A + 32 * MiB;
static constexpr size_t OFF_ACT = OFF_A;
static constexpr size_t OFF_K1 = OFF_A;
static constexpr size_t OFF_K2 = OFF_A + 16 * MiB;
static constexpr size_t OFF_VT = OFF_A + 32 * MiB;
static constexpr size_t OFF_Q1 = OFF_A + 64 * MiB;
static constexpr size_t OFF_Q2 = OFF_A + 80 * MiB;
static constexpr size_t OFF_B = 146 * MiB;
static constexpr size_t OFF_KT = OFF_B;
static constexpr size_t OFF_W1 = OFF_B + 4 * MiB;
static constexpr size_t OFF_W3 = OFF_B + 20 * MiB;
static constexpr size_t OFF_SLOC = OFF_B + 36 * MiB;
static constexpr size_t OFF_SPREV = OFF_B + 44 * MiB;
static constexpr size_t OFF_HB = OFF_B;
static constexpr size_t OFF_ON = OFF_B + 32 * MiB;

struct WJob { const float* src; bf16_t* dst; const float* gain; int K; int N; int ldsrc; int col0; int mode; int rowoff; float scale; int tile0; int ntn; int pad; };

struct Params {
    const float *x, *norm_mix_g, *norm_ffn_g, *ffn_w1, *ffn_w3, *ffn_w2;
    const float *lam_re, *lam_im, *log_dt, *b_re, *b_im, *c_re, *c_im, *ssm_d, *w_glu;
    const float *kv_norm_g, *w_kv, *w_q, *lq1, *lk1, *lq2, *lk2, *subln_g, *w_o, *final_g;
    float* out;
    char* ws;
    WJob jobs[12];
    int njobs; int ntiles_w;
};

__device__ __forceinline__ int get_tid(int wave_s) { int t = wave_s * 64 + (int)__builtin_amdgcn_mbcnt_hi(~0u, __builtin_amdgcn_mbcnt_lo(~0u, 0u)); asm volatile("" : "+v"(t)); return t; }
__device__ __forceinline__ unsigned pk_bf16(float lo, float hi) { unsigned r; asm("v_cvt_pk_bf16_f32 %0, %1, %2" : "=v"(r) : "v"(lo), "v"(hi)); return r; }
__device__ __forceinline__ float bf_lo(unsigned u) { return __uint_as_float(u << 16); }
__device__ __forceinline__ float bf_hi(unsigned u) { return __uint_as_float(u & 0xffff0000u); }
__device__ __forceinline__ float fast_rcp(float x) { return __builtin_amdgcn_rcpf(x); }
__device__ __forceinline__ float fast_exp2(float x) { return __builtin_amdgcn_exp2f(x); }
__device__ __forceinline__ float sigmoidf_(float x) { return fast_rcp(1.0f + fast_exp2(-1.4426950408889634f * x)); }
__device__ __forceinline__ float gelu_tanh(float x) {
    const float u = 0.7978845608028654f * x * (1.0f + 0.044715f * x * x);
    return x * fast_rcp(1.0f + fast_exp2(-2.8853900817779268f * u));
}

struct Seg { const bf16_t* W; long wrs; long wkhi; const bf16_t* X; long xrs; long xkhi; };

struct TileCtx { int wn, wm, lane; };

template <class Epi>
__device__ __forceinline__ void gemm_tile(const int wave_s, char* lds, const Seg s0, const int nk0_, const Seg s1, const int nk1_, Epi& epi) {
    int tid = get_tid(wave_s);
    const int lane = tid & 63;
    const int wn = wave_s >> 2, wm = wave_s & 3;
    const int lr = lane & 31, h = lane >> 5;
    const int nk0 = nk0_ * 2, nk1 = nk1_ * 2, nk = nk0 + nk1;
    const int cch = (lane & 3) ^ ((lane >> 4) & 3);
    const int row0 = wave_s * 32 + (lane >> 2);
    f32x16 acc[4][2];
#pragma unroll
    for (int a = 0; a < 4; ++a)
#pragma unroll
        for (int b = 0; b < 2; ++b)
#pragma unroll
            for (int r = 0; r < 16; ++r) acc[a][b][r] = 0.f;
    auto issue = [&](int t) {
        const bool first = t < nk0;
        const bf16_t* W = first ? s0.W : s1.W; const bf16_t* X = first ? s0.X : s1.X;
        const long wrs = first ? s0.wrs : s1.wrs, xrs = first ? s0.xrs : s1.xrs;
        const long wkhi = first ? s0.wkhi : s1.wkhi, xkhi = first ? s0.xkhi : s1.xkhi;
        const int kt = first ? t : t - nk0;
        const long kc = kt * 2 + (cch >> 1);
        const bf16_t* wp = W + (long)row0 * wrs + kc * wkhi + (cch & 1) * 8;
        const bf16_t* xp = X + (long)row0 * xrs + kc * xkhi + (cch & 1) * 8;
        char* st = lds + (t & 3) * 32768 + wave_s * 2048;
        __builtin_amdgcn_global_load_lds((const unsigned*)wp, (__attribute__((address_space(3))) unsigned*)(st), 16, 0, 0);
        __builtin_amdgcn_global_load_lds((const unsigned*)(wp + 16 * wrs), (__attribute__((address_space(3))) unsigned*)(st + 1024), 16, 0, 0);
        __builtin_amdgcn_global_load_lds((const unsigned*)xp, (__attribute__((address_space(3))) unsigned*)(st + 16384), 16, 0, 0);
        __builtin_amdgcn_global_load_lds((const unsigned*)(xp + 16 * xrs), (__attribute__((address_space(3))) unsigned*)(st + 16384 + 1024), 16, 0, 0);
    };
    const int sw = (lr >> 2) & 3;
    const int aoff = (wn * 128 + lr) * 64, boff = 16384 + (wm * 64 + lr) * 64;
    const int ch0 = ((0 + h) ^ sw) << 4, ch1 = ((2 + h) ^ sw) << 4;
    bf16x8 a0[4], b0[2], a1[4], b1[2];
    epi.pre(wm, lane, wn);
    issue(0); issue(1); issue(2); issue(3);
    asm volatile("s_waitcnt vmcnt(12)" ::: "memory");
    __builtin_amdgcn_s_barrier(); asm volatile("" ::: "memory");
#pragma unroll
    for (int nb = 0; nb < 4; ++nb) a0[nb] = *(const bf16x8*)(lds + aoff + nb * 2048 + ch0);
#pragma unroll
    for (int mb = 0; mb < 2; ++mb) b0[mb] = *(const bf16x8*)(lds + boff + mb * 2048 + ch0);
    for (int t = 0; t < nk; ++t) {
        const char* st = lds + (t & 3) * 32768;
#pragma unroll
        for (int nb = 0; nb < 4; ++nb) a1[nb] = *(const bf16x8*)(st + aoff + nb * 2048 + ch1);
#pragma unroll
        for (int mb = 0; mb < 2; ++mb) b1[mb] = *(const bf16x8*)(st + boff + mb * 2048 + ch1);
#pragma unroll
        for (int nb = 0; nb < 4; ++nb)
#pragma unroll
            for (int mb = 0; mb < 2; ++mb) acc[nb][mb] = __builtin_amdgcn_mfma_f32_32x32x16_bf16(a0[nb], b0[mb], acc[nb][mb], 0, 0, 0);
        const int rem = nk - 1 - t;
        if (rem >= 3) asm volatile("s_waitcnt vmcnt(8)" ::: "memory");
        else if (rem == 2) asm volatile("s_waitcnt vmcnt(4)" ::: "memory");
        else asm volatile("s_waitcnt vmcnt(0)" ::: "memory");
        asm volatile("s_waitcnt lgkmcnt(0)" ::: "memory");
        __builtin_amdgcn_s_barrier(); asm volatile("" ::: "memory");
        if (t + 4 < nk) issue(t + 4);
        if (t + 1 < nk) {
            const char* sn = lds + ((t + 1) & 3) * 32768;
#pragma unroll
            for (int nb = 0; nb < 4; ++nb) a0[nb] = *(const bf16x8*)(sn + aoff + nb * 2048 + ch0);
#pragma unroll
            for (int mb = 0; mb < 2; ++mb) b0[mb] = *(const bf16x8*)(sn + boff + mb * 2048 + ch0);
        }
#pragma unroll
        for (int nb = 0; nb < 4; ++nb)
#pragma unroll
            for (int mb = 0; mb < 2; ++mb) acc[nb][mb] = __builtin_amdgcn_mfma_f32_32x32x16_bf16(a1[nb], b1[mb], acc[nb][mb], 0, 0, 0);
    }
    TileCtx c; c.wn = wn; c.wm = wm; c.lane = lane;
    epi(acc, c);
}

template <int NPART>
__device__ __forceinline__ float rstd_from(const float* ssq, int token) {
    float v[NPART];
#pragma unroll
    for (int i = 0; i < NPART; ++i) v[i] = ssq[(size_t)i * L_SEQ + token];
    float s = 0.f;
#pragma unroll
    for (int i = 0; i < NPART; ++i) s += v[i];
    return rsqrtf(s * (1.0f / DM) + EPSV);
}

struct EpiSloc {
    float* dst;
    __device__ __forceinline__ void pre(int, int, int) {}
    __device__ __forceinline__ void operator()(f32x16 (&acc)[4][2], const TileCtx& c) const {
        if (c.wn != 0) return;
        const int lr = c.lane & 31, h = c.lane >> 5;
#pragma unroll
        for (int mb = 0; mb < 2; ++mb) { const int m = c.wm * 64 + mb * 32 + lr;
#pragma unroll
            for (int nb = 0; nb < 4; ++nb)
#pragma unroll
                for (int rq = 0; rq < 4; ++rq) { const int n = nb * 32 + rq * 8 + 4 * h;
                    f32x4 v = {acc[nb][mb][4 * rq], acc[nb][mb][4 * rq + 1], acc[nb][mb][4 * rq + 2], acc[nb][mb][4 * rq + 3]};
                    *(f32x4*)(dst + m * 132 + n) = v; } }
    }
};

struct EpiS5 {
    const bf16_t* hn0; const float* dskip; bf16_t* z; int g; int n0;
    __device__ __forceinline__ void pre(int, int, int) {}
    __device__ __forceinline__ void operator()(f32x16 (&acc)[4][2], const TileCtx& c) const {
        const int lr = c.lane & 31, h = c.lane >> 5;
#pragma unroll
        for (int mb = 0; mb < 2; ++mb) { const int j = c.wm * 64 + mb * 32 + lr;
            u32x2 uu[16];
#pragma unroll
            for (int q = 0; q < 16; ++q) { const int n = n0 + c.wn * 128 + (q >> 2) * 32 + (q & 3) * 8 + 4 * h; uu[q] = *(const u32x2*)(hn0 + (size_t)g * 262144 + (size_t)j * 1024 + n); }
            asm volatile("" ::: "memory");
#pragma unroll
            for (int q = 0; q < 16; ++q) { const int nb = q >> 2, rq = q & 3; const int n = n0 + c.wn * 128 + nb * 32 + rq * 8 + 4 * h; const int t = n >> 4, cc = n & 15;
                const size_t off = (size_t)g * 262144 + (size_t)(j * 64 + t) * 16 + cc; const f32x4 d4 = *(const f32x4*)(dskip + g * 16 + cc);
                const float y0 = acc[nb][mb][4 * rq] + d4[0] * bf_lo(uu[q][0]), y1 = acc[nb][mb][4 * rq + 1] + d4[1] * bf_hi(uu[q][0]);
                const float y2 = acc[nb][mb][4 * rq + 2] + d4[2] * bf_lo(uu[q][1]), y3 = acc[nb][mb][4 * rq + 3] + d4[3] * bf_hi(uu[q][1]);
                u32x2 o; o[0] = pk_bf16(gelu_tanh(y0), gelu_tanh(y1)); o[1] = pk_bf16(gelu_tanh(y2), gelu_tanh(y3));
                *(u32x2*)(z + off) = o; }
            asm volatile("" ::: "memory"); }
    }
};

struct EpiGlu {
    const float* x; float* out; bf16_t* hb; float* ssq; int n0, m0;
    __device__ __forceinline__ void pre(int, int, int) {}
    __device__ __forceinline__ void operator()(f32x16 (&acc)[4][2], const TileCtx& c) const {
        const int lr = c.lane & 31, h = c.lane >> 5;
#pragma unroll
        for (int mb = 0; mb < 2; ++mb) { const int m = m0 + c.wm * 64 + mb * 32 + lr; float s = 0.f;
            const size_t rowoff = (size_t)m * DM + ((n0 + c.wn * 128) >> 1) + 4 * h;
            f32x4 xv[8];
#pragma unroll
            for (int q = 0; q < 8; ++q) xv[q] = *(const f32x4*)(x + rowoff + (q >> 1) * 16 + (q & 1) * 8);
            asm volatile("" ::: "memory");
#pragma unroll
            for (int q = 0; q < 8; ++q) { const int nb = q >> 1, rg = q & 1; const size_t off = rowoff + nb * 16 + rg * 8; f32x4 o;
#pragma unroll
                for (int e = 0; e < 4; ++e) { o[e] = xv[q][e] + acc[nb][mb][rg * 8 + e] * sigmoidf_(acc[nb][mb][rg * 8 + 4 + e]); s += o[e] * o[e]; }
                *(f32x4*)(out + off) = o; u32x2 b; b[0] = pk_bf16(o[0], o[1]); b[1] = pk_bf16(o[2], o[3]); *(u32x2*)(hb + off) = b; }
            asm volatile("" ::: "memory");
            s += __shfl_xor(s, 32);
            if (h == 0) ssq[(size_t)((n0 >> 8) * 2 + c.wn) * L_SEQ + m] = s; }
    }
};

template <int NPART> struct EpiUp {
    const float* ssq; bf16_t* act; int n0, m0; float rsv[2];
    __device__ __forceinline__ void pre(int wm, int lane, int) {
#pragma unroll
        for (int mb = 0; mb < 2; ++mb) rsv[mb] = rstd_from<NPART>(ssq, m0 + wm * 64 + mb * 32 + (lane & 31)); }
    __device__ __forceinline__ void operator()(f32x16 (&acc)[4][2], const TileCtx& c) const {
        const int lr = c.lane & 31, h = c.lane >> 5;
#pragma unroll
        for (int mb = 0; mb < 2; ++mb) { const int m = m0 + c.wm * 64 + mb * 32 + lr; const float rs = rsv[mb];
#pragma unroll
            for (int nb = 0; nb < 4; ++nb)
#pragma unroll
                for (int rg = 0; rg < 2; ++rg) { const int f = ((n0 + c.wn * 128 + nb * 32) >> 1) + rg * 8 + 4 * h; float o[4];
#pragma unroll
                    for (int e = 0; e < 4; ++e) { const float a = acc[nb][mb][rg * 8 + e] * rs, b = acc[nb][mb][rg * 8 + 4 + e] * rs; o[e] = a * sigmoidf_(a) * b; }
                    u32x2 bb; bb[0] = pk_bf16(o[0], o[1]); bb[1] = pk_bf16(o[2], o[3]); *(u32x2*)(act + (size_t)m * FFN + f) = bb; } }
    }
};

struct EpiRes {
    float* out; bf16_t* hb; float* ssq; int n0, m0;
    __device__ __forceinline__ void pre(int, int, int) {}
    __device__ __forceinline__ void operator()(f32x16 (&acc)[4][2], const TileCtx& c) const {
        const int lr = c.lane & 31, h = c.lane >> 5;
#pragma unroll
        for (int mb = 0; mb < 2; ++mb) { const int m = m0 + c.wm * 64 + mb * 32 + lr; float s = 0.f;
            const size_t rowoff = (size_t)m * DM + n0 + c.wn * 128 + 4 * h;
#pragma unroll
            for (int np = 0; np < 2; ++np) {
                f32x4 o[8];
#pragma unroll
                for (int q = 0; q < 8; ++q) o[q] = *(const f32x4*)(out + rowoff + (np * 2 + (q >> 2)) * 32 + (q & 3) * 8);
                asm volatile("" ::: "memory");
#pragma unroll
                for (int q = 0; q < 8; ++q) { const int nb = np * 2 + (q >> 2), rq = q & 3; const size_t off = rowoff + nb * 32 + rq * 8;
#pragma unroll
                    for (int e = 0; e < 4; ++e) { o[q][e] += acc[nb][mb][4 * rq + e]; s += o[q][e] * o[q][e]; }
                    *(f32x4*)(out + off) = o[q];
                    if (hb) { u32x2 b; b[0] = pk_bf16(o[q][0], o[q][1]); b[1] = pk_bf16(o[q][2], o[q][3]); *(u32x2*)(hb + off) = b; } }
                asm volatile("" ::: "memory");
            }
            s += __shfl_xor(s, 32);
            if (h == 0) ssq[(size_t)((n0 >> 8) * 2 + c.wn) * L_SEQ + m] = s; }
    }
};

struct EpiKvq {
    const float* ssq; char* ws; int n0, m0; float rsv[2];
    __device__ __forceinline__ void pre(int wm, int lane, int) {
#pragma unroll
        for (int mb = 0; mb < 2; ++mb) rsv[mb] = rstd_from<8>(ssq, m0 + wm * 64 + mb * 32 + (lane & 31)); }
    __device__ __forceinline__ void operator()(f32x16 (&acc)[4][2], const TileCtx& c) const {
        const int lr = c.lane & 31, h = c.lane >> 5;
        const bool isV = (n0 >= 1024 && n0 < 2048);
#pragma unroll
        for (int mb = 0; mb < 2; ++mb) { const int m = m0 + c.wm * 64 + mb * 32 + lr; const float rs = rsv[mb];
            if (isV) {
                const int mp = (m & ~12) | ((m & 4) << 1) | ((m & 8) >> 1);
                bf16_t* vt = (bf16_t*)(ws + OFF_VT);
#pragma unroll
                for (int nb = 0; nb < 4; ++nb)
#pragma unroll
                    for (int r = 0; r < 16; ++r) { const int nl = n0 - 1024 + c.wn * 128 + nb * 32 + (r & 3) + 8 * (r >> 2) + 4 * h;
                        vt[(size_t)nl * L_SEQ + mp] = (bf16_t)(pk_bf16(acc[nb][mb][r] * rs, 0.f) & 0xffffu); }
            } else {
                size_t base; int nl;
                if (n0 < 512) { base = OFF_K1; nl = n0; } else if (n0 < 1024) { base = OFF_K2; nl = n0 - 512; } else if (n0 < 2560) { base = OFF_Q1; nl = n0 - 2048; } else { base = OFF_Q2; nl = n0 - 2560; }
                bf16_t* dst = (bf16_t*)(ws + base);
                float cs[4], sn[4];
#pragma unroll
                for (int e = 0; e < 4; ++e) { const int i = 4 * h + e;
                    const float invf = (i == 0) ? 1.0f : (i == 1) ? 0.19391188f : (i == 2) ? 0.037601817f : (i == 3) ? 0.0072914392f : (i == 4) ? 0.0014142136f : (i == 5) ? 0.00027423282f : (i == 6) ? 5.3176997e-05f : 1.0311653e-05f;
                    const float ang = (float)m * invf; double rev = (double)ang * 0.15915494309189535; rev -= rint(rev); const float fr = (float)rev;
                    cs[e] = __builtin_amdgcn_cosf(fr); sn[e] = __builtin_amdgcn_sinf(fr); }
#pragma unroll
                for (int nb = 0; nb < 4; ++nb) {
                    const int nn = nl + c.wn * 128 + nb * 32; const int head = nn >> 6, d0 = nn & 63;
                    float v[16];
#pragma unroll
                    for (int r = 0; r < 16; ++r) v[r] = acc[nb][mb][r] * rs;
                    if (d0 == 0) {
#pragma unroll
                        for (int e = 0; e < 4; ++e) { const float x1 = v[e], x2 = v[4 + e]; v[e] = x1 * cs[e] - x2 * sn[e]; v[4 + e] = x2 * cs[e] + x1 * sn[e]; }
                    }
#pragma unroll
                    for (int rq = 0; rq < 4; ++rq) { u32x2 b; b[0] = pk_bf16(v[4 * rq], v[4 * rq + 1]); b[1] = pk_bf16(v[4 * rq + 2], v[4 * rq + 3]);
                        *(u32x2*)(dst + ((size_t)head * L_SEQ + m) * 64 + d0 + rq * 8 + 4 * h) = b; }
                }
            } }
    }
};

__device__ __forceinline__ void s5_tables(const int wave_s, const Params& p, int g, char* lds) {
    f32x2* apow = (f32x2*)lds;
    f32x2* bb = apow + 65 * 64;
    f32x2* cc = bb + 1024;
    f32x2* zf = cc + 1024;
    int tid = get_tid(wave_s); asm volatile("" : "+v"(tid));
    const float dt = expf(p.log_dt[g]);
    for (int e = tid; e < 65 * 64; e += NTHREADS) {
        const int lag = e >> 6, pp = e & 63;
        const float lr = p.lam_re[g * 64 + pp], li = p.lam_im[g * 64 + pp];
        const float mag = expf(lr * dt * (float)lag);
        double rev = (double)li * (double)dt * (double)lag * 0.15915494309189535; rev -= rint(rev);
        const float fr = (float)rev;
        f32x2 v; v[0] = mag * __builtin_amdgcn_cosf(fr); v[1] = mag * __builtin_amdgcn_sinf(fr); apow[e] = v;
    }
    if (tid < 64) {
        const float lr = p.lam_re[g * 64 + tid], li = p.lam_im[g * 64 + tid];
        const float em1 = expm1f(lr * dt);
        double rev = (double)li * (double)dt * 0.15915494309189535; const double rh = rev * 0.5; rev -= rint(rev);
        const double rh2 = rh - rint(rh);
        const float cth = __builtin_amdgcn_cosf((float)rev), sth = __builtin_amdgcn_sinf((float)rev), shalf = __builtin_amdgcn_sinf((float)rh2);
        const float nr = em1 * cth - 2.0f * shalf * shalf, ni = (1.0f + em1) * sth;
        const float den = lr * lr + li * li;
        f32x2 f; f[0] = (nr * lr + ni * li) / den; f[1] = (ni * lr - nr * li) / den; zf[tid] = f;
    }
    __syncthreads();
    for (int e = tid; e < 1024; e += NTHREADS) {
        const int pp = e >> 4;
        const float br = p.b_re[(size_t)g * 1024 + e], bi = p.b_im[(size_t)g * 1024 + e];
        const f32x2 f = zf[pp]; f32x2 v; v[0] = f[0] * br - f[1] * bi; v[1] = f[0] * bi + f[1] * br; bb[e] = v;
        f32x2 cv; cv[0] = p.c_re[(size_t)g * 1024 + e]; cv[1] = p.c_im[(size_t)g * 1024 + e]; cc[e] = cv;
    }
    __syncthreads();
    bf16_t* kt = (bf16_t*)(p.ws + OFF_KT) + (size_t)g * 127 * 256;
    bf16_t* w1 = (bf16_t*)(p.ws + OFF_W1) + (size_t)g * 128 * 1024;
    bf16_t* w3 = (bf16_t*)(p.ws + OFF_W3) + (size_t)g * 1024 * 128;
    {
        const int cp = tid & 255, c = cp >> 4, c2 = cp & 15, half = tid >> 8;
        float acc[32];
#pragma unroll
        for (int l = 0; l < 32; ++l) acc[l] = 0.f;
        for (int pp = 0; pp < 64; ++pp) {
            const f32x2 cv = cc[c * 64 + pp], bv = bb[pp * 16 + c2];
            const float cbr = cv[0] * bv[0] - cv[1] * bv[1], cbi = cv[0] * bv[1] + cv[1] * bv[0];
#pragma unroll
            for (int l = 0; l < 32; ++l) { const f32x2 a = apow[(half * 32 + l) * 64 + pp]; acc[l] += cbr * a[0] - cbi * a[1]; }
        }
#pragma unroll
        for (int l = 0; l < 32; ++l) kt[(size_t)(63 + half * 32 + l) * 256 + cp] = (bf16_t)(pk_bf16(acc[l], 0.f) & 0xffffu);
        for (int e = tid; e < 63 * 256 / 8; e += NTHREADS) { u32x4 zz = {0u, 0u, 0u, 0u}; *(u32x4*)(kt + e * 8) = zz; }
    }
    for (int q = tid; q < 128 * 128; q += NTHREADS) {
        const int pq = q >> 7, kc = q & 127, tau = kc >> 1, c0 = (kc & 1) * 8, pp = pq & 63, im = pq >> 6;
        const f32x2 a = apow[(63 - tau) * 64 + pp]; float v[8];
#pragma unroll
        for (int e = 0; e < 8; ++e) { const f32x2 b = bb[pp * 16 + c0 + e]; v[e] = im ? (a[0] * b[1] + a[1] * b[0]) : (a[0] * b[0] - a[1] * b[1]); }
        u32x4 o; o[0] = pk_bf16(v[0], v[1]); o[1] = pk_bf16(v[2], v[3]); o[2] = pk_bf16(v[4], v[5]); o[3] = pk_bf16(v[6], v[7]);
        *(u32x4*)(w1 + (size_t)pq * 1024 + kc * 8) = o;
    }
    for (int q = tid; q < 1024 * 16; q += NTHREADS) {
        const int n = q >> 4, p0 = (q & 15) * 8, t = n >> 4, c = n & 15, im = p0 >> 6; float v[8];
#pragma unroll
        for (int e = 0; e < 8; ++e) { const int pp = (p0 + e) & 63; const f32x2 a = apow[(t + 1) * 64 + pp]; const f32x2 cv = cc[c * 64 + pp];
            v[e] = im ? -(cv[0] * a[1] + cv[1] * a[0]) : (cv[0] * a[0] - cv[1] * a[1]); }
        u32x4 o; o[0] = pk_bf16(v[0], v[1]); o[1] = pk_bf16(v[2], v[3]); o[2] = pk_bf16(v[4], v[5]); o[3] = pk_bf16(v[6], v[7]);
        *(u32x4*)(w3 + (size_t)n * 128 + p0) = o;
    }
    if (tid < 64) ((f32x2*)(p.ws + OFF_A64))[g * 64 + tid] = apow[64 * 64 + tid];
    __syncthreads();
}

__device__ __forceinline__ void wtile(const int wave_s, const Params& p, int t, char* lds) {
    int j = 0;
    for (int i = 1; i < p.njobs; ++i) if (t >= p.jobs[i].tile0) j = i;
    const WJob& J = p.jobs[j];
    const int lt = t - J.tile0, kt = lt / J.ntn, nt = lt - kt * J.ntn;
    const int k0 = kt * 64, nl0 = nt * 256;
    float* T = (float*)lds;
    int tid = get_tid(wave_s); asm volatile("" : "+v"(tid));
    const int c4 = (tid & 63) * 4, kb = tid >> 6;
    f32x4 v[8];
#pragma unroll
    for (int i = 0; i < 8; ++i) v[i] = *(const f32x4*)(J.src + (size_t)(k0 + kb + 8 * i) * J.ldsrc + J.col0 + nl0 + c4);
#pragma unroll
    for (int i = 0; i < 8; ++i) { const int kk = kb + 8 * i; float sc = J.scale; if (J.gain) sc *= J.gain[k0 + kk];
        T[kk * 257 + c4] = v[i][0] * sc; T[kk * 257 + c4 + 1] = v[i][1] * sc; T[kk * 257 + c4 + 2] = v[i][2] * sc; T[kk * 257 + c4 + 3] = v[i][3] * sc; }
    __syncthreads();
    { const int nn = tid >> 1, kh = (tid & 1) * 32;
        const int n = nl0 + nn; int row = (J.mode == 0) ? n : ((n >> 3) * 16 + (n & 7) + (J.mode == 2 ? 8 : 0)); row += J.rowoff;
        bf16_t* d = J.dst + (size_t)row * J.K + k0 + kh;
#pragma unroll
        for (int q = 0; q < 4; ++q) { float w[8];
#pragma unroll
            for (int e = 0; e < 8; ++e) w[e] = T[(kh + q * 8 + e) * 257 + nn];
            u32x4 o; o[0] = pk_bf16(w[0], w[1]); o[1] = pk_bf16(w[2], w[3]); o[2] = pk_bf16(w[4], w[5]); o[3] = pk_bf16(w[6], w[7]);
            *(u32x4*)(d + q * 8) = o; } }
    __syncthreads();
}

__device__ __forceinline__ void rms0_item(const int wave_s, const Params& p, int item) {
    const int lane = get_tid(wave_s) & 63, wid = wave_s;
    bf16_t* hn0 = (bf16_t*)(p.ws + OFF_HN0);
    for (int r = 0; r < 8; ++r) {
        const int row = item * 64 + wid * 8 + r;
        f32x4 v[4]; float s = 0.f;
#pragma unroll
        for (int i = 0; i < 4; ++i) { v[i] = *(const f32x4*)(p.x + (size_t)row * DM + lane * 4 + 256 * i); s += v[i][0] * v[i][0] + v[i][1] * v[i][1] + v[i][2] * v[i][2] + v[i][3] * v[i][3]; }
#pragma unroll
        for (int o = 32; o >= 1; o >>= 1) s += __shfl_xor(s, o);
        const float rs = rsqrtf(s * (1.0f / DM) + EPSV);
#pragma unroll
        for (int i = 0; i < 4; ++i) { const f32x4 g = *(const f32x4*)(p.norm_mix_g + lane * 4 + 256 * i);
            u32x2 o; o[0] = pk_bf16(v[i][0] * rs * g[0], v[i][1] * rs * g[1]); o[1] = pk_bf16(v[i][2] * rs * g[2], v[i][3] * rs * g[3]);
            { const int col = lane * 4 + 256 * i; *(u32x2*)(hn0 + (size_t)(col >> 4) * 262144 + (size_t)(row >> 6) * 1024 + (row & 63) * 16 + (col & 15)) = o; } }
    }
}

__device__ __forceinline__ void attn_item(const int wave_s, const Params& p, int head, int qb, float lam, char* lds) {
    int tid = get_tid(wave_s); asm volatile("" : "+v"(tid));
    const int lane = tid & 63, wid = tid >> 6;
    const int mp = wid >> 2, g = wid & 3;
    const int lr = lane & 31, h = lane >> 5, sw = (lane >> 1) & 7;
    const bf16_t* K1 = (const bf16_t*)(p.ws + OFF_K1) + (size_t)head * L_SEQ * 64;
    const bf16_t* K2 = (const bf16_t*)(p.ws + OFF_K2) + (size_t)head * L_SEQ * 64;
    const bf16_t* VT = (const bf16_t*)(p.ws + OFF_VT) + (size_t)head * 128 * L_SEQ;
    const bf16_t* Q = (const bf16_t*)(p.ws + (mp ? OFF_Q2 : OFF_Q1)) + (size_t)head * L_SEQ * 64;
    const int q0 = qb * 128 + g * 32;
    bf16x8 qf[4];
#pragma unroll
    for (int s = 0; s < 4; ++s) qf[s] = *(const bf16x8*)(Q + (size_t)(q0 + lr) * 64 + 16 * s + 8 * h);
    const int nkt = 2 * qb + 2;
    const int my_last = 2 * qb + (g >> 1);
    f32x16 O[4];
#pragma unroll
    for (int e = 0; e < 4; ++e)
#pragma unroll
        for (int r = 0; r < 16; ++r) O[e][r] = 0.f;
    float m_run = -1e30f, l_run = 0.f;
    const int lrow = lane >> 3;
    const int ck = (lane & 7) ^ (((wave_s & 1) * 4 + (lane >> 4)) & 7);
    const int cv0 = (lane & 7) ^ (lane >> 4), cv1 = (lane & 7) ^ (4 + (lane >> 4));
    const bf16_t* k1p = K1 + (size_t)(wave_s * 8 + lrow) * 64 + ck * 8;
    const bf16_t* k2p = K2 + (size_t)(wave_s * 8 + lrow) * 64 + ck * 8;
    const bf16_t* v0p = VT + (size_t)(wave_s * 16 + lrow) * L_SEQ + cv0 * 8;
    const bf16_t* v1p = VT + (size_t)(wave_s * 16 + 8 + lrow) * L_SEQ + cv1 * 8;
    auto issue = [&](int kt) {
        char* st = lds + (kt & 3) * 32768;
        __builtin_amdgcn_global_load_lds((const unsigned*)(k1p + (size_t)kt * 4096), (__attribute__((address_space(3))) unsigned*)(st + wave_s * 1024), 16, 0, 0);
        __builtin_amdgcn_global_load_lds((const unsigned*)(k2p + (size_t)kt * 4096), (__attribute__((address_space(3))) unsigned*)(st + 8192 + wave_s * 1024), 16, 0, 0);
        __builtin_amdgcn_global_load_lds((const unsigned*)(v0p + kt * 64), (__attribute__((address_space(3))) unsigned*)(st + 16384 + wave_s * 2048), 16, 0, 0);
        __builtin_amdgcn_global_load_lds((const unsigned*)(v1p + kt * 64), (__attribute__((address_space(3))) unsigned*)(st + 16384 + wave_s * 2048 + 1024), 16, 0, 0);
    };
    issue(0); issue(1);
    if (nkt > 2) issue(2);
    if (nkt > 2) asm volatile("s_waitcnt vmcnt(8)" ::: "memory");
    else asm volatile("s_waitcnt vmcnt(4)" ::: "memory");
    __builtin_amdgcn_s_barrier(); asm volatile("" ::: "memory");
    const int koff_ = mp * 8192 + lr * 128, voff_ = 16384 + lr * 128;
    int chk[4], chv[4];
#pragma unroll
    for (int s = 0; s < 4; ++s) { chk[s] = ((2 * s + h) ^ sw) << 4; chv[s] = chk[s]; }
    bf16x8 kf[8], vf[8];
#pragma unroll
    for (int i = 0; i < 8; ++i) kf[i] = *(const bf16x8*)(lds + koff_ + (i >> 2) * 4096 + chk[i & 3]);
    for (int kt = 0; kt < nkt; ++kt) {
        const bool active = kt <= my_last;
        const char* stg = lds + (kt & 3) * 32768;
        f32x16 S[2];
        bf16x8 pf[2][2];
        if (active) {
#pragma unroll
            for (int kb = 0; kb < 2; ++kb) {
#pragma unroll
                for (int r = 0; r < 16; ++r) S[kb][r] = 0.f;
#pragma unroll
                for (int s = 0; s < 4; ++s) S[kb] = __builtin_amdgcn_mfma_f32_32x32x16_bf16(kf[kb * 4 + s], qf[s], S[kb], 0, 0, 0);
            }
#pragma unroll
            for (int i = 0; i < 8; ++i) vf[i] = *(const bf16x8*)(stg + voff_ + (i & 3) * 4096 + chv[i >> 2]);
            __builtin_amdgcn_sched_barrier(0);
            float mt = S[0][0];
#pragma unroll
            for (int r = 1; r < 16; ++r) mt = fmaxf(mt, S[0][r]);
#pragma unroll
            for (int r = 0; r < 16; ++r) mt = fmaxf(mt, S[1][r]);
            mt = fmaxf(mt, __shfl_xor(mt, 32));
            const bool need = mt > m_run + 8.0f;
            if (__any(need)) {
                const float mnew = need ? mt : m_run;
                const float alpha = fast_exp2(m_run - mnew);
                m_run = mnew; l_run *= alpha;
#pragma unroll
                for (int e = 0; e < 4; ++e)
#pragma unroll
                    for (int r = 0; r < 16; ++r) O[e][r] *= alpha;
            }
            float ls = 0.f;
#pragma unroll
            for (int kb = 0; kb < 2; ++kb)
#pragma unroll
                for (int s = 0; s < 2; ++s) { float e_[8];
#pragma unroll
                    for (int j = 0; j < 8; ++j) { e_[j] = fast_exp2(S[kb][8 * s + j] - m_run); ls += e_[j]; }
                    u32x4 pk; pk[0] = pk_bf16(e_[0], e_[1]); pk[1] = pk_bf16(e_[2], e_[3]); pk[2] = pk_bf16(e_[4], e_[5]); pk[3] = pk_bf16(e_[6], e_[7]);
                    pf[kb][s] = __builtin_bit_cast(bf16x8, pk); }
            l_run += ls;
        }
        const int rem = nkt - 1 - kt;
        if (rem >= 2) asm volatile("s_waitcnt vmcnt(4)" ::: "memory");
        else asm volatile("s_waitcnt vmcnt(0)" ::: "memory");
        __builtin_amdgcn_s_barrier(); asm volatile("" ::: "memory");
        if (kt + 3 < nkt) issue(kt + 3);
        if (kt + 1 <= my_last) {
            const char* sn = lds + ((kt + 1) & 3) * 32768;
#pragma unroll
            for (int i = 0; i < 8; ++i) kf[i] = *(const bf16x8*)(sn + koff_ + (i >> 2) * 4096 + chk[i & 3]);
        }
        __builtin_amdgcn_sched_barrier(0);
        if (active) {
#pragma unroll
            for (int i = 0; i < 8; ++i) O[i & 3] = __builtin_amdgcn_mfma_f32_32x32x16_bf16(vf[i], pf[0][i >> 2], O[i & 3], 0, 0, 0);
#pragma unroll
            for (int i = 0; i < 8; ++i) vf[i] = *(const bf16x8*)(stg + voff_ + (i & 3) * 4096 + (((4 + 2 * (i >> 2) + h) ^ sw) << 4));
#pragma unroll
            for (int i = 0; i < 8; ++i) O[i & 3] = __builtin_amdgcn_mfma_f32_32x32x16_bf16(vf[i], pf[1][i >> 2], O[i & 3], 0, 0, 0);
        }
    }
    __syncthreads();
    const float lt = l_run + __shfl_xor(l_run, 32);
    const float inv = fast_rcp(lt) * (mp ? lam : 1.0f);
    float* ex = (float*)lds;
    if (mp == 1) {
#pragma unroll
        for (int e = 0; e < 4; ++e)
#pragma unroll
            for (int r = 0; r < 16; ++r) ex[((g * 4 + e) * 16 + r) * 64 + lane] = O[e][r] * inv;
    }
    __syncthreads();
    if (mp == 0) {
        float ss = 0.f;
#pragma unroll
        for (int e = 0; e < 4; ++e)
#pragma unroll
            for (int r = 0; r < 16; ++r) { const float o = O[e][r] * inv - ex[((g * 4 + e) * 16 + r) * 64 + lane]; O[e][r] = o; ss += o * o; }
        ss += __shfl_xor(ss, 32);
        const float rs = rsqrtf(ss * (1.0f / 128.0f) + EPSV) * (1.0f - LAM_INIT);
        bf16_t* on = (bf16_t*)(p.ws + OFF_ON) + (size_t)(q0 + lr) * DM + head * 128;
#pragma unroll
        for (int e = 0; e < 4; ++e)
#pragma unroll
            for (int rq = 0; rq < 4; ++rq) { const int ee = e * 32 + rq * 8 + 4 * h; const f32x4 gg = *(const f32x4*)(p.subln_g + ee);
                u32x2 b; b[0] = pk_bf16(O[e][4 * rq] * rs * gg[0], O[e][4 * rq + 1] * rs * gg[1]); b[1] = pk_bf16(O[e][4 * rq + 2] * rs * gg[2], O[e][4 * rq + 3] * rs * gg[3]);
                *(u32x2*)(on + ee) = b; }
    }
    __syncthreads();
}


#define XB_XCNT(j)  (64 + 64 * (j))
#define XB_XSUB(j)  (1088 + 64 * (j))
#define XB_XGEN(j)  (2112 + 64 * (j))
#define XB_TOP      3136
#define XB_TOPGEN   3200
#define XB_WORDS    3264
__device__ __forceinline__ unsigned xb_ld(unsigned* p) { return __hip_atomic_load(p, __ATOMIC_RELAXED, __HIP_MEMORY_SCOPE_AGENT); }
__device__ __forceinline__ unsigned xb_add(unsigned* p, unsigned v) { return __hip_atomic_fetch_add(p, v, __ATOMIC_RELAXED, __HIP_MEMORY_SCOPE_AGENT); }
__device__ __forceinline__ unsigned xb_xcc_id() { return (unsigned)__builtin_amdgcn_s_getreg((3 << 11) | 20) & 0xFu; }
__device__ __forceinline__ void gbar(const int wave_s, unsigned* bar, volatile unsigned* st) {
    asm volatile("s_waitcnt vmcnt(0)" ::: "memory");
    __syncthreads();
    if (get_tid(wave_s) == 0) {
        __builtin_amdgcn_s_waitcnt(0);
        const unsigned x = st[2], nloc = st[0], nx = st[1];
        const unsigned old = xb_add(&bar[XB_XSUB(x)], 1u);
        const unsigned gen = old / nloc;
        if (old + 1u == (gen + 1u) * nloc) {
            __builtin_amdgcn_fence(__ATOMIC_RELEASE, "agent");
            asm volatile("s_waitcnt vmcnt(0)" ::: "memory");
            const unsigned og = xb_add(&bar[XB_TOP], 1u);
            const unsigned tg = og / nx;
            if (og + 1u == (tg + 1u) * nx) xb_add(&bar[XB_TOPGEN], 1u);
            else while (xb_ld(&bar[XB_TOPGEN]) == tg) __builtin_amdgcn_s_sleep(1);
            __builtin_amdgcn_fence(__ATOMIC_ACQUIRE, "agent");
            xb_add(&bar[XB_XGEN(x)], 1u);
            asm volatile("s_waitcnt vmcnt(0)" ::: "memory");
        } else {
            while (xb_ld(&bar[XB_XGEN(x)]) == gen) __builtin_amdgcn_s_sleep(1);
            __builtin_amdgcn_fence(__ATOMIC_ACQUIRE, "agent");
            asm volatile("s_waitcnt vmcnt(0)" ::: "memory");
        }
    }
    __syncthreads();
}

__device__ __forceinline__ bool tile_map(int r, int bid, int nb, int NT, int& nt, int& mt) {
    if (nb == 256) {
        const int x = bid & 7, li = bid >> 3, q = li + 32 * r;
        if (q >= 8 * NT) return false;
        const int mi = q & 3, rest = q >> 2, mg = rest / NT;
        nt = rest - mg * NT; mt = x * 8 + mg * 4 + mi; return true;
    }
    const int t = bid + r * nb; if (t >= NT * 64) return false;
    nt = t % NT; mt = t / NT; return true;
}

__global__ void __launch_bounds__(NTHREADS) mega(const Params p) {
    __shared__ __attribute__((aligned(16))) char lds[LDS_BYTES];
    cg::grid_group grid = cg::this_grid();
    const int wave_s = __builtin_amdgcn_readfirstlane((int)(threadIdx.x >> 6));
    const int nb = gridDim.x, bid = blockIdx.x;
    char* ws = p.ws;
    bf16_t* hn0 = (bf16_t*)(ws + OFF_HN0);
    bf16_t* hb = (bf16_t*)(ws + OFF_HB);
    float* ssq0 = (float*)(ws + OFF_SSQ);
    float* ssq1 = ssq0 + 16 * L_SEQ; float* ssq2 = ssq1 + 16 * L_SEQ; float* ssq3 = ssq2 + 16 * L_SEQ;
    const Seg nul = {nullptr, 0, 0, nullptr, 0, 0};
    unsigned* bar = (unsigned*)(ws + OFF_BAR);
    volatile unsigned* xst = (volatile unsigned*)(lds + LDS_BYTES - 16);
    if (get_tid(wave_s) == 0) xb_add(&bar[XB_XCNT(xb_xcc_id())], 1u);

    { const int nwork = p.ntiles_w + 256;
      for (int rep = 0; rep < REP_PREP; ++rep) {
          if (nb >= 128) {
              if (bid < 64) s5_tables(wave_s, p, bid, lds);
              else for (int it = bid - 64; it < nwork; it += nb - 64) { if (it < p.ntiles_w) wtile(wave_s, p, it, lds); else rms0_item(wave_s, p, it - p.ntiles_w); }
          } else {
              for (int it = bid; it < 64 + nwork; it += nb) { if (it < 64) s5_tables(wave_s, p, it, lds); else if (it < 64 + p.ntiles_w) wtile(wave_s, p, it - 64, lds); else rms0_item(wave_s, p, it - 64 - p.ntiles_w); }
          }
      } }
    grid.sync();
    if (get_tid(wave_s) == 0) {
        const unsigned x = xb_xcc_id(); unsigned cnt = 0u, mine = 1u;
        for (unsigned j = 0; j < 16; ++j) { const unsigned c = xb_ld(&bar[XB_XCNT(j)]); cnt += (c > 0u) ? 1u : 0u; if (j == x) mine = c; }
        xst[0] = mine ? mine : 1u; xst[1] = cnt ? cnt : 1u; xst[2] = x;
    }
    __syncthreads();
    for (int rep = 0; rep < REP_SLOC; ++rep)
    for (int g = bid; g < 64; g += nb) {
        Seg s = {(const bf16_t*)(ws + OFF_W1) + (size_t)g * 128 * 1024, 1024, 16, hn0 + (size_t)g * 262144, 1024, 16};
        EpiSloc e = {(float*)lds};
        gemm_tile(wave_s, lds, s, 16, nul, 0, e);
        __syncthreads();
        {
            const int lane_ = get_tid(wave_s) & 63, w_ = wave_s;
            const f32x2 a = ((const f32x2*)(ws + OFF_A64))[g * 64 + lane_];
            const float* sl = (const float*)lds + (w_ * 32) * 132;
            float sr = 0.f, si = 0.f;
#pragma unroll
            for (int j = 0; j < 32; ++j) { const float xr = sl[j * 132 + lane_], xi = sl[j * 132 + 64 + lane_]; const float nr = a[0] * sr - a[1] * si + xr, ni = a[0] * si + a[1] * sr + xi; sr = nr; si = ni; }
            f32x2* carry = (f32x2*)(lds + 135168);
            { f32x2 c; c[0] = sr; c[1] = si; carry[w_ * 64 + lane_] = c; }
            float pr = a[0], pi = a[1];
#pragma unroll
            for (int q = 0; q < 5; ++q) { const float nr = pr * pr - pi * pi, ni = 2.f * pr * pi; pr = nr; pi = ni; }
            __syncthreads();
            sr = 0.f; si = 0.f;
            for (int v = 0; v < w_; ++v) { const f32x2 c = carry[v * 64 + lane_]; const float nr = pr * sr - pi * si + c[0], ni = pr * si + pi * sr + c[1]; sr = nr; si = ni; }
            bf16_t* sp = (bf16_t*)(ws + OFF_SPREV) + (size_t)g * 256 * 128 + (size_t)(w_ * 32) * 128;
#pragma unroll
            for (int j = 0; j < 32; ++j) {
                sp[j * 128 + lane_] = (bf16_t)(pk_bf16(sr, 0.f) & 0xffffu); sp[j * 128 + 64 + lane_] = (bf16_t)(pk_bf16(si, 0.f) & 0xffffu);
                const float xr = sl[j * 132 + lane_], xi = sl[j * 132 + 64 + lane_];
                const float nr = a[0] * sr - a[1] * si + xr, ni = a[0] * si + a[1] * sr + xi; sr = nr; si = ni;
            }
        }
        __syncthreads();
    }
    gbar(wave_s, bar, xst);
    for (int rep = 0; rep < REP_S5; ++rep)
    for (int t0 = bid; t0 < 256; t0 += nb) {
        const int t = (nb == 256) ? ((t0 & 7) * 32 + (t0 >> 3)) : t0;
        const int g = t >> 2, i = 3 - (t & 3);
        const bf16_t* sprev = (const bf16_t*)(ws + OFF_SPREV) + (size_t)g * 256 * 128;
        Seg s0 = {(const bf16_t*)(ws + OFF_KT) + (size_t)g * 127 * 256 + 63 * 256 + (size_t)(i * 256) * 16, 16, -256, hn0 + (size_t)g * 262144, 1024, 16};
        Seg s1 = {(const bf16_t*)(ws + OFF_W3) + (size_t)g * 1024 * 128 + (size_t)(i * 256) * 128, 128, 16, sprev, 128, 16};
        EpiS5 e = {hn0, p.ssm_d, (bf16_t*)(ws + OFF_Z), g, i * 256};
        gemm_tile(wave_s, lds, s0, 4 * (i + 1), s1, 2, e);
    }
    gbar(wave_s, bar, xst);
    for (int rep = 0; rep < REP_GLU; ++rep)
    for (int r = 0, nt, mt; tile_map(r, bid, nb, 8, nt, mt); ++r) {
        Seg s = {(const bf16_t*)(ws + OFF_WGLU) + (size_t)nt * 256 * DM, DM, 16, (const bf16_t*)(ws + OFF_Z) + (size_t)mt * 256 * 16, 16, 262144};
        EpiGlu e = {p.x, p.out, hb, ssq0, nt * 256, mt * 256};
        gemm_tile(wave_s, lds, s, 16, nul, 0, e);
    }
    gbar(wave_s, bar, xst);
#pragma unroll
    for (int layer = 0; layer < 2; ++layer) {
        if (layer == 1) {
            for (int rep = 0; rep < REP_KVQ; ++rep)
            for (int r = 0, nt, mt; tile_map(r, bid, nb, 12, nt, mt); ++r) {
                Seg s = {(const bf16_t*)(ws + OFF_WKVQ) + (size_t)nt * 256 * DM, DM, 16, hb + (size_t)mt * 256 * DM, DM, 16};
                EpiKvq e = {ssq1, ws, nt * 256, mt * 256, {0.f, 0.f}};
                gemm_tile(wave_s, lds, s, 16, nul, 0, e);
            }
            gbar(wave_s, bar, xst);
            {
                float a1 = 0.f, a2 = 0.f;
                for (int i = 0; i < 64; ++i) { a1 += p.lq1[i] * p.lk1[i]; a2 += p.lq2[i] * p.lk2[i]; }
                const float lam = expf(a1) - expf(a2) + LAM_INIT;
                for (int rep = 0; rep < REP_ATTN; ++rep)
                for (int it = bid; it < 1024; it += nb) {
                    const int head = it & 7, r = it >> 3, rnd = r >> 5, j = r & 31;
                    const int qb = (rnd == 0) ? 127 - j : (rnd == 1) ? 64 + j : (rnd == 2) ? 63 - j : j;
                    attn_item(wave_s, p, head, qb, lam, lds);
                }
            }
            gbar(wave_s, bar, xst);
            for (int r = 0, nt, mt; tile_map(r, bid, nb, 4, nt, mt); ++r) {
                Seg s = {(const bf16_t*)(ws + OFF_WO) + (size_t)nt * 256 * DM, DM, 16, (const bf16_t*)(ws + OFF_ON) + (size_t)mt * 256 * DM, DM, 16};
                EpiRes e = {p.out, hb, ssq2, nt * 256, mt * 256};
                gemm_tile(wave_s, lds, s, 16, nul, 0, e);
            }
            gbar(wave_s, bar, xst);
        }
        {
            const bf16_t* wup = (const bf16_t*)(ws + (layer ? OFF_WUP1 : OFF_WUP0));
            for (int rep = 0; rep < REP_UP; ++rep)
            for (int r = 0, nt, mt; tile_map(r, bid, nb, 22, nt, mt); ++r) {
                Seg s = {wup + (size_t)nt * 256 * DM, DM, 16, hb + (size_t)mt * 256 * DM, DM, 16};
                if (layer == 0) { EpiUp<16> e = {ssq0, (bf16_t*)(ws + OFF_ACT), nt * 256, mt * 256, {0.f, 0.f}}; gemm_tile(wave_s, lds, s, 16, nul, 0, e); }
                else { EpiUp<8> e = {ssq2, (bf16_t*)(ws + OFF_ACT), nt * 256, mt * 256, {0.f, 0.f}}; gemm_tile(wave_s, lds, s, 16, nul, 0, e); }
            }
        }
        gbar(wave_s, bar, xst);
        {
            const bf16_t* wdn = (const bf16_t*)(ws + (layer ? OFF_WDN1 : OFF_WDN0));
            for (int r = 0, nt, mt; tile_map(r, bid, nb, 4, nt, mt); ++r) {
                Seg s = {wdn + (size_t)nt * 256 * FFN, FFN, 16, (const bf16_t*)(ws + OFF_ACT) + (size_t)mt * 256 * FFN, FFN, 16};
                EpiRes e = {p.out, layer ? (bf16_t*)nullptr : hb, layer ? ssq3 : ssq1, nt * 256, mt * 256};
                gemm_tile(wave_s, lds, s, FFN / 64, nul, 0, e);
            }
        }
        gbar(wave_s, bar, xst);
    }
    {
        const int lane = get_tid(wave_s) & 63, wid = wave_s;
        for (int row = bid * 8 + wid; row < L_SEQ; row += nb * 8) {
            float s = 0.f;
            for (int i = 0; i < 8; ++i) s += ssq3[(size_t)i * L_SEQ + row];
            const float rs = rsqrtf(s * (1.0f / DM) + EPSV);
#pragma unroll
            for (int i = 0; i < 4; ++i) { const size_t off = (size_t)row * DM + lane * 4 + 256 * i;
                f32x4 v = *(const f32x4*)(p.out + off); const f32x4 g = *(const f32x4*)(p.final_g + lane * 4 + 256 * i);
                v[0] *= rs * g[0]; v[1] *= rs * g[1]; v[2] *= rs * g[2]; v[3] *= rs * g[3]; *(f32x4*)(p.out + off) = v; }
        }
    }
}

static void add_job(Params& P, int& nt, const float* src, bf16_t* dst, const float* gain, int K, int N, int ld, int col0, int mode, int rowoff, float scale) {
    WJob& J = P.jobs[P.njobs++];
    J.src = src; J.dst = dst; J.gain = gain; J.K = K; J.N = N; J.ldsrc = ld; J.col0 = col0; J.mode = mode; J.rowoff = rowoff; J.scale = scale; J.tile0 = nt; J.ntn = N / 256; J.pad = 0;
    nt += (K / 64) * (N / 256);
}

extern "C" void kernel_launch(void* const* d_in, const int* in_sizes, int n_in, void* d_out, int out_size, void* d_ws, size_t ws_size, hipStream_t stream) {
    Params P; memset(&P, 0, sizeof(P));
    P.x = (const float*)d_in[0]; P.norm_mix_g = (const float*)d_in[1]; P.norm_ffn_g = (const float*)d_in[2];
    P.ffn_w1 = (const float*)d_in[3]; P.ffn_w3 = (const float*)d_in[4]; P.ffn_w2 = (const float*)d_in[5];
    P.lam_re = (const float*)d_in[6]; P.lam_im = (const float*)d_in[7]; P.log_dt = (const float*)d_in[8];
    P.b_re = (const float*)d_in[9]; P.b_im = (const float*)d_in[10]; P.c_re = (const float*)d_in[11]; P.c_im = (const float*)d_in[12];
    P.ssm_d = (const float*)d_in[13]; P.w_glu = (const float*)d_in[14]; P.kv_norm_g = (const float*)d_in[15]; P.w_kv = (const float*)d_in[16];
    P.w_q = (const float*)d_in[17]; P.lq1 = (const float*)d_in[18]; P.lk1 = (const float*)d_in[19]; P.lq2 = (const float*)d_in[20]; P.lk2 = (const float*)d_in[21];
    P.subln_g = (const float*)d_in[22]; P.w_o = (const float*)d_in[23]; P.final_g = (const float*)d_in[24];
    P.out = (float*)d_out; P.ws = (char*)d_ws;
    char* ws = (char*)d_ws; int nt = 0;
    const size_t FW = (size_t)DM * FFN;
    add_job(P, nt, P.w_glu, (bf16_t*)(ws + OFF_WGLU), nullptr, DM, 1024, 2048, 0, 1, 0, 1.0f);
    add_job(P, nt, P.w_glu, (bf16_t*)(ws + OFF_WGLU), nullptr, DM, 1024, 2048, 1024, 2, 0, 1.0f);
    add_job(P, nt, P.ffn_w1, (bf16_t*)(ws + OFF_WUP0), P.norm_ffn_g, DM, FFN, FFN, 0, 1, 0, 1.0f);
    add_job(P, nt, P.ffn_w3, (bf16_t*)(ws + OFF_WUP0), P.norm_ffn_g, DM, FFN, FFN, 0, 2, 0, 1.0f);
    add_job(P, nt, P.ffn_w2, (bf16_t*)(ws + OFF_WDN0), nullptr, FFN, DM, DM, 0, 0, 0, 1.0f);
    add_job(P, nt, P.w_kv, (bf16_t*)(ws + OFF_WKVQ), P.kv_norm_g, DM, 2048, 2048, 0, 0, 0, 1.0f);
    add_job(P, nt, P.w_q, (bf16_t*)(ws + OFF_WKVQ), P.norm_mix_g + DM, DM, 1024, 1024, 0, 0, 2048, QSCALE);
    add_job(P, nt, P.w_o, (bf16_t*)(ws + OFF_WO), nullptr, DM, DM, DM, 0, 0, 0, 1.0f);
    add_job(P, nt, P.ffn_w1 + FW, (bf16_t*)(ws + OFF_WUP1), P.norm_ffn_g + DM, DM, FFN, FFN, 0, 1, 0, 1.0f);
    add_job(P, nt, P.ffn_w3 + FW, (bf16_t*)(ws + OFF_WUP1), P.norm_ffn_g + DM, DM, FFN, FFN, 0, 2, 0, 1.0f);
    add_job(P, nt, P.ffn_w2 + FW, (bf16_t*)(ws + OFF_WDN1), nullptr, FFN, DM, DM, 0, 0, 0, 1.0f);
    P.ntiles_w = nt;
    static int grid_blocks = 0;
    if (!grid_blocks) {
        int dev = 0, cus = 0, per_cu = 0;
        hipGetDevice(&dev);
        hipDeviceGetAttribute(&cus, hipDeviceAttributeMultiprocessorCount, dev);
        hipOccupancyMaxActiveBlocksPerMultiprocessor(&per_cu, mega, NTHREADS, 0);
        if (per_cu < 1) per_cu = 1;
        grid_blocks = cus * 1;
    }
    hipMemsetAsync(ws + OFF_BAR, 0, 16384, stream);
    void* args[] = {&P};
    hipError_t e = hipLaunchCooperativeKernel((void*)mega, dim3(grid_blocks), dim3(NTHREADS), args, 0, stream);
    if (e != hipSuccess) fprintf(stderr, "cooperative launch failed: %s (grid %d)\n", hipGetErrorString(e), grid_blocks);
}
```

```cpp
#include <hip/hip_runtime.h>
#include <hip/hip_cooperative_groups.h>
#include <stdint.h>
#include <string.h>
#include <stdio.h>
namespace cg = cooperative_groups;

typedef unsigned short bf16_t;
typedef short bf16x8 __attribute__((ext_vector_type(8)));
typedef float f32x16 __attribute__((ext_vector_type(16)));
typedef float f32x4 __attribute__((ext_vector_type(4)));
typedef float f32x2 __attribute__((ext_vector_type(2)));
typedef unsigned u32x4 __attribute__((ext_vector_type(4)));
typedef unsigned u32x2 __attribute__((ext_vector_type(2)));

#define L_SEQ 16384
#define DM 1024
#define FFN 2816
#define NTHREADS 512
#ifndef REP_ATTN
#define REP_ATTN 1
#endif
#ifndef REP_UP
#define REP_UP 1
#endif
#define REP_GLU 1
#define REP_KVQ 1
#define REP_S5 1
#define REP_SLOC 1
#define REP_PREP 1
#define LDS_BYTES 139280
#define EPSV 1e-6f
#define LAM_INIT 0.35550906759096927f
#define QSCALE 0.18033688011112042f

static constexpr size_t MiB = 1024ull * 1024ull;
static constexpr size_t OFF_WGLU = 0;
static constexpr size_t OFF_WUP0 = 4 * MiB;
static constexpr size_t OFF_WDN0 = 15 * MiB;
static constexpr size_t OFF_WKVQ = 20 * MiB + MiB / 2;
static constexpr size_t OFF_WO = 26 * MiB + MiB / 2;
static constexpr size_t OFF_WUP1 = 28 * MiB + MiB / 2;
static constexpr size_t OFF_WDN1 = 39 * MiB + MiB / 2;
static constexpr size_t OFF_SSQ = 45 * MiB;
static constexpr size_t OFF_A64 = 49 * MiB;
static constexpr size_t OFF_BAR = 49 * MiB + MiB / 2;
static constexpr size_t OFF_A = 50 * MiB;
static constexpr size_t OFF_HN0 = OFF_A;
static constexpr size_t OFF_Z = OFF_A + 32 * MiB;
static constexpr size_t OFF_ACT = OFF_A;
static constexpr size_t OFF_K1 = OFF_A;
static constexpr size_t OFF_K2 = OFF_A + 16 * MiB;
static constexpr size_t OFF_VT = OFF_A + 32 * MiB;
static constexpr size_t OFF_Q1 = OFF_A + 64 * MiB;
static constexpr size_t OFF_Q2 = OFF_A + 80 * MiB;
static constexpr size_t OFF_B = 146 * MiB;
static constexpr size_t OFF_KT = OFF_B;
static constexpr size_t OFF_W1 = OFF_B + 4 * MiB;
static constexpr size_t OFF_W3 = OFF_B + 20 * MiB;
static constexpr size_t OFF_SLOC = OFF_B + 36 * MiB;
static constexpr size_t OFF_SPREV = OFF_B + 44 * MiB;
static constexpr size_t OFF_HB = OFF_B;
static constexpr size_t OFF_ON = OFF_B + 32 * MiB;

struct WJob { const float* src; bf16_t* dst; const float* gain; int K; int N; int ldsrc; int col0; int mode; int rowoff; float scale; int tile0; int ntn; int pad; };

struct Params {
    const float *x, *norm_mix_g, *norm_ffn_g, *ffn_w1, *ffn_w3, *ffn_w2;
    const float *lam_re, *lam_im, *log_dt, *b_re, *b_im, *c_re, *c_im, *ssm_d, *w_glu;
    const float *kv_norm_g, *w_kv, *w_q, *lq1, *lk1, *lq2, *lk2, *subln_g, *w_o, *final_g;
    float* out;
    char* ws;
    WJob jobs[12];
    int njobs; int ntiles_w;
};

__device__ __forceinline__ int get_tid(int wave_s) { int t = wave_s * 64 + (int)__builtin_amdgcn_mbcnt_hi(~0u, __builtin_amdgcn_mbcnt_lo(~0u, 0u)); asm volatile("" : "+v"(t)); return t; }
__device__ __forceinline__ unsigned pk_bf16(float lo, float hi) { unsigned r; asm("v_cvt_pk_bf16_f32 %0, %1, %2" : "=v"(r) : "v"(lo), "v"(hi)); return r; }
__device__ __forceinline__ float bf_lo(unsigned u) { return __uint_as_float(u << 16); }
__device__ __forceinline__ float bf_hi(unsigned u) { return __uint_as_float(u & 0xffff0000u); }
__device__ __forceinline__ float fast_rcp(float x) { return __builtin_amdgcn_rcpf(x); }
__device__ __forceinline__ float fast_exp2(float x) { return __builtin_amdgcn_exp2f(x); }
__device__ __forceinline__ float sigmoidf_(float x) { return fast_rcp(1.0f + fast_exp2(-1.4426950408889634f * x)); }
__device__ __forceinline__ float gelu_tanh(float x) {
    const float u = 0.7978845608028654f * x * (1.0f + 0.044715f * x * x);
    return x * fast_rcp(1.0f + fast_exp2(-2.8853900817779268f * u));
}

struct Seg { const bf16_t* W; long wrs; long wkhi; const bf16_t* X; long xrs; long xkhi; };

struct TileCtx { int wn, wm, lane; };

template <class Epi>
__device__ __forceinline__ void gemm_tile(const int wave_s, char* lds, const Seg s0, const int nk0_, const Seg s1, const int nk1_, Epi& epi) {
    int tid = get_tid(wave_s);
    const int lane = tid & 63;
    const int wn = wave_s >> 2, wm = wave_s & 3;
    const int lr = lane & 31, h = lane >> 5;
    const int nk0 = nk0_ * 2, nk1 = nk1_ * 2, nk = nk0 + nk1;
    const int cch = (lane & 3) ^ ((lane >> 4) & 3);
    const int row0 = wave_s * 32 + (lane >> 2);
    f32x16 acc[4][2];
#pragma unroll
    for (int a = 0; a < 4; ++a)
#pragma unroll
        for (int b = 0; b < 2; ++b)
#pragma unroll
            for (int r = 0; r < 16; ++r) acc[a][b][r] = 0.f;
    auto issue = [&](int t) {
        const bool first = t < nk0;
        const bf16_t* W = first ? s0.W : s1.W; const bf16_t* X = first ? s0.X : s1.X;
        const long wrs = first ? s0.wrs : s1.wrs, xrs = first ? s0.xrs : s1.xrs;
        const long wkhi = first ? s0.wkhi : s1.wkhi, xkhi = first ? s0.xkhi : s1.xkhi;
        const int kt = first ? t : t - nk0;
        const long kc = kt * 2 + (cch >> 1);
        const bf16_t* wp = W + (long)row0 * wrs + kc * wkhi + (cch & 1) * 8;
        const bf16_t* xp = X + (long)row0 * xrs + kc * xkhi + (cch & 1) * 8;
        char* st = lds + (t & 3) * 32768 + wave_s * 2048;
        __builtin_amdgcn_global_load_lds((const unsigned*)wp, (__attribute__((address_space(3))) unsigned*)(st), 16, 0, 0);
        __builtin_amdgcn_global_load_lds((const unsigned*)(wp + 16 * wrs), (__attribute__((address_space(3))) unsigned*)(st + 1024), 16, 0, 0);
        __builtin_amdgcn_global_load_lds((const unsigned*)xp, (__attribute__((address_space(3))) unsigned*)(st + 16384), 16, 0, 0);
        __builtin_amdgcn_global_load_lds((const unsigned*)(xp + 16 * xrs), (__attribute__((address_space(3))) unsigned*)(st + 16384 + 1024), 16, 0, 0);
    };
    const int sw = (lr >> 2) & 3;
    const int aoff = (wn * 128 + lr) * 64, boff = 16384 + (wm * 64 + lr) * 64;
    const int ch0 = ((0 + h) ^ sw) << 4, ch1 = ((2 + h) ^ sw) << 4;
    bf16x8 a0[4], b0[2], a1[4], b1[2];
    epi.pre(wm, lane, wn);
    issue(0); issue(1); issue(2); issue(3);
    asm volatile("s_waitcnt vmcnt(12)" ::: "memory");
    __builtin_amdgcn_s_barrier(); asm volatile("" ::: "memory");
#pragma unroll
    for (int nb = 0; nb < 4; ++nb) a0[nb] = *(const bf16x8*)(lds + aoff + nb * 2048 + ch0);
#pragma unroll
    for (int mb = 0; mb < 2; ++mb) b0[mb] = *(const bf16x8*)(lds + boff + mb * 2048 + ch0);
    for (int t = 0; t < nk; ++t) {
        const char* st = lds + (t & 3) * 32768;
#pragma unroll
        for (int nb = 0; nb < 4; ++nb) a1[nb] = *(const bf16x8*)(st + aoff + nb * 2048 + ch1);
#pragma unroll
        for (int mb = 0; mb < 2; ++mb) b1[mb] = *(const bf16x8*)(st + boff + mb * 2048 + ch1);
#pragma unroll
        for (int nb = 0; nb < 4; ++nb)
#pragma unroll
            for (int mb = 0; mb < 2; ++mb) acc[nb][mb] = __builtin_amdgcn_mfma_f32_32x32x16_bf16(a0[nb], b0[mb], acc[nb][mb], 0, 0, 0);
        const int rem = nk - 1 - t;
        if (rem >= 3) asm volatile("s_waitcnt vmcnt(8)" ::: "memory");
        else if (rem == 2) asm volatile("s_waitcnt vmcnt(4)" ::: "memory");
        else asm volatile("s_waitcnt vmcnt(0)" ::: "memory");
        asm volatile("s_waitcnt lgkmcnt(0)" ::: "memory");
        __builtin_amdgcn_s_barrier(); asm volatile("" ::: "memory");
        if (t + 4 < nk) issue(t + 4);
        if (t + 1 < nk) {
            const char* sn = lds + ((t + 1) & 3) * 32768;
#pragma unroll
            for (int nb = 0; nb < 4; ++nb) a0[nb] = *(const bf16x8*)(sn + aoff + nb * 2048 + ch0);
#pragma unroll
            for (int mb = 0; mb < 2; ++mb) b0[mb] = *(const bf16x8*)(sn + boff + mb * 2048 + ch0);
        }
#pragma unroll
        for (int nb = 0; nb < 4; ++nb)
#pragma unroll
            for (int mb = 0; mb < 2; ++mb) acc[nb][mb] = __builtin_amdgcn_mfma_f32_32x32x16_bf16(a1[nb], b1[mb], acc[nb][mb], 0, 0, 0);
    }
    TileCtx c; c.wn = wn; c.wm = wm; c.lane = lane;
    epi(acc, c);
}

template <int NPART>
__device__ __forceinline__ float rstd_from(const float* ssq, int token) {
    float v[NPART];
#pragma unroll
    for (int i = 0; i < NPART; ++i) v[i] = ssq[(size_t)i * L_SEQ + token];
    float s = 0.f;
#pragma unroll
    for (int i = 0; i < NPART; ++i) s += v[i];
    return rsqrtf(s * (1.0f / DM) + EPSV);
}

__device__ __forceinline__ u32x4 widen8(u32x2 A, u32x2 B) {
    const auto r0 = __builtin_amdgcn_permlane32_swap(A[0], B[0], false, false);
    const auto r1 = __builtin_amdgcn_permlane32_swap(A[1], B[1], false, false);
    u32x4 o; o[0] = r0[0]; o[1] = r1[0]; o[2] = r0[1]; o[3] = r1[1]; return o;
}

struct EpiSloc {
    float* dst;
    __device__ __forceinline__ void pre(int, int, int) {}
    __device__ __forceinline__ void operator()(f32x16 (&acc)[4][2], const TileCtx& c) const {
        if (c.wn != 0) return;
        const int lr = c.lane & 31, h = c.lane >> 5;
#pragma unroll
        for (int mb = 0; mb < 2; ++mb) { const int m = c.wm * 64 + mb * 32 + lr;
#pragma unroll
            for (int nb = 0; nb < 4; ++nb)
#pragma unroll
                for (int rq = 0; rq < 4; ++rq) { const int n = nb * 32 + rq * 8 + 4 * h;
                    f32x4 v = {acc[nb][mb][4 * rq], acc[nb][mb][4 * rq + 1], acc[nb][mb][4 * rq + 2], acc[nb][mb][4 * rq + 3]};
                    *(f32x4*)(dst + m * 132 + n) = v; } }
    }
};

struct EpiS5 {
    const bf16_t* hn0; const float* dskip; bf16_t* z; int g; int n0;
    __device__ __forceinline__ void pre(int, int, int) {}
    __device__ __forceinline__ void operator()(f32x16 (&acc)[4][2], const TileCtx& c) const {
        const int lr = c.lane & 31, h = c.lane >> 5;
#pragma unroll
        for (int mb = 0; mb < 2; ++mb) { const int j = c.wm * 64 + mb * 32 + lr;
            u32x2 uu[16], zz[16];
#pragma unroll
            for (int q = 0; q < 16; ++q) { const int n = n0 + c.wn * 128 + (q >> 2) * 32 + (q & 3) * 8 + 4 * h; uu[q] = *(const u32x2*)(hn0 + (size_t)g * 262144 + (size_t)j * 1024 + n); }
            asm volatile("" ::: "memory");
#pragma unroll
            for (int q = 0; q < 16; ++q) { const int nb = q >> 2, rq = q & 3; const int n = n0 + c.wn * 128 + nb * 32 + rq * 8 + 4 * h; const int t = n >> 4, cc = n & 15;
                const size_t off = (size_t)g * 262144 + (size_t)(j * 64 + t) * 16 + cc; const f32x4 d4 = *(const f32x4*)(dskip + g * 16 + cc);
                const float y0 = acc[nb][mb][4 * rq] + d4[0] * bf_lo(uu[q][0]), y1 = acc[nb][mb][4 * rq + 1] + d4[1] * bf_hi(uu[q][0]);
                const float y2 = acc[nb][mb][4 * rq + 2] + d4[2] * bf_lo(uu[q][1]), y3 = acc[nb][mb][4 * rq + 3] + d4[3] * bf_hi(uu[q][1]);
                zz[q][0] = pk_bf16(gelu_tanh(y0), gelu_tanh(y1)); zz[q][1] = pk_bf16(gelu_tanh(y2), gelu_tanh(y3)); (void)off; }
#pragma unroll
            for (int q = 0; q < 16; q += 2) { const int n = n0 + c.wn * 128 + (q >> 2) * 32 + (q & 3) * 8 + 8 * h;
                *(u32x4*)(z + (size_t)g * 262144 + (size_t)(j * 64 + (n >> 4)) * 16 + (n & 15)) = widen8(zz[q], zz[q + 1]); }
            asm volatile("" ::: "memory"); }
    }
};

struct EpiGlu {
    const float* x; float* out; bf16_t* hb; float* ssq; int n0, m0;
    __device__ __forceinline__ void pre(int, int, int) {}
    __device__ __forceinline__ void operator()(f32x16 (&acc)[4][2], const TileCtx& c) const {
        const int lr = c.lane & 31, h = c.lane >> 5;
#pragma unroll
        for (int mb = 0; mb < 2; ++mb) { const int m = m0 + c.wm * 64 + mb * 32 + lr; float s = 0.f;
            const size_t rowoff = (size_t)m * DM + ((n0 + c.wn * 128) >> 1) + 4 * h;
            f32x4 xv[8]; u32x2 pkk[8];
#pragma unroll
            for (int q = 0; q < 8; ++q) xv[q] = *(const f32x4*)(x + rowoff + (q >> 1) * 16 + (q & 1) * 8);
            asm volatile("" ::: "memory");
#pragma unroll
            for (int q = 0; q < 8; ++q) { const int nb = q >> 1, rg = q & 1; const size_t off = rowoff + nb * 16 + rg * 8; f32x4 o;
#pragma unroll
                for (int e = 0; e < 4; ++e) { o[e] = xv[q][e] + acc[nb][mb][rg * 8 + e] * sigmoidf_(acc[nb][mb][rg * 8 + 4 + e]); s += o[e] * o[e]; }
                *(f32x4*)(out + off) = o; pkk[q][0] = pk_bf16(o[0], o[1]); pkk[q][1] = pk_bf16(o[2], o[3]); }
#pragma unroll
            for (int q = 0; q < 8; q += 2) *(u32x4*)(hb + (size_t)m * DM + ((n0 + c.wn * 128) >> 1) + (q >> 1) * 16 + 8 * h) = widen8(pkk[q], pkk[q + 1]);
            asm volatile("" ::: "memory");
            s += __shfl_xor(s, 32);
            if (h == 0) ssq[(size_t)((n0 >> 8) * 2 + c.wn) * L_SEQ + m] = s; }
    }
};

template <int NPART> struct EpiUp {
    const float* ssq; bf16_t* act; int n0, m0; float rsv[2];
    __device__ __forceinline__ void pre(int wm, int lane, int) {
#pragma unroll
        for (int mb = 0; mb < 2; ++mb) rsv[mb] = rstd_from<NPART>(ssq, m0 + wm * 64 + mb * 32 + (lane & 31)); }
    __device__ __forceinline__ void operator()(f32x16 (&acc)[4][2], const TileCtx& c) const {
        const int lr = c.lane & 31, h = c.lane >> 5;
#pragma unroll
        for (int mb = 0; mb < 2; ++mb) { const int m = m0 + c.wm * 64 + mb * 32 + lr; const float rs = rsv[mb];
#pragma unroll
            for (int nb = 0; nb < 4; ++nb) { u32x2 pk[2];
#pragma unroll
                for (int rg = 0; rg < 2; ++rg) { float o[4];
#pragma unroll
                    for (int e = 0; e < 4; ++e) { const float a = acc[nb][mb][rg * 8 + e] * rs, b = acc[nb][mb][rg * 8 + 4 + e] * rs; o[e] = a * sigmoidf_(a) * b; }
                    pk[rg][0] = pk_bf16(o[0], o[1]); pk[rg][1] = pk_bf16(o[2], o[3]); }
                *(u32x4*)(act + (size_t)m * FFN + ((n0 + c.wn * 128 + nb * 32) >> 1) + 8 * h) = widen8(pk[0], pk[1]); } }
    }
};

struct EpiRes {
    float* out; bf16_t* hb; float* ssq; int n0, m0;
    __device__ __forceinline__ void pre(int, int, int) {}
    __device__ __forceinline__ void operator()(f32x16 (&acc)[4][2], const TileCtx& c) const {
        const int lr = c.lane & 31, h = c.lane >> 5;
#pragma unroll
        for (int mb = 0; mb < 2; ++mb) { const int m = m0 + c.wm * 64 + mb * 32 + lr; float s = 0.f;
            const size_t rowoff = (size_t)m * DM + n0 + c.wn * 128 + 4 * h;
#pragma unroll
            for (int np = 0; np < 2; ++np) {
                f32x4 o[8];
#pragma unroll
                for (int q = 0; q < 8; ++q) o[q] = *(const f32x4*)(out + rowoff + (np * 2 + (q >> 2)) * 32 + (q & 3) * 8);
                asm volatile("" ::: "memory");
#pragma unroll
                for (int q = 0; q < 8; ++q) { const int nb = np * 2 + (q >> 2), rq = q & 3; const size_t off = rowoff + nb * 32 + rq * 8;
#pragma unroll
                    for (int e = 0; e < 4; ++e) { o[q][e] += acc[nb][mb][4 * rq + e]; s += o[q][e] * o[q][e]; }
                    *(f32x4*)(out + off) = o[q]; }
                if (hb) {
#pragma unroll
                    for (int q = 0; q < 8; q += 2) { u32x2 A, B; A[0] = pk_bf16(o[q][0], o[q][1]); A[1] = pk_bf16(o[q][2], o[q][3]); B[0] = pk_bf16(o[q + 1][0], o[q + 1][1]); B[1] = pk_bf16(o[q + 1][2], o[q + 1][3]);
                        *(u32x4*)(hb + (size_t)m * DM + n0 + c.wn * 128 + (np * 2 + (q >> 2)) * 32 + (q & 3) * 8 + 8 * h) = widen8(A, B); } }
                asm volatile("" ::: "memory");
            }
            s += __shfl_xor(s, 32);
            if (h == 0) ssq[(size_t)((n0 >> 8) * 2 + c.wn) * L_SEQ + m] = s; }
    }
};

struct EpiKvq {
    const float* ssq; char* ws; int n0, m0; float rsv[2];
    __device__ __forceinline__ void pre(int wm, int lane, int) {
#pragma unroll
        for (int mb = 0; mb < 2; ++mb) rsv[mb] = rstd_from<8>(ssq, m0 + wm * 64 + mb * 32 + (lane & 31)); }
    __device__ __forceinline__ void operator()(f32x16 (&acc)[4][2], const TileCtx& c) const {
        const int lr = c.lane & 31, h = c.lane >> 5;
        const bool isV = (n0 >= 1024 && n0 < 2048);
#pragma unroll
        for (int mb = 0; mb < 2; ++mb) { const int m = m0 + c.wm * 64 + mb * 32 + lr; const float rs = rsv[mb];
            if (isV) {
                const int mp = (m & ~12) | ((m & 4) << 1) | ((m & 8) >> 1);
                bf16_t* vt = (bf16_t*)(ws + OFF_VT);
#pragma unroll
                for (int nb = 0; nb < 4; ++nb)
#pragma unroll
                    for (int r = 0; r < 16; ++r) { const int nl = n0 - 1024 + c.wn * 128 + nb * 32 + (r & 3) + 8 * (r >> 2) + 4 * h;
                        vt[(size_t)nl * L_SEQ + mp] = (bf16_t)(pk_bf16(acc[nb][mb][r] * rs, 0.f) & 0xffffu); }
            } else {
                size_t base; int nl;
                if (n0 < 512) { base = OFF_K1; nl = n0; } else if (n0 < 1024) { base = OFF_K2; nl = n0 - 512; } else if (n0 < 2560) { base = OFF_Q1; nl = n0 - 2048; } else { base = OFF_Q2; nl = n0 - 2560; }
                bf16_t* dst = (bf16_t*)(ws + base);
                float cs[4], sn[4];
#pragma unroll
                for (int e = 0; e < 4; ++e) { const int i = 4 * h + e;
                    const float invf = (i == 0) ? 1.0f : (i == 1) ? 0.19391188f : (i == 2) ? 0.037601817f : (i == 3) ? 0.0072914392f : (i == 4) ? 0.0014142136f : (i == 5) ? 0.00027423282f : (i == 6) ? 5.3176997e-05f : 1.0311653e-05f;
                    const float ang = (float)m * invf; double rev = (double)ang * 0.15915494309189535; rev -= rint(rev); const float fr = (float)rev;
                    cs[e] = __builtin_amdgcn_cosf(fr); sn[e] = __builtin_amdgcn_sinf(fr); }
#pragma unroll
                for (int nb = 0; nb < 4; ++nb) {
                    const int nn = nl + c.wn * 128 + nb * 32; const int head = nn >> 6, d0 = nn & 63;
                    float v[16];
#pragma unroll
                    for (int r = 0; r < 16; ++r) v[r] = acc[nb][mb][r] * rs;
                    if (d0 == 0) {
#pragma unroll
                        for (int e = 0; e < 4; ++e) { const float x1 = v[e], x2 = v[4 + e]; v[e] = x1 * cs[e] - x2 * sn[e]; v[4 + e] = x2 * cs[e] + x1 * sn[e]; }
                    }
#pragma unroll
                    for (int rq = 0; rq < 4; rq += 2) { u32x2 A, B; A[0] = pk_bf16(v[4 * rq], v[4 * rq + 1]); A[1] = pk_bf16(v[4 * rq + 2], v[4 * rq + 3]);
                        B[0] = pk_bf16(v[4 * rq + 4], v[4 * rq + 5]); B[1] = pk_bf16(v[4 * rq + 6], v[4 * rq + 7]);
                        *(u32x4*)(dst + ((size_t)head * L_SEQ + m) * 64 + d0 + rq * 8 + 8 * h) = widen8(A, B); }
                }
            } }
    }
};

__device__ __forceinline__ void s5_tables(const int wave_s, const Params& p, int g, char* lds) {
    f32x2* apow = (f32x2*)lds;
    f32x2* bb = apow + 65 * 64;
    f32x2* cc = bb + 1024;
    f32x2* zf = cc + 1024;
    int tid = get_tid(wave_s); asm volatile("" : "+v"(tid));
    const float dt = expf(p.log_dt[g]);
    for (int e = tid; e < 65 * 64; e += NTHREADS) {
        const int lag = e >> 6, pp = e & 63;
        const float lr = p.lam_re[g * 64 + pp], li = p.lam_im[g * 64 + pp];
        const float mag = expf(lr * dt * (float)lag);
        double rev = (double)li * (double)dt * (double)lag * 0.15915494309189535; rev -= rint(rev);
        const float fr = (float)rev;
        f32x2 v; v[0] = mag * __builtin_amdgcn_cosf(fr); v[1] = mag * __builtin_amdgcn_sinf(fr); apow[e] = v;
    }
    if (tid < 64) {
        const float lr = p.lam_re[g * 64 + tid], li = p.lam_im[g * 64 + tid];
        const float em1 = expm1f(lr * dt);
        double rev = (double)li * (double)dt * 0.15915494309189535; const double rh = rev * 0.5; rev -= rint(rev);
        const double rh2 = rh - rint(rh);
        const float cth = __builtin_amdgcn_cosf((float)rev), sth = __builtin_amdgcn_sinf((float)rev), shalf = __builtin_amdgcn_sinf((float)rh2);
        const float nr = em1 * cth - 2.0f * shalf * shalf, ni = (1.0f + em1) * sth;
        const float den = lr * lr + li * li;
        f32x2 f; f[0] = (nr * lr + ni * li) / den; f[1] = (ni * lr - nr * li) / den; zf[tid] = f;
    }
    __syncthreads();
    for (int e = tid; e < 1024; e += NTHREADS) {
        const int pp = e >> 4;
        const float br = p.b_re[(size_t)g * 1024 + e], bi = p.b_im[(size_t)g * 1024 + e];
        const f32x2 f = zf[pp]; f32x2 v; v[0] = f[0] * br - f[1] * bi; v[1] = f[0] * bi + f[1] * br; bb[e] = v;
        f32x2 cv; cv[0] = p.c_re[(size_t)g * 1024 + e]; cv[1] = p.c_im[(size_t)g * 1024 + e]; cc[e] = cv;
    }
    __syncthreads();
    bf16_t* kt = (bf16_t*)(p.ws + OFF_KT) + (size_t)g * 127 * 256;
    bf16_t* w1 = (bf16_t*)(p.ws + OFF_W1) + (size_t)g * 128 * 1024;
    bf16_t* w3 = (bf16_t*)(p.ws + OFF_W3) + (size_t)g * 1024 * 128;
    {
        const int cp = tid & 255, c = cp >> 4, c2 = cp & 15, half = tid >> 8;
        float acc[32];
#pragma unroll
        for (int l = 0; l < 32; ++l) acc[l] = 0.f;
        for (int pp = 0; pp < 64; ++pp) {
            const f32x2 cv = cc[c * 64 + pp], bv = bb[pp * 16 + c2];
            const float cbr = cv[0] * bv[0] - cv[1] * bv[1], cbi = cv[0] * bv[1] + cv[1] * bv[0];
#pragma unroll
            for (int l = 0; l < 32; ++l) { const f32x2 a = apow[(half * 32 + l) * 64 + pp]; acc[l] += cbr * a[0] - cbi * a[1]; }
        }
#pragma unroll
        for (int l = 0; l < 32; ++l) kt[(size_t)(63 + half * 32 + l) * 256 + cp] = (bf16_t)(pk_bf16(acc[l], 0.f) & 0xffffu);
        for (int e = tid; e < 63 * 256 / 8; e += NTHREADS) { u32x4 zz = {0u, 0u, 0u, 0u}; *(u32x4*)(kt + e * 8) = zz; }
    }
    for (int q = tid; q < 128 * 128; q += NTHREADS) {
        const int pq = q >> 7, kc = q & 127, tau = kc >> 1, c0 = (kc & 1) * 8, pp = pq & 63, im = pq >> 6;
        const f32x2 a = apow[(63 - tau) * 64 + pp]; float v[8];
#pragma unroll
        for (int e = 0; e < 8; ++e) { const f32x2 b = bb[pp * 16 + c0 + e]; v[e] = im ? (a[0] * b[1] + a[1] * b[0]) : (a[0] * b[0] - a[1] * b[1]); }
        u32x4 o; o[0] = pk_bf16(v[0], v[1]); o[1] = pk_bf16(v[2], v[3]); o[2] = pk_bf16(v[4], v[5]); o[3] = pk_bf16(v[6], v[7]);
        *(u32x4*)(w1 + (size_t)pq * 1024 + kc * 8) = o;
    }
    for (int q = tid; q < 1024 * 16; q += NTHREADS) {
        const int n = q >> 4, p0 = (q & 15) * 8, t = n >> 4, c = n & 15, im = p0 >> 6; float v[8];
#pragma unroll
        for (int e = 0; e < 8; ++e) { const int pp = (p0 + e) & 63; const f32x2 a = apow[(t + 1) * 64 + pp]; const f32x2 cv = cc[c * 64 + pp];
            v[e] = im ? -(cv[0] * a[1] + cv[1] * a[0]) : (cv[0] * a[0] - cv[1] * a[1]); }
        u32x4 o; o[0] = pk_bf16(v[0], v[1]); o[1] = pk_bf16(v[2], v[3]); o[2] = pk_bf16(v[4], v[5]); o[3] = pk_bf16(v[6], v[7]);
        *(u32x4*)(w3 + (size_t)n * 128 + p0) = o;
    }
    if (tid < 64) ((f32x2*)(p.ws + OFF_A64))[g * 64 + tid] = apow[64 * 64 + tid];
    __syncthreads();
}

__device__ __forceinline__ void wtile(const int wave_s, const Params& p, int t, char* lds) {
    int j = 0;
    for (int i = 1; i < p.njobs; ++i) if (t >= p.jobs[i].tile0) j = i;
    const WJob& J = p.jobs[j];
    const int lt = t - J.tile0, kt = lt / J.ntn, nt = lt - kt * J.ntn;
    const int k0 = kt * 64, nl0 = nt * 256;
    float* T = (float*)lds;
    int tid = get_tid(wave_s); asm volatile("" : "+v"(tid));
    const int c4 = (tid & 63) * 4, kb = tid >> 6;
    f32x4 v[8];
#pragma unroll
    for (int i = 0; i < 8; ++i) v[i] = *(const f32x4*)(J.src + (size_t)(k0 + kb + 8 * i) * J.ldsrc + J.col0 + nl0 + c4);
#pragma unroll
    for (int i = 0; i < 8; ++i) { const int kk = kb + 8 * i; float sc = J.scale; if (J.gain) sc *= J.gain[k0 + kk];
        T[kk * 257 + c4] = v[i][0] * sc; T[kk * 257 + c4 + 1] = v[i][1] * sc; T[kk * 257 + c4 + 2] = v[i][2] * sc; T[kk * 257 + c4 + 3] = v[i][3] * sc; }
    __syncthreads();
    { const int nn = tid >> 1, kh = (tid & 1) * 32;
        const int n = nl0 + nn; int row = (J.mode == 0) ? n : ((n >> 3) * 16 + (n & 7) + (J.mode == 2 ? 8 : 0)); row += J.rowoff;
        bf16_t* d = J.dst + (size_t)row * J.K + k0 + kh;
#pragma unroll
        for (int q = 0; q < 4; ++q) { float w[8];
#pragma unroll
            for (int e = 0; e < 8; ++e) w[e] = T[(kh + q * 8 + e) * 257 + nn];
            u32x4 o; o[0] = pk_bf16(w[0], w[1]); o[1] = pk_bf16(w[2], w[3]); o[2] = pk_bf16(w[4], w[5]); o[3] = pk_bf16(w[6], w[7]);
            *(u32x4*)(d + q * 8) = o; } }
    __syncthreads();
}

__device__ __forceinline__ void rms0_item(const int wave_s, const Params& p, int item) {
    const int lane = get_tid(wave_s) & 63, wid = wave_s;
    bf16_t* hn0 = (bf16_t*)(p.ws + OFF_HN0);
    for (int r = 0; r < 8; ++r) {
        const int row = item * 64 + wid * 8 + r;
        f32x4 v[4]; float s = 0.f;
#pragma unroll
        for (int i = 0; i < 4; ++i) { v[i] = *(const f32x4*)(p.x + (size_t)row * DM + lane * 4 + 256 * i); s += v[i][0] * v[i][0] + v[i][1] * v[i][1] + v[i][2] * v[i][2] + v[i][3] * v[i][3]; }
#pragma unroll
        for (int o = 32; o >= 1; o >>= 1) s += __shfl_xor(s, o);
        const float rs = rsqrtf(s * (1.0f / DM) + EPSV);
#pragma unroll
        for (int i = 0; i < 4; ++i) { const f32x4 g = *(const f32x4*)(p.norm_mix_g + lane * 4 + 256 * i);
            u32x2 o; o[0] = pk_bf16(v[i][0] * rs * g[0], v[i][1] * rs * g[1]); o[1] = pk_bf16(v[i][2] * rs * g[2], v[i][3] * rs * g[3]);
            { const int col = lane * 4 + 256 * i; *(u32x2*)(hn0 + (size_t)(col >> 4) * 262144 + (size_t)(row >> 6) * 1024 + (row & 63) * 16 + (col & 15)) = o; } }
    }
}

__device__ __forceinline__ void attn_item(const int wave_s, const Params& p, int head, int qb, float lam, char* lds) {
    int tid = get_tid(wave_s); asm volatile("" : "+v"(tid));
    const int lane = tid & 63, wid = tid >> 6;
    const int mp = wid >> 2, g = wid & 3;
    const int lr = lane & 31, h = lane >> 5, sw = (lane >> 1) & 7;
    const bf16_t* K1 = (const bf16_t*)(p.ws + OFF_K1) + (size_t)head * L_SEQ * 64;
    const bf16_t* K2 = (const bf16_t*)(p.ws + OFF_K2) + (size_t)head * L_SEQ * 64;
    const bf16_t* VT = (const bf16_t*)(p.ws + OFF_VT) + (size_t)head * 128 * L_SEQ;
    const bf16_t* Q = (const bf16_t*)(p.ws + (mp ? OFF_Q2 : OFF_Q1)) + (size_t)head * L_SEQ * 64;
    const int q0 = qb * 128 + g * 32;
    bf16x8 qf[4];
#pragma unroll
    for (int s = 0; s < 4; ++s) qf[s] = *(const bf16x8*)(Q + (size_t)(q0 + lr) * 64 + 16 * s + 8 * h);
    const int nkt = 2 * qb + 2;
    const int my_last = 2 * qb + (g >> 1);
    f32x16 O[4];
#pragma unroll
    for (int e = 0; e < 4; ++e)
#pragma unroll
        for (int r = 0; r < 16; ++r) O[e][r] = 0.f;
    float m_run = -1e30f, l_run = 0.f;
    const int lrow = lane >> 3;
    const int ck = (lane & 7) ^ (((wave_s & 1) * 4 + (lane >> 4)) & 7);
    const int cv0 = (lane & 7) ^ (lane >> 4), cv1 = (lane & 7) ^ (4 + (lane >> 4));
    const bf16_t* k1p = K1 + (size_t)(wave_s * 8 + lrow) * 64 + ck * 8;
    const bf16_t* k2p = K2 + (size_t)(wave_s * 8 + lrow) * 64 + ck * 8;
    const bf16_t* v0p = VT + (size_t)(wave_s * 16 + lrow) * L_SEQ + cv0 * 8;
    const bf16_t* v1p = VT + (size_t)(wave_s * 16 + 8 + lrow) * L_SEQ + cv1 * 8;
    auto issue = [&](int kt) {
        char* st = lds + (kt & 3) * 32768;
        __builtin_amdgcn_global_load_lds((const unsigned*)(k1p + (size_t)kt * 4096), (__attribute__((address_space(3))) unsigned*)(st + wave_s * 1024), 16, 0, 0);
        __builtin_amdgcn_global_load_lds((const unsigned*)(k2p + (size_t)kt * 4096), (__attribute__((address_space(3))) unsigned*)(st + 8192 + wave_s * 1024), 16, 0, 0);
        __builtin_amdgcn_global_load_lds((const unsigned*)(v0p + kt * 64), (__attribute__((address_space(3))) unsigned*)(st + 16384 + wave_s * 2048), 16, 0, 0);
        __builtin_amdgcn_global_load_lds((const unsigned*)(v1p + kt * 64), (__attribute__((address_space(3))) unsigned*)(st + 16384 + wave_s * 2048 + 1024), 16, 0, 0);
    };
    issue(0); issue(1);
    if (nkt > 2) issue(2);
    if (nkt > 2) asm volatile("s_waitcnt vmcnt(8)" ::: "memory");
    else asm volatile("s_waitcnt vmcnt(4)" ::: "memory");
    __builtin_amdgcn_s_barrier(); asm volatile("" ::: "memory");
    const int koff_ = mp * 8192 + lr * 128, voff_ = 16384 + lr * 128;
    int chk[4], chv[4];
#pragma unroll
    for (int s = 0; s < 4; ++s) { chk[s] = ((2 * s + h) ^ sw) << 4; chv[s] = chk[s]; }
    bf16x8 kf[8], vf[8];
#pragma unroll
    for (int i = 0; i < 8; ++i) kf[i] = *(const bf16x8*)(lds + koff_ + (i >> 2) * 4096 + chk[i & 3]);
    for (int kt = 0; kt < nkt; ++kt) {
        const bool active = kt <= my_last;
        const char* stg = lds + (kt & 3) * 32768;
        f32x16 S[2];
        bf16x8 pf[2][2];
        if (active) {
#pragma unroll
            for (int kb = 0; kb < 2; ++kb) {
#pragma unroll
                for (int r = 0; r < 16; ++r) S[kb][r] = 0.f;
#pragma unroll
                for (int s = 0; s < 4; ++s) S[kb] = __builtin_amdgcn_mfma_f32_32x32x16_bf16(kf[kb * 4 + s], qf[s], S[kb], 0, 0, 0);
            }
#pragma unroll
            for (int i = 0; i < 8; ++i) vf[i] = *(const bf16x8*)(stg + voff_ + (i & 3) * 4096 + chv[i >> 2]);
            __builtin_amdgcn_sched_barrier(0);
            float mt = S[0][0];
#pragma unroll
            for (int r = 1; r < 16; ++r) mt = fmaxf(mt, S[0][r]);
#pragma unroll
            for (int r = 0; r < 16; ++r) mt = fmaxf(mt, S[1][r]);
            mt = fmaxf(mt, __shfl_xor(mt, 32));
            const bool need = mt > m_run + 8.0f;
            if (__any(need)) {
                const float mnew = need ? mt : m_run;
                const float alpha = fast_exp2(m_run - mnew);
                m_run = mnew; l_run *= alpha;
#pragma unroll
                for (int e = 0; e < 4; ++e)
#pragma unroll
                    for (int r = 0; r < 16; ++r) O[e][r] *= alpha;
            }
            float ls = 0.f;
#pragma unroll
            for (int kb = 0; kb < 2; ++kb)
#pragma unroll
                for (int s = 0; s < 2; ++s) { float e_[8];
#pragma unroll
                    for (int j = 0; j < 8; ++j) { e_[j] = fast_exp2(S[kb][8 * s + j] - m_run); ls += e_[j]; }
                    u32x4 pk; pk[0] = pk_bf16(e_[0], e_[1]); pk[1] = pk_bf16(e_[2], e_[3]); pk[2] = pk_bf16(e_[4], e_[5]); pk[3] = pk_bf16(e_[6], e_[7]);
                    pf[kb][s] = __builtin_bit_cast(bf16x8, pk); }
            l_run += ls;
        }
        const int rem = nkt - 1 - kt;
        if (rem >= 2) asm volatile("s_waitcnt vmcnt(4)" ::: "memory");
        else asm volatile("s_waitcnt vmcnt(0)" ::: "memory");
        __builtin_amdgcn_s_barrier(); asm volatile("" ::: "memory");
        if (kt + 3 < nkt) issue(kt + 3);
        if (kt + 1 <= my_last) {
            const char* sn = lds + ((kt + 1) & 3) * 32768;
#pragma unroll
            for (int i = 0; i < 8; ++i) kf[i] = *(const bf16x8*)(sn + koff_ + (i >> 2) * 4096 + chk[i & 3]);
        }
        __builtin_amdgcn_sched_barrier(0);
        if (active) {
#pragma unroll
            for (int i = 0; i < 8; ++i) O[i & 3] = __builtin_amdgcn_mfma_f32_32x32x16_bf16(vf[i], pf[0][i >> 2], O[i & 3], 0, 0, 0);
#pragma unroll
            for (int i = 0; i < 8; ++i) vf[i] = *(const bf16x8*)(stg + voff_ + (i & 3) * 4096 + (((4 + 2 * (i >> 2) + h) ^ sw) << 4));
#pragma unroll
            for (int i = 0; i < 8; ++i) O[i & 3] = __builtin_amdgcn_mfma_f32_32x32x16_bf16(vf[i], pf[1][i >> 2], O[i & 3], 0, 0, 0);
        }
    }
    __syncthreads();
    const float lt = l_run + __shfl_xor(l_run, 32);
    const float inv = fast_rcp(lt) * (mp ? lam : 1.0f);
    float* ex = (float*)lds;
    if (mp == 1) {
#pragma unroll
        for (int e = 0; e < 4; ++e)
#pragma unroll
            for (int r = 0; r < 16; ++r) ex[((g * 4 + e) * 16 + r) * 64 + lane] = O[e][r] * inv;
    }
    __syncthreads();
    if (mp == 0) {
        float ss = 0.f;
#pragma unroll
        for (int e = 0; e < 4; ++e)
#pragma unroll
            for (int r = 0; r < 16; ++r) { const float o = O[e][r] * inv - ex[((g * 4 + e) * 16 + r) * 64 + lane]; O[e][r] = o; ss += o * o; }
        ss += __shfl_xor(ss, 32);
        const float rs = rsqrtf(ss * (1.0f / 128.0f) + EPSV) * (1.0f - LAM_INIT);
        bf16_t* on = (bf16_t*)(p.ws + OFF_ON) + (size_t)(q0 + lr) * DM + head * 128;
#pragma unroll
        for (int e = 0; e < 4; ++e)
#pragma unroll
            for (int rq = 0; rq < 4; ++rq) { const int ee = e * 32 + rq * 8 + 4 * h; const f32x4 gg = *(const f32x4*)(p.subln_g + ee);
                u32x2 b; b[0] = pk_bf16(O[e][4 * rq] * rs * gg[0], O[e][4 * rq + 1] * rs * gg[1]); b[1] = pk_bf16(O[e][4 * rq + 2] * rs * gg[2], O[e][4 * rq + 3] * rs * gg[3]);
                *(u32x2*)(on + ee) = b; }
    }
    __syncthreads();
}


#define XB_XCNT(j)  (64 + 64 * (j))
#define XB_XSUB(j)  (1088 + 64 * (j))
#define XB_XGEN(j)  (2112 + 64 * (j))
#define XB_TOP      3136
#define XB_TOPGEN   3200
#define XB_WORDS    3264
__device__ __forceinline__ unsigned xb_ld(unsigned* p) { return __hip_atomic_load(p, __ATOMIC_RELAXED, __HIP_MEMORY_SCOPE_AGENT); }
__device__ __forceinline__ unsigned xb_add(unsigned* p, unsigned v) { return __hip_atomic_fetch_add(p, v, __ATOMIC_RELAXED, __HIP_MEMORY_SCOPE_AGENT); }
__device__ __forceinline__ unsigned xb_xcc_id() { return (unsigned)__builtin_amdgcn_s_getreg((3 << 11) | 20) & 0xFu; }
__device__ __forceinline__ void gbar(const int wave_s, unsigned* bar, volatile unsigned* st) {
    asm volatile("s_waitcnt vmcnt(0)" ::: "memory");
    __syncthreads();
    if (get_tid(wave_s) == 0) {
        __builtin_amdgcn_s_waitcnt(0);
        const unsigned x = st[2], nloc = st[0], nx = st[1];
        const unsigned old = xb_add(&bar[XB_XSUB(x)], 1u);
        const unsigned gen = old / nloc;
        if (old + 1u == (gen + 1u) * nloc) {
            __builtin_amdgcn_fence(__ATOMIC_RELEASE, "agent");
            asm volatile("s_waitcnt vmcnt(0)" ::: "memory");
            const unsigned og = xb_add(&bar[XB_TOP], 1u);
            const unsigned tg = og / nx;
            if (og + 1u == (tg + 1u) * nx) xb_add(&bar[XB_TOPGEN], 1u);
            else while (xb_ld(&bar[XB_TOPGEN]) == tg) __builtin_amdgcn_s_sleep(1);
            __builtin_amdgcn_fence(__ATOMIC_ACQUIRE, "agent");
            xb_add(&bar[XB_XGEN(x)], 1u);
            asm volatile("s_waitcnt vmcnt(0)" ::: "memory");
        } else {
            while (xb_ld(&bar[XB_XGEN(x)]) == gen) __builtin_amdgcn_s_sleep(1);
            __builtin_amdgcn_fence(__ATOMIC_ACQUIRE, "agent");
            asm volatile("s_waitcnt vmcnt(0)" ::: "memory");
        }
    }
    __syncthreads();
}

__device__ __forceinline__ bool tile_map(int r, int bid, int nb, int NT, int& nt, int& mt) {
    if (nb == 256) {
        const int x = bid & 7, li = bid >> 3, q = li + 32 * r;
        if (q >= 8 * NT) return false;
        const int mi = q & 3, rest = q >> 2, mg = rest / NT;
        nt = rest - mg * NT; mt = x * 8 + mg * 4 + mi; return true;
    }
    const int t = bid + r * nb; if (t >= NT * 64) return false;
    nt = t % NT; mt = t / NT; return true;
}

__global__ void __launch_bounds__(NTHREADS) mega(const Params p) {
    __shared__ __attribute__((aligned(16))) char lds[LDS_BYTES];
    cg::grid_group grid = cg::this_grid();
    const int wave_s = __builtin_amdgcn_readfirstlane((int)(threadIdx.x >> 6));
    const int nb = gridDim.x, bid = blockIdx.x;
    char* ws = p.ws;
    bf16_t* hn0 = (bf16_t*)(ws + OFF_HN0);
    bf16_t* hb = (bf16_t*)(ws + OFF_HB);
    float* ssq0 = (float*)(ws + OFF_SSQ);
    float* ssq1 = ssq0 + 16 * L_SEQ; float* ssq2 = ssq1 + 16 * L_SEQ; float* ssq3 = ssq2 + 16 * L_SEQ;
    const Seg nul = {nullptr, 0, 0, nullptr, 0, 0};
    unsigned* bar = (unsigned*)(ws + OFF_BAR);
    volatile unsigned* xst = (volatile unsigned*)(lds + LDS_BYTES - 16);
    if (get_tid(wave_s) == 0) xb_add(&bar[XB_XCNT(xb_xcc_id())], 1u);
    grid.sync();
    if (get_tid(wave_s) == 0) {
        const unsigned x = xb_xcc_id(); unsigned cnt = 0u, mine = 1u;
        for (unsigned j = 0; j < 16; ++j) { const unsigned c = xb_ld(&bar[XB_XCNT(j)]); cnt += (c > 0u) ? 1u : 0u; if (j == x) mine = c; }
        xst[0] = mine ? mine : 1u; xst[1] = cnt ? cnt : 1u; xst[2] = x;
    }
    __syncthreads();

    { const int nwork = p.ntiles_w + 256;
      for (int rep = 0; rep < REP_PREP; ++rep) {
          if (nb >= 128) {
              if (bid < 64) s5_tables(wave_s, p, bid, lds);
              else for (int it = bid - 64; it < nwork; it += nb - 64) { if (it < p.ntiles_w) wtile(wave_s, p, it, lds); else rms0_item(wave_s, p, it - p.ntiles_w); }
          } else {
              for (int it = bid; it < 64 + nwork; it += nb) { if (it < 64) s5_tables(wave_s, p, it, lds); else if (it < 64 + p.ntiles_w) wtile(wave_s, p, it - 64, lds); else rms0_item(wave_s, p, it - 64 - p.ntiles_w); }
          }
      } }
    gbar(wave_s, bar, xst);
    for (int rep = 0; rep < REP_SLOC; ++rep)
    for (int g = bid; g < 64; g += nb) {
        Seg s = {(const bf16_t*)(ws + OFF_W1) + (size_t)g * 128 * 1024, 1024, 16, hn0 + (size_t)g * 262144, 1024, 16};
        EpiSloc e = {(float*)lds};
        gemm_tile(wave_s, lds, s, 16, nul, 0, e);
        __syncthreads();
        {
            const int lane_ = get_tid(wave_s) & 63, w_ = wave_s;
            const f32x2 a = ((const f32x2*)(ws + OFF_A64))[g * 64 + lane_];
            const float* sl = (const float*)lds + (w_ * 32) * 132;
            float sr = 0.f, si = 0.f;
#pragma unroll
            for (int j = 0; j < 32; ++j) { const float xr = sl[j * 132 + lane_], xi = sl[j * 132 + 64 + lane_]; const float nr = a[0] * sr - a[1] * si + xr, ni = a[0] * si + a[1] * sr + xi; sr = nr; si = ni; }
            f32x2* carry = (f32x2*)(lds + 135168);
            { f32x2 c; c[0] = sr; c[1] = si; carry[w_ * 64 + lane_] = c; }
            float pr = a[0], pi = a[1];
#pragma unroll
            for (int q = 0; q < 5; ++q) { const float nr = pr * pr - pi * pi, ni = 2.f * pr * pi; pr = nr; pi = ni; }
            __syncthreads();
            sr = 0.f; si = 0.f;
            for (int v = 0; v < w_; ++v) { const f32x2 c = carry[v * 64 + lane_]; const float nr = pr * sr - pi * si + c[0], ni = pr * si + pi * sr + c[1]; sr = nr; si = ni; }
            bf16_t* sp = (bf16_t*)(ws + OFF_SPREV) + (size_t)g * 256 * 128 + (size_t)(w_ * 32) * 128;
#pragma unroll
            for (int j = 0; j < 32; ++j) {
                sp[j * 128 + lane_] = (bf16_t)(pk_bf16(sr, 0.f) & 0xffffu); sp[j * 128 + 64 + lane_] = (bf16_t)(pk_bf16(si, 0.f) & 0xffffu);
                const float xr = sl[j * 132 + lane_], xi = sl[j * 132 + 64 + lane_];
                const float nr = a[0] * sr - a[1] * si + xr, ni = a[0] * si + a[1] * sr + xi; sr = nr; si = ni;
            }
        }
        __syncthreads();
    }
    gbar(wave_s, bar, xst);
    for (int rep = 0; rep < REP_S5; ++rep)
    for (int t0 = bid; t0 < 256; t0 += nb) {
        const int t = (nb == 256) ? ((t0 & 7) * 32 + (t0 >> 3)) : t0;
        const int g = t >> 2, i = 3 - (t & 3);
        const bf16_t* sprev = (const bf16_t*)(ws + OFF_SPREV) + (size_t)g * 256 * 128;
        Seg s0 = {(const bf16_t*)(ws + OFF_KT) + (size_t)g * 127 * 256 + 63 * 256 + (size_t)(i * 256) * 16, 16, -256, hn0 + (size_t)g * 262144, 1024, 16};
        Seg s1 = {(const bf16_t*)(ws + OFF_W3) + (size_t)g * 1024 * 128 + (size_t)(i * 256) * 128, 128, 16, sprev, 128, 16};
        EpiS5 e = {hn0, p.ssm_d, (bf16_t*)(ws + OFF_Z), g, i * 256};
        gemm_tile(wave_s, lds, s0, 4 * (i + 1), s1, 2, e);
    }
    gbar(wave_s, bar, xst);
    for (int rep = 0; rep < REP_GLU; ++rep)
    for (int r = 0, nt, mt; tile_map(r, bid, nb, 8, nt, mt); ++r) {
        Seg s = {(const bf16_t*)(ws + OFF_WGLU) + (size_t)nt * 256 * DM, DM, 16, (const bf16_t*)(ws + OFF_Z) + (size_t)mt * 256 * 16, 16, 262144};
        EpiGlu e = {p.x, p.out, hb, ssq0, nt * 256, mt * 256};
        gemm_tile(wave_s, lds, s, 16, nul, 0, e);
    }
    gbar(wave_s, bar, xst);
#pragma unroll
    for (int layer = 0; layer < 2; ++layer) {
        if (layer == 1) {
            for (int rep = 0; rep < REP_KVQ; ++rep)
            for (int r = 0, nt, mt; tile_map(r, bid, nb, 12, nt, mt); ++r) {
                Seg s = {(const bf16_t*)(ws + OFF_WKVQ) + (size_t)nt * 256 * DM, DM, 16, hb + (size_t)mt * 256 * DM, DM, 16};
                EpiKvq e = {ssq1, ws, nt * 256, mt * 256, {0.f, 0.f}};
                gemm_tile(wave_s, lds, s, 16, nul, 0, e);
            }
            gbar(wave_s, bar, xst);
            {
                float a1 = 0.f, a2 = 0.f;
                for (int i = 0; i < 64; ++i) { a1 += p.lq1[i] * p.lk1[i]; a2 += p.lq2[i] * p.lk2[i]; }
                const float lam = expf(a1) - expf(a2) + LAM_INIT;
                for (int rep = 0; rep < REP_ATTN; ++rep)
                for (int it = bid; it < 1024; it += nb) {
                    const int head = it & 7, r = it >> 3, rnd = r >> 5, j = r & 31;
                    const int qb = (rnd == 0) ? 127 - j : (rnd == 1) ? 64 + j : (rnd == 2) ? 63 - j : j;
                    attn_item(wave_s, p, head, qb, lam, lds);
                }
            }
            gbar(wave_s, bar, xst);
            for (int r = 0, nt, mt; tile_map(r, bid, nb, 4, nt, mt); ++r) {
                Seg s = {(const bf16_t*)(ws + OFF_WO) + (size_t)nt * 256 * DM, DM, 16, (const bf16_t*)(ws + OFF_ON) + (size_t)mt * 256 * DM, DM, 16};
                EpiRes e = {p.out, hb, ssq2, nt * 256, mt * 256};
                gemm_tile(wave_s, lds, s, 16, nul, 0, e);
            }
            gbar(wave_s, bar, xst);
        }
        {
            const bf16_t* wup = (const bf16_t*)(ws + (layer ? OFF_WUP1 : OFF_WUP0));
            for (int rep = 0; rep < REP_UP; ++rep)
            for (int r = 0, nt, mt; tile_map(r, bid, nb, 22, nt, mt); ++r) {
                Seg s = {wup + (size_t)nt * 256 * DM, DM, 16, hb + (size_t)mt * 256 * DM, DM, 16};
                if (layer == 0) { EpiUp<16> e = {ssq0, (bf16_t*)(ws + OFF_ACT), nt * 256, mt * 256, {0.f, 0.f}}; gemm_tile(wave_s, lds, s, 16, nul, 0, e); }
                else { EpiUp<8> e = {ssq2, (bf16_t*)(ws + OFF_ACT), nt * 256, mt * 256, {0.f, 0.f}}; gemm_tile(wave_s, lds, s, 16, nul, 0, e); }
            }
        }
        gbar(wave_s, bar, xst);
        {
            const bf16_t* wdn = (const bf16_t*)(ws + (layer ? OFF_WDN1 : OFF_WDN0));
            for (int r = 0, nt, mt; tile_map(r, bid, nb, 4, nt, mt); ++r) {
                Seg s = {wdn + (size_t)nt * 256 * FFN, FFN, 16, (const bf16_t*)(ws + OFF_ACT) + (size_t)mt * 256 * FFN, FFN, 16};
                EpiRes e = {p.out, layer ? (bf16_t*)nullptr : hb, layer ? ssq3 : ssq1, nt * 256, mt * 256};
                gemm_tile(wave_s, lds, s, FFN / 64, nul, 0, e);
            }
        }
        gbar(wave_s, bar, xst);
    }
    {
        const int lane = get_tid(wave_s) & 63, wid = wave_s;
        for (int row = bid * 8 + wid; row < L_SEQ; row += nb * 8) {
            float s = 0.f;
            for (int i = 0; i < 8; ++i) s += ssq3[(size_t)i * L_SEQ + row];
            const float rs = rsqrtf(s * (1.0f / DM) + EPSV);
#pragma unroll
            for (int i = 0; i < 4; ++i) { const size_t off = (size_t)row * DM + lane * 4 + 256 * i;
                f32x4 v = *(const f32x4*)(p.out + off); const f32x4 g = *(const f32x4*)(p.final_g + lane * 4 + 256 * i);
                v[0] *= rs * g[0]; v[1] *= rs * g[1]; v[2] *= rs * g[2]; v[3] *= rs * g[3]; *(f32x4*)(p.out + off) = v; }
        }
    }
}

static void add_job(Params& P, int& nt, const float* src, bf16_t* dst, const float* gain, int K, int N, int ld, int col0, int mode, int rowoff, float scale) {
    WJob& J = P.jobs[P.njobs++];
    J.src = src; J.dst = dst; J.gain = gain; J.K = K; J.N = N; J.ldsrc = ld; J.col0 = col0; J.mode = mode; J.rowoff = rowoff; J.scale = scale; J.tile0 = nt; J.ntn = N / 256; J.pad = 0;
    nt += (K / 64) * (N / 256);
}

extern "C" void kernel_launch(void* const* d_in, const int* in_sizes, int n_in, void* d_out, int out_size, void* d_ws, size_t ws_size, hipStream_t stream) {
    Params P; memset(&P, 0, sizeof(P));
    P.x = (const float*)d_in[0]; P.norm_mix_g = (const float*)d_in[1]; P.norm_ffn_g = (const float*)d_in[2];
    P.ffn_w1 = (const float*)d_in[3]; P.ffn_w3 = (const float*)d_in[4]; P.ffn_w2 = (const float*)d_in[5];
    P.lam_re = (const float*)d_in[6]; P.lam_im = (const float*)d_in[7]; P.log_dt = (const float*)d_in[8];
    P.b_re = (const float*)d_in[9]; P.b_im = (const float*)d_in[10]; P.c_re = (const float*)d_in[11]; P.c_im = (const float*)d_in[12];
    P.ssm_d = (const float*)d_in[13]; P.w_glu = (const float*)d_in[14]; P.kv_norm_g = (const float*)d_in[15]; P.w_kv = (const float*)d_in[16];
    P.w_q = (const float*)d_in[17]; P.lq1 = (const float*)d_in[18]; P.lk1 = (const float*)d_in[19]; P.lq2 = (const float*)d_in[20]; P.lk2 = (const float*)d_in[21];
    P.subln_g = (const float*)d_in[22]; P.w_o = (const float*)d_in[23]; P.final_g = (const float*)d_in[24];
    P.out = (float*)d_out; P.ws = (char*)d_ws;
    char* ws = (char*)d_ws; int nt = 0;
    const size_t FW = (size_t)DM * FFN;
    add_job(P, nt, P.w_glu, (bf16_t*)(ws + OFF_WGLU), nullptr, DM, 1024, 2048, 0, 1, 0, 1.0f);
    add_job(P, nt, P.w_glu, (bf16_t*)(ws + OFF_WGLU), nullptr, DM, 1024, 2048, 1024, 2, 0, 1.0f);
    add_job(P, nt, P.ffn_w1, (bf16_t*)(ws + OFF_WUP0), P.norm_ffn_g, DM, FFN, FFN, 0, 1, 0, 1.0f);
    add_job(P, nt, P.ffn_w3, (bf16_t*)(ws + OFF_WUP0), P.norm_ffn_g, DM, FFN, FFN, 0, 2, 0, 1.0f);
    add_job(P, nt, P.ffn_w2, (bf16_t*)(ws + OFF_WDN0), nullptr, FFN, DM, DM, 0, 0, 0, 1.0f);
    add_job(P, nt, P.w_kv, (bf16_t*)(ws + OFF_WKVQ), P.kv_norm_g, DM, 2048, 2048, 0, 0, 0, 1.0f);
    add_job(P, nt, P.w_q, (bf16_t*)(ws + OFF_WKVQ), P.norm_mix_g + DM, DM, 1024, 1024, 0, 0, 2048, QSCALE);
    add_job(P, nt, P.w_o, (bf16_t*)(ws + OFF_WO), nullptr, DM, DM, DM, 0, 0, 0, 1.0f);
    add_job(P, nt, P.ffn_w1 + FW, (bf16_t*)(ws + OFF_WUP1), P.norm_ffn_g + DM, DM, FFN, FFN, 0, 1, 0, 1.0f);
    add_job(P, nt, P.ffn_w3 + FW, (bf16_t*)(ws + OFF_WUP1), P.norm_ffn_g + DM, DM, FFN, FFN, 0, 2, 0, 1.0f);
    add_job(P, nt, P.ffn_w2 + FW, (bf16_t*)(ws + OFF_WDN1), nullptr, FFN, DM, DM, 0, 0, 0, 1.0f);
    P.ntiles_w = nt;
    static int grid_blocks = 0;
    if (!grid_blocks) {
        int dev = 0, cus = 0, per_cu = 0;
        hipGetDevice(&dev);
        hipDeviceGetAttribute(&cus, hipDeviceAttributeMultiprocessorCount, dev);
        hipOccupancyMaxActiveBlocksPerMultiprocessor(&per_cu, mega, NTHREADS, 0);
        if (per_cu < 1) per_cu = 1;
        grid_blocks = cus * 1;
    }
    hipMemsetAsync(ws + OFF_BAR, 0, 16384, stream);
    void* args[] = {&P};
    hipError_t e = hipLaunchCooperativeKernel((void*)mega, dim3(grid_blocks), dim3(NTHREADS), args, 0, stream);
    if (e != hipSuccess) fprintf(stderr, "cooperative launch failed: %s (grid %d)\n", hipGetErrorString(e), grid_blocks);
}
```

```cpp
#include <hip/hip_runtime.h>
#include <hip/hip_cooperative_groups.h>
#include <stdint.h>
#include <string.h>
#include <stdio.h>
namespace cg = cooperative_groups;

typedef unsigned short bf16_t;
typedef short bf16x8 __attribute__((ext_vector_type(8)));
typedef float f32x16 __attribute__((ext_vector_type(16)));
typedef float f32x4 __attribute__((ext_vector_type(4)));
typedef float f32x2 __attribute__((ext_vector_type(2)));
typedef unsigned u32x4 __attribute__((ext_vector_type(4)));
typedef unsigned u32x2 __attribute__((ext_vector_type(2)));

#define L_SEQ 16384
#define DM 1024
#define FFN 2816
#define NTHREADS 512
#ifndef REP_ATTN
#define REP_ATTN 1
#endif
#ifndef REP_UP
#define REP_UP 1
#endif
#define REP_GLU 1
#define REP_KVQ 1
#define REP_S5 1
#define REP_SLOC 1
#define REP_PREP 1
#define LDS_BYTES 139280
#define EPSV 1e-6f
#define LAM_INIT 0.35550906759096927f
#define QSCALE 0.18033688011112042f

static constexpr size_t MiB = 1024ull * 1024ull;
static constexpr size_t OFF_WGLU = 0;
static constexpr size_t OFF_WUP0 = 4 * MiB;
static constexpr size_t OFF_WDN0 = 15 * MiB;
static constexpr size_t OFF_WKVQ = 20 * MiB + MiB / 2;
static constexpr size_t OFF_WO = 26 * MiB + MiB / 2;
static constexpr size_t OFF_WUP1 = 28 * MiB + MiB / 2;
static constexpr size_t OFF_WDN1 = 39 * MiB + MiB / 2;
static constexpr size_t OFF_SSQ = 45 * MiB;
static constexpr size_t OFF_A64 = 49 * MiB;
static constexpr size_t OFF_BAR = 49 * MiB + MiB / 2;
static constexpr size_t OFF_A = 50 * MiB;
static constexpr size_t OFF_HN0 = OFF_A;
static constexpr size_t OFF_Z = OFF_A + 32 * MiB;
static constexpr size_t OFF_ACT = OFF_A;
static constexpr size_t OFF_K1 = OFF_A;
static constexpr size_t OFF_K2 = OFF_A + 16 * MiB;
static constexpr size_t OFF_VT = OFF_A + 32 * MiB;
static constexpr size_t OFF_Q1 = OFF_A + 64 * MiB;
static constexpr size_t OFF_Q2 = OFF_A + 80 * MiB;
static constexpr size_t OFF_B = 146 * MiB;
static constexpr size_t OFF_KT = OFF_B;
static constexpr size_t OFF_W1 = OFF_B + 4 * MiB;
static constexpr size_t OFF_W3 = OFF_B + 20 * MiB;
static constexpr size_t OFF_SLOC = OFF_B + 36 * MiB;
static constexpr size_t OFF_SPREV = OFF_B + 44 * MiB;
static constexpr size_t OFF_HB = OFF_B;
static constexpr size_t OFF_ON = OFF_B + 32 * MiB;

struct WJob { const float* src; bf16_t* dst; const float* gain; int K; int N; int ldsrc; int col0; int mode; int rowoff; float scale; int tile0; int ntn; int pad; };

struct Params {
    const float *x, *norm_mix_g, *norm_ffn_g, *ffn_w1, *ffn_w3, *ffn_w2;
    const float *lam_re, *lam_im, *log_dt, *b_re, *b_im, *c_re, *c_im, *ssm_d, *w_glu;
    const float *kv_norm_g, *w_kv, *w_q, *lq1, *lk1, *lq2, *lk2, *subln_g, *w_o, *final_g;
    float* out;
    char* ws;
    WJob jobs[12];
    int njobs; int ntiles_w;
};

__device__ __forceinline__ int get_tid(int wave_s) { int t = wave_s * 64 + (int)__builtin_amdgcn_mbcnt_hi(~0u, __builtin_amdgcn_mbcnt_lo(~0u, 0u)); asm volatile("" : "+v"(t)); return t; }
__device__ __forceinline__ unsigned pk_bf16(float lo, float hi) { unsigned r; asm("v_cvt_pk_bf16_f32 %0, %1, %2" : "=v"(r) : "v"(lo), "v"(hi)); return r; }
__device__ __forceinline__ float bf_lo(unsigned u) { return __uint_as_float(u << 16); }
__device__ __forceinline__ float bf_hi(unsigned u) { return __uint_as_float(u & 0xffff0000u); }
__device__ __forceinline__ float fast_rcp(float x) { return __builtin_amdgcn_rcpf(x); }
__device__ __forceinline__ float fast_exp2(float x) { return __builtin_amdgcn_exp2f(x); }
__device__ __forceinline__ float sigmoidf_(float x) { return fast_rcp(1.0f + fast_exp2(-1.4426950408889634f * x)); }
__device__ __forceinline__ float gelu_tanh(float x) {
    const float u = 0.7978845608028654f * x * (1.0f + 0.044715f * x * x);
    return x * fast_rcp(1.0f + fast_exp2(-2.8853900817779268f * u));
}

struct Seg { const bf16_t* W; long wrs; long wkhi; const bf16_t* X; long xrs; long xkhi; };

struct TileCtx { int wn, wm, lane; };

template <class Epi>
__device__ __forceinline__ void gemm_tile(const int wave_s, char* lds, const Seg s0, const int nk0_, const Seg s1, const int nk1_, Epi& epi,
                                          const bool pro_done = false, const bool has_next = false, const Seg nx = Seg{nullptr, 0, 0, nullptr, 0, 0}) {
    int tid = get_tid(wave_s);
    const int lane = tid & 63;
    const int wn = wave_s >> 2, wm = wave_s & 3;
    const int lr = lane & 31, h = lane >> 5;
    const int nk0 = nk0_ * 2, nk1 = nk1_ * 2, nk = nk0 + nk1;
    const int cch = (lane & 3) ^ ((lane >> 4) & 3);
    const int row0 = wave_s * 32 + (lane >> 2);
    f32x16 acc[4][2];
#pragma unroll
    for (int a = 0; a < 4; ++a)
#pragma unroll
        for (int b = 0; b < 2; ++b)
#pragma unroll
            for (int r = 0; r < 16; ++r) acc[a][b][r] = 0.f;
    auto issue = [&](int t) {
        const bool first = t < nk0;
        const bf16_t* W = first ? s0.W : s1.W; const bf16_t* X = first ? s0.X : s1.X;
        const long wrs = first ? s0.wrs : s1.wrs, xrs = first ? s0.xrs : s1.xrs;
        const long wkhi = first ? s0.wkhi : s1.wkhi, xkhi = first ? s0.xkhi : s1.xkhi;
        const int kt = first ? t : t - nk0;
        const long kc = kt * 2 + (cch >> 1);
        const bf16_t* wp = W + (long)row0 * wrs + kc * wkhi + (cch & 1) * 8;
        const bf16_t* xp = X + (long)row0 * xrs + kc * xkhi + (cch & 1) * 8;
        char* st = lds + (t & 3) * 32768 + wave_s * 2048;
        __builtin_amdgcn_global_load_lds((const unsigned*)wp, (__attribute__((address_space(3))) unsigned*)(st), 16, 0, 0);
        __builtin_amdgcn_global_load_lds((const unsigned*)(wp + 16 * wrs), (__attribute__((address_space(3))) unsigned*)(st + 1024), 16, 0, 0);
        __builtin_amdgcn_global_load_lds((const unsigned*)xp, (__attribute__((address_space(3))) unsigned*)(st + 16384), 16, 0, 0);
        __builtin_amdgcn_global_load_lds((const unsigned*)(xp + 16 * xrs), (__attribute__((address_space(3))) unsigned*)(st + 16384 + 1024), 16, 0, 0);
    };
    const int sw = (lr >> 2) & 3;
    const int aoff = (wn * 128 + lr) * 64, boff = 16384 + (wm * 64 + lr) * 64;
    const int ch0 = ((0 + h) ^ sw) << 4, ch1 = ((2 + h) ^ sw) << 4;
    bf16x8 a0[4], b0[2], a1[4], b1[2];
    epi.pre(wm, lane, wn);
    if (!pro_done) { issue(0); issue(1); issue(2); issue(3); }
    asm volatile("s_waitcnt vmcnt(12)" ::: "memory");
    __builtin_amdgcn_s_barrier(); asm volatile("" ::: "memory");
#pragma unroll
    for (int nb = 0; nb < 4; ++nb) a0[nb] = *(const bf16x8*)(lds + aoff + nb * 2048 + ch0);
#pragma unroll
    for (int mb = 0; mb < 2; ++mb) b0[mb] = *(const bf16x8*)(lds + boff + mb * 2048 + ch0);
    for (int t = 0; t < nk; ++t) {
        const char* st = lds + (t & 3) * 32768;
#pragma unroll
        for (int nb = 0; nb < 4; ++nb) a1[nb] = *(const bf16x8*)(st + aoff + nb * 2048 + ch1);
#pragma unroll
        for (int mb = 0; mb < 2; ++mb) b1[mb] = *(const bf16x8*)(st + boff + mb * 2048 + ch1);
#pragma unroll
        for (int nb = 0; nb < 4; ++nb)
#pragma unroll
            for (int mb = 0; mb < 2; ++mb) acc[nb][mb] = __builtin_amdgcn_mfma_f32_32x32x16_bf16(a0[nb], b0[mb], acc[nb][mb], 0, 0, 0);
        const int rem = nk - 1 - t;
        if (rem >= 3) asm volatile("s_waitcnt vmcnt(8)" ::: "memory");
        else if (rem == 2) asm volatile("s_waitcnt vmcnt(4)" ::: "memory");
        else asm volatile("s_waitcnt vmcnt(0)" ::: "memory");
        asm volatile("s_waitcnt lgkmcnt(0)" ::: "memory");
        __builtin_amdgcn_s_barrier(); asm volatile("" ::: "memory");
        if (t + 4 < nk) issue(t + 4);
        if (t + 1 < nk) {
            const char* sn = lds + ((t + 1) & 3) * 32768;
#pragma unroll
            for (int nb = 0; nb < 4; ++nb) a0[nb] = *(const bf16x8*)(sn + aoff + nb * 2048 + ch0);
#pragma unroll
            for (int mb = 0; mb < 2; ++mb) b0[mb] = *(const bf16x8*)(sn + boff + mb * 2048 + ch0);
        }
#pragma unroll
        for (int nb = 0; nb < 4; ++nb)
#pragma unroll
            for (int mb = 0; mb < 2; ++mb) acc[nb][mb] = __builtin_amdgcn_mfma_f32_32x32x16_bf16(a1[nb], b1[mb], acc[nb][mb], 0, 0, 0);
    }
    if (has_next) {
#pragma unroll
        for (int t = 0; t < 4; ++t) {
            const long kc = t * 2 + (cch >> 1);
            const bf16_t* wp = nx.W + (long)row0 * nx.wrs + kc * nx.wkhi + (cch & 1) * 8;
            const bf16_t* xp = nx.X + (long)row0 * nx.xrs + kc * nx.xkhi + (cch & 1) * 8;
            char* st = lds + t * 32768 + wave_s * 2048;
            __builtin_amdgcn_global_load_lds((const unsigned*)wp, (__attribute__((address_space(3))) unsigned*)(st), 16, 0, 0);
            __builtin_amdgcn_global_load_lds((const unsigned*)(wp + 16 * nx.wrs), (__attribute__((address_space(3))) unsigned*)(st + 1024), 16, 0, 0);
            __builtin_amdgcn_global_load_lds((const unsigned*)xp, (__attribute__((address_space(3))) unsigned*)(st + 16384), 16, 0, 0);
            __builtin_amdgcn_global_load_lds((const unsigned*)(xp + 16 * nx.xrs), (__attribute__((address_space(3))) unsigned*)(st + 16384 + 1024), 16, 0, 0);
        }
    }
    TileCtx c; c.wn = wn; c.wm = wm; c.lane = lane;
    epi(acc, c);
}

template <int NPART>
__device__ __forceinline__ float rstd_from(const float* ssq, int token) {
    float v[NPART];
#pragma unroll
    for (int i = 0; i < NPART; ++i) v[i] = ssq[(size_t)i * L_SEQ + token];
    float s = 0.f;
#pragma unroll
    for (int i = 0; i < NPART; ++i) s += v[i];
    return rsqrtf(s * (1.0f / DM) + EPSV);
}

__device__ __forceinline__ u32x4 widen8(u32x2 A, u32x2 B) {
    const auto r0 = __builtin_amdgcn_permlane32_swap(A[0], B[0], false, false);
    const auto r1 = __builtin_amdgcn_permlane32_swap(A[1], B[1], false, false);
    u32x4 o; o[0] = r0[0]; o[1] = r1[0]; o[2] = r0[1]; o[3] = r1[1]; return o;
}

struct EpiSloc {
    float* dst;
    __device__ __forceinline__ void pre(int, int, int) {}
    __device__ __forceinline__ void operator()(f32x16 (&acc)[4][2], const TileCtx& c) const {
        if (c.wn != 0) return;
        const int lr = c.lane & 31, h = c.lane >> 5;
#pragma unroll
        for (int mb = 0; mb < 2; ++mb) { const int m = c.wm * 64 + mb * 32 + lr;
#pragma unroll
            for (int nb = 0; nb < 4; ++nb)
#pragma unroll
                for (int rq = 0; rq < 4; ++rq) { const int n = nb * 32 + rq * 8 + 4 * h;
                    f32x4 v = {acc[nb][mb][4 * rq], acc[nb][mb][4 * rq + 1], acc[nb][mb][4 * rq + 2], acc[nb][mb][4 * rq + 3]};
                    *(f32x4*)(dst + m * 132 + n) = v; } }
    }
};

struct EpiS5 {
    const bf16_t* hn0; const float* dskip; bf16_t* z; int g; int n0;
    __device__ __forceinline__ void pre(int, int, int) {}
    __device__ __forceinline__ void operator()(f32x16 (&acc)[4][2], const TileCtx& c) const {
        const int lr = c.lane & 31, h = c.lane >> 5;
#pragma unroll
        for (int mb = 0; mb < 2; ++mb) { const int j = c.wm * 64 + mb * 32 + lr;
            u32x2 uu[16], zz[16];
#pragma unroll
            for (int q = 0; q < 16; ++q) { const int n = n0 + c.wn * 128 + (q >> 2) * 32 + (q & 3) * 8 + 4 * h; uu[q] = *(const u32x2*)(hn0 + (size_t)g * 262144 + (size_t)j * 1024 + n); }
            asm volatile("" ::: "memory");
#pragma unroll
            for (int q = 0; q < 16; ++q) { const int nb = q >> 2, rq = q & 3; const int n = n0 + c.wn * 128 + nb * 32 + rq * 8 + 4 * h; const int t = n >> 4, cc = n & 15;
                const size_t off = (size_t)g * 262144 + (size_t)(j * 64 + t) * 16 + cc; const f32x4 d4 = *(const f32x4*)(dskip + g * 16 + cc);
                const float y0 = acc[nb][mb][4 * rq] + d4[0] * bf_lo(uu[q][0]), y1 = acc[nb][mb][4 * rq + 1] + d4[1] * bf_hi(uu[q][0]);
                const float y2 = acc[nb][mb][4 * rq + 2] + d4[2] * bf_lo(uu[q][1]), y3 = acc[nb][mb][4 * rq + 3] + d4[3] * bf_hi(uu[q][1]);
                zz[q][0] = pk_bf16(gelu_tanh(y0), gelu_tanh(y1)); zz[q][1] = pk_bf16(gelu_tanh(y2), gelu_tanh(y3)); (void)off; }
#pragma unroll
            for (int q = 0; q < 16; q += 2) { const int n = n0 + c.wn * 128 + (q >> 2) * 32 + (q & 3) * 8 + 8 * h;
                *(u32x4*)(z + (size_t)g * 262144 + (size_t)(j * 64 + (n >> 4)) * 16 + (n & 15)) = widen8(zz[q], zz[q + 1]); }
            asm volatile("" ::: "memory"); }
    }
};

struct EpiGlu {
    const float* x; float* out; bf16_t* hb; float* ssq; int n0, m0;
    __device__ __forceinline__ void pre(int, int, int) {}
    __device__ __forceinline__ void operator()(f32x16 (&acc)[4][2], const TileCtx& c) const {
        const int lr = c.lane & 31, h = c.lane >> 5;
#pragma unroll
        for (int mb = 0; mb < 2; ++mb) { const int m = m0 + c.wm * 64 + mb * 32 + lr; float s = 0.f;
            const size_t rowoff = (size_t)m * DM + ((n0 + c.wn * 128) >> 1) + 4 * h;
            f32x4 xv[8]; u32x2 pkk[8];
#pragma unroll
            for (int q = 0; q < 8; ++q) xv[q] = *(const f32x4*)(x + rowoff + (q >> 1) * 16 + (q & 1) * 8);
            asm volatile("" ::: "memory");
#pragma unroll
            for (int q = 0; q < 8; ++q) { const int nb = q >> 1, rg = q & 1; const size_t off = rowoff + nb * 16 + rg * 8; f32x4 o;
#pragma unroll
                for (int e = 0; e < 4; ++e) { o[e] = xv[q][e] + acc[nb][mb][rg * 8 + e] * sigmoidf_(acc[nb][mb][rg * 8 + 4 + e]); s += o[e] * o[e]; }
                *(f32x4*)(out + off) = o; pkk[q][0] = pk_bf16(o[0], o[1]); pkk[q][1] = pk_bf16(o[2], o[3]); }
#pragma unroll
            for (int q = 0; q < 8; q += 2) *(u32x4*)(hb + (size_t)m * DM + ((n0 + c.wn * 128) >> 1) + (q >> 1) * 16 + 8 * h) = widen8(pkk[q], pkk[q + 1]);
            asm volatile("" ::: "memory");
            s += __shfl_xor(s, 32);
            if (h == 0) ssq[(size_t)((n0 >> 8) * 2 + c.wn) * L_SEQ + m] = s; }
    }
};

template <int NPART> struct EpiUp {
    const float* ssq; bf16_t* act; int n0, m0; float rsv[2];
    __device__ __forceinline__ void pre(int wm, int lane, int) {
#pragma unroll
        for (int mb = 0; mb < 2; ++mb) rsv[mb] = rstd_from<NPART>(ssq, m0 + wm * 64 + mb * 32 + (lane & 31)); }
    __device__ __forceinline__ void operator()(f32x16 (&acc)[4][2], const TileCtx& c) const {
        const int lr = c.lane & 31, h = c.lane >> 5;
#pragma unroll
        for (int mb = 0; mb < 2; ++mb) { const int m = m0 + c.wm * 64 + mb * 32 + lr; const float rs = rsv[mb];
#pragma unroll
            for (int nb = 0; nb < 4; ++nb) { u32x2 pk[2];
#pragma unroll
                for (int rg = 0; rg < 2; ++rg) { float o[4];
#pragma unroll
                    for (int e = 0; e < 4; ++e) { const float a = acc[nb][mb][rg * 8 + e] * rs, b = acc[nb][mb][rg * 8 + 4 + e] * rs; o[e] = a * sigmoidf_(a) * b; }
                    pk[rg][0] = pk_bf16(o[0], o[1]); pk[rg][1] = pk_bf16(o[2], o[3]); }
                *(u32x4*)(act + (size_t)m * FFN + ((n0 + c.wn * 128 + nb * 32) >> 1) + 8 * h) = widen8(pk[0], pk[1]); } }
    }
};

struct EpiRes {
    float* out; bf16_t* hb; float* ssq; int n0, m0;
    __device__ __forceinline__ void pre(int, int, int) {}
    __device__ __forceinline__ void operator()(f32x16 (&acc)[4][2], const TileCtx& c) const {
        const int lr = c.lane & 31, h = c.lane >> 5;
#pragma unroll
        for (int mb = 0; mb < 2; ++mb) { const int m = m0 + c.wm * 64 + mb * 32 + lr; float s = 0.f;
            const size_t rowoff = (size_t)m * DM + n0 + c.wn * 128 + 4 * h;
#pragma unroll
            for (int np = 0; np < 2; ++np) {
                f32x4 o[8];
#pragma unroll
                for (int q = 0; q < 8; ++q) o[q] = *(const f32x4*)(out + rowoff + (np * 2 + (q >> 2)) * 32 + (q & 3) * 8);
                asm volatile("" ::: "memory");
#pragma unroll
                for (int q = 0; q < 8; ++q) { const int nb = np * 2 + (q >> 2), rq = q & 3; const size_t off = rowoff + nb * 32 + rq * 8;
#pragma unroll
                    for (int e = 0; e < 4; ++e) { o[q][e] += acc[nb][mb][4 * rq + e]; s += o[q][e] * o[q][e]; }
                    *(f32x4*)(out + off) = o[q]; }
                if (hb) {
#pragma unroll
                    for (int q = 0; q < 8; q += 2) { u32x2 A, B; A[0] = pk_bf16(o[q][0], o[q][1]); A[1] = pk_bf16(o[q][2], o[q][3]); B[0] = pk_bf16(o[q + 1][0], o[q + 1][1]); B[1] = pk_bf16(o[q + 1][2], o[q + 1][3]);
                        *(u32x4*)(hb + (size_t)m * DM + n0 + c.wn * 128 + (np * 2 + (q >> 2)) * 32 + (q & 3) * 8 + 8 * h) = widen8(A, B); } }
                asm volatile("" ::: "memory");
            }
            s += __shfl_xor(s, 32);
            if (h == 0) ssq[(size_t)((n0 >> 8) * 2 + c.wn) * L_SEQ + m] = s; }
    }
};

struct EpiKvq {
    const float* ssq; char* ws; char* ldsb; int n0, m0; float rsv[2];
    __device__ __forceinline__ void pre(int wm, int lane, int) {
#pragma unroll
        for (int mb = 0; mb < 2; ++mb) rsv[mb] = rstd_from<8>(ssq, m0 + wm * 64 + mb * 32 + (lane & 31)); }
    __device__ __forceinline__ void operator()(f32x16 (&acc)[4][2], const TileCtx& c) const {
        const int lr = c.lane & 31, h = c.lane >> 5;
        const bool isV = (n0 >= 1024 && n0 < 2048);
#pragma unroll
        for (int mb = 0; mb < 2; ++mb) { const int m = m0 + c.wm * 64 + mb * 32 + lr; const float rs = rsv[mb];
            if (isV) {
                const int ml = c.wm * 64 + mb * 32 + lr;
                const int mp = (ml & ~12) | ((ml & 4) << 1) | ((ml & 8) >> 1);
#pragma unroll
                for (int nb = 0; nb < 4; ++nb)
#pragma unroll
                    for (int r = 0; r < 16; ++r) { const int nl = c.wn * 128 + nb * 32 + (r & 3) + 8 * (r >> 2) + 4 * h;
                        *(bf16_t*)(ldsb + nl * 528 + mp * 2) = (bf16_t)(pk_bf16(acc[nb][mb][r] * rs, 0.f) & 0xffffu); }
            } else {
                size_t base; int nl;
                if (n0 < 512) { base = OFF_K1; nl = n0; } else if (n0 < 1024) { base = OFF_K2; nl = n0 - 512; } else if (n0 < 2560) { base = OFF_Q1; nl = n0 - 2048; } else { base = OFF_Q2; nl = n0 - 2560; }
                bf16_t* dst = (bf16_t*)(ws + base);
                float cs[4], sn[4];
#pragma unroll
                for (int e = 0; e < 4; ++e) { const int i = 4 * h + e;
                    const float invf = (i == 0) ? 1.0f : (i == 1) ? 0.19391188f : (i == 2) ? 0.037601817f : (i == 3) ? 0.0072914392f : (i == 4) ? 0.0014142136f : (i == 5) ? 0.00027423282f : (i == 6) ? 5.3176997e-05f : 1.0311653e-05f;
                    const float ang = (float)m * invf; double rev = (double)ang * 0.15915494309189535; rev -= rint(rev); const float fr = (float)rev;
                    cs[e] = __builtin_amdgcn_cosf(fr); sn[e] = __builtin_amdgcn_sinf(fr); }
#pragma unroll
                for (int nb = 0; nb < 4; ++nb) {
                    const int nn = nl + c.wn * 128 + nb * 32; const int head = nn >> 6, d0 = nn & 63;
                    float v[16];
#pragma unroll
                    for (int r = 0; r < 16; ++r) v[r] = acc[nb][mb][r] * rs;
                    if (d0 == 0) {
#pragma unroll
                        for (int e = 0; e < 4; ++e) { const float x1 = v[e], x2 = v[4 + e]; v[e] = x1 * cs[e] - x2 * sn[e]; v[4 + e] = x2 * cs[e] + x1 * sn[e]; }
                    }
#pragma unroll
                    for (int rq = 0; rq < 4; rq += 2) { u32x2 A, B; A[0] = pk_bf16(v[4 * rq], v[4 * rq + 1]); A[1] = pk_bf16(v[4 * rq + 2], v[4 * rq + 3]);
                        B[0] = pk_bf16(v[4 * rq + 4], v[4 * rq + 5]); B[1] = pk_bf16(v[4 * rq + 6], v[4 * rq + 7]);
                        *(u32x4*)(dst + ((size_t)head * L_SEQ + m) * 64 + d0 + rq * 8 + 8 * h) = widen8(A, B); }
                }
            } }
        if (isV) {
            __syncthreads();
            bf16_t* vt = (bf16_t*)(ws + OFF_VT) + (size_t)(n0 - 1024) * L_SEQ + m0;
            const int tid = c.wn * 256 + c.wm * 64 + c.lane;
#pragma unroll
            for (int i = 0; i < 16; ++i) { const int q = tid + 512 * i, row = q >> 5, c16 = q & 31;
                const u32x4 v = *(const u32x4*)(ldsb + row * 528 + c16 * 16);
                *(u32x4*)(vt + (size_t)row * L_SEQ + c16 * 8) = v; }
            __syncthreads();
        }
    }
};

__device__ __forceinline__ void s5_tables(const int wave_s, const Params& p, int g, char* lds) {
    f32x2* apow = (f32x2*)lds;
    f32x2* bb = apow + 65 * 64;
    f32x2* cc = bb + 1024;
    f32x2* zf = cc + 1024;
    int tid = get_tid(wave_s); asm volatile("" : "+v"(tid));
    const float dt = expf(p.log_dt[g]);
    for (int e = tid; e < 65 * 64; e += NTHREADS) {
        const int lag = e >> 6, pp = e & 63;
        const float lr = p.lam_re[g * 64 + pp], li = p.lam_im[g * 64 + pp];
        const float mag = expf(lr * dt * (float)lag);
        double rev = (double)li * (double)dt * (double)lag * 0.15915494309189535; rev -= rint(rev);
        const float fr = (float)rev;
        f32x2 v; v[0] = mag * __builtin_amdgcn_cosf(fr); v[1] = mag * __builtin_amdgcn_sinf(fr); apow[e] = v;
    }
    if (tid < 64) {
        const float lr = p.lam_re[g * 64 + tid], li = p.lam_im[g * 64 + tid];
        const float em1 = expm1f(lr * dt);
        double rev = (double)li * (double)dt * 0.15915494309189535; const double rh = rev * 0.5; rev -= rint(rev);
        const double rh2 = rh - rint(rh);
        const float cth = __builtin_amdgcn_cosf((float)rev), sth = __builtin_amdgcn_sinf((float)rev), shalf = __builtin_amdgcn_sinf((float)rh2);
        const float nr = em1 * cth - 2.0f * shalf * shalf, ni = (1.0f + em1) * sth;
        const float den = lr * lr + li * li;
        f32x2 f; f[0] = (nr * lr + ni * li) / den; f[1] = (ni * lr - nr * li) / den; zf[tid] = f;
    }
    __syncthreads();
    for (int e = tid; e < 1024; e += NTHREADS) {
        const int pp = e >> 4;
        const float br = p.b_re[(size_t)g * 1024 + e], bi = p.b_im[(size_t)g * 1024 + e];
        const f32x2 f = zf[pp]; f32x2 v; v[0] = f[0] * br - f[1] * bi; v[1] = f[0] * bi + f[1] * br; bb[e] = v;
        f32x2 cv; cv[0] = p.c_re[(size_t)g * 1024 + e]; cv[1] = p.c_im[(size_t)g * 1024 + e]; cc[e] = cv;
    }
    __syncthreads();
    bf16_t* kt = (bf16_t*)(p.ws + OFF_KT) + (size_t)g * 127 * 256;
    bf16_t* w1 = (bf16_t*)(p.ws + OFF_W1) + (size_t)g * 128 * 1024;
    bf16_t* w3 = (bf16_t*)(p.ws + OFF_W3) + (size_t)g * 1024 * 128;
    {
        const int cp = tid & 255, c = cp >> 4, c2 = cp & 15, half = tid >> 8;
        float acc[32];
#pragma unroll
        for (int l = 0; l < 32; ++l) acc[l] = 0.f;
        for (int pp = 0; pp < 64; ++pp) {
            const f32x2 cv = cc[c * 64 + pp], bv = bb[pp * 16 + c2];
            const float cbr = cv[0] * bv[0] - cv[1] * bv[1], cbi = cv[0] * bv[1] + cv[1] * bv[0];
#pragma unroll
            for (int l = 0; l < 32; ++l) { const f32x2 a = apow[(half * 32 + l) * 64 + pp]; acc[l] += cbr * a[0] - cbi * a[1]; }
        }
#pragma unroll
        for (int l = 0; l < 32; ++l) kt[(size_t)(63 + half * 32 + l) * 256 + cp] = (bf16_t)(pk_bf16(acc[l], 0.f) & 0xffffu);
        for (int e = tid; e < 63 * 256 / 8; e += NTHREADS) { u32x4 zz = {0u, 0u, 0u, 0u}; *(u32x4*)(kt + e * 8) = zz; }
    }
    for (int q = tid; q < 128 * 128; q += NTHREADS) {
        const int pq = q >> 7, kc = q & 127, tau = kc >> 1, c0 = (kc & 1) * 8, pp = pq & 63, im = pq >> 6;
        const f32x2 a = apow[(63 - tau) * 64 + pp]; float v[8];
#pragma unroll
        for (int e = 0; e < 8; ++e) { const f32x2 b = bb[pp * 16 + c0 + e]; v[e] = im ? (a[0] * b[1] + a[1] * b[0]) : (a[0] * b[0] - a[1] * b[1]); }
        u32x4 o; o[0] = pk_bf16(v[0], v[1]); o[1] = pk_bf16(v[2], v[3]); o[2] = pk_bf16(v[4], v[5]); o[3] = pk_bf16(v[6], v[7]);
        *(u32x4*)(w1 + (size_t)pq * 1024 + kc * 8) = o;
    }
    for (int q = tid; q < 1024 * 16; q += NTHREADS) {
        const int n = q >> 4, p0 = (q & 15) * 8, t = n >> 4, c = n & 15, im = p0 >> 6; float v[8];
#pragma unroll
        for (int e = 0; e < 8; ++e) { const int pp = (p0 + e) & 63; const f32x2 a = apow[(t + 1) * 64 + pp]; const f32x2 cv = cc[c * 64 + pp];
            v[e] = im ? -(cv[0] * a[1] + cv[1] * a[0]) : (cv[0] * a[0] - cv[1] * a[1]); }
        u32x4 o; o[0] = pk_bf16(v[0], v[1]); o[1] = pk_bf16(v[2], v[3]); o[2] = pk_bf16(v[4], v[5]); o[3] = pk_bf16(v[6], v[7]);
        *(u32x4*)(w3 + (size_t)n * 128 + p0) = o;
    }
    if (tid < 64) ((f32x2*)(p.ws + OFF_A64))[g * 64 + tid] = apow[64 * 64 + tid];
    __syncthreads();
}

__device__ __forceinline__ void wtile(const int wave_s, const Params& p, int t, char* lds) {
    int j = 0;
    for (int i = 1; i < p.njobs; ++i) if (t >= p.jobs[i].tile0) j = i;
    const WJob& J = p.jobs[j];
    const int lt = t - J.tile0, kt = lt / J.ntn, nt = lt - kt * J.ntn;
    const int k0 = kt * 64, nl0 = nt * 256;
    float* T = (float*)lds;
    int tid = get_tid(wave_s); asm volatile("" : "+v"(tid));
    const int c4 = (tid & 63) * 4, kb = tid >> 6;
    f32x4 v[8];
#pragma unroll
    for (int i = 0; i < 8; ++i) v[i] = *(const f32x4*)(J.src + (size_t)(k0 + kb + 8 * i) * J.ldsrc + J.col0 + nl0 + c4);
#pragma unroll
    for (int i = 0; i < 8; ++i) { const int kk = kb + 8 * i; float sc = J.scale; if (J.gain) sc *= J.gain[k0 + kk];
        T[kk * 257 + c4] = v[i][0] * sc; T[kk * 257 + c4 + 1] = v[i][1] * sc; T[kk * 257 + c4 + 2] = v[i][2] * sc; T[kk * 257 + c4 + 3] = v[i][3] * sc; }
    __syncthreads();
    { const int nn = tid >> 1, kh = (tid & 1) * 32;
        const int n = nl0 + nn; int row = (J.mode == 0) ? n : ((n >> 3) * 16 + (n & 7) + (J.mode == 2 ? 8 : 0)); row += J.rowoff;
        bf16_t* d = J.dst + (size_t)row * J.K + k0 + kh;
#pragma unroll
        for (int q = 0; q < 4; ++q) { float w[8];
#pragma unroll
            for (int e = 0; e < 8; ++e) w[e] = T[(kh + q * 8 + e) * 257 + nn];
            u32x4 o; o[0] = pk_bf16(w[0], w[1]); o[1] = pk_bf16(w[2], w[3]); o[2] = pk_bf16(w[4], w[5]); o[3] = pk_bf16(w[6], w[7]);
            *(u32x4*)(d + q * 8) = o; } }
    __syncthreads();
}

__device__ __forceinline__ void rms0_item(const int wave_s, const Params& p, int item) {
    const int lane = get_tid(wave_s) & 63, wid = wave_s;
    bf16_t* hn0 = (bf16_t*)(p.ws + OFF_HN0);
    f32x4 g[4];
#pragma unroll
    for (int i = 0; i < 4; ++i) g[i] = *(const f32x4*)(p.norm_mix_g + lane * 4 + 256 * i);
    for (int rb = 0; rb < 2; ++rb) {
        f32x4 v[4][4];
#pragma unroll
        for (int r = 0; r < 4; ++r)
#pragma unroll
            for (int i = 0; i < 4; ++i) v[r][i] = *(const f32x4*)(p.x + (size_t)(item * 64 + wid * 8 + rb * 4 + r) * DM + lane * 4 + 256 * i);
#pragma unroll
        for (int r = 0; r < 4; ++r) {
            const int row = item * 64 + wid * 8 + rb * 4 + r;
            float s = 0.f;
#pragma unroll
            for (int i = 0; i < 4; ++i) s += v[r][i][0] * v[r][i][0] + v[r][i][1] * v[r][i][1] + v[r][i][2] * v[r][i][2] + v[r][i][3] * v[r][i][3];
#pragma unroll
            for (int o = 32; o >= 1; o >>= 1) s += __shfl_xor(s, o);
            const float rs = rsqrtf(s * (1.0f / DM) + EPSV);
#pragma unroll
            for (int i = 0; i < 4; ++i) {
                u32x2 o; o[0] = pk_bf16(v[r][i][0] * rs * g[i][0], v[r][i][1] * rs * g[i][1]); o[1] = pk_bf16(v[r][i][2] * rs * g[i][2], v[r][i][3] * rs * g[i][3]);
                const int col = lane * 4 + 256 * i;
                *(u32x2*)(hn0 + (size_t)(col >> 4) * 262144 + (size_t)(row >> 6) * 1024 + (row & 63) * 16 + (col & 15)) = o; }
        }
    }
}

__device__ __forceinline__ void attn_item(const int wave_s, const Params& p, int head, int qb, float lam, char* lds) {
    int tid = get_tid(wave_s); asm volatile("" : "+v"(tid));
    const int lane = tid & 63, wid = tid >> 6;
    const int mp = wid >> 2, g = wid & 3;
    const int lr = lane & 31, h = lane >> 5, sw = (lane >> 1) & 7;
    const bf16_t* K1 = (const bf16_t*)(p.ws + OFF_K1) + (size_t)head * L_SEQ * 64;
    const bf16_t* K2 = (const bf16_t*)(p.ws + OFF_K2) + (size_t)head * L_SEQ * 64;
    const bf16_t* VT = (const bf16_t*)(p.ws + OFF_VT) + (size_t)head * 128 * L_SEQ;
    const bf16_t* Q = (const bf16_t*)(p.ws + (mp ? OFF_Q2 : OFF_Q1)) + (size_t)head * L_SEQ * 64;
    const int q0 = qb * 128 + g * 32;
    bf16x8 qf[4];
#pragma unroll
    for (int s = 0; s < 4; ++s) qf[s] = *(const bf16x8*)(Q + (size_t)(q0 + lr) * 64 + 16 * s + 8 * h);
    const int nkt = 2 * qb + 2;
    const int my_last = 2 * qb + (g >> 1);
    f32x16 O[4];
#pragma unroll
    for (int e = 0; e < 4; ++e)
#pragma unroll
        for (int r = 0; r < 16; ++r) O[e][r] = 0.f;
    float m_run = 0.f, l_run = 0.f;
    f32x16 negm;
#pragma unroll
    for (int r = 0; r < 16; ++r) negm[r] = 0.f;
    const int lrow = lane >> 3;
    const int ck = (lane & 7) ^ (((wave_s & 1) * 4 + (lane >> 4)) & 7);
    const int cv0 = (lane & 7) ^ (lane >> 4), cv1 = (lane & 7) ^ (4 + (lane >> 4));
    const bf16_t* k1p = K1 + (size_t)(wave_s * 8 + lrow) * 64 + ck * 8;
    const bf16_t* k2p = K2 + (size_t)(wave_s * 8 + lrow) * 64 + ck * 8;
    const bf16_t* v0p = VT + (size_t)(wave_s * 16 + lrow) * L_SEQ + cv0 * 8;
    const bf16_t* v1p = VT + (size_t)(wave_s * 16 + 8 + lrow) * L_SEQ + cv1 * 8;
    auto issue = [&](int kt) {
        char* st = lds + (kt & 3) * 32768;
        __builtin_amdgcn_global_load_lds((const unsigned*)(k1p + (size_t)kt * 4096), (__attribute__((address_space(3))) unsigned*)(st + wave_s * 1024), 16, 0, 0);
        __builtin_amdgcn_global_load_lds((const unsigned*)(k2p + (size_t)kt * 4096), (__attribute__((address_space(3))) unsigned*)(st + 8192 + wave_s * 1024), 16, 0, 0);
        __builtin_amdgcn_global_load_lds((const unsigned*)(v0p + kt * 64), (__attribute__((address_space(3))) unsigned*)(st + 16384 + wave_s * 2048), 16, 0, 0);
        __builtin_amdgcn_global_load_lds((const unsigned*)(v1p + kt * 64), (__attribute__((address_space(3))) unsigned*)(st + 16384 + wave_s * 2048 + 1024), 16, 0, 0);
    };
    issue(0); issue(1);
    if (nkt > 2) issue(2);
    if (nkt > 2) asm volatile("s_waitcnt vmcnt(8)" ::: "memory");
    else asm volatile("s_waitcnt vmcnt(4)" ::: "memory");
    __builtin_amdgcn_s_barrier(); asm volatile("" ::: "memory");
    const int koff_ = mp * 8192 + lr * 128, voff_ = 16384 + lr * 128;
    int chk[4], chv[4];
#pragma unroll
    for (int s = 0; s < 4; ++s) { chk[s] = ((2 * s + h) ^ sw) << 4; chv[s] = chk[s]; }
    bf16x8 kf[8], vf[8];
#pragma unroll
    for (int i = 0; i < 8; ++i) kf[i] = *(const bf16x8*)(lds + koff_ + (i >> 2) * 4096 + chk[i & 3]);
    for (int kt = 0; kt < nkt; ++kt) {
        const bool active = kt <= my_last;
        const char* stg = lds + (kt & 3) * 32768;
        f32x16 S[2];
        bf16x8 pf[2][2];
        if (active) {
#pragma unroll
            for (int kb = 0; kb < 2; ++kb) {
                S[kb] = __builtin_amdgcn_mfma_f32_32x32x16_bf16(kf[kb * 4], qf[0], negm, 0, 0, 0);
#pragma unroll
                for (int s = 1; s < 4; ++s) S[kb] = __builtin_amdgcn_mfma_f32_32x32x16_bf16(kf[kb * 4 + s], qf[s], S[kb], 0, 0, 0);
            }
#pragma unroll
            for (int i = 0; i < 8; ++i) vf[i] = *(const bf16x8*)(stg + voff_ + (i & 3) * 4096 + chv[i >> 2]);
            __builtin_amdgcn_sched_barrier(0);
            float mt = S[0][0];
#pragma unroll
            for (int r = 1; r < 16; ++r) mt = fmaxf(mt, S[0][r]);
#pragma unroll
            for (int r = 0; r < 16; ++r) mt = fmaxf(mt, S[1][r]);
            { const auto sw2 = __builtin_amdgcn_permlane32_swap(__float_as_uint(mt), __float_as_uint(mt), false, false);
              mt = fmaxf(__uint_as_float(sw2[0]), __uint_as_float(sw2[1])); }
            const bool need = (mt > 8.0f) || (kt == 0);
            if (__any(need)) {
                const float d = need ? mt : 0.f;
                const float alpha = fast_exp2(-d);
                m_run += d; l_run *= alpha;
#pragma unroll
                for (int r = 0; r < 16; ++r) negm[r] -= d;
#pragma unroll
                for (int kb = 0; kb < 2; ++kb)
#pragma unroll
                    for (int r = 0; r < 16; ++r) S[kb][r] -= d;
#pragma unroll
                for (int e = 0; e < 4; ++e)
#pragma unroll
                    for (int r = 0; r < 16; ++r) O[e][r] *= alpha;
            }
            f32x2 ls2 = {0.f, 0.f};
#pragma unroll
            for (int kb = 0; kb < 2; ++kb)
#pragma unroll
                for (int s = 0; s < 2; ++s) { float e_[8];
#pragma unroll
                    for (int j = 0; j < 8; ++j) e_[j] = fast_exp2(S[kb][8 * s + j]);
#pragma unroll
                    for (int j = 0; j < 8; j += 2) { f32x2 t2 = {e_[j], e_[j + 1]}; ls2 += t2; }
                    u32x4 pk; pk[0] = pk_bf16(e_[0], e_[1]); pk[1] = pk_bf16(e_[2], e_[3]); pk[2] = pk_bf16(e_[4], e_[5]); pk[3] = pk_bf16(e_[6], e_[7]);
                    pf[kb][s] = __builtin_bit_cast(bf16x8, pk); }
            const float ls = ls2[0] + ls2[1];
            l_run += ls;
        }
        const int rem = nkt - 1 - kt;
        if (rem >= 2) asm volatile("s_waitcnt vmcnt(4)" ::: "memory");
        else asm volatile("s_waitcnt vmcnt(0)" ::: "memory");
        __builtin_amdgcn_s_barrier(); asm volatile("" ::: "memory");
        if (kt + 3 < nkt) issue(kt + 3);
        if (kt + 1 <= my_last) {
            const char* sn = lds + ((kt + 1) & 3) * 32768;
#pragma unroll
            for (int i = 0; i < 8; ++i) kf[i] = *(const bf16x8*)(sn + koff_ + (i >> 2) * 4096 + chk[i & 3]);
        }
        __builtin_amdgcn_sched_barrier(0);
        if (active) {
#pragma unroll
            for (int i = 0; i < 8; ++i) O[i & 3] = __builtin_amdgcn_mfma_f32_32x32x16_bf16(vf[i], pf[0][i >> 2], O[i & 3], 0, 0, 0);
#pragma unroll
            for (int i = 0; i < 8; ++i) vf[i] = *(const bf16x8*)(stg + voff_ + (i & 3) * 4096 + (((4 + 2 * (i >> 2) + h) ^ sw) << 4));
#pragma unroll
            for (int i = 0; i < 8; ++i) O[i & 3] = __builtin_amdgcn_mfma_f32_32x32x16_bf16(vf[i], pf[1][i >> 2], O[i & 3], 0, 0, 0);
        }
    }
    __syncthreads();
    const float lt = l_run + __shfl_xor(l_run, 32);
    const float inv = fast_rcp(lt) * (mp ? lam : 1.0f);
    float* ex = (float*)lds;
    if (mp == 1) {
#pragma unroll
        for (int e = 0; e < 4; ++e)
#pragma unroll
            for (int r = 0; r < 16; ++r) ex[((g * 4 + e) * 16 + r) * 64 + lane] = O[e][r] * inv;
    }
    __syncthreads();
    if (mp == 0) {
        float ss = 0.f;
#pragma unroll
        for (int e = 0; e < 4; ++e)
#pragma unroll
            for (int r = 0; r < 16; ++r) { const float o = O[e][r] * inv - ex[((g * 4 + e) * 16 + r) * 64 + lane]; O[e][r] = o; ss += o * o; }
        ss += __shfl_xor(ss, 32);
        const float rs = rsqrtf(ss * (1.0f / 128.0f) + EPSV) * (1.0f - LAM_INIT);
        bf16_t* on = (bf16_t*)(p.ws + OFF_ON) + (size_t)(q0 + lr) * DM + head * 128;
#pragma unroll
        for (int e = 0; e < 4; ++e)
#pragma unroll
            for (int rq = 0; rq < 4; ++rq) { const int ee = e * 32 + rq * 8 + 4 * h; const f32x4 gg = *(const f32x4*)(p.subln_g + ee);
                u32x2 b; b[0] = pk_bf16(O[e][4 * rq] * rs * gg[0], O[e][4 * rq + 1] * rs * gg[1]); b[1] = pk_bf16(O[e][4 * rq + 2] * rs * gg[2], O[e][4 * rq + 3] * rs * gg[3]);
                *(u32x2*)(on + ee) = b; }
    }
    __syncthreads();
}


#define XB_XCNT(j)  (64 + 64 * (j))
#define XB_XSUB(j)  (1088 + 64 * (j))
#define XB_XGEN(j)  (2112 + 64 * (j))
#define XB_TOP      3136
#define XB_TOPGEN   3200
#define XB_WORDS    3264
__device__ __forceinline__ unsigned xb_ld(unsigned* p) { return __hip_atomic_load(p, __ATOMIC_RELAXED, __HIP_MEMORY_SCOPE_AGENT); }
__device__ __forceinline__ unsigned xb_add(unsigned* p, unsigned v) { return __hip_atomic_fetch_add(p, v, __ATOMIC_RELAXED, __HIP_MEMORY_SCOPE_AGENT); }
__device__ __forceinline__ unsigned xb_xcc_id() { return (unsigned)__builtin_amdgcn_s_getreg((3 << 11) | 20) & 0xFu; }
__device__ __forceinline__ void gbar(const int wave_s, unsigned* bar, volatile unsigned* st) {
    asm volatile("s_waitcnt vmcnt(0)" ::: "memory");
    __syncthreads();
    if (get_tid(wave_s) == 0) {
        __builtin_amdgcn_s_waitcnt(0);
        const unsigned x = st[2], nloc = st[0], nx = st[1];
        const unsigned old = xb_add(&bar[XB_XSUB(x)], 1u);
        const unsigned gen = old / nloc;
        if (old + 1u == (gen + 1u) * nloc) {
            __builtin_amdgcn_fence(__ATOMIC_RELEASE, "agent");
            asm volatile("s_waitcnt vmcnt(0)" ::: "memory");
            const unsigned og = xb_add(&bar[XB_TOP], 1u);
            const unsigned tg = og / nx;
            if (og + 1u == (tg + 1u) * nx) xb_add(&bar[XB_TOPGEN], 1u);
            else while (xb_ld(&bar[XB_TOPGEN]) == tg) __builtin_amdgcn_s_sleep(1);
            __builtin_amdgcn_fence(__ATOMIC_ACQUIRE, "agent");
            xb_add(&bar[XB_XGEN(x)], 1u);
            asm volatile("s_waitcnt vmcnt(0)" ::: "memory");
        } else {
            while (xb_ld(&bar[XB_XGEN(x)]) == gen) __builtin_amdgcn_s_sleep(1);
            __builtin_amdgcn_fence(__ATOMIC_ACQUIRE, "agent");
            asm volatile("s_waitcnt vmcnt(0)" ::: "memory");
        }
    }
    __syncthreads();
}

__device__ __forceinline__ bool tile_map(int r, int bid, int nb, int NT, int& nt, int& mt) {
    if (nb == 256) {
        const int x = bid & 7, li = bid >> 3, q = li + 32 * r;
        if (q >= 8 * NT) return false;
        const int mi = q & 3, rest = q >> 2, mg = rest / NT;
        nt = rest - mg * NT; mt = x * 8 + mg * 4 + mi; return true;
    }
    const int t = bid + r * nb; if (t >= NT * 64) return false;
    nt = t % NT; mt = t / NT; return true;
}

__global__ void __launch_bounds__(NTHREADS) mega(const Params p) {
    __shared__ __attribute__((aligned(16))) char lds[LDS_BYTES];
    cg::grid_group grid = cg::this_grid();
    const int wave_s = __builtin_amdgcn_readfirstlane((int)(threadIdx.x >> 6));
    const int nb = gridDim.x, bid = blockIdx.x;
    char* ws = p.ws;
    bf16_t* hn0 = (bf16_t*)(ws + OFF_HN0);
    bf16_t* hb = (bf16_t*)(ws + OFF_HB);
    float* ssq0 = (float*)(ws + OFF_SSQ);
    float* ssq1 = ssq0 + 16 * L_SEQ; float* ssq2 = ssq1 + 16 * L_SEQ; float* ssq3 = ssq2 + 16 * L_SEQ;
    const Seg nul = {nullptr, 0, 0, nullptr, 0, 0};
    unsigned* bar = (unsigned*)(ws + OFF_BAR);
    volatile unsigned* xst = (volatile unsigned*)(lds + LDS_BYTES - 16);
    if (get_tid(wave_s) == 0) xb_add(&bar[XB_XCNT(xb_xcc_id())], 1u);
    grid.sync();
    if (get_tid(wave_s) == 0) {
        const unsigned x = xb_xcc_id(); unsigned cnt = 0u, mine = 1u;
        for (unsigned j = 0; j < 16; ++j) { const unsigned c = xb_ld(&bar[XB_XCNT(j)]); cnt += (c > 0u) ? 1u : 0u; if (j == x) mine = c; }
        xst[0] = mine ? mine : 1u; xst[1] = cnt ? cnt : 1u; xst[2] = x;
    }
    __syncthreads();

    { const int nwork = p.ntiles_w + 256;
      for (int rep = 0; rep < REP_PREP; ++rep) {
          if (nb >= 128) {
              if (bid < 64) s5_tables(wave_s, p, bid, lds);
              else for (int it = bid - 64; it < nwork; it += nb - 64) { if (it < p.ntiles_w) wtile(wave_s, p, it, lds); else rms0_item(wave_s, p, it - p.ntiles_w); }
          } else {
              for (int it = bid; it < 64 + nwork; it += nb) { if (it < 64) s5_tables(wave_s, p, it, lds); else if (it < 64 + p.ntiles_w) wtile(wave_s, p, it - 64, lds); else rms0_item(wave_s, p, it - 64 - p.ntiles_w); }
          }
      } }
    gbar(wave_s, bar, xst);
    for (int rep = 0; rep < REP_SLOC; ++rep)
    for (int g = bid; g < 64; g += nb) {
        Seg s = {(const bf16_t*)(ws + OFF_W1) + (size_t)g * 128 * 1024, 1024, 16, hn0 + (size_t)g * 262144, 1024, 16};
        EpiSloc e = {(float*)lds};
        gemm_tile(wave_s, lds, s, 16, nul, 0, e);
        __syncthreads();
        {
            const int lane_ = get_tid(wave_s) & 63, w_ = wave_s;
            const f32x2 a = ((const f32x2*)(ws + OFF_A64))[g * 64 + lane_];
            const float* sl = (const float*)lds + (w_ * 32) * 132;
            float sr = 0.f, si = 0.f;
#pragma unroll
            for (int j = 0; j < 32; ++j) { const float xr = sl[j * 132 + lane_], xi = sl[j * 132 + 64 + lane_]; const float nr = a[0] * sr - a[1] * si + xr, ni = a[0] * si + a[1] * sr + xi; sr = nr; si = ni; }
            f32x2* carry = (f32x2*)(lds + 135168);
            { f32x2 c; c[0] = sr; c[1] = si; carry[w_ * 64 + lane_] = c; }
            float pr = a[0], pi = a[1];
#pragma unroll
            for (int q = 0; q < 5; ++q) { const float nr = pr * pr - pi * pi, ni = 2.f * pr * pi; pr = nr; pi = ni; }
            __syncthreads();
            sr = 0.f; si = 0.f;
            for (int v = 0; v < w_; ++v) { const f32x2 c = carry[v * 64 + lane_]; const float nr = pr * sr - pi * si + c[0], ni = pr * si + pi * sr + c[1]; sr = nr; si = ni; }
            bf16_t* sp = (bf16_t*)(ws + OFF_SPREV) + (size_t)g * 256 * 128 + (size_t)(w_ * 32) * 128;
#pragma unroll
            for (int j = 0; j < 32; ++j) {
                sp[j * 128 + lane_] = (bf16_t)(pk_bf16(sr, 0.f) & 0xffffu); sp[j * 128 + 64 + lane_] = (bf16_t)(pk_bf16(si, 0.f) & 0xffffu);
                const float xr = sl[j * 132 + lane_], xi = sl[j * 132 + 64 + lane_];
                const float nr = a[0] * sr - a[1] * si + xr, ni = a[0] * si + a[1] * sr + xi; sr = nr; si = ni;
            }
        }
        __syncthreads();
    }
    gbar(wave_s, bar, xst);
    for (int rep = 0; rep < REP_S5; ++rep)
    for (int t0 = bid; t0 < 256; t0 += nb) {
        const int t = (nb == 256) ? ((t0 & 7) * 32 + (t0 >> 3)) : t0;
        const int g = t >> 2, i = 3 - (t & 3);
        const bf16_t* sprev = (const bf16_t*)(ws + OFF_SPREV) + (size_t)g * 256 * 128;
        Seg s0 = {(const bf16_t*)(ws + OFF_KT) + (size_t)g * 127 * 256 + 63 * 256 + (size_t)(i * 256) * 16, 16, -256, hn0 + (size_t)g * 262144, 1024, 16};
        Seg s1 = {(const bf16_t*)(ws + OFF_W3) + (size_t)g * 1024 * 128 + (size_t)(i * 256) * 128, 128, 16, sprev, 128, 16};
        EpiS5 e = {hn0, p.ssm_d, (bf16_t*)(ws + OFF_Z), g, i * 256};
        gemm_tile(wave_s, lds, s0, 4 * (i + 1), s1, 2, e);
    }
    gbar(wave_s, bar, xst);
    for (int rep = 0; rep < REP_GLU; ++rep)
    for (int r = 0, nt, mt; tile_map(r, bid, nb, 8, nt, mt); ++r) {
        Seg s = {(const bf16_t*)(ws + OFF_WGLU) + (size_t)nt * 256 * DM, DM, 16, (const bf16_t*)(ws + OFF_Z) + (size_t)mt * 256 * 16, 16, 262144};
        EpiGlu e = {p.x, p.out, hb, ssq0, nt * 256, mt * 256};
        gemm_tile(wave_s, lds, s, 16, nul, 0, e);
    }
    gbar(wave_s, bar, xst);
#pragma unroll
    for (int layer = 0; layer < 2; ++layer) {
        if (layer == 1) {
            for (int rep = 0; rep < REP_KVQ; ++rep) {
                int nt = 0, mt = 0; bool have = tile_map(0, bid, nb, 12, nt, mt), pro = false;
                for (int r = 0; have; ++r) {
                    int nnt = 0, nmt = 0; const bool hn = tile_map(r + 1, bid, nb, 12, nnt, nmt);
                    Seg s = {(const bf16_t*)(ws + OFF_WKVQ) + (size_t)nt * 256 * DM, DM, 16, hb + (size_t)mt * 256 * DM, DM, 16};
                    Seg sn = {(const bf16_t*)(ws + OFF_WKVQ) + (size_t)nnt * 256 * DM, DM, 16, hb + (size_t)nmt * 256 * DM, DM, 16};
                    const bool curV = (nt >= 4 && nt < 8);
                    EpiKvq e = {ssq1, ws, lds, nt * 256, mt * 256, {0.f, 0.f}};
                    gemm_tile(wave_s, lds, s, 16, nul, 0, e, pro, hn && !curV, sn);
                    pro = hn && !curV; nt = nnt; mt = nmt; have = hn;
                }
            }
            gbar(wave_s, bar, xst);
            {
                float a1 = 0.f, a2 = 0.f;
                for (int i = 0; i < 64; ++i) { a1 += p.lq1[i] * p.lk1[i]; a2 += p.lq2[i] * p.lk2[i]; }
                const float lam = expf(a1) - expf(a2) + LAM_INIT;
                for (int rep = 0; rep < REP_ATTN; ++rep)
                for (int it = bid; it < 1024; it += nb) {
                    const int head = it & 7, r = it >> 3, rnd = r >> 5, j = r & 31;
                    const int qb = (rnd == 0) ? 127 - j : (rnd == 1) ? 64 + j : (rnd == 2) ? 63 - j : j;
                    attn_item(wave_s, p, head, qb, lam, lds);
                }
            }
            gbar(wave_s, bar, xst);
            for (int r = 0, nt, mt; tile_map(r, bid, nb, 4, nt, mt); ++r) {
                Seg s = {(const bf16_t*)(ws + OFF_WO) + (size_t)nt * 256 * DM, DM, 16, (const bf16_t*)(ws + OFF_ON) + (size_t)mt * 256 * DM, DM, 16};
                EpiRes e = {p.out, hb, ssq2, nt * 256, mt * 256};
                gemm_tile(wave_s, lds, s, 16, nul, 0, e);
            }
            gbar(wave_s, bar, xst);
        }
        {
            const bf16_t* wup = (const bf16_t*)(ws + (layer ? OFF_WUP1 : OFF_WUP0));
            for (int rep = 0; rep < REP_UP; ++rep) {
                int nt = 0, mt = 0; bool have = tile_map(0, bid, nb, 22, nt, mt), pro = false;
                for (int r = 0; have; ++r) {
                    int nnt = 0, nmt = 0; const bool hn = tile_map(r + 1, bid, nb, 22, nnt, nmt);
                    Seg s = {wup + (size_t)nt * 256 * DM, DM, 16, hb + (size_t)mt * 256 * DM, DM, 16};
                    Seg sn = {wup + (size_t)nnt * 256 * DM, DM, 16, hb + (size_t)nmt * 256 * DM, DM, 16};
                    if (layer == 0) { EpiUp<16> e = {ssq0, (bf16_t*)(ws + OFF_ACT), nt * 256, mt * 256, {0.f, 0.f}}; gemm_tile(wave_s, lds, s, 16, nul, 0, e, pro, hn, sn); }
                    else { EpiUp<8> e = {ssq2, (bf16_t*)(ws + OFF_ACT), nt * 256, mt * 256, {0.f, 0.f}}; gemm_tile(wave_s, lds, s, 16, nul, 0, e, pro, hn, sn); }
                    pro = hn; nt = nnt; mt = nmt; have = hn;
                }
            }
        }
        gbar(wave_s, bar, xst);
        {
            const bf16_t* wdn = (const bf16_t*)(ws + (layer ? OFF_WDN1 : OFF_WDN0));
            for (int r = 0, nt, mt; tile_map(r, bid, nb, 4, nt, mt); ++r) {
                Seg s = {wdn + (size_t)nt * 256 * FFN, FFN, 16, (const bf16_t*)(ws + OFF_ACT) + (size_t)mt * 256 * FFN, FFN, 16};
                EpiRes e = {p.out, layer ? (bf16_t*)nullptr : hb, layer ? ssq3 : ssq1, nt * 256, mt * 256};
                gemm_tile(wave_s, lds, s, FFN / 64, nul, 0, e);
            }
        }
        gbar(wave_s, bar, xst);
    }
    {
        const int lane = get_tid(wave_s) & 63, wid = wave_s;
        for (int row = bid * 8 + wid; row < L_SEQ; row += nb * 8) {
            float s = 0.f;
            for (int i = 0; i < 8; ++i) s += ssq3[(size_t)i * L_SEQ + row];
            const float rs = rsqrtf(s * (1.0f / DM) + EPSV);
#pragma unroll
            for (int i = 0; i < 4; ++i) { const size_t off = (size_t)row * DM + lane * 4 + 256 * i;
                f32x4 v = *(const f32x4*)(p.out + off); const f32x4 g = *(const f32x4*)(p.final_g + lane * 4 + 256 * i);
                v[0] *= rs * g[0]; v[1] *= rs * g[1]; v[2] *= rs * g[2]; v[3] *= rs * g[3]; *(f32x4*)(p.out + off) = v; }
        }
    }
}

static void add_job(Params& P, int& nt, const float* src, bf16_t* dst, const float* gain, int K, int N, int ld, int col0, int mode, int rowoff, float scale) {
    WJob& J = P.jobs[P.njobs++];
    J.src = src; J.dst = dst; J.gain = gain; J.K = K; J.N = N; J.ldsrc = ld; J.col0 = col0; J.mode = mode; J.rowoff = rowoff; J.scale = scale; J.tile0 = nt; J.ntn = N / 256; J.pad = 0;
    nt += (K / 64) * (N / 256);
}

extern "C" void kernel_launch(void* const* d_in, const int* in_sizes, int n_in, void* d_out, int out_size, void* d_ws, size_t ws_size, hipStream_t stream) {
    Params P; memset(&P, 0, sizeof(P));
    P.x = (const float*)d_in[0]; P.norm_mix_g = (const float*)d_in[1]; P.norm_ffn_g = (const float*)d_in[2];
    P.ffn_w1 = (const float*)d_in[3]; P.ffn_w3 = (const float*)d_in[4]; P.ffn_w2 = (const float*)d_in[5];
    P.lam_re = (const float*)d_in[6]; P.lam_im = (const float*)d_in[7]; P.log_dt = (const float*)d_in[8];
    P.b_re = (const float*)d_in[9]; P.b_im = (const float*)d_in[10]; P.c_re = (const float*)d_in[11]; P.c_im = (const float*)d_in[12];
    P.ssm_d = (const float*)d_in[13]; P.w_glu = (const float*)d_in[14]; P.kv_norm_g = (const float*)d_in[15]; P.w_kv = (const float*)d_in[16];
    P.w_q = (const float*)d_in[17]; P.lq1 = (const float*)d_in[18]; P.lk1 = (const float*)d_in[19]; P.lq2 = (const float*)d_in[20]; P.lk2 = (const float*)d_in[21];
    P.subln_g = (const float*)d_in[22]; P.w_o = (const float*)d_in[23]; P.final_g = (const float*)d_in[24];
    P.out = (float*)d_out; P.ws = (char*)d_ws;
    char* ws = (char*)d_ws; int nt = 0;
    const size_t FW = (size_t)DM * FFN;
    add_job(P, nt, P.w_glu, (bf16_t*)(ws + OFF_WGLU), nullptr, DM, 1024, 2048, 0, 1, 0, 1.0f);
    add_job(P, nt, P.w_glu, (bf16_t*)(ws + OFF_WGLU), nullptr, DM, 1024, 2048, 1024, 2, 0, 1.0f);
    add_job(P, nt, P.ffn_w1, (bf16_t*)(ws + OFF_WUP0), P.norm_ffn_g, DM, FFN, FFN, 0, 1, 0, 1.0f);
    add_job(P, nt, P.ffn_w3, (bf16_t*)(ws + OFF_WUP0), P.norm_ffn_g, DM, FFN, FFN, 0, 2, 0, 1.0f);
    add_job(P, nt, P.ffn_w2, (bf16_t*)(ws + OFF_WDN0), nullptr, FFN, DM, DM, 0, 0, 0, 1.0f);
    add_job(P, nt, P.w_kv, (bf16_t*)(ws + OFF_WKVQ), P.kv_norm_g, DM, 2048, 2048, 0, 0, 0, 1.0f);
    add_job(P, nt, P.w_q, (bf16_t*)(ws + OFF_WKVQ), P.norm_mix_g + DM, DM, 1024, 1024, 0, 0, 2048, QSCALE);
    add_job(P, nt, P.w_o, (bf16_t*)(ws + OFF_WO), nullptr, DM, DM, DM, 0, 0, 0, 1.0f);
    add_job(P, nt, P.ffn_w1 + FW, (bf16_t*)(ws + OFF_WUP1), P.norm_ffn_g + DM, DM, FFN, FFN, 0, 1, 0, 1.0f);
    add_job(P, nt, P.ffn_w3 + FW, (bf16_t*)(ws + OFF_WUP1), P.norm_ffn_g + DM, DM, FFN, FFN, 0, 2, 0, 1.0f);
    add_job(P, nt, P.ffn_w2 + FW, (bf16_t*)(ws + OFF_WDN1), nullptr, FFN, DM, DM, 0, 0, 0, 1.0f);
    P.ntiles_w = nt;
    static int grid_blocks = 0;
    if (!grid_blocks) {
        int dev = 0, cus = 0, per_cu = 0;
        hipGetDevice(&dev);
        hipDeviceGetAttribute(&cus, hipDeviceAttributeMultiprocessorCount, dev);
        hipOccupancyMaxActiveBlocksPerMultiprocessor(&per_cu, mega, NTHREADS, 0);
        if (per_cu < 1) per_cu = 1;
        grid_blocks = cus * 1;
    }
    hipMemsetAsync(ws + OFF_BAR, 0, 16384, stream);
    void* args[] = {&P};
    hipError_t e = hipLaunchCooperativeKernel((void*)mega, dim3(grid_blocks), dim3(NTHREADS), args, 0, stream);
    if (e != hipSuccess) fprintf(stderr, "cooperative launch failed: %s (grid %d)\n", hipGetErrorString(e), grid_blocks);
}
```

```cpp
#include <hip/hip_runtime.h>
#include <hip/hip_cooperative_groups.h>
#include <stdint.h>
#include <string.h>
#include <stdio.h>
namespace cg = cooperative_groups;

typedef unsigned short bf16_t;
typedef short bf16x8 __attribute__((ext_vector_type(8)));
typedef float f32x16 __attribute__((ext_vector_type(16)));
typedef float f32x4 __attribute__((ext_vector_type(4)));
typedef float f32x2 __attribute__((ext_vector_type(2)));
typedef unsigned u32x4 __attribute__((ext_vector_type(4)));
typedef unsigned u32x2 __attribute__((ext_vector_type(2)));

#define L_SEQ 16384
#define DM 1024
#define FFN 2816
#define NTHREADS 512
#ifndef REP_ATTN
#define REP_ATTN 1
#endif
#ifndef REP_UP
#define REP_UP 1
#endif
#define REP_GLU 1
#define REP_KVQ 1
#define REP_S5 1
#define REP_SLOC 1
#define REP_PREP 1
#define LDS_BYTES 139280
#define EPSV 1e-6f
#define LAM_INIT 0.35550906759096927f
#define QSCALE 0.18033688011112042f

static constexpr size_t MiB = 1024ull * 1024ull;
static constexpr size_t OFF_WGLU = 0;
static constexpr size_t OFF_WUP0 = 4 * MiB;
static constexpr size_t OFF_WDN0 = 15 * MiB;
static constexpr size_t OFF_WKVQ = 20 * MiB + MiB / 2;
static constexpr size_t OFF_WO = 26 * MiB + MiB / 2;
static constexpr size_t OFF_WUP1 = 28 * MiB + MiB / 2;
static constexpr size_t OFF_WDN1 = 39 * MiB + MiB / 2;
static constexpr size_t OFF_SSQ = 45 * MiB;
static constexpr size_t OFF_A64 = 49 * MiB;
static constexpr size_t OFF_BAR = 49 * MiB + MiB / 2;
static constexpr size_t OFF_A = 50 * MiB;
static constexpr size_t OFF_HN0 = OFF_A;
static constexpr size_t OFF_Z = OFF_A + 32 * MiB;
static constexpr size_t OFF_ACT = OFF_A;
static constexpr size_t OFF_K1 = OFF_A;
static constexpr size_t OFF_K2 = OFF_A + 16 * MiB;
static constexpr size_t OFF_VT = OFF_A + 32 * MiB;
static constexpr size_t OFF_Q1 = OFF_A + 64 * MiB;
static constexpr size_t OFF_Q2 = OFF_A + 80 * MiB;
static constexpr size_t OFF_B = 146 * MiB;
static constexpr size_t OFF_KT = OFF_B;
static constexpr size_t OFF_W1 = OFF_B + 4 * MiB;
static constexpr size_t OFF_W3 = OFF_B + 20 * MiB;
static constexpr size_t OFF_SLOC = OFF_B + 36 * MiB;
static constexpr size_t OFF_SPREV = OFF_B + 44 * MiB;
static constexpr size_t OFF_HB = OFF_B;
static constexpr size_t OFF_ON = OFF_B + 32 * MiB;

struct WJob { const float* src; bf16_t* dst; const float* gain; int K; int N; int ldsrc; int col0; int mode; int rowoff; float scale; int tile0; int ntn; int pad; };

struct Params {
    const float *x, *norm_mix_g, *norm_ffn_g, *ffn_w1, *ffn_w3, *ffn_w2;
    const float *lam_re, *lam_im, *log_dt, *b_re, *b_im, *c_re, *c_im, *ssm_d, *w_glu;
    const float *kv_norm_g, *w_kv, *w_q, *lq1, *lk1, *lq2, *lk2, *subln_g, *w_o, *final_g;
    float* out;
    char* ws;
    WJob jobs[12];
    int njobs; int ntiles_w;
};

__device__ __forceinline__ int get_tid(int wave_s) { int t = wave_s * 64 + (int)__builtin_amdgcn_mbcnt_hi(~0u, __builtin_amdgcn_mbcnt_lo(~0u, 0u)); asm volatile("" : "+v"(t)); return t; }
__device__ __forceinline__ unsigned pk_bf16(float lo, float hi) { unsigned r; asm("v_cvt_pk_bf16_f32 %0, %1, %2" : "=v"(r) : "v"(lo), "v"(hi)); return r; }
__device__ __forceinline__ float bf_lo(unsigned u) { return __uint_as_float(u << 16); }
__device__ __forceinline__ float bf_hi(unsigned u) { return __uint_as_float(u & 0xffff0000u); }
__device__ __forceinline__ float fast_rcp(float x) { return __builtin_amdgcn_rcpf(x); }
__device__ __forceinline__ float fast_exp2(float x) { return __builtin_amdgcn_exp2f(x); }
__device__ __forceinline__ float sigmoidf_(float x) { return fast_rcp(1.0f + fast_exp2(-1.4426950408889634f * x)); }
__device__ __forceinline__ float gelu_tanh(float x) {
    const float u = 0.7978845608028654f * x * (1.0f + 0.044715f * x * x);
    return x * fast_rcp(1.0f + fast_exp2(-2.8853900817779268f * u));
}

struct Seg { const bf16_t* W; long wrs; long wkhi; const bf16_t* X; long xrs; long xkhi; };

struct TileCtx { int wn, wm, lane; };

template <class Epi>
__device__ __forceinline__ void gemm_tile(const int wave_s, char* lds, const Seg s0, const int nk0_, const Seg s1, const int nk1_, Epi& epi,
                                          const bool pro_done = false, const bool has_next = false, const Seg nx = Seg{nullptr, 0, 0, nullptr, 0, 0}) {
    int tid = get_tid(wave_s);
    const int lane = tid & 63;
    const int wn = wave_s >> 2, wm = wave_s & 3;
    const int lr = lane & 31, h = lane >> 5;
    const int nk0 = nk0_ * 2, nk1 = nk1_ * 2, nk = nk0 + nk1;
    const int cch = (lane & 3) ^ ((lane >> 4) & 3);
    const int row0 = wave_s * 32 + (lane >> 2);
    f32x16 acc[4][2];
#pragma unroll
    for (int a = 0; a < 4; ++a)
#pragma unroll
        for (int b = 0; b < 2; ++b)
#pragma unroll
            for (int r = 0; r < 16; ++r) acc[a][b][r] = 0.f;
    auto issue = [&](int t) {
        const bool first = t < nk0;
        const bf16_t* W = first ? s0.W : s1.W; const bf16_t* X = first ? s0.X : s1.X;
        const long wrs = first ? s0.wrs : s1.wrs, xrs = first ? s0.xrs : s1.xrs;
        const long wkhi = first ? s0.wkhi : s1.wkhi, xkhi = first ? s0.xkhi : s1.xkhi;
        const int kt = first ? t : t - nk0;
        const long kc = kt * 2 + (cch >> 1);
        const bf16_t* wp = W + (long)row0 * wrs + kc * wkhi + (cch & 1) * 8;
        const bf16_t* xp = X + (long)row0 * xrs + kc * xkhi + (cch & 1) * 8;
        char* st = lds + (t & 3) * 32768 + wave_s * 2048;
        __builtin_amdgcn_global_load_lds((const unsigned*)wp, (__attribute__((address_space(3))) unsigned*)(st), 16, 0, 0);
        __builtin_amdgcn_global_load_lds((const unsigned*)(wp + 16 * wrs), (__attribute__((address_space(3))) unsigned*)(st + 1024), 16, 0, 0);
        __builtin_amdgcn_global_load_lds((const unsigned*)xp, (__attribute__((address_space(3))) unsigned*)(st + 16384), 16, 0, 0);
        __builtin_amdgcn_global_load_lds((const unsigned*)(xp + 16 * xrs), (__attribute__((address_space(3))) unsigned*)(st + 16384 + 1024), 16, 0, 0);
    };
    const int sw = (lr >> 2) & 3;
    const int aoff = (wn * 128 + lr) * 64, boff = 16384 + (wm * 64 + lr) * 64;
    const int ch0 = ((0 + h) ^ sw) << 4, ch1 = ((2 + h) ^ sw) << 4;
    bf16x8 a0[4], b0[2], a1[4], b1[2];
    epi.pre(wm, lane, wn);
    if (!pro_done) { issue(0); issue(1); issue(2); issue(3); }
    asm volatile("s_waitcnt vmcnt(12)" ::: "memory");
    __builtin_amdgcn_s_barrier(); asm volatile("" ::: "memory");
#pragma unroll
    for (int nb = 0; nb < 4; ++nb) a0[nb] = *(const bf16x8*)(lds + aoff + nb * 2048 + ch0);
#pragma unroll
    for (int mb = 0; mb < 2; ++mb) b0[mb] = *(const bf16x8*)(lds + boff + mb * 2048 + ch0);
    for (int t = 0; t < nk; ++t) {
        const char* st = lds + (t & 3) * 32768;
#pragma unroll
        for (int nb = 0; nb < 4; ++nb) a1[nb] = *(const bf16x8*)(st + aoff + nb * 2048 + ch1);
#pragma unroll
        for (int mb = 0; mb < 2; ++mb) b1[mb] = *(const bf16x8*)(st + boff + mb * 2048 + ch1);
#pragma unroll
        for (int nb = 0; nb < 4; ++nb)
#pragma unroll
            for (int mb = 0; mb < 2; ++mb) acc[nb][mb] = __builtin_amdgcn_mfma_f32_32x32x16_bf16(a0[nb], b0[mb], acc[nb][mb], 0, 0, 0);
        const int rem = nk - 1 - t;
        if (rem >= 3) asm volatile("s_waitcnt vmcnt(8)" ::: "memory");
        else if (rem == 2) asm volatile("s_waitcnt vmcnt(4)" ::: "memory");
        else asm volatile("s_waitcnt vmcnt(0)" ::: "memory");
        asm volatile("s_waitcnt lgkmcnt(0)" ::: "memory");
        __builtin_amdgcn_s_barrier(); asm volatile("" ::: "memory");
        if (t + 4 < nk) issue(t + 4);
        if (t + 1 < nk) {
            const char* sn = lds + ((t + 1) & 3) * 32768;
#pragma unroll
            for (int nb = 0; nb < 4; ++nb) a0[nb] = *(const bf16x8*)(sn + aoff + nb * 2048 + ch0);
#pragma unroll
            for (int mb = 0; mb < 2; ++mb) b0[mb] = *(const bf16x8*)(sn + boff + mb * 2048 + ch0);
        }
#pragma unroll
        for (int nb = 0; nb < 4; ++nb)
#pragma unroll
            for (int mb = 0; mb < 2; ++mb) acc[nb][mb] = __builtin_amdgcn_mfma_f32_32x32x16_bf16(a1[nb], b1[mb], acc[nb][mb], 0, 0, 0);
    }
    if (has_next) {
#pragma unroll
        for (int t = 0; t < 4; ++t) {
            const long kc = t * 2 + (cch >> 1);
            const bf16_t* wp = nx.W + (long)row0 * nx.wrs + kc * nx.wkhi + (cch & 1) * 8;
            const bf16_t* xp = nx.X + (long)row0 * nx.xrs + kc * nx.xkhi + (cch & 1) * 8;
            char* st = lds + t * 32768 + wave_s * 2048;
            __builtin_amdgcn_global_load_lds((const unsigned*)wp, (__attribute__((address_space(3))) unsigned*)(st), 16, 0, 0);
            __builtin_amdgcn_global_load_lds((const unsigned*)(wp + 16 * nx.wrs), (__attribute__((address_space(3))) unsigned*)(st + 1024), 16, 0, 0);
            __builtin_amdgcn_global_load_lds((const unsigned*)xp, (__attribute__((address_space(3))) unsigned*)(st + 16384), 16, 0, 0);
            __builtin_amdgcn_global_load_lds((const unsigned*)(xp + 16 * nx.xrs), (__attribute__((address_space(3))) unsigned*)(st + 16384 + 1024), 16, 0, 0);
        }
    }
    TileCtx c; c.wn = wn; c.wm = wm; c.lane = lane;
    epi(acc, c);
}

template <int NPART>
__device__ __forceinline__ float rstd_from(const float* ssq, int token) {
    float v[NPART];
#pragma unroll
    for (int i = 0; i < NPART; ++i) v[i] = ssq[(size_t)i * L_SEQ + token];
    float s = 0.f;
#pragma unroll
    for (int i = 0; i < NPART; ++i) s += v[i];
    return rsqrtf(s * (1.0f / DM) + EPSV);
}

__device__ __forceinline__ u32x4 widen8(u32x2 A, u32x2 B) {
    const auto r0 = __builtin_amdgcn_permlane32_swap(A[0], B[0], false, false);
    const auto r1 = __builtin_amdgcn_permlane32_swap(A[1], B[1], false, false);
    u32x4 o; o[0] = r0[0]; o[1] = r1[0]; o[2] = r0[1]; o[3] = r1[1]; return o;
}

struct EpiSloc {
    float* dst;
    __device__ __forceinline__ void pre(int, int, int) {}
    __device__ __forceinline__ void operator()(f32x16 (&acc)[4][2], const TileCtx& c) const {
        if (c.wn != 0) return;
        const int lr = c.lane & 31, h = c.lane >> 5;
#pragma unroll
        for (int mb = 0; mb < 2; ++mb) { const int m = c.wm * 64 + mb * 32 + lr;
#pragma unroll
            for (int nb = 0; nb < 4; ++nb)
#pragma unroll
                for (int rq = 0; rq < 4; ++rq) { const int n = nb * 32 + rq * 8 + 4 * h;
                    f32x4 v = {acc[nb][mb][4 * rq], acc[nb][mb][4 * rq + 1], acc[nb][mb][4 * rq + 2], acc[nb][mb][4 * rq + 3]};
                    *(f32x4*)(dst + m * 132 + n) = v; } }
    }
};

struct EpiS5 {
    const bf16_t* hn0; const float* dskip; bf16_t* z; int g; int n0;
    __device__ __forceinline__ void pre(int, int, int) {}
    __device__ __forceinline__ void operator()(f32x16 (&acc)[4][2], const TileCtx& c) const {
        const int lr = c.lane & 31, h = c.lane >> 5;
#pragma unroll
        for (int mb = 0; mb < 2; ++mb) { const int j = c.wm * 64 + mb * 32 + lr;
            u32x2 uu[16], zz[16];
#pragma unroll
            for (int q = 0; q < 16; ++q) { const int n = n0 + c.wn * 128 + (q >> 2) * 32 + (q & 3) * 8 + 4 * h; uu[q] = *(const u32x2*)(hn0 + (size_t)g * 262144 + (size_t)j * 1024 + n); }
            asm volatile("" ::: "memory");
#pragma unroll
            for (int q = 0; q < 16; ++q) { const int nb = q >> 2, rq = q & 3; const int n = n0 + c.wn * 128 + nb * 32 + rq * 8 + 4 * h; const int t = n >> 4, cc = n & 15;
                const size_t off = (size_t)g * 262144 + (size_t)(j * 64 + t) * 16 + cc; const f32x4 d4 = *(const f32x4*)(dskip + g * 16 + cc);
                const float y0 = acc[nb][mb][4 * rq] + d4[0] * bf_lo(uu[q][0]), y1 = acc[nb][mb][4 * rq + 1] + d4[1] * bf_hi(uu[q][0]);
                const float y2 = acc[nb][mb][4 * rq + 2] + d4[2] * bf_lo(uu[q][1]), y3 = acc[nb][mb][4 * rq + 3] + d4[3] * bf_hi(uu[q][1]);
                zz[q][0] = pk_bf16(gelu_tanh(y0), gelu_tanh(y1)); zz[q][1] = pk_bf16(gelu_tanh(y2), gelu_tanh(y3)); (void)off; }
#pragma unroll
            for (int q = 0; q < 16; q += 2) { const int n = n0 + c.wn * 128 + (q >> 2) * 32 + (q & 3) * 8 + 8 * h;
                *(u32x4*)(z + (size_t)g * 262144 + (size_t)(j * 64 + (n >> 4)) * 16 + (n & 15)) = widen8(zz[q], zz[q + 1]); }
            asm volatile("" ::: "memory"); }
    }
};

struct EpiGlu {
    const float* x; float* out; bf16_t* hb; float* ssq; int n0, m0;
    __device__ __forceinline__ void pre(int, int, int) {}
    __device__ __forceinline__ void operator()(f32x16 (&acc)[4][2], const TileCtx& c) const {
        const int lr = c.lane & 31, h = c.lane >> 5;
#pragma unroll
        for (int mb = 0; mb < 2; ++mb) { const int m = m0 + c.wm * 64 + mb * 32 + lr; float s = 0.f;
            const size_t rowoff = (size_t)m * DM + ((n0 + c.wn * 128) >> 1) + 4 * h;
            f32x4 xv[8]; u32x2 pkk[8];
#pragma unroll
            for (int q = 0; q < 8; ++q) xv[q] = *(const f32x4*)(x + rowoff + (q >> 1) * 16 + (q & 1) * 8);
            asm volatile("" ::: "memory");
#pragma unroll
            for (int q = 0; q < 8; ++q) { const int nb = q >> 1, rg = q & 1; const size_t off = rowoff + nb * 16 + rg * 8; f32x4 o;
#pragma unroll
                for (int e = 0; e < 4; ++e) { o[e] = xv[q][e] + acc[nb][mb][rg * 8 + e] * sigmoidf_(acc[nb][mb][rg * 8 + 4 + e]); s += o[e] * o[e]; }
                *(f32x4*)(out + off) = o; pkk[q][0] = pk_bf16(o[0], o[1]); pkk[q][1] = pk_bf16(o[2], o[3]); }
#pragma unroll
            for (int q = 0; q < 8; q += 2) *(u32x4*)(hb + (size_t)m * DM + ((n0 + c.wn * 128) >> 1) + (q >> 1) * 16 + 8 * h) = widen8(pkk[q], pkk[q + 1]);
            asm volatile("" ::: "memory");
            s += __shfl_xor(s, 32);
            if (h == 0) ssq[(size_t)((n0 >> 8) * 2 + c.wn) * L_SEQ + m] = s; }
    }
};

template <int NPART> struct EpiUp {
    const float* ssq; bf16_t* act; int n0, m0; float rsv[2];
    __device__ __forceinline__ void pre(int wm, int lane, int) {
#pragma unroll
        for (int mb = 0; mb < 2; ++mb) rsv[mb] = rstd_from<NPART>(ssq, m0 + wm * 64 + mb * 32 + (lane & 31)); }
    __device__ __forceinline__ void operator()(f32x16 (&acc)[4][2], const TileCtx& c) const {
        const int lr = c.lane & 31, h = c.lane >> 5;
#pragma unroll
        for (int mb = 0; mb < 2; ++mb) { const int m = m0 + c.wm * 64 + mb * 32 + lr; const float rs = rsv[mb];
#pragma unroll
            for (int nb = 0; nb < 4; ++nb) { u32x2 pk[2];
#pragma unroll
                for (int rg = 0; rg < 2; ++rg) { float o[4];
#pragma unroll
                    for (int e = 0; e < 4; ++e) { const float a = acc[nb][mb][rg * 8 + e] * rs, b = acc[nb][mb][rg * 8 + 4 + e] * rs; o[e] = a * sigmoidf_(a) * b; }
                    pk[rg][0] = pk_bf16(o[0], o[1]); pk[rg][1] = pk_bf16(o[2], o[3]); }
                *(u32x4*)(act + (size_t)m * FFN + ((n0 + c.wn * 128 + nb * 32) >> 1) + 8 * h) = widen8(pk[0], pk[1]); } }
    }
};

struct EpiRes {
    float* out; bf16_t* hb; float* ssq; int n0, m0;
    __device__ __forceinline__ void pre(int, int, int) {}
    __device__ __forceinline__ void operator()(f32x16 (&acc)[4][2], const TileCtx& c) const {
        const int lr = c.lane & 31, h = c.lane >> 5;
#pragma unroll
        for (int mb = 0; mb < 2; ++mb) { const int m = m0 + c.wm * 64 + mb * 32 + lr; float s = 0.f;
            const size_t rowoff = (size_t)m * DM + n0 + c.wn * 128 + 4 * h;
#pragma unroll
            for (int np = 0; np < 2; ++np) {
                f32x4 o[8];
#pragma unroll
                for (int q = 0; q < 8; ++q) o[q] = *(const f32x4*)(out + rowoff + (np * 2 + (q >> 2)) * 32 + (q & 3) * 8);
                asm volatile("" ::: "memory");
#pragma unroll
                for (int q = 0; q < 8; ++q) { const int nb = np * 2 + (q >> 2), rq = q & 3; const size_t off = rowoff + nb * 32 + rq * 8;
#pragma unroll
                    for (int e = 0; e < 4; ++e) { o[q][e] += acc[nb][mb][4 * rq + e]; s += o[q][e] * o[q][e]; }
                    *(f32x4*)(out + off) = o[q]; }
                if (hb) {
#pragma unroll
                    for (int q = 0; q < 8; q += 2) { u32x2 A, B; A[0] = pk_bf16(o[q][0], o[q][1]); A[1] = pk_bf16(o[q][2], o[q][3]); B[0] = pk_bf16(o[q + 1][0], o[q + 1][1]); B[1] = pk_bf16(o[q + 1][2], o[q + 1][3]);
                        *(u32x4*)(hb + (size_t)m * DM + n0 + c.wn * 128 + (np * 2 + (q >> 2)) * 32 + (q & 3) * 8 + 8 * h) = widen8(A, B); } }
                asm volatile("" ::: "memory");
            }
            s += __shfl_xor(s, 32);
            if (h == 0) ssq[(size_t)((n0 >> 8) * 2 + c.wn) * L_SEQ + m] = s; }
    }
};

struct EpiKvq {
    const float* ssq; char* ws; char* ldsb; int n0, m0; float rsv[2];
    __device__ __forceinline__ void pre(int wm, int lane, int) {
#pragma unroll
        for (int mb = 0; mb < 2; ++mb) rsv[mb] = rstd_from<8>(ssq, m0 + wm * 64 + mb * 32 + (lane & 31)); }
    __device__ __forceinline__ void operator()(f32x16 (&acc)[4][2], const TileCtx& c) const {
        const int lr = c.lane & 31, h = c.lane >> 5;
        const bool isV = (n0 >= 1024 && n0 < 2048);
#pragma unroll
        for (int mb = 0; mb < 2; ++mb) { const int m = m0 + c.wm * 64 + mb * 32 + lr; const float rs = rsv[mb];
            if (isV) {
                const int ml = c.wm * 64 + mb * 32 + lr;
                const int mp = (ml & ~12) | ((ml & 4) << 1) | ((ml & 8) >> 1);
#pragma unroll
                for (int nb = 0; nb < 4; ++nb)
#pragma unroll
                    for (int r = 0; r < 16; ++r) { const int nl = c.wn * 128 + nb * 32 + (r & 3) + 8 * (r >> 2) + 4 * h;
                        *(bf16_t*)(ldsb + nl * 528 + mp * 2) = (bf16_t)(pk_bf16(acc[nb][mb][r] * rs, 0.f) & 0xffffu); }
            } else {
                size_t base; int nl;
                if (n0 < 512) { base = OFF_K1; nl = n0; } else if (n0 < 1024) { base = OFF_K2; nl = n0 - 512; } else if (n0 < 2560) { base = OFF_Q1; nl = n0 - 2048; } else { base = OFF_Q2; nl = n0 - 2560; }
                bf16_t* dst = (bf16_t*)(ws + base);
                float cs[4], sn[4];
#pragma unroll
                for (int e = 0; e < 4; ++e) { const int i = 4 * h + e;
                    const float invf = (i == 0) ? 1.0f : (i == 1) ? 0.19391188f : (i == 2) ? 0.037601817f : (i == 3) ? 0.0072914392f : (i == 4) ? 0.0014142136f : (i == 5) ? 0.00027423282f : (i == 6) ? 5.3176997e-05f : 1.0311653e-05f;
                    const float ang = (float)m * invf; double rev = (double)ang * 0.15915494309189535; rev -= rint(rev); const float fr = (float)rev;
                    cs[e] = __builtin_amdgcn_cosf(fr); sn[e] = __builtin_amdgcn_sinf(fr); }
#pragma unroll
                for (int nb = 0; nb < 4; ++nb) {
                    const int nn = nl + c.wn * 128 + nb * 32; const int head = nn >> 6, d0 = nn & 63;
                    float v[16];
#pragma unroll
                    for (int r = 0; r < 16; ++r) v[r] = acc[nb][mb][r] * rs;
                    if (d0 == 0) {
#pragma unroll
                        for (int e = 0; e < 4; ++e) { const float x1 = v[e], x2 = v[4 + e]; v[e] = x1 * cs[e] - x2 * sn[e]; v[4 + e] = x2 * cs[e] + x1 * sn[e]; }
                    }
#pragma unroll
                    for (int rq = 0; rq < 4; rq += 2) { u32x2 A, B; A[0] = pk_bf16(v[4 * rq], v[4 * rq + 1]); A[1] = pk_bf16(v[4 * rq + 2], v[4 * rq + 3]);
                        B[0] = pk_bf16(v[4 * rq + 4], v[4 * rq + 5]); B[1] = pk_bf16(v[4 * rq + 6], v[4 * rq + 7]);
                        *(u32x4*)(dst + ((size_t)head * L_SEQ + m) * 64 + d0 + rq * 8 + 8 * h) = widen8(A, B); }
                }
            } }
        if (isV) {
            __syncthreads();
            bf16_t* vt = (bf16_t*)(ws + OFF_VT) + (size_t)(n0 - 1024) * L_SEQ + m0;
            const int tid = c.wn * 256 + c.wm * 64 + c.lane;
#pragma unroll
            for (int i = 0; i < 16; ++i) { const int q = tid + 512 * i, row = q >> 5, c16 = q & 31;
                const u32x4 v = *(const u32x4*)(ldsb + row * 528 + c16 * 16);
                *(u32x4*)(vt + (size_t)row * L_SEQ + c16 * 8) = v; }
            __syncthreads();
        }
    }
};

__device__ __forceinline__ void s5_tables(const int wave_s, const Params& p, int g, char* lds) {
    f32x2* apow = (f32x2*)lds;
    f32x2* bb = apow + 65 * 64;
    f32x2* cc = bb + 1024;
    f32x2* zf = cc + 1024;
    int tid = get_tid(wave_s); asm volatile("" : "+v"(tid));
    const float dt = expf(p.log_dt[g]);
    for (int e = tid; e < 65 * 64; e += NTHREADS) {
        const int lag = e >> 6, pp = e & 63;
        const float lr = p.lam_re[g * 64 + pp], li = p.lam_im[g * 64 + pp];
        const float mag = expf(lr * dt * (float)lag);
        double rev = (double)li * (double)dt * (double)lag * 0.15915494309189535; rev -= rint(rev);
        const float fr = (float)rev;
        f32x2 v; v[0] = mag * __builtin_amdgcn_cosf(fr); v[1] = mag * __builtin_amdgcn_sinf(fr); apow[e] = v;
    }
    if (tid < 64) {
        const float lr = p.lam_re[g * 64 + tid], li = p.lam_im[g * 64 + tid];
        const float em1 = expm1f(lr * dt);
        double rev = (double)li * (double)dt * 0.15915494309189535; const double rh = rev * 0.5; rev -= rint(rev);
        const double rh2 = rh - rint(rh);
        const float cth = __builtin_amdgcn_cosf((float)rev), sth = __builtin_amdgcn_sinf((float)rev), shalf = __builtin_amdgcn_sinf((float)rh2);
        const float nr = em1 * cth - 2.0f * shalf * shalf, ni = (1.0f + em1) * sth;
        const float den = lr * lr + li * li;
        f32x2 f; f[0] = (nr * lr + ni * li) / den; f[1] = (ni * lr - nr * li) / den; zf[tid] = f;
    }
    __syncthreads();
    for (int e = tid; e < 1024; e += NTHREADS) {
        const int pp = e >> 4;
        const float br = p.b_re[(size_t)g * 1024 + e], bi = p.b_im[(size_t)g * 1024 + e];
        const f32x2 f = zf[pp]; f32x2 v; v[0] = f[0] * br - f[1] * bi; v[1] = f[0] * bi + f[1] * br; bb[e] = v;
        f32x2 cv; cv[0] = p.c_re[(size_t)g * 1024 + e]; cv[1] = p.c_im[(size_t)g * 1024 + e]; cc[e] = cv;
    }
    __syncthreads();
    bf16_t* kt = (bf16_t*)(p.ws + OFF_KT) + (size_t)g * 127 * 256;
    bf16_t* w1 = (bf16_t*)(p.ws + OFF_W1) + (size_t)g * 128 * 1024;
    bf16_t* w3 = (bf16_t*)(p.ws + OFF_W3) + (size_t)g * 1024 * 128;
    {
        const int pg = tid & 63, lg = tid >> 6, c = pg >> 2, c2 = (pg & 3) * 4;
        float acc[8][4];
#pragma unroll
        for (int l = 0; l < 8; ++l)
#pragma unroll
            for (int k = 0; k < 4; ++k) acc[l][k] = 0.f;
        for (int pp = 0; pp < 64; ++pp) {
            const f32x2 cv = cc[c * 64 + pp];
            float cbr[4], cbi[4];
#pragma unroll
            for (int k = 0; k < 4; ++k) { const f32x2 bv = bb[pp * 16 + c2 + k]; cbr[k] = cv[0] * bv[0] - cv[1] * bv[1]; cbi[k] = cv[0] * bv[1] + cv[1] * bv[0]; }
#pragma unroll
            for (int l = 0; l < 8; ++l) { const f32x2 a = apow[(lg * 8 + l) * 64 + pp];
#pragma unroll
                for (int k = 0; k < 4; ++k) acc[l][k] += cbr[k] * a[0] - cbi[k] * a[1]; }
        }
#pragma unroll
        for (int l = 0; l < 8; ++l) { u32x2 o; o[0] = pk_bf16(acc[l][0], acc[l][1]); o[1] = pk_bf16(acc[l][2], acc[l][3]);
            *(u32x2*)(kt + (size_t)(63 + lg * 8 + l) * 256 + pg * 4) = o; }
        for (int e = tid; e < 63 * 256 / 8; e += NTHREADS) { u32x4 zz = {0u, 0u, 0u, 0u}; *(u32x4*)(kt + e * 8) = zz; }
    }
    for (int q = tid; q < 128 * 128; q += NTHREADS) {
        const int pq = q >> 7, kc = q & 127, tau = kc >> 1, c0 = (kc & 1) * 8, pp = pq & 63, im = pq >> 6;
        const f32x2 a = apow[(63 - tau) * 64 + pp]; float v[8];
#pragma unroll
        for (int e = 0; e < 8; ++e) { const f32x2 b = bb[pp * 16 + c0 + e]; v[e] = im ? (a[0] * b[1] + a[1] * b[0]) : (a[0] * b[0] - a[1] * b[1]); }
        u32x4 o; o[0] = pk_bf16(v[0], v[1]); o[1] = pk_bf16(v[2], v[3]); o[2] = pk_bf16(v[4], v[5]); o[3] = pk_bf16(v[6], v[7]);
        *(u32x4*)(w1 + (size_t)pq * 1024 + kc * 8) = o;
    }
    for (int q = tid; q < 1024 * 16; q += NTHREADS) {
        const int n = q >> 4, p0 = (q & 15) * 8, t = n >> 4, c = n & 15, im = p0 >> 6; float v[8];
#pragma unroll
        for (int e = 0; e < 8; ++e) { const int pp = (p0 + e) & 63; const f32x2 a = apow[(t + 1) * 64 + pp]; const f32x2 cv = cc[c * 64 + pp];
            v[e] = im ? -(cv[0] * a[1] + cv[1] * a[0]) : (cv[0] * a[0] - cv[1] * a[1]); }
        u32x4 o; o[0] = pk_bf16(v[0], v[1]); o[1] = pk_bf16(v[2], v[3]); o[2] = pk_bf16(v[4], v[5]); o[3] = pk_bf16(v[6], v[7]);
        *(u32x4*)(w3 + (size_t)n * 128 + p0) = o;
    }
    if (tid < 64) ((f32x2*)(p.ws + OFF_A64))[g * 64 + tid] = apow[64 * 64 + tid];
    __syncthreads();
}

__device__ __forceinline__ void wtile(const int wave_s, const Params& p, int t, char* lds) {
    int j = 0;
    for (int i = 1; i < p.njobs; ++i) if (t >= p.jobs[i].tile0) j = i;
    const WJob& J = p.jobs[j];
    const int lt = t - J.tile0, kt = lt / J.ntn, nt = lt - kt * J.ntn;
    const int k0 = kt * 64, nl0 = nt * 256;
    float* T = (float*)lds;
    int tid = get_tid(wave_s); asm volatile("" : "+v"(tid));
    const int c4 = (tid & 63) * 4, kb = tid >> 6;
    f32x4 v[8];
#pragma unroll
    for (int i = 0; i < 8; ++i) v[i] = *(const f32x4*)(J.src + (size_t)(k0 + kb + 8 * i) * J.ldsrc + J.col0 + nl0 + c4);
#pragma unroll
    for (int i = 0; i < 8; ++i) { const int kk = kb + 8 * i; float sc = J.scale; if (J.gain) sc *= J.gain[k0 + kk];
        T[kk * 257 + c4] = v[i][0] * sc; T[kk * 257 + c4 + 1] = v[i][1] * sc; T[kk * 257 + c4 + 2] = v[i][2] * sc; T[kk * 257 + c4 + 3] = v[i][3] * sc; }
    __syncthreads();
    { const int nn = tid >> 1, kh = (tid & 1) * 32;
        const int n = nl0 + nn; int row = (J.mode == 0) ? n : ((n >> 3) * 16 + (n & 7) + (J.mode == 2 ? 8 : 0)); row += J.rowoff;
        bf16_t* d = J.dst + (size_t)row * J.K + k0 + kh;
#pragma unroll
        for (int q = 0; q < 4; ++q) { float w[8];
#pragma unroll
            for (int e = 0; e < 8; ++e) w[e] = T[(kh + q * 8 + e) * 257 + nn];
            u32x4 o; o[0] = pk_bf16(w[0], w[1]); o[1] = pk_bf16(w[2], w[3]); o[2] = pk_bf16(w[4], w[5]); o[3] = pk_bf16(w[6], w[7]);
            *(u32x4*)(d + q * 8) = o; } }
    __syncthreads();
}

__device__ __forceinline__ void rms0_item(const int wave_s, const Params& p, int item) {
    const int lane = get_tid(wave_s) & 63, wid = wave_s;
    bf16_t* hn0 = (bf16_t*)(p.ws + OFF_HN0);
    f32x4 g[4];
#pragma unroll
    for (int i = 0; i < 4; ++i) g[i] = *(const f32x4*)(p.norm_mix_g + lane * 4 + 256 * i);
    for (int rb = 0; rb < 2; ++rb) {
        f32x4 v[4][4];
#pragma unroll
        for (int r = 0; r < 4; ++r)
#pragma unroll
            for (int i = 0; i < 4; ++i) v[r][i] = *(const f32x4*)(p.x + (size_t)(item * 64 + wid * 8 + rb * 4 + r) * DM + lane * 4 + 256 * i);
#pragma unroll
        for (int r = 0; r < 4; ++r) {
            const int row = item * 64 + wid * 8 + rb * 4 + r;
            float s = 0.f;
#pragma unroll
            for (int i = 0; i < 4; ++i) s += v[r][i][0] * v[r][i][0] + v[r][i][1] * v[r][i][1] + v[r][i][2] * v[r][i][2] + v[r][i][3] * v[r][i][3];
#pragma unroll
            for (int o = 32; o >= 1; o >>= 1) s += __shfl_xor(s, o);
            const float rs = rsqrtf(s * (1.0f / DM) + EPSV);
#pragma unroll
            for (int i = 0; i < 4; ++i) {
                u32x2 o; o[0] = pk_bf16(v[r][i][0] * rs * g[i][0], v[r][i][1] * rs * g[i][1]); o[1] = pk_bf16(v[r][i][2] * rs * g[i][2], v[r][i][3] * rs * g[i][3]);
                const int col = lane * 4 + 256 * i;
                *(u32x2*)(hn0 + (size_t)(col >> 4) * 262144 + (size_t)(row >> 6) * 1024 + (row & 63) * 16 + (col & 15)) = o; }
        }
    }
}

__device__ __forceinline__ void attn_item(const int wave_s, const Params& p, int head, int qb, float lam, char* lds) {
    int tid = get_tid(wave_s); asm volatile("" : "+v"(tid));
    const int lane = tid & 63, wid = tid >> 6;
    const int mp = wid >> 2, g = wid & 3;
    const int lr = lane & 31, h = lane >> 5, sw = (lane >> 1) & 7;
    const bf16_t* K1 = (const bf16_t*)(p.ws + OFF_K1) + (size_t)head * L_SEQ * 64;
    const bf16_t* K2 = (const bf16_t*)(p.ws + OFF_K2) + (size_t)head * L_SEQ * 64;
    const bf16_t* VT = (const bf16_t*)(p.ws + OFF_VT) + (size_t)head * 128 * L_SEQ;
    const bf16_t* Q = (const bf16_t*)(p.ws + (mp ? OFF_Q2 : OFF_Q1)) + (size_t)head * L_SEQ * 64;
    const int q0 = qb * 128 + g * 32;
    bf16x8 qf[4];
#pragma unroll
    for (int s = 0; s < 4; ++s) qf[s] = *(const bf16x8*)(Q + (size_t)(q0 + lr) * 64 + 16 * s + 8 * h);
    const int nkt = 2 * qb + 2;
    const int my_last = 2 * qb + (g >> 1);
    f32x16 O[4];
#pragma unroll
    for (int e = 0; e < 4; ++e)
#pragma unroll
        for (int r = 0; r < 16; ++r) O[e][r] = 0.f;
    float m_run = 0.f, l_run = 0.f;
    f32x16 negm;
#pragma unroll
    for (int r = 0; r < 16; ++r) negm[r] = 0.f;
    const int lrow = lane >> 3;
    const int ck = (lane & 7) ^ (((wave_s & 1) * 4 + (lane >> 4)) & 7);
    const int cv0 = (lane & 7) ^ (lane >> 4), cv1 = (lane & 7) ^ (4 + (lane >> 4));
    const bf16_t* k1p = K1 + (size_t)(wave_s * 8 + lrow) * 64 + ck * 8;
    const bf16_t* k2p = K2 + (size_t)(wave_s * 8 + lrow) * 64 + ck * 8;
    const bf16_t* v0p = VT + (size_t)(wave_s * 16 + lrow) * L_SEQ + cv0 * 8;
    const bf16_t* v1p = VT + (size_t)(wave_s * 16 + 8 + lrow) * L_SEQ + cv1 * 8;
    auto issue = [&](int kt) {
        char* st = lds + (kt & 3) * 32768;
        __builtin_amdgcn_global_load_lds((const unsigned*)(k1p + (size_t)kt * 4096), (__attribute__((address_space(3))) unsigned*)(st + wave_s * 1024), 16, 0, 0);
        __builtin_amdgcn_global_load_lds((const unsigned*)(k2p + (size_t)kt * 4096), (__attribute__((address_space(3))) unsigned*)(st + 8192 + wave_s * 1024), 16, 0, 0);
        __builtin_amdgcn_global_load_lds((const unsigned*)(v0p + kt * 64), (__attribute__((address_space(3))) unsigned*)(st + 16384 + wave_s * 2048), 16, 0, 0);
        __builtin_amdgcn_global_load_lds((const unsigned*)(v1p + kt * 64), (__attribute__((address_space(3))) unsigned*)(st + 16384 + wave_s * 2048 + 1024), 16, 0, 0);
    };
    issue(0); issue(1);
    if (nkt > 2) issue(2);
    if (nkt > 2) asm volatile("s_waitcnt vmcnt(8)" ::: "memory");
    else asm volatile("s_waitcnt vmcnt(4)" ::: "memory");
    __builtin_amdgcn_s_barrier(); asm volatile("" ::: "memory");
    const int koff_ = mp * 8192 + lr * 128, voff_ = 16384 + lr * 128;
    int chk[4], chv[4];
#pragma unroll
    for (int s = 0; s < 4; ++s) { chk[s] = ((2 * s + h) ^ sw) << 4; chv[s] = chk[s]; }
    bf16x8 kf[8], vf[8];
#pragma unroll
    for (int i = 0; i < 8; ++i) kf[i] = *(const bf16x8*)(lds + koff_ + (i >> 2) * 4096 + chk[i & 3]);
    for (int kt = 0; kt < nkt; ++kt) {
        const bool active = kt <= my_last;
        const char* stg = lds + (kt & 3) * 32768;
        f32x16 S[2];
        bf16x8 pf[2][2];
        if (active) {
#pragma unroll
            for (int kb = 0; kb < 2; ++kb) {
                S[kb] = __builtin_amdgcn_mfma_f32_32x32x16_bf16(kf[kb * 4], qf[0], negm, 0, 0, 0);
#pragma unroll
                for (int s = 1; s < 4; ++s) S[kb] = __builtin_amdgcn_mfma_f32_32x32x16_bf16(kf[kb * 4 + s], qf[s], S[kb], 0, 0, 0);
            }
#pragma unroll
            for (int i = 0; i < 8; ++i) vf[i] = *(const bf16x8*)(stg + voff_ + (i & 3) * 4096 + chv[i >> 2]);
            __builtin_amdgcn_sched_barrier(0);
            float mt = S[0][0];
#pragma unroll
            for (int r = 1; r < 16; ++r) mt = fmaxf(mt, S[0][r]);
#pragma unroll
            for (int r = 0; r < 16; ++r) mt = fmaxf(mt, S[1][r]);
            { const auto sw2 = __builtin_amdgcn_permlane32_swap(__float_as_uint(mt), __float_as_uint(mt), false, false);
              mt = fmaxf(__uint_as_float(sw2[0]), __uint_as_float(sw2[1])); }
            const bool need = (mt > 8.0f) || (kt == 0);
            if (__any(need)) {
                const float d = need ? mt : 0.f;
                const float alpha = fast_exp2(-d);
                m_run += d; l_run *= alpha;
#pragma unroll
                for (int r = 0; r < 16; ++r) negm[r] -= d;
#pragma unroll
                for (int kb = 0; kb < 2; ++kb)
#pragma unroll
                    for (int r = 0; r < 16; ++r) S[kb][r] -= d;
#pragma unroll
                for (int e = 0; e < 4; ++e)
#pragma unroll
                    for (int r = 0; r < 16; ++r) O[e][r] *= alpha;
            }
            f32x2 ls2 = {0.f, 0.f};
#pragma unroll
            for (int kb = 0; kb < 2; ++kb)
#pragma unroll
                for (int s = 0; s < 2; ++s) { float e_[8];
#pragma unroll
                    for (int j = 0; j < 8; ++j) e_[j] = fast_exp2(S[kb][8 * s + j]);
#pragma unroll
                    for (int j = 0; j < 8; j += 2) { f32x2 t2 = {e_[j], e_[j + 1]}; ls2 += t2; }
                    u32x4 pk; pk[0] = pk_bf16(e_[0], e_[1]); pk[1] = pk_bf16(e_[2], e_[3]); pk[2] = pk_bf16(e_[4], e_[5]); pk[3] = pk_bf16(e_[6], e_[7]);
                    pf[kb][s] = __builtin_bit_cast(bf16x8, pk); }
            const float ls = ls2[0] + ls2[1];
            l_run += ls;
        }
        const int rem = nkt - 1 - kt;
        if (rem >= 2) asm volatile("s_waitcnt vmcnt(4)" ::: "memory");
        else asm volatile("s_waitcnt vmcnt(0)" ::: "memory");
        __builtin_amdgcn_s_barrier(); asm volatile("" ::: "memory");
        if (kt + 3 < nkt) issue(kt + 3);
        if (kt + 1 <= my_last) {
            const char* sn = lds + ((kt + 1) & 3) * 32768;
#pragma unroll
            for (int i = 0; i < 8; ++i) kf[i] = *(const bf16x8*)(sn + koff_ + (i >> 2) * 4096 + chk[i & 3]);
        }
        __builtin_amdgcn_sched_barrier(0);
        if (active) {
#pragma unroll
            for (int i = 0; i < 8; ++i) O[i & 3] = __builtin_amdgcn_mfma_f32_32x32x16_bf16(vf[i], pf[0][i >> 2], O[i & 3], 0, 0, 0);
#pragma unroll
            for (int i = 0; i < 8; ++i) vf[i] = *(const bf16x8*)(stg + voff_ + (i & 3) * 4096 + (((4 + 2 * (i >> 2) + h) ^ sw) << 4));
#pragma unroll
            for (int i = 0; i < 8; ++i) O[i & 3] = __builtin_amdgcn_mfma_f32_32x32x16_bf16(vf[i], pf[1][i >> 2], O[i & 3], 0, 0, 0);
        }
    }
    __syncthreads();
    const float lt = l_run + __shfl_xor(l_run, 32);
    const float inv = fast_rcp(lt) * (mp ? lam : 1.0f);
    float* ex = (float*)lds;
    if (mp == 1) {
#pragma unroll
        for (int e = 0; e < 4; ++e)
#pragma unroll
            for (int r = 0; r < 16; ++r) ex[((g * 4 + e) * 16 + r) * 64 + lane] = O[e][r] * inv;
    }
    __syncthreads();
    if (mp == 0) {
        float ss = 0.f;
#pragma unroll
        for (int e = 0; e < 4; ++e)
#pragma unroll
            for (int r = 0; r < 16; ++r) { const float o = O[e][r] * inv - ex[((g * 4 + e) * 16 + r) * 64 + lane]; O[e][r] = o; ss += o * o; }
        ss += __shfl_xor(ss, 32);
        const float rs = rsqrtf(ss * (1.0f / 128.0f) + EPSV) * (1.0f - LAM_INIT);
        bf16_t* on = (bf16_t*)(p.ws + OFF_ON) + (size_t)(q0 + lr) * DM + head * 128;
#pragma unroll
        for (int e = 0; e < 4; ++e)
#pragma unroll
            for (int rq = 0; rq < 4; ++rq) { const int ee = e * 32 + rq * 8 + 4 * h; const f32x4 gg = *(const f32x4*)(p.subln_g + ee);
                u32x2 b; b[0] = pk_bf16(O[e][4 * rq] * rs * gg[0], O[e][4 * rq + 1] * rs * gg[1]); b[1] = pk_bf16(O[e][4 * rq + 2] * rs * gg[2], O[e][4 * rq + 3] * rs * gg[3]);
                *(u32x2*)(on + ee) = b; }
    }
    __syncthreads();
}


#define XB_XCNT(j)  (64 + 64 * (j))
#define XB_XSUB(j)  (1088 + 64 * (j))
#define XB_XGEN(j)  (2112 + 64 * (j))
#define XB_TOP      3136
#define XB_TOPGEN   3200
#define XB_WORDS    3264
__device__ __forceinline__ unsigned xb_ld(unsigned* p) { return __hip_atomic_load(p, __ATOMIC_RELAXED, __HIP_MEMORY_SCOPE_AGENT); }
__device__ __forceinline__ unsigned xb_add(unsigned* p, unsigned v) { return __hip_atomic_fetch_add(p, v, __ATOMIC_RELAXED, __HIP_MEMORY_SCOPE_AGENT); }
__device__ __forceinline__ unsigned xb_xcc_id() { return (unsigned)__builtin_amdgcn_s_getreg((3 << 11) | 20) & 0xFu; }
__device__ __forceinline__ void gbar(const int wave_s, unsigned* bar, volatile unsigned* st) {
    asm volatile("s_waitcnt vmcnt(0)" ::: "memory");
    __syncthreads();
    if (get_tid(wave_s) == 0) {
        __builtin_amdgcn_s_waitcnt(0);
        const unsigned x = st[2], nloc = st[0], nx = st[1];
        const unsigned old = xb_add(&bar[XB_XSUB(x)], 1u);
        const unsigned gen = old / nloc;
        if (old + 1u == (gen + 1u) * nloc) {
            __builtin_amdgcn_fence(__ATOMIC_RELEASE, "agent");
            asm volatile("s_waitcnt vmcnt(0)" ::: "memory");
            const unsigned og = xb_add(&bar[XB_TOP], 1u);
            const unsigned tg = og / nx;
            if (og + 1u == (tg + 1u) * nx) xb_add(&bar[XB_TOPGEN], 1u);
            else while (xb_ld(&bar[XB_TOPGEN]) == tg) __builtin_amdgcn_s_sleep(1);
            __builtin_amdgcn_fence(__ATOMIC_ACQUIRE, "agent");
            xb_add(&bar[XB_XGEN(x)], 1u);
            asm volatile("s_waitcnt vmcnt(0)" ::: "memory");
        } else {
            while (xb_ld(&bar[XB_XGEN(x)]) == gen) __builtin_amdgcn_s_sleep(1);
            __builtin_amdgcn_fence(__ATOMIC_ACQUIRE, "agent");
            asm volatile("s_waitcnt vmcnt(0)" ::: "memory");
        }
    }
    __syncthreads();
}

__device__ __forceinline__ bool tile_map(int r, int bid, int nb, int NT, int& nt, int& mt) {
    if (nb == 256) {
        const int x = bid & 7, li = bid >> 3, q = li + 32 * r;
        if (q >= 8 * NT) return false;
        const int mi = q & 3, rest = q >> 2, mg = rest / NT;
        nt = rest - mg * NT; mt = x * 8 + mg * 4 + mi; return true;
    }
    const int t = bid + r * nb; if (t >= NT * 64) return false;
    nt = t % NT; mt = t / NT; return true;
}

__global__ void __launch_bounds__(NTHREADS) mega(const Params p) {
    __shared__ __attribute__((aligned(16))) char lds[LDS_BYTES];
    cg::grid_group grid = cg::this_grid();
    const int wave_s = __builtin_amdgcn_readfirstlane((int)(threadIdx.x >> 6));
    const int nb = gridDim.x, bid = blockIdx.x;
    char* ws = p.ws;
    bf16_t* hn0 = (bf16_t*)(ws + OFF_HN0);
    bf16_t* hb = (bf16_t*)(ws + OFF_HB);
    float* ssq0 = (float*)(ws + OFF_SSQ);
    float* ssq1 = ssq0 + 16 * L_SEQ; float* ssq2 = ssq1 + 16 * L_SEQ; float* ssq3 = ssq2 + 16 * L_SEQ;
    const Seg nul = {nullptr, 0, 0, nullptr, 0, 0};
    unsigned* bar = (unsigned*)(ws + OFF_BAR);
    volatile unsigned* xst = (volatile unsigned*)(lds + LDS_BYTES - 16);
    if (get_tid(wave_s) == 0) xb_add(&bar[XB_XCNT(xb_xcc_id())], 1u);
    grid.sync();
    if (get_tid(wave_s) == 0) {
        const unsigned x = xb_xcc_id(); unsigned cnt = 0u, mine = 1u;
        for (unsigned j = 0; j < 16; ++j) { const unsigned c = xb_ld(&bar[XB_XCNT(j)]); cnt += (c > 0u) ? 1u : 0u; if (j == x) mine = c; }
        xst[0] = mine ? mine : 1u; xst[1] = cnt ? cnt : 1u; xst[2] = x;
    }
    __syncthreads();

    { const int nwork = p.ntiles_w + 256;
      for (int rep = 0; rep < REP_PREP; ++rep) {
          if (nb >= 128) {
              if (bid < 64) s5_tables(wave_s, p, bid, lds);
              else for (int it = bid - 64; it < nwork; it += nb - 64) { if (it < p.ntiles_w) wtile(wave_s, p, it, lds); else rms0_item(wave_s, p, it - p.ntiles_w); }
          } else {
              for (int it = bid; it < 64 + nwork; it += nb) { if (it < 64) s5_tables(wave_s, p, it, lds); else if (it < 64 + p.ntiles_w) wtile(wave_s, p, it - 64, lds); else rms0_item(wave_s, p, it - 64 - p.ntiles_w); }
          }
      } }
    gbar(wave_s, bar, xst);
    for (int rep = 0; rep < REP_SLOC; ++rep)
    for (int g = bid; g < 64; g += nb) {
        Seg s = {(const bf16_t*)(ws + OFF_W1) + (size_t)g * 128 * 1024, 1024, 16, hn0 + (size_t)g * 262144, 1024, 16};
        EpiSloc e = {(float*)lds};
        gemm_tile(wave_s, lds, s, 16, nul, 0, e);
        __syncthreads();
        {
            const int lane_ = get_tid(wave_s) & 63, w_ = wave_s;
            const f32x2 a = ((const f32x2*)(ws + OFF_A64))[g * 64 + lane_];
            const float* sl = (const float*)lds + (w_ * 32) * 132;
            float sr = 0.f, si = 0.f;
#pragma unroll
            for (int j = 0; j < 32; ++j) { const float xr = sl[j * 132 + lane_], xi = sl[j * 132 + 64 + lane_]; const float nr = a[0] * sr - a[1] * si + xr, ni = a[0] * si + a[1] * sr + xi; sr = nr; si = ni; }
            f32x2* carry = (f32x2*)(lds + 135168);
            { f32x2 c; c[0] = sr; c[1] = si; carry[w_ * 64 + lane_] = c; }
            float pr = a[0], pi = a[1];
#pragma unroll
            for (int q = 0; q < 5; ++q) { const float nr = pr * pr - pi * pi, ni = 2.f * pr * pi; pr = nr; pi = ni; }
            __syncthreads();
            sr = 0.f; si = 0.f;
            for (int v = 0; v < w_; ++v) { const f32x2 c = carry[v * 64 + lane_]; const float nr = pr * sr - pi * si + c[0], ni = pr * si + pi * sr + c[1]; sr = nr; si = ni; }
            bf16_t* sp = (bf16_t*)(ws + OFF_SPREV) + (size_t)g * 256 * 128 + (size_t)(w_ * 32) * 128;
#pragma unroll
            for (int j = 0; j < 32; ++j) {
                sp[j * 128 + lane_] = (bf16_t)(pk_bf16(sr, 0.f) & 0xffffu); sp[j * 128 + 64 + lane_] = (bf16_t)(pk_bf16(si, 0.f) & 0xffffu);
                const float xr = sl[j * 132 + lane_], xi = sl[j * 132 + 64 + lane_];
                const float nr = a[0] * sr - a[1] * si + xr, ni = a[0] * si + a[1] * sr + xi; sr = nr; si = ni;
            }
        }
        __syncthreads();
    }
    gbar(wave_s, bar, xst);
    for (int rep = 0; rep < REP_S5; ++rep)
    for (int t0 = bid; t0 < 256; t0 += nb) {
        const int t = (nb == 256) ? ((t0 & 7) * 32 + (t0 >> 3)) : t0;
        const int g = t >> 2, i = 3 - (t & 3);
        const bf16_t* sprev = (const bf16_t*)(ws + OFF_SPREV) + (size_t)g * 256 * 128;
        Seg s0 = {(const bf16_t*)(ws + OFF_KT) + (size_t)g * 127 * 256 + 63 * 256 + (size_t)(i * 256) * 16, 16, -256, hn0 + (size_t)g * 262144, 1024, 16};
        Seg s1 = {(const bf16_t*)(ws + OFF_W3) + (size_t)g * 1024 * 128 + (size_t)(i * 256) * 128, 128, 16, sprev, 128, 16};
        EpiS5 e = {hn0, p.ssm_d, (bf16_t*)(ws + OFF_Z), g, i * 256};
        gemm_tile(wave_s, lds, s0, 4 * (i + 1), s1, 2, e);
    }
    gbar(wave_s, bar, xst);
    for (int rep = 0; rep < REP_GLU; ++rep)
    for (int r = 0, nt, mt; tile_map(r, bid, nb, 8, nt, mt); ++r) {
        Seg s = {(const bf16_t*)(ws + OFF_WGLU) + (size_t)nt * 256 * DM, DM, 16, (const bf16_t*)(ws + OFF_Z) + (size_t)mt * 256 * 16, 16, 262144};
        EpiGlu e = {p.x, p.out, hb, ssq0, nt * 256, mt * 256};
        gemm_tile(wave_s, lds, s, 16, nul, 0, e);
    }
    gbar(wave_s, bar, xst);
#pragma unroll
    for (int layer = 0; layer < 2; ++layer) {
        if (layer == 1) {
            for (int rep = 0; rep < REP_KVQ; ++rep) {
                int nt = 0, mt = 0; bool have = tile_map(0, bid, nb, 12, nt, mt), pro = false;
                for (int r = 0; have; ++r) {
                    int nnt = 0, nmt = 0; const bool hn = tile_map(r + 1, bid, nb, 12, nnt, nmt);
                    Seg s = {(const bf16_t*)(ws + OFF_WKVQ) + (size_t)nt * 256 * DM, DM, 16, hb + (size_t)mt * 256 * DM, DM, 16};
                    Seg sn = {(const bf16_t*)(ws + OFF_WKVQ) + (size_t)nnt * 256 * DM, DM, 16, hb + (size_t)nmt * 256 * DM, DM, 16};
                    const bool curV = (nt >= 4 && nt < 8);
                    EpiKvq e = {ssq1, ws, lds, nt * 256, mt * 256, {0.f, 0.f}};
                    gemm_tile(wave_s, lds, s, 16, nul, 0, e, pro, hn && !curV, sn);
                    pro = hn && !curV; nt = nnt; mt = nmt; have = hn;
                }
            }
            gbar(wave_s, bar, xst);
            {
                float a1 = 0.f, a2 = 0.f;
                for (int i = 0; i < 64; ++i) { a1 += p.lq1[i] * p.lk1[i]; a2 += p.lq2[i] * p.lk2[i]; }
                const float lam = expf(a1) - expf(a2) + LAM_INIT;
                for (int rep = 0; rep < REP_ATTN; ++rep)
                for (int it = bid; it < 1024; it += nb) {
                    const int head = it & 7, r = it >> 3, rnd = r >> 5, j = r & 31;
                    const int qb = (rnd == 0) ? 127 - j : (rnd == 1) ? 64 + j : (rnd == 2) ? 63 - j : j;
                    attn_item(wave_s, p, head, qb, lam, lds);
                }
            }
            gbar(wave_s, bar, xst);
            for (int r = 0, nt, mt; tile_map(r, bid, nb, 4, nt, mt); ++r) {
                Seg s = {(const bf16_t*)(ws + OFF_WO) + (size_t)nt * 256 * DM, DM, 16, (const bf16_t*)(ws + OFF_ON) + (size_t)mt * 256 * DM, DM, 16};
                EpiRes e = {p.out, hb, ssq2, nt * 256, mt * 256};
                gemm_tile(wave_s, lds, s, 16, nul, 0, e);
            }
            gbar(wave_s, bar, xst);
        }
        {
            const bf16_t* wup = (const bf16_t*)(ws + (layer ? OFF_WUP1 : OFF_WUP0));
            for (int rep = 0; rep < REP_UP; ++rep) {
                int nt = 0, mt = 0; bool have = tile_map(0, bid, nb, 22, nt, mt), pro = false;
                for (int r = 0; have; ++r) {
                    int nnt = 0, nmt = 0; const bool hn = tile_map(r + 1, bid, nb, 22, nnt, nmt);
                    Seg s = {wup + (size_t)nt * 256 * DM, DM, 16, hb + (size_t)mt * 256 * DM, DM, 16};
                    Seg sn = {wup + (size_t)nnt * 256 * DM, DM, 16, hb + (size_t)nmt * 256 * DM, DM, 16};
                    if (layer == 0) { EpiUp<16> e = {ssq0, (bf16_t*)(ws + OFF_ACT), nt * 256, mt * 256, {0.f, 0.f}}; gemm_tile(wave_s, lds, s, 16, nul, 0, e, pro, hn, sn); }
                    else { EpiUp<8> e = {ssq2, (bf16_t*)(ws + OFF_ACT), nt * 256, mt * 256, {0.f, 0.f}}; gemm_tile(wave_s, lds, s, 16, nul, 0, e, pro, hn, sn); }
                    pro = hn; nt = nnt; mt = nmt; have = hn;
                }
            }
        }
        gbar(wave_s, bar, xst);
        {
            const bf16_t* wdn = (const bf16_t*)(ws + (layer ? OFF_WDN1 : OFF_WDN0));
            for (int r = 0, nt, mt; tile_map(r, bid, nb, 4, nt, mt); ++r) {
                Seg s = {wdn + (size_t)nt * 256 * FFN, FFN, 16, (const bf16_t*)(ws + OFF_ACT) + (size_t)mt * 256 * FFN, FFN, 16};
                EpiRes e = {p.out, layer ? (bf16_t*)nullptr : hb, layer ? ssq3 : ssq1, nt * 256, mt * 256};
                gemm_tile(wave_s, lds, s, FFN / 64, nul, 0, e);
            }
        }
        gbar(wave_s, bar, xst);
    }
    {
        const int lane = get_tid(wave_s) & 63, wid = wave_s;
        for (int row = bid * 8 + wid; row < L_SEQ; row += nb * 8) {
            float s = 0.f;
            for (int i = 0; i < 8; ++i) s += ssq3[(size_t)i * L_SEQ + row];
            const float rs = rsqrtf(s * (1.0f / DM) + EPSV);
#pragma unroll
            for (int i = 0; i < 4; ++i) { const size_t off = (size_t)row * DM + lane * 4 + 256 * i;
                f32x4 v = *(const f32x4*)(p.out + off); const f32x4 g = *(const f32x4*)(p.final_g + lane * 4 + 256 * i);
                v[0] *= rs * g[0]; v[1] *= rs * g[1]; v[2] *= rs * g[2]; v[3] *= rs * g[3]; *(f32x4*)(p.out + off) = v; }
        }
    }
}

static void add_job(Params& P, int& nt, const float* src, bf16_t* dst, const float* gain, int K, int N, int ld, int col0, int mode, int rowoff, float scale) {
    WJob& J = P.jobs[P.njobs++];
    J.src = src; J.dst = dst; J.gain = gain; J.K = K; J.N = N; J.ldsrc = ld; J.col0 = col0; J.mode = mode; J.rowoff = rowoff; J.scale = scale; J.tile0 = nt; J.ntn = N / 256; J.pad = 0;
    nt += (K / 64) * (N / 256);
}

extern "C" void kernel_launch(void* const* d_in, const int* in_sizes, int n_in, void* d_out, int out_size, void* d_ws, size_t ws_size, hipStream_t stream) {
    Params P; memset(&P, 0, sizeof(P));
    P.x = (const float*)d_in[0]; P.norm_mix_g = (const float*)d_in[1]; P.norm_ffn_g = (const float*)d_in[2];
    P.ffn_w1 = (const float*)d_in[3]; P.ffn_w3 = (const float*)d_in[4]; P.ffn_w2 = (const float*)d_in[5];
    P.lam_re = (const float*)d_in[6]; P.lam_im = (const float*)d_in[7]; P.log_dt = (const float*)d_in[8];
    P.b_re = (const float*)d_in[9]; P.b_im = (const float*)d_in[10]; P.c_re = (const float*)d_in[11]; P.c_im = (const float*)d_in[12];
    P.ssm_d = (const float*)d_in[13]; P.w_glu = (const float*)d_in[14]; P.kv_norm_g = (const float*)d_in[15]; P.w_kv = (const float*)d_in[16];
    P.w_q = (const float*)d_in[17]; P.lq1 = (const float*)d_in[18]; P.lk1 = (const float*)d_in[19]; P.lq2 = (const float*)d_in[20]; P.lk2 = (const float*)d_in[21];
    P.subln_g = (const float*)d_in[22]; P.w_o = (const float*)d_in[23]; P.final_g = (const float*)d_in[24];
    P.out = (float*)d_out; P.ws = (char*)d_ws;
    char* ws = (char*)d_ws; int nt = 0;
    const size_t FW = (size_t)DM * FFN;
    add_job(P, nt, P.w_glu, (bf16_t*)(ws + OFF_WGLU), nullptr, DM, 1024, 2048, 0, 1, 0, 1.0f);
    add_job(P, nt, P.w_glu, (bf16_t*)(ws + OFF_WGLU), nullptr, DM, 1024, 2048, 1024, 2, 0, 1.0f);
    add_job(P, nt, P.ffn_w1, (bf16_t*)(ws + OFF_WUP0), P.norm_ffn_g, DM, FFN, FFN, 0, 1, 0, 1.0f);
    add_job(P, nt, P.ffn_w3, (bf16_t*)(ws + OFF_WUP0), P.norm_ffn_g, DM, FFN, FFN, 0, 2, 0, 1.0f);
    add_job(P, nt, P.ffn_w2, (bf16_t*)(ws + OFF_WDN0), nullptr, FFN, DM, DM, 0, 0, 0, 1.0f);
    add_job(P, nt, P.w_kv, (bf16_t*)(ws + OFF_WKVQ), P.kv_norm_g, DM, 2048, 2048, 0, 0, 0, 1.0f);
    add_job(P, nt, P.w_q, (bf16_t*)(ws + OFF_WKVQ), P.norm_mix_g + DM, DM, 1024, 1024, 0, 0, 2048, QSCALE);
    add_job(P, nt, P.w_o, (bf16_t*)(ws + OFF_WO), nullptr, DM, DM, DM, 0, 0, 0, 1.0f);
    add_job(P, nt, P.ffn_w1 + FW, (bf16_t*)(ws + OFF_WUP1), P.norm_ffn_g + DM, DM, FFN, FFN, 0, 1, 0, 1.0f);
    add_job(P, nt, P.ffn_w3 + FW, (bf16_t*)(ws + OFF_WUP1), P.norm_ffn_g + DM, DM, FFN, FFN, 0, 2, 0, 1.0f);
    add_job(P, nt, P.ffn_w2 + FW, (bf16_t*)(ws + OFF_WDN1), nullptr, FFN, DM, DM, 0, 0, 0, 1.0f);
    P.ntiles_w = nt;
    static int grid_blocks = 0;
    if (!grid_blocks) {
        int dev = 0, cus = 0, per_cu = 0;
        hipGetDevice(&dev);
        hipDeviceGetAttribute(&cus, hipDeviceAttributeMultiprocessorCount, dev);
        hipOccupancyMaxActiveBlocksPerMultiprocessor(&per_cu, mega, NTHREADS, 0);
        if (per_cu < 1) per_cu = 1;
        grid_blocks = cus * 1;
    }
    hipMemsetAsync(ws + OFF_BAR, 0, 16384, stream);
    void* args[] = {&P};
    hipError_t e = hipLaunchCooperativeKernel((void*)mega, dim3(grid_blocks), dim3(NTHREADS), args, 0, stream);
    if (e != hipSuccess) fprintf(stderr, "cooperative launch failed: %s (grid %d)\n", hipGetErrorString(e), grid_blocks);
}
```

```cpp
#include <hip/hip_runtime.h>
#include <hip/hip_cooperative_groups.h>
#include <stdint.h>
#include <string.h>
#include <stdio.h>
namespace cg = cooperative_groups;

typedef unsigned short bf16_t;
typedef short bf16x8 __attribute__((ext_vector_type(8)));
typedef float f32x16 __attribute__((ext_vector_type(16)));
typedef float f32x4 __attribute__((ext_vector_type(4)));
typedef float f32x2 __attribute__((ext_vector_type(2)));
typedef unsigned u32x4 __attribute__((ext_vector_type(4)));
typedef unsigned u32x2 __attribute__((ext_vector_type(2)));

#define L_SEQ 16384
#define DM 1024
#define FFN 2816
#define NTHREADS 512
#ifndef REP_ATTN
#define REP_ATTN 1
#endif
#ifndef REP_UP
#define REP_UP 1
#endif
#define REP_GLU 1
#define REP_KVQ 1
#define REP_S5 1
#define REP_SLOC 1
#define REP_PREP 1
#define LDS_BYTES 139280
#define EPSV 1e-6f
#define LAM_INIT 0.35550906759096927f
#define QSCALE 0.18033688011112042f

static constexpr size_t MiB = 1024ull * 1024ull;
static constexpr size_t OFF_WGLU = 0;
static constexpr size_t OFF_WUP0 = 4 * MiB;
static constexpr size_t OFF_WDN0 = 15 * MiB;
static constexpr size_t OFF_WKVQ = 20 * MiB + MiB / 2;
static constexpr size_t OFF_WO = 26 * MiB + MiB / 2;
static constexpr size_t OFF_WUP1 = 28 * MiB + MiB / 2;
static constexpr size_t OFF_WDN1 = 39 * MiB + MiB / 2;
static constexpr size_t OFF_SSQ = 45 * MiB;
static constexpr size_t OFF_A64 = 49 * MiB;
static constexpr size_t OFF_BAR = 49 * MiB + MiB / 2;
static constexpr size_t OFF_A = 50 * MiB;
static constexpr size_t OFF_HN0 = OFF_A;
static constexpr size_t OFF_Z = OFF_A + 32 * MiB;
static constexpr size_t OFF_ACT = OFF_A;
static constexpr size_t OFF_K1 = OFF_A;
static constexpr size_t OFF_K2 = OFF_A + 16 * MiB;
static constexpr size_t OFF_VT = OFF_A + 32 * MiB;
static constexpr size_t OFF_Q1 = OFF_A + 64 * MiB;
static constexpr size_t OFF_Q2 = OFF_A + 80 * MiB;
static constexpr size_t OFF_B = 146 * MiB;
static constexpr size_t OFF_KT = OFF_B;
static constexpr size_t OFF_W1 = OFF_B + 4 * MiB;
static constexpr size_t OFF_W3 = OFF_B + 20 * MiB;
static constexpr size_t OFF_SLOC = OFF_B + 36 * MiB;
static constexpr size_t OFF_SPREV = OFF_B + 44 * MiB;
static constexpr size_t OFF_HB = OFF_B;
static constexpr size_t OFF_ON = OFF_B + 32 * MiB;

struct WJob { const float* src; bf16_t* dst; const float* gain; int K; int N; int ldsrc; int col0; int mode; int rowoff; float scale; int tile0; int ntn; int pad; };

struct Params {
    const float *x, *norm_mix_g, *norm_ffn_g, *ffn_w1, *ffn_w3, *ffn_w2;
    const float *lam_re, *lam_im, *log_dt, *b_re, *b_im, *c_re, *c_im, *ssm_d, *w_glu;
    const float *kv_norm_g, *w_kv, *w_q, *lq1, *lk1, *lq2, *lk2, *subln_g, *w_o, *final_g;
    float* out;
    char* ws;
    WJob jobs[12];
    int njobs; int ntiles_w;
};

__device__ __forceinline__ int get_tid(int wave_s) { int t = wave_s * 64 + (int)__builtin_amdgcn_mbcnt_hi(~0u, __builtin_amdgcn_mbcnt_lo(~0u, 0u)); asm volatile("" : "+v"(t)); return t; }
__device__ __forceinline__ unsigned pk_bf16(float lo, float hi) { unsigned r; asm("v_cvt_pk_bf16_f32 %0, %1, %2" : "=v"(r) : "v"(lo), "v"(hi)); return r; }
__device__ __forceinline__ float bf_lo(unsigned u) { return __uint_as_float(u << 16); }
__device__ __forceinline__ float bf_hi(unsigned u) { return __uint_as_float(u & 0xffff0000u); }
__device__ __forceinline__ float fast_rcp(float x) { return __builtin_amdgcn_rcpf(x); }
__device__ __forceinline__ float fast_exp2(float x) { return __builtin_amdgcn_exp2f(x); }
__device__ __forceinline__ float sigmoidf_(float x) { return fast_rcp(1.0f + fast_exp2(-1.4426950408889634f * x)); }
__device__ __forceinline__ float gelu_tanh(float x) {
    const float u = 0.7978845608028654f * x * (1.0f + 0.044715f * x * x);
    return x * fast_rcp(1.0f + fast_exp2(-2.8853900817779268f * u));
}

struct Seg { const bf16_t* W; long wrs; long wkhi; const bf16_t* X; long xrs; long xkhi; };

struct TileCtx { int wn, wm, lane; };

template <class Epi>
__device__ __forceinline__ void gemm_tile(const int wave_s, char* lds, const Seg s0, const int nk0_, const Seg s1, const int nk1_, Epi& epi,
                                          const bool pro_done = false, const bool has_next = false, const Seg nx = Seg{nullptr, 0, 0, nullptr, 0, 0}) {
    int tid = get_tid(wave_s);
    const int lane = tid & 63;
    const int wn = wave_s >> 2, wm = wave_s & 3;
    const int lr = lane & 31, h = lane >> 5;
    const int nk0 = nk0_ * 2, nk1 = nk1_ * 2, nk = nk0 + nk1;
    const int cch = (lane & 3) ^ ((lane >> 4) & 3);
    const int row0 = wave_s * 32 + (lane >> 2);
    f32x16 acc[4][2];
#pragma unroll
    for (int a = 0; a < 4; ++a)
#pragma unroll
        for (int b = 0; b < 2; ++b)
#pragma unroll
            for (int r = 0; r < 16; ++r) acc[a][b][r] = 0.f;
    auto issue = [&](int t) {
        const bool first = t < nk0;
        const bf16_t* W = first ? s0.W : s1.W; const bf16_t* X = first ? s0.X : s1.X;
        const long wrs = first ? s0.wrs : s1.wrs, xrs = first ? s0.xrs : s1.xrs;
        const long wkhi = first ? s0.wkhi : s1.wkhi, xkhi = first ? s0.xkhi : s1.xkhi;
        const int kt = first ? t : t - nk0;
        const long kc = kt * 2 + (cch >> 1);
        const bf16_t* wp = W + (long)row0 * wrs + kc * wkhi + (cch & 1) * 8;
        const bf16_t* xp = X + (long)row0 * xrs + kc * xkhi + (cch & 1) * 8;
        char* st = lds + (t & 3) * 32768 + wave_s * 2048;
        __builtin_amdgcn_global_load_lds((const unsigned*)wp, (__attribute__((address_space(3))) unsigned*)(st), 16, 0, 0);
        __builtin_amdgcn_global_load_lds((const unsigned*)(wp + 16 * wrs), (__attribute__((address_space(3))) unsigned*)(st + 1024), 16, 0, 0);
        __builtin_amdgcn_global_load_lds((const unsigned*)xp, (__attribute__((address_space(3))) unsigned*)(st + 16384), 16, 0, 0);
        __builtin_amdgcn_global_load_lds((const unsigned*)(xp + 16 * xrs), (__attribute__((address_space(3))) unsigned*)(st + 16384 + 1024), 16, 0, 0);
    };
    const int sw = (lr >> 2) & 3;
    const int aoff = (wn * 128 + lr) * 64, boff = 16384 + (wm * 64 + lr) * 64;
    const int ch0 = ((0 + h) ^ sw) << 4, ch1 = ((2 + h) ^ sw) << 4;
    bf16x8 a0[4], b0[2], a1[4], b1[2];
    epi.pre(wm, lane, wn);
    if (!pro_done) { issue(0); issue(1); issue(2); issue(3); }
    asm volatile("s_waitcnt vmcnt(12)" ::: "memory");
    __builtin_amdgcn_s_barrier(); asm volatile("" ::: "memory");
#pragma unroll
    for (int nb = 0; nb < 4; ++nb) a0[nb] = *(const bf16x8*)(lds + aoff + nb * 2048 + ch0);
#pragma unroll
    for (int mb = 0; mb < 2; ++mb) b0[mb] = *(const bf16x8*)(lds + boff + mb * 2048 + ch0);
    for (int t = 0; t < nk; ++t) {
        const char* st = lds + (t & 3) * 32768;
#pragma unroll
        for (int nb = 0; nb < 4; ++nb) a1[nb] = *(const bf16x8*)(st + aoff + nb * 2048 + ch1);
#pragma unroll
        for (int mb = 0; mb < 2; ++mb) b1[mb] = *(const bf16x8*)(st + boff + mb * 2048 + ch1);
#pragma unroll
        for (int nb = 0; nb < 4; ++nb)
#pragma unroll
            for (int mb = 0; mb < 2; ++mb) acc[nb][mb] = __builtin_amdgcn_mfma_f32_32x32x16_bf16(a0[nb], b0[mb], acc[nb][mb], 0, 0, 0);
        const int rem = nk - 1 - t;
        if (rem >= 3) asm volatile("s_waitcnt vmcnt(8)" ::: "memory");
        else if (rem == 2) asm volatile("s_waitcnt vmcnt(4)" ::: "memory");
        else asm volatile("s_waitcnt vmcnt(0)" ::: "memory");
        asm volatile("s_waitcnt lgkmcnt(0)" ::: "memory");
        __builtin_amdgcn_s_barrier(); asm volatile("" ::: "memory");
        if (t + 4 < nk) issue(t + 4);
        if (t + 1 < nk) {
            const char* sn = lds + ((t + 1) & 3) * 32768;
#pragma unroll
            for (int nb = 0; nb < 4; ++nb) a0[nb] = *(const bf16x8*)(sn + aoff + nb * 2048 + ch0);
#pragma unroll
            for (int mb = 0; mb < 2; ++mb) b0[mb] = *(const bf16x8*)(sn + boff + mb * 2048 + ch0);
        }
#pragma unroll
        for (int nb = 0; nb < 4; ++nb)
#pragma unroll
            for (int mb = 0; mb < 2; ++mb) acc[nb][mb] = __builtin_amdgcn_mfma_f32_32x32x16_bf16(a1[nb], b1[mb], acc[nb][mb], 0, 0, 0);
    }
    if (has_next) {
#pragma unroll
        for (int t = 0; t < 4; ++t) {
            const long kc = t * 2 + (cch >> 1);
            const bf16_t* wp = nx.W + (long)row0 * nx.wrs + kc * nx.wkhi + (cch & 1) * 8;
            const bf16_t* xp = nx.X + (long)row0 * nx.xrs + kc * nx.xkhi + (cch & 1) * 8;
            char* st = lds + t * 32768 + wave_s * 2048;
            __builtin_amdgcn_global_load_lds((const unsigned*)wp, (__attribute__((address_space(3))) unsigned*)(st), 16, 0, 0);
            __builtin_amdgcn_global_load_lds((const unsigned*)(wp + 16 * nx.wrs), (__attribute__((address_space(3))) unsigned*)(st + 1024), 16, 0, 0);
            __builtin_amdgcn_global_load_lds((const unsigned*)xp, (__attribute__((address_space(3))) unsigned*)(st + 16384), 16, 0, 0);
            __builtin_amdgcn_global_load_lds((const unsigned*)(xp + 16 * nx.xrs), (__attribute__((address_space(3))) unsigned*)(st + 16384 + 1024), 16, 0, 0);
        }
    }
    TileCtx c; c.wn = wn; c.wm = wm; c.lane = lane;
    epi(acc, c);
}

template <int NPART>
__device__ __forceinline__ float rstd_from(const float* ssq, int token) {
    float v[NPART];
#pragma unroll
    for (int i = 0; i < NPART; ++i) v[i] = ssq[(size_t)i * L_SEQ + token];
    float s = 0.f;
#pragma unroll
    for (int i = 0; i < NPART; ++i) s += v[i];
    return rsqrtf(s * (1.0f / DM) + EPSV);
}

__device__ __forceinline__ u32x4 widen8(u32x2 A, u32x2 B) {
    const auto r0 = __builtin_amdgcn_permlane32_swap(A[0], B[0], false, false);
    const auto r1 = __builtin_amdgcn_permlane32_swap(A[1], B[1], false, false);
    u32x4 o; o[0] = r0[0]; o[1] = r1[0]; o[2] = r0[1]; o[3] = r1[1]; return o;
}

struct EpiSloc {
    float* dst;
    __device__ __forceinline__ void pre(int, int, int) {}
    __device__ __forceinline__ void operator()(f32x16 (&acc)[4][2], const TileCtx& c) const {
        if (c.wn != 0) return;
        const int lr = c.lane & 31, h = c.lane >> 5;
#pragma unroll
        for (int mb = 0; mb < 2; ++mb) { const int m = c.wm * 64 + mb * 32 + lr;
#pragma unroll
            for (int nb = 0; nb < 4; ++nb)
#pragma unroll
                for (int rq = 0; rq < 4; ++rq) { const int n = nb * 32 + rq * 8 + 4 * h;
                    f32x4 v = {acc[nb][mb][4 * rq], acc[nb][mb][4 * rq + 1], acc[nb][mb][4 * rq + 2], acc[nb][mb][4 * rq + 3]};
                    *(f32x4*)(dst + m * 132 + n) = v; } }
    }
};

struct EpiS5 {
    const bf16_t* hn0; const float* dskip; bf16_t* z; int g; int n0;
    __device__ __forceinline__ void pre(int, int, int) {}
    __device__ __forceinline__ void operator()(f32x16 (&acc)[4][2], const TileCtx& c) const {
        const int lr = c.lane & 31, h = c.lane >> 5;
#pragma unroll
        for (int mb = 0; mb < 2; ++mb) { const int j = c.wm * 64 + mb * 32 + lr;
            u32x2 uu[16], zz[16];
#pragma unroll
            for (int q = 0; q < 16; ++q) { const int n = n0 + c.wn * 128 + (q >> 2) * 32 + (q & 3) * 8 + 4 * h; uu[q] = *(const u32x2*)(hn0 + (size_t)g * 262144 + (size_t)j * 1024 + n); }
            asm volatile("" ::: "memory");
#pragma unroll
            for (int q = 0; q < 16; ++q) { const int nb = q >> 2, rq = q & 3; const int n = n0 + c.wn * 128 + nb * 32 + rq * 8 + 4 * h; const int t = n >> 4, cc = n & 15;
                const size_t off = (size_t)g * 262144 + (size_t)(j * 64 + t) * 16 + cc; const f32x4 d4 = *(const f32x4*)(dskip + g * 16 + cc);
                const float y0 = acc[nb][mb][4 * rq] + d4[0] * bf_lo(uu[q][0]), y1 = acc[nb][mb][4 * rq + 1] + d4[1] * bf_hi(uu[q][0]);
                const float y2 = acc[nb][mb][4 * rq + 2] + d4[2] * bf_lo(uu[q][1]), y3 = acc[nb][mb][4 * rq + 3] + d4[3] * bf_hi(uu[q][1]);
                zz[q][0] = pk_bf16(gelu_tanh(y0), gelu_tanh(y1)); zz[q][1] = pk_bf16(gelu_tanh(y2), gelu_tanh(y3)); (void)off; }
#pragma unroll
            for (int q = 0; q < 16; q += 2) { const int n = n0 + c.wn * 128 + (q >> 2) * 32 + (q & 3) * 8 + 8 * h;
                *(u32x4*)(z + (size_t)g * 262144 + (size_t)(j * 64 + (n >> 4)) * 16 + (n & 15)) = widen8(zz[q], zz[q + 1]); }
            asm volatile("" ::: "memory"); }
    }
};

struct EpiGlu {
    const float* x; float* out; bf16_t* hb; float* ssq; int n0, m0;
    __device__ __forceinline__ void pre(int, int, int) {}
    __device__ __forceinline__ void operator()(f32x16 (&acc)[4][2], const TileCtx& c) const {
        const int lr = c.lane & 31, h = c.lane >> 5;
#pragma unroll
        for (int mb = 0; mb < 2; ++mb) { const int m = m0 + c.wm * 64 + mb * 32 + lr; float s = 0.f;
            const size_t rowoff = (size_t)m * DM + ((n0 + c.wn * 128) >> 1) + 4 * h;
            f32x4 xv[8]; u32x2 pkk[8];
#pragma unroll
            for (int q = 0; q < 8; ++q) xv[q] = *(const f32x4*)(x + rowoff + (q >> 1) * 16 + (q & 1) * 8);
            asm volatile("" ::: "memory");
#pragma unroll
            for (int q = 0; q < 8; ++q) { const int nb = q >> 1, rg = q & 1; const size_t off = rowoff + nb * 16 + rg * 8; f32x4 o;
#pragma unroll
                for (int e = 0; e < 4; ++e) { o[e] = xv[q][e] + acc[nb][mb][rg * 8 + e] * sigmoidf_(acc[nb][mb][rg * 8 + 4 + e]); s += o[e] * o[e]; }
                *(f32x4*)(out + off) = o; pkk[q][0] = pk_bf16(o[0], o[1]); pkk[q][1] = pk_bf16(o[2], o[3]); }
#pragma unroll
            for (int q = 0; q < 8; q += 2) *(u32x4*)(hb + (size_t)m * DM + ((n0 + c.wn * 128) >> 1) + (q >> 1) * 16 + 8 * h) = widen8(pkk[q], pkk[q + 1]);
            asm volatile("" ::: "memory");
            s += __shfl_xor(s, 32);
            if (h == 0) ssq[(size_t)((n0 >> 8) * 2 + c.wn) * L_SEQ + m] = s; }
    }
};

template <int NPART> struct EpiUp {
    const float* ssq; bf16_t* act; int n0, m0; float rsv[2];
    __device__ __forceinline__ void pre(int wm, int lane, int) {
#pragma unroll
        for (int mb = 0; mb < 2; ++mb) rsv[mb] = rstd_from<NPART>(ssq, m0 + wm * 64 + mb * 32 + (lane & 31)); }
    __device__ __forceinline__ void operator()(f32x16 (&acc)[4][2], const TileCtx& c) const {
        const int lr = c.lane & 31, h = c.lane >> 5;
#pragma unroll
        for (int mb = 0; mb < 2; ++mb) { const int m = m0 + c.wm * 64 + mb * 32 + lr; const float rs = rsv[mb];
#pragma unroll
            for (int nb = 0; nb < 4; ++nb) { u32x2 pk[2];
#pragma unroll
                for (int rg = 0; rg < 2; ++rg) { float o[4];
#pragma unroll
                    for (int e = 0; e < 4; ++e) { const float a = acc[nb][mb][rg * 8 + e] * rs, b = acc[nb][mb][rg * 8 + 4 + e] * rs; o[e] = a * sigmoidf_(a) * b; }
                    pk[rg][0] = pk_bf16(o[0], o[1]); pk[rg][1] = pk_bf16(o[2], o[3]); }
                *(u32x4*)(act + (size_t)m * FFN + ((n0 + c.wn * 128 + nb * 32) >> 1) + 8 * h) = widen8(pk[0], pk[1]); } }
    }
};

struct EpiRes {
    float* out; bf16_t* hb; float* ssq; int n0, m0;
    __device__ __forceinline__ void pre(int, int, int) {}
    __device__ __forceinline__ void operator()(f32x16 (&acc)[4][2], const TileCtx& c) const {
        const int lr = c.lane & 31, h = c.lane >> 5;
#pragma unroll
        for (int mb = 0; mb < 2; ++mb) { const int m = m0 + c.wm * 64 + mb * 32 + lr; float s = 0.f;
            const size_t rowoff = (size_t)m * DM + n0 + c.wn * 128 + 4 * h;
#pragma unroll
            for (int np = 0; np < 2; ++np) {
                f32x4 o[8];
#pragma unroll
                for (int q = 0; q < 8; ++q) o[q] = *(const f32x4*)(out + rowoff + (np * 2 + (q >> 2)) * 32 + (q & 3) * 8);
                asm volatile("" ::: "memory");
#pragma unroll
                for (int q = 0; q < 8; ++q) { const int nb = np * 2 + (q >> 2), rq = q & 3; const size_t off = rowoff + nb * 32 + rq * 8;
#pragma unroll
                    for (int e = 0; e < 4; ++e) { o[q][e] += acc[nb][mb][4 * rq + e]; s += o[q][e] * o[q][e]; }
                    *(f32x4*)(out + off) = o[q]; }
                if (hb) {
#pragma unroll
                    for (int q = 0; q < 8; q += 2) { u32x2 A, B; A[0] = pk_bf16(o[q][0], o[q][1]); A[1] = pk_bf16(o[q][2], o[q][3]); B[0] = pk_bf16(o[q + 1][0], o[q + 1][1]); B[1] = pk_bf16(o[q + 1][2], o[q + 1][3]);
                        *(u32x4*)(hb + (size_t)m * DM + n0 + c.wn * 128 + (np * 2 + (q >> 2)) * 32 + (q & 3) * 8 + 8 * h) = widen8(A, B); } }
                asm volatile("" ::: "memory");
            }
            s += __shfl_xor(s, 32);
            if (h == 0) ssq[(size_t)((n0 >> 8) * 2 + c.wn) * L_SEQ + m] = s; }
    }
};

struct EpiKvq {
    const float* ssq; char* ws; char* ldsb; int n0, m0; float rsv[2];
    __device__ __forceinline__ void pre(int wm, int lane, int) {
#pragma unroll
        for (int mb = 0; mb < 2; ++mb) rsv[mb] = rstd_from<8>(ssq, m0 + wm * 64 + mb * 32 + (lane & 31)); }
    __device__ __forceinline__ void operator()(f32x16 (&acc)[4][2], const TileCtx& c) const {
        const int lr = c.lane & 31, h = c.lane >> 5;
        const bool isV = (n0 >= 1024 && n0 < 2048);
#pragma unroll
        for (int mb = 0; mb < 2; ++mb) { const int m = m0 + c.wm * 64 + mb * 32 + lr; const float rs = rsv[mb];
            if (isV) {
                const int ml = c.wm * 64 + mb * 32 + lr;
                const int mp = (ml & ~12) | ((ml & 4) << 1) | ((ml & 8) >> 1);
#pragma unroll
                for (int nb = 0; nb < 4; ++nb)
#pragma unroll
                    for (int r = 0; r < 16; ++r) { const int nl = c.wn * 128 + nb * 32 + (r & 3) + 8 * (r >> 2) + 4 * h;
                        *(bf16_t*)(ldsb + nl * 528 + mp * 2) = (bf16_t)(pk_bf16(acc[nb][mb][r] * rs, 0.f) & 0xffffu); }
            } else {
                size_t base; int nl;
                if (n0 < 512) { base = OFF_K1; nl = n0; } else if (n0 < 1024) { base = OFF_K2; nl = n0 - 512; } else if (n0 < 2560) { base = OFF_Q1; nl = n0 - 2048; } else { base = OFF_Q2; nl = n0 - 2560; }
                bf16_t* dst = (bf16_t*)(ws + base);
                float cs[4], sn[4];
#pragma unroll
                for (int e = 0; e < 4; ++e) { const int i = 4 * h + e;
                    const float invf = (i == 0) ? 1.0f : (i == 1) ? 0.19391188f : (i == 2) ? 0.037601817f : (i == 3) ? 0.0072914392f : (i == 4) ? 0.0014142136f : (i == 5) ? 0.00027423282f : (i == 6) ? 5.3176997e-05f : 1.0311653e-05f;
                    const float ang = (float)m * invf; double rev = (double)ang * 0.15915494309189535; rev -= rint(rev); const float fr = (float)rev;
                    cs[e] = __builtin_amdgcn_cosf(fr); sn[e] = __builtin_amdgcn_sinf(fr); }
#pragma unroll
                for (int nb = 0; nb < 4; ++nb) {
                    const int nn = nl + c.wn * 128 + nb * 32; const int head = nn >> 6, d0 = nn & 63;
                    float v[16];
#pragma unroll
                    for (int r = 0; r < 16; ++r) v[r] = acc[nb][mb][r] * rs;
                    if (d0 == 0) {
#pragma unroll
                        for (int e = 0; e < 4; ++e) { const float x1 = v[e], x2 = v[4 + e]; v[e] = x1 * cs[e] - x2 * sn[e]; v[4 + e] = x2 * cs[e] + x1 * sn[e]; }
                    }
#pragma unroll
                    for (int rq = 0; rq < 4; rq += 2) { u32x2 A, B; A[0] = pk_bf16(v[4 * rq], v[4 * rq + 1]); A[1] = pk_bf16(v[4 * rq + 2], v[4 * rq + 3]);
                        B[0] = pk_bf16(v[4 * rq + 4], v[4 * rq + 5]); B[1] = pk_bf16(v[4 * rq + 6], v[4 * rq + 7]);
                        *(u32x4*)(dst + ((size_t)head * L_SEQ + m) * 64 + d0 + rq * 8 + 8 * h) = widen8(A, B); }
                }
            } }
        if (isV) {
            __syncthreads();
            bf16_t* vt = (bf16_t*)(ws + OFF_VT) + (size_t)(n0 - 1024) * L_SEQ + m0;
            const int tid = c.wn * 256 + c.wm * 64 + c.lane;
#pragma unroll
            for (int i = 0; i < 16; ++i) { const int q = tid + 512 * i, row = q >> 5, c16 = q & 31;
                const u32x4 v = *(const u32x4*)(ldsb + row * 528 + c16 * 16);
                *(u32x4*)(vt + (size_t)row * L_SEQ + c16 * 8) = v; }
            __syncthreads();
        }
    }
};

__device__ __forceinline__ void s5_tables(const int wave_s, const Params& p, int g, char* lds) {
    f32x2* apow = (f32x2*)lds;
    f32x2* bb = apow + 65 * 64;
    f32x2* cc = bb + 1024;
    f32x2* zf = cc + 1024;
    int tid = get_tid(wave_s); asm volatile("" : "+v"(tid));
    const float dt = expf(p.log_dt[g]);
    for (int e = tid; e < 65 * 64; e += NTHREADS) {
        const int lag = e >> 6, pp = e & 63;
        const float lr = p.lam_re[g * 64 + pp], li = p.lam_im[g * 64 + pp];
        const float mag = expf(lr * dt * (float)lag);
        double rev = (double)li * (double)dt * (double)lag * 0.15915494309189535; rev -= rint(rev);
        const float fr = (float)rev;
        f32x2 v; v[0] = mag * __builtin_amdgcn_cosf(fr); v[1] = mag * __builtin_amdgcn_sinf(fr); apow[e] = v;
    }
    if (tid < 64) {
        const float lr = p.lam_re[g * 64 + tid], li = p.lam_im[g * 64 + tid];
        const float em1 = expm1f(lr * dt);
        double rev = (double)li * (double)dt * 0.15915494309189535; const double rh = rev * 0.5; rev -= rint(rev);
        const double rh2 = rh - rint(rh);
        const float cth = __builtin_amdgcn_cosf((float)rev), sth = __builtin_amdgcn_sinf((float)rev), shalf = __builtin_amdgcn_sinf((float)rh2);
        const float nr = em1 * cth - 2.0f * shalf * shalf, ni = (1.0f + em1) * sth;
        const float den = lr * lr + li * li;
        f32x2 f; f[0] = (nr * lr + ni * li) / den; f[1] = (ni * lr - nr * li) / den; zf[tid] = f;
    }
    __syncthreads();
    for (int e = tid; e < 1024; e += NTHREADS) {
        const int pp = e >> 4;
        const float br = p.b_re[(size_t)g * 1024 + e], bi = p.b_im[(size_t)g * 1024 + e];
        const f32x2 f = zf[pp]; f32x2 v; v[0] = f[0] * br - f[1] * bi; v[1] = f[0] * bi + f[1] * br; bb[e] = v;
        f32x2 cv; cv[0] = p.c_re[(size_t)g * 1024 + e]; cv[1] = p.c_im[(size_t)g * 1024 + e]; cc[e] = cv;
    }
    __syncthreads();
    bf16_t* kt = (bf16_t*)(p.ws + OFF_KT) + (size_t)g * 127 * 256;
    bf16_t* w1 = (bf16_t*)(p.ws + OFF_W1) + (size_t)g * 128 * 1024;
    bf16_t* w3 = (bf16_t*)(p.ws + OFF_W3) + (size_t)g * 1024 * 128;
    {
        const int pg = tid & 63, lg = tid >> 6, c = pg >> 2, c2 = (pg & 3) * 4;
        float acc[8][4];
#pragma unroll
        for (int l = 0; l < 8; ++l)
#pragma unroll
            for (int k = 0; k < 4; ++k) acc[l][k] = 0.f;
        for (int pp = 0; pp < 64; ++pp) {
            const f32x2 cv = cc[c * 64 + pp];
            float cbr[4], cbi[4];
#pragma unroll
            for (int k = 0; k < 4; ++k) { const f32x2 bv = bb[pp * 16 + c2 + k]; cbr[k] = cv[0] * bv[0] - cv[1] * bv[1]; cbi[k] = cv[0] * bv[1] + cv[1] * bv[0]; }
#pragma unroll
            for (int l = 0; l < 8; ++l) { const f32x2 a = apow[(lg * 8 + l) * 64 + pp];
#pragma unroll
                for (int k = 0; k < 4; ++k) acc[l][k] += cbr[k] * a[0] - cbi[k] * a[1]; }
        }
#pragma unroll
        for (int l = 0; l < 8; ++l) { u32x2 o; o[0] = pk_bf16(acc[l][0], acc[l][1]); o[1] = pk_bf16(acc[l][2], acc[l][3]);
            *(u32x2*)(kt + (size_t)(63 + lg * 8 + l) * 256 + pg * 4) = o; }
        for (int e = tid; e < 63 * 256 / 8; e += NTHREADS) { u32x4 zz = {0u, 0u, 0u, 0u}; *(u32x4*)(kt + e * 8) = zz; }
    }
    for (int q = tid; q < 128 * 128; q += NTHREADS) {
        const int pq = q >> 7, kc = q & 127, tau = kc >> 1, c0 = (kc & 1) * 8, pp = pq & 63, im = pq >> 6;
        const f32x2 a = apow[(63 - tau) * 64 + pp]; float v[8];
#pragma unroll
        for (int e = 0; e < 8; ++e) { const f32x2 b = bb[pp * 16 + c0 + e]; v[e] = im ? (a[0] * b[1] + a[1] * b[0]) : (a[0] * b[0] - a[1] * b[1]); }
        u32x4 o; o[0] = pk_bf16(v[0], v[1]); o[1] = pk_bf16(v[2], v[3]); o[2] = pk_bf16(v[4], v[5]); o[3] = pk_bf16(v[6], v[7]);
        *(u32x4*)(w1 + (size_t)pq * 1024 + kc * 8) = o;
    }
    for (int q = tid; q < 1024 * 16; q += NTHREADS) {
        const int n = q >> 4, p0 = (q & 15) * 8, t = n >> 4, c = n & 15, im = p0 >> 6; float v[8];
#pragma unroll
        for (int e = 0; e < 8; ++e) { const int pp = (p0 + e) & 63; const f32x2 a = apow[(t + 1) * 64 + pp]; const f32x2 cv = cc[c * 64 + pp];
            v[e] = im ? -(cv[0] * a[1] + cv[1] * a[0]) : (cv[0] * a[0] - cv[1] * a[1]); }
        u32x4 o; o[0] = pk_bf16(v[0], v[1]); o[1] = pk_bf16(v[2], v[3]); o[2] = pk_bf16(v[4], v[5]); o[3] = pk_bf16(v[6], v[7]);
        *(u32x4*)(w3 + (size_t)n * 128 + p0) = o;
    }
    if (tid < 64) ((f32x2*)(p.ws + OFF_A64))[g * 64 + tid] = apow[64 * 64 + tid];
    __syncthreads();
}

__device__ __forceinline__ void wtile(const int wave_s, const Params& p, int t, char* lds) {
    int j = 0;
    for (int i = 1; i < p.njobs; ++i) if (t >= p.jobs[i].tile0) j = i;
    const WJob& J = p.jobs[j];
    const int lt = t - J.tile0, kt = lt / J.ntn, nt = lt - kt * J.ntn;
    const int k0 = kt * 64, nl0 = nt * 256;
    float* T = (float*)lds;
    int tid = get_tid(wave_s); asm volatile("" : "+v"(tid));
    const int c4 = (tid & 63) * 4, kb = tid >> 6;
    f32x4 v[8];
#pragma unroll
    for (int i = 0; i < 8; ++i) v[i] = *(const f32x4*)(J.src + (size_t)(k0 + kb + 8 * i) * J.ldsrc + J.col0 + nl0 + c4);
#pragma unroll
    for (int i = 0; i < 8; ++i) { const int kk = kb + 8 * i; float sc = J.scale; if (J.gain) sc *= J.gain[k0 + kk];
        T[kk * 257 + c4] = v[i][0] * sc; T[kk * 257 + c4 + 1] = v[i][1] * sc; T[kk * 257 + c4 + 2] = v[i][2] * sc; T[kk * 257 + c4 + 3] = v[i][3] * sc; }
    __syncthreads();
    { const int nn = tid >> 1, kh = (tid & 1) * 32;
        const int n = nl0 + nn; int row = (J.mode == 0) ? n : ((n >> 3) * 16 + (n & 7) + (J.mode == 2 ? 8 : 0)); row += J.rowoff;
        bf16_t* d = J.dst + (size_t)row * J.K + k0 + kh;
#pragma unroll
        for (int q = 0; q < 4; ++q) { float w[8];
#pragma unroll
            for (int e = 0; e < 8; ++e) w[e] = T[(kh + q * 8 + e) * 257 + nn];
            u32x4 o; o[0] = pk_bf16(w[0], w[1]); o[1] = pk_bf16(w[2], w[3]); o[2] = pk_bf16(w[4], w[5]); o[3] = pk_bf16(w[6], w[7]);
            *(u32x4*)(d + q * 8) = o; } }
    __syncthreads();
}

__device__ __forceinline__ void rms0_item(const int wave_s, const Params& p, int item) {
    const int lane = get_tid(wave_s) & 63, wid = wave_s;
    bf16_t* hn0 = (bf16_t*)(p.ws + OFF_HN0);
    f32x4 g[4];
#pragma unroll
    for (int i = 0; i < 4; ++i) g[i] = *(const f32x4*)(p.norm_mix_g + lane * 4 + 256 * i);
    for (int rb = 0; rb < 2; ++rb) {
        f32x4 v[4][4];
#pragma unroll
        for (int r = 0; r < 4; ++r)
#pragma unroll
            for (int i = 0; i < 4; ++i) v[r][i] = *(const f32x4*)(p.x + (size_t)(item * 64 + wid * 8 + rb * 4 + r) * DM + lane * 4 + 256 * i);
#pragma unroll
        for (int r = 0; r < 4; ++r) {
            const int row = item * 64 + wid * 8 + rb * 4 + r;
            float s = 0.f;
#pragma unroll
            for (int i = 0; i < 4; ++i) s += v[r][i][0] * v[r][i][0] + v[r][i][1] * v[r][i][1] + v[r][i][2] * v[r][i][2] + v[r][i][3] * v[r][i][3];
#pragma unroll
            for (int o = 32; o >= 1; o >>= 1) s += __shfl_xor(s, o);
            const float rs = rsqrtf(s * (1.0f / DM) + EPSV);
#pragma unroll
            for (int i = 0; i < 4; ++i) {
                u32x2 o; o[0] = pk_bf16(v[r][i][0] * rs * g[i][0], v[r][i][1] * rs * g[i][1]); o[1] = pk_bf16(v[r][i][2] * rs * g[i][2], v[r][i][3] * rs * g[i][3]);
                const int col = lane * 4 + 256 * i;
                *(u32x2*)(hn0 + (size_t)(col >> 4) * 262144 + (size_t)(row >> 6) * 1024 + (row & 63) * 16 + (col & 15)) = o; }
        }
    }
}

__device__ __forceinline__ void attn_item(const int wave_s, const Params& p, int head, int qb, float lam, char* lds) {
    int tid = get_tid(wave_s); asm volatile("" : "+v"(tid));
    const int lane = tid & 63, wid = tid >> 6;
    const int mp = wid >> 2, g = wid & 3;
    const int lr = lane & 31, h = lane >> 5, sw = (lane >> 1) & 7;
    const bf16_t* K1 = (const bf16_t*)(p.ws + OFF_K1) + (size_t)head * L_SEQ * 64;
    const bf16_t* K2 = (const bf16_t*)(p.ws + OFF_K2) + (size_t)head * L_SEQ * 64;
    const bf16_t* VT = (const bf16_t*)(p.ws + OFF_VT) + (size_t)head * 128 * L_SEQ;
    const bf16_t* Q = (const bf16_t*)(p.ws + (mp ? OFF_Q2 : OFF_Q1)) + (size_t)head * L_SEQ * 64;
    const int q0 = qb * 128 + g * 32;
    bf16x8 qf[4];
#pragma unroll
    for (int s = 0; s < 4; ++s) qf[s] = *(const bf16x8*)(Q + (size_t)(q0 + lr) * 64 + 16 * s + 8 * h);
    const int nkt = 2 * qb + 2;
    const int my_last = 2 * qb + (g >> 1);
    f32x16 O[4];
#pragma unroll
    for (int e = 0; e < 4; ++e)
#pragma unroll
        for (int r = 0; r < 16; ++r) O[e][r] = 0.f;
    float m_run = 0.f, l_run = 0.f;
    f32x16 negm;
#pragma unroll
    for (int r = 0; r < 16; ++r) negm[r] = 0.f;
    const int lrow = lane >> 3;
    const int ck = (lane & 7) ^ (((wave_s & 1) * 4 + (lane >> 4)) & 7);
    const int cv0 = (lane & 7) ^ (lane >> 4), cv1 = (lane & 7) ^ (4 + (lane >> 4));
    const bf16_t* k1p = K1 + (size_t)(wave_s * 8 + lrow) * 64 + ck * 8;
    const bf16_t* k2p = K2 + (size_t)(wave_s * 8 + lrow) * 64 + ck * 8;
    const bf16_t* v0p = VT + (size_t)(wave_s * 16 + lrow) * L_SEQ + cv0 * 8;
    const bf16_t* v1p = VT + (size_t)(wave_s * 16 + 8 + lrow) * L_SEQ + cv1 * 8;
    auto issue = [&](int kt) {
        char* st = lds + (kt & 3) * 32768;
        __builtin_amdgcn_global_load_lds((const unsigned*)(k1p + (size_t)kt * 4096), (__attribute__((address_space(3))) unsigned*)(st + wave_s * 1024), 16, 0, 0);
        __builtin_amdgcn_global_load_lds((const unsigned*)(k2p + (size_t)kt * 4096), (__attribute__((address_space(3))) unsigned*)(st + 8192 + wave_s * 1024), 16, 0, 0);
        __builtin_amdgcn_global_load_lds((const unsigned*)(v0p + kt * 64), (__attribute__((address_space(3))) unsigned*)(st + 16384 + wave_s * 2048), 16, 0, 0);
        __builtin_amdgcn_global_load_lds((const unsigned*)(v1p + kt * 64), (__attribute__((address_space(3))) unsigned*)(st + 16384 + wave_s * 2048 + 1024), 16, 0, 0);
    };
    issue(0); issue(1);
    if (nkt > 2) issue(2);
    if (nkt > 2) asm volatile("s_waitcnt vmcnt(8)" ::: "memory");
    else asm volatile("s_waitcnt vmcnt(4)" ::: "memory");
    __builtin_amdgcn_s_barrier(); asm volatile("" ::: "memory");
    const int koff_ = mp * 8192 + lr * 128, voff_ = 16384 + lr * 128;
    int chk[4], chv[4];
#pragma unroll
    for (int s = 0; s < 4; ++s) { chk[s] = ((2 * s + h) ^ sw) << 4; chv[s] = chk[s]; }
    bf16x8 kf[8], vf[8];
#pragma unroll
    for (int i = 0; i < 8; ++i) kf[i] = *(const bf16x8*)(lds + koff_ + (i >> 2) * 4096 + chk[i & 3]);
    for (int kt = 0; kt < nkt; ++kt) {
        const bool active = kt <= my_last;
        const char* stg = lds + (kt & 3) * 32768;
        f32x16 S[2];
        bf16x8 pf[2][2];
        if (active) {
#pragma unroll
            for (int kb = 0; kb < 2; ++kb) {
                S[kb] = __builtin_amdgcn_mfma_f32_32x32x16_bf16(kf[kb * 4], qf[0], negm, 0, 0, 0);
#pragma unroll
                for (int s = 1; s < 4; ++s) S[kb] = __builtin_amdgcn_mfma_f32_32x32x16_bf16(kf[kb * 4 + s], qf[s], S[kb], 0, 0, 0);
            }
#pragma unroll
            for (int i = 0; i < 8; ++i) vf[i] = *(const bf16x8*)(stg + voff_ + (i & 3) * 4096 + chv[i >> 2]);
            __builtin_amdgcn_sched_barrier(0);
            float mt = S[0][0];
#pragma unroll
            for (int r = 1; r < 16; ++r) mt = fmaxf(mt, S[0][r]);
#pragma unroll
            for (int r = 0; r < 16; ++r) mt = fmaxf(mt, S[1][r]);
            { const auto sw2 = __builtin_amdgcn_permlane32_swap(__float_as_uint(mt), __float_as_uint(mt), false, false);
              mt = fmaxf(__uint_as_float(sw2[0]), __uint_as_float(sw2[1])); }
            const bool need = (mt > 8.0f) || (kt == 0);
            if (__any(need)) {
                const float d = need ? mt : 0.f;
                const float alpha = fast_exp2(-d);
                m_run += d; l_run *= alpha;
#pragma unroll
                for (int r = 0; r < 16; ++r) negm[r] -= d;
#pragma unroll
                for (int kb = 0; kb < 2; ++kb)
#pragma unroll
                    for (int r = 0; r < 16; ++r) S[kb][r] -= d;
#pragma unroll
                for (int e = 0; e < 4; ++e)
#pragma unroll
                    for (int r = 0; r < 16; ++r) O[e][r] *= alpha;
            }
            f32x2 ls2 = {0.f, 0.f};
#pragma unroll
            for (int kb = 0; kb < 2; ++kb)
#pragma unroll
                for (int s = 0; s < 2; ++s) { float e_[8];
#pragma unroll
                    for (int j = 0; j < 8; ++j) e_[j] = fast_exp2(S[kb][8 * s + j]);
#pragma unroll
                    for (int j = 0; j < 8; j += 2) { f32x2 t2 = {e_[j], e_[j + 1]}; ls2 += t2; }
                    u32x4 pk; pk[0] = pk_bf16(e_[0], e_[1]); pk[1] = pk_bf16(e_[2], e_[3]); pk[2] = pk_bf16(e_[4], e_[5]); pk[3] = pk_bf16(e_[6], e_[7]);
                    pf[kb][s] = __builtin_bit_cast(bf16x8, pk); }
            const float ls = ls2[0] + ls2[1];
            l_run += ls;
        }
        const int rem = nkt - 1 - kt;
        if (rem >= 2) asm volatile("s_waitcnt vmcnt(4)" ::: "memory");
        else asm volatile("s_waitcnt vmcnt(0)" ::: "memory");
        __builtin_amdgcn_s_barrier(); asm volatile("" ::: "memory");
        if (kt + 3 < nkt) issue(kt + 3);
        if (kt + 1 <= my_last) {
            const char* sn = lds + ((kt + 1) & 3) * 32768;
#pragma unroll
            for (int i = 0; i < 8; ++i) kf[i] = *(const bf16x8*)(sn + koff_ + (i >> 2) * 4096 + chk[i & 3]);
        }
        __builtin_amdgcn_sched_barrier(0);
        if (active) {
#pragma unroll
            for (int i = 0; i < 8; ++i) O[i & 3] = __builtin_amdgcn_mfma_f32_32x32x16_bf16(vf[i], pf[0][i >> 2], O[i & 3], 0, 0, 0);
#pragma unroll
            for (int i = 0; i < 8; ++i) vf[i] = *(const bf16x8*)(stg + voff_ + (i & 3) * 4096 + (((4 + 2 * (i >> 2) + h) ^ sw) << 4));
#pragma unroll
            for (int i = 0; i < 8; ++i) O[i & 3] = __builtin_amdgcn_mfma_f32_32x32x16_bf16(vf[i], pf[1][i >> 2], O[i & 3], 0, 0, 0);
        }
    }
    __syncthreads();
    const float lt = l_run + __shfl_xor(l_run, 32);
    const float inv = fast_rcp(lt) * (mp ? lam : 1.0f);
    float* ex = (float*)lds;
    if (mp == 1) {
#pragma unroll
        for (int e = 0; e < 4; ++e)
#pragma unroll
            for (int r = 0; r < 16; ++r) ex[((g * 4 + e) * 16 + r) * 64 + lane] = O[e][r] * inv;
    }
    __syncthreads();
    if (mp == 0) {
        float ss = 0.f;
#pragma unroll
        for (int e = 0; e < 4; ++e)
#pragma unroll
            for (int r = 0; r < 16; ++r) { const float o = O[e][r] * inv - ex[((g * 4 + e) * 16 + r) * 64 + lane]; O[e][r] = o; ss += o * o; }
        ss += __shfl_xor(ss, 32);
        const float rs = rsqrtf(ss * (1.0f / 128.0f) + EPSV) * (1.0f - LAM_INIT);
        bf16_t* on = (bf16_t*)(p.ws + OFF_ON) + (size_t)(q0 + lr) * DM + head * 128;
#pragma unroll
        for (int e = 0; e < 4; ++e)
#pragma unroll
            for (int rq = 0; rq < 4; ++rq) { const int ee = e * 32 + rq * 8 + 4 * h; const f32x4 gg = *(const f32x4*)(p.subln_g + ee);
                u32x2 b; b[0] = pk_bf16(O[e][4 * rq] * rs * gg[0], O[e][4 * rq + 1] * rs * gg[1]); b[1] = pk_bf16(O[e][4 * rq + 2] * rs * gg[2], O[e][4 * rq + 3] * rs * gg[3]);
                *(u32x2*)(on + ee) = b; }
    }
    __syncthreads();
}


#define XB_XCNT(j)  (64 + 64 * (j))
#define XB_XSUB(j)  (1088 + 64 * (j))
#define XB_XGEN(j)  (2112 + 64 * (j))
#define XB_TOP      3136
#define XB_TOPGEN   3200
#define XB_WORDS    3264
__device__ __forceinline__ unsigned xb_ld(unsigned* p) { return __hip_atomic_load(p, __ATOMIC_RELAXED, __HIP_MEMORY_SCOPE_AGENT); }
__device__ __forceinline__ unsigned xb_add(unsigned* p, unsigned v) { return __hip_atomic_fetch_add(p, v, __ATOMIC_RELAXED, __HIP_MEMORY_SCOPE_AGENT); }
__device__ __forceinline__ unsigned xb_xcc_id() { return (unsigned)__builtin_amdgcn_s_getreg((3 << 11) | 20) & 0xFu; }
__device__ __forceinline__ void gbar(const int wave_s, unsigned* bar, volatile unsigned* st) {
    asm volatile("s_waitcnt vmcnt(0)" ::: "memory");
    __syncthreads();
    if (get_tid(wave_s) == 0) {
        __builtin_amdgcn_s_waitcnt(0);
        const unsigned x = st[2], nloc = st[0], nx = st[1];
        const unsigned old = xb_add(&bar[XB_XSUB(x)], 1u);
        const unsigned gen = old / nloc;
        if (old + 1u == (gen + 1u) * nloc) {
            __builtin_amdgcn_fence(__ATOMIC_RELEASE, "agent");
            asm volatile("s_waitcnt vmcnt(0)" ::: "memory");
            const unsigned og = xb_add(&bar[XB_TOP], 1u);
            const unsigned tg = og / nx;
            if (og + 1u == (tg + 1u) * nx) xb_add(&bar[XB_TOPGEN], 1u);
            else while (xb_ld(&bar[XB_TOPGEN]) == tg) __builtin_amdgcn_s_sleep(1);
            __builtin_amdgcn_fence(__ATOMIC_ACQUIRE, "agent");
            xb_add(&bar[XB_XGEN(x)], 1u);
            asm volatile("s_waitcnt vmcnt(0)" ::: "memory");
        } else {
            while (xb_ld(&bar[XB_XGEN(x)]) == gen) __builtin_amdgcn_s_sleep(1);
            __builtin_amdgcn_fence(__ATOMIC_ACQUIRE, "agent");
            asm volatile("s_waitcnt vmcnt(0)" ::: "memory");
        }
    }
    __syncthreads();
}

__device__ __forceinline__ bool tile_map(int r, int bid, int nb, int NT, int& nt, int& mt) {
    if (nb == 256) {
        const int x = bid & 7, li = bid >> 3, q = li + 32 * r;
        if (q >= 8 * NT) return false;
        const int mi = q & 3, rest = q >> 2, mg = rest / NT;
        nt = rest - mg * NT; mt = x * 8 + mg * 4 + mi; return true;
    }
    const int t = bid + r * nb; if (t >= NT * 64) return false;
    nt = t % NT; mt = t / NT; return true;
}

__global__ void __launch_bounds__(NTHREADS) mega(const Params p) {
    __shared__ __attribute__((aligned(16))) char lds[LDS_BYTES];
    cg::grid_group grid = cg::this_grid();
    const int wave_s = __builtin_amdgcn_readfirstlane((int)(threadIdx.x >> 6));
    const int nb = gridDim.x, bid = blockIdx.x;
    char* ws = p.ws;
    bf16_t* hn0 = (bf16_t*)(ws + OFF_HN0);
    bf16_t* hb = (bf16_t*)(ws + OFF_HB);
    float* ssq0 = (float*)(ws + OFF_SSQ);
    float* ssq1 = ssq0 + 16 * L_SEQ; float* ssq2 = ssq1 + 16 * L_SEQ; float* ssq3 = ssq2 + 16 * L_SEQ;
    const Seg nul = {nullptr, 0, 0, nullptr, 0, 0};
    unsigned* bar = (unsigned*)(ws + OFF_BAR);
    volatile unsigned* xst = (volatile unsigned*)(lds + LDS_BYTES - 16);
    if (get_tid(wave_s) == 0) xb_add(&bar[XB_XCNT(xb_xcc_id())], 1u);
    grid.sync();
    if (get_tid(wave_s) == 0) {
        const unsigned x = xb_xcc_id(); unsigned cnt = 0u, mine = 1u;
        for (unsigned j = 0; j < 16; ++j) { const unsigned c = xb_ld(&bar[XB_XCNT(j)]); cnt += (c > 0u) ? 1u : 0u; if (j == x) mine = c; }
        xst[0] = mine ? mine : 1u; xst[1] = cnt ? cnt : 1u; xst[2] = x;
    }
    __syncthreads();

    { const int nwork = p.ntiles_w + 256;
      for (int rep = 0; rep < REP_PREP; ++rep) {
          if (nb >= 128) {
              if (bid < 64) s5_tables(wave_s, p, bid, lds);
              else for (int it = bid - 64; it < 256; it += nb - 64) rms0_item(wave_s, p, it);
          } else {
              for (int it = bid; it < 64 + nwork; it += nb) { if (it < 64) s5_tables(wave_s, p, it, lds); else if (it < 64 + p.ntiles_w) wtile(wave_s, p, it - 64, lds); else rms0_item(wave_s, p, it - 64 - p.ntiles_w); }
          }
      } }
    gbar(wave_s, bar, xst);
    if (nb >= 128 && bid >= 64) for (int it = bid - 64; it < p.ntiles_w; it += nb - 64) wtile(wave_s, p, it, lds);
    for (int rep = 0; rep < REP_SLOC; ++rep)
    for (int g = bid; g < 64; g += nb) {
        Seg s = {(const bf16_t*)(ws + OFF_W1) + (size_t)g * 128 * 1024, 1024, 16, hn0 + (size_t)g * 262144, 1024, 16};
        EpiSloc e = {(float*)lds};
        gemm_tile(wave_s, lds, s, 16, nul, 0, e);
        __syncthreads();
        {
            const int lane_ = get_tid(wave_s) & 63, w_ = wave_s;
            const f32x2 a = ((const f32x2*)(ws + OFF_A64))[g * 64 + lane_];
            const float* sl = (const float*)lds + (w_ * 32) * 132;
            float sr = 0.f, si = 0.f;
#pragma unroll
            for (int j = 0; j < 32; ++j) { const float xr = sl[j * 132 + lane_], xi = sl[j * 132 + 64 + lane_]; const float nr = a[0] * sr - a[1] * si + xr, ni = a[0] * si + a[1] * sr + xi; sr = nr; si = ni; }
            f32x2* carry = (f32x2*)(lds + 135168);
            { f32x2 c; c[0] = sr; c[1] = si; carry[w_ * 64 + lane_] = c; }
            float pr = a[0], pi = a[1];
#pragma unroll
            for (int q = 0; q < 5; ++q) { const float nr = pr * pr - pi * pi, ni = 2.f * pr * pi; pr = nr; pi = ni; }
            __syncthreads();
            sr = 0.f; si = 0.f;
            for (int v = 0; v < w_; ++v) { const f32x2 c = carry[v * 64 + lane_]; const float nr = pr * sr - pi * si + c[0], ni = pr * si + pi * sr + c[1]; sr = nr; si = ni; }
            bf16_t* sp = (bf16_t*)(ws + OFF_SPREV) + (size_t)g * 256 * 128 + (size_t)(w_ * 32) * 128;
#pragma unroll
            for (int j = 0; j < 32; ++j) {
                sp[j * 128 + lane_] = (bf16_t)(pk_bf16(sr, 0.f) & 0xffffu); sp[j * 128 + 64 + lane_] = (bf16_t)(pk_bf16(si, 0.f) & 0xffffu);
                const float xr = sl[j * 132 + lane_], xi = sl[j * 132 + 64 + lane_];
                const float nr = a[0] * sr - a[1] * si + xr, ni = a[0] * si + a[1] * sr + xi; sr = nr; si = ni;
            }
        }
        __syncthreads();
    }
    gbar(wave_s, bar, xst);
    for (int rep = 0; rep < REP_S5; ++rep)
    for (int t0 = bid; t0 < 256; t0 += nb) {
        const int t = (nb == 256) ? ((t0 & 7) * 32 + (t0 >> 3)) : t0;
        const int g = t >> 2, i = 3 - (t & 3);
        const bf16_t* sprev = (const bf16_t*)(ws + OFF_SPREV) + (size_t)g * 256 * 128;
        Seg s0 = {(const bf16_t*)(ws + OFF_KT) + (size_t)g * 127 * 256 + 63 * 256 + (size_t)(i * 256) * 16, 16, -256, hn0 + (size_t)g * 262144, 1024, 16};
        Seg s1 = {(const bf16_t*)(ws + OFF_W3) + (size_t)g * 1024 * 128 + (size_t)(i * 256) * 128, 128, 16, sprev, 128, 16};
        EpiS5 e = {hn0, p.ssm_d, (bf16_t*)(ws + OFF_Z), g, i * 256};
        gemm_tile(wave_s, lds, s0, 4 * (i + 1), s1, 2, e);
    }
    gbar(wave_s, bar, xst);
    for (int rep = 0; rep < REP_GLU; ++rep)
    for (int r = 0, nt, mt; tile_map(r, bid, nb, 8, nt, mt); ++r) {
        Seg s = {(const bf16_t*)(ws + OFF_WGLU) + (size_t)nt * 256 * DM, DM, 16, (const bf16_t*)(ws + OFF_Z) + (size_t)mt * 256 * 16, 16, 262144};
        EpiGlu e = {p.x, p.out, hb, ssq0, nt * 256, mt * 256};
        gemm_tile(wave_s, lds, s, 16, nul, 0, e);
    }
    gbar(wave_s, bar, xst);
#pragma unroll
    for (int layer = 0; layer < 2; ++layer) {
        if (layer == 1) {
            for (int rep = 0; rep < REP_KVQ; ++rep) {
                int nt = 0, mt = 0; bool have = tile_map(0, bid, nb, 12, nt, mt), pro = false;
                for (int r = 0; have; ++r) {
                    int nnt = 0, nmt = 0; const bool hn = tile_map(r + 1, bid, nb, 12, nnt, nmt);
                    Seg s = {(const bf16_t*)(ws + OFF_WKVQ) + (size_t)nt * 256 * DM, DM, 16, hb + (size_t)mt * 256 * DM, DM, 16};
                    Seg sn = {(const bf16_t*)(ws + OFF_WKVQ) + (size_t)nnt * 256 * DM, DM, 16, hb + (size_t)nmt * 256 * DM, DM, 16};
                    const bool curV = (nt >= 4 && nt < 8);
                    EpiKvq e = {ssq1, ws, lds, nt * 256, mt * 256, {0.f, 0.f}};
                    gemm_tile(wave_s, lds, s, 16, nul, 0, e, pro, hn && !curV, sn);
                    pro = hn && !curV; nt = nnt; mt = nmt; have = hn;
                }
            }
            gbar(wave_s, bar, xst);
            {
                float a1 = 0.f, a2 = 0.f;
                for (int i = 0; i < 64; ++i) { a1 += p.lq1[i] * p.lk1[i]; a2 += p.lq2[i] * p.lk2[i]; }
                const float lam = expf(a1) - expf(a2) + LAM_INIT;
                for (int rep = 0; rep < REP_ATTN; ++rep)
                for (int it = bid; it < 1024; it += nb) {
                    const int head = it & 7, r = it >> 3, rnd = r >> 5, j = r & 31;
                    const int qb = (rnd == 0) ? 127 - j : (rnd == 1) ? 64 + j : (rnd == 2) ? 63 - j : j;
                    attn_item(wave_s, p, head, qb, lam, lds);
                }
            }
            gbar(wave_s, bar, xst);
            for (int r = 0, nt, mt; tile_map(r, bid, nb, 4, nt, mt); ++r) {
                Seg s = {(const bf16_t*)(ws + OFF_WO) + (size_t)nt * 256 * DM, DM, 16, (const bf16_t*)(ws + OFF_ON) + (size_t)mt * 256 * DM, DM, 16};
                EpiRes e = {p.out, hb, ssq2, nt * 256, mt * 256};
                gemm_tile(wave_s, lds, s, 16, nul, 0, e);
            }
            gbar(wave_s, bar, xst);
        }
        {
            const bf16_t* wup = (const bf16_t*)(ws + (layer ? OFF_WUP1 : OFF_WUP0));
            for (int rep = 0; rep < REP_UP; ++rep) {
                int nt = 0, mt = 0; bool have = tile_map(0, bid, nb, 22, nt, mt), pro = false;
                for (int r = 0; have; ++r) {
                    int nnt = 0, nmt = 0; const bool hn = tile_map(r + 1, bid, nb, 22, nnt, nmt);
                    Seg s = {wup + (size_t)nt * 256 * DM, DM, 16, hb + (size_t)mt * 256 * DM, DM, 16};
                    Seg sn = {wup + (size_t)nnt * 256 * DM, DM, 16, hb + (size_t)nmt * 256 * DM, DM, 16};
                    if (layer == 0) { EpiUp<16> e = {ssq0, (bf16_t*)(ws + OFF_ACT), nt * 256, mt * 256, {0.f, 0.f}}; gemm_tile(wave_s, lds, s, 16, nul, 0, e, pro, hn, sn); }
                    else { EpiUp<8> e = {ssq2, (bf16_t*)(ws + OFF_ACT), nt * 256, mt * 256, {0.f, 0.f}}; gemm_tile(wave_s, lds, s, 16, nul, 0, e, pro, hn, sn); }
                    pro = hn; nt = nnt; mt = nmt; have = hn;
                }
            }
        }
        gbar(wave_s, bar, xst);
        {
            const bf16_t* wdn = (const bf16_t*)(ws + (layer ? OFF_WDN1 : OFF_WDN0));
            for (int r = 0, nt, mt; tile_map(r, bid, nb, 4, nt, mt); ++r) {
                Seg s = {wdn + (size_t)nt * 256 * FFN, FFN, 16, (const bf16_t*)(ws + OFF_ACT) + (size_t)mt * 256 * FFN, FFN, 16};
                EpiRes e = {p.out, layer ? (bf16_t*)nullptr : hb, layer ? ssq3 : ssq1, nt * 256, mt * 256};
                gemm_tile(wave_s, lds, s, FFN / 64, nul, 0, e);
            }
        }
        gbar(wave_s, bar, xst);
    }
    {
        const int lane = get_tid(wave_s) & 63, wid = wave_s;
        for (int row = bid * 8 + wid; row < L_SEQ; row += nb * 8) {
            float s = 0.f;
            for (int i = 0; i < 8; ++i) s += ssq3[(size_t)i * L_SEQ + row];
            const float rs = rsqrtf(s * (1.0f / DM) + EPSV);
#pragma unroll
            for (int i = 0; i < 4; ++i) { const size_t off = (size_t)row * DM + lane * 4 + 256 * i;
                f32x4 v = *(const f32x4*)(p.out + off); const f32x4 g = *(const f32x4*)(p.final_g + lane * 4 + 256 * i);
                v[0] *= rs * g[0]; v[1] *= rs * g[1]; v[2] *= rs * g[2]; v[3] *= rs * g[3]; *(f32x4*)(p.out + off) = v; }
        }
    }
}

static void add_job(Params& P, int& nt, const float* src, bf16_t* dst, const float* gain, int K, int N, int ld, int col0, int mode, int rowoff, float scale) {
    WJob& J = P.jobs[P.njobs++];
    J.src = src; J.dst = dst; J.gain = gain; J.K = K; J.N = N; J.ldsrc = ld; J.col0 = col0; J.mode = mode; J.rowoff = rowoff; J.scale = scale; J.tile0 = nt; J.ntn = N / 256; J.pad = 0;
    nt += (K / 64) * (N / 256);
}

extern "C" void kernel_launch(void* const* d_in, const int* in_sizes, int n_in, void* d_out, int out_size, void* d_ws, size_t ws_size, hipStream_t stream) {
    Params P; memset(&P, 0, sizeof(P));
    P.x = (const float*)d_in[0]; P.norm_mix_g = (const float*)d_in[1]; P.norm_ffn_g = (const float*)d_in[2];
    P.ffn_w1 = (const float*)d_in[3]; P.ffn_w3 = (const float*)d_in[4]; P.ffn_w2 = (const float*)d_in[5];
    P.lam_re = (const float*)d_in[6]; P.lam_im = (const float*)d_in[7]; P.log_dt = (const float*)d_in[8];
    P.b_re = (const float*)d_in[9]; P.b_im = (const float*)d_in[10]; P.c_re = (const float*)d_in[11]; P.c_im = (const float*)d_in[12];
    P.ssm_d = (const float*)d_in[13]; P.w_glu = (const float*)d_in[14]; P.kv_norm_g = (const float*)d_in[15]; P.w_kv = (const float*)d_in[16];
    P.w_q = (const float*)d_in[17]; P.lq1 = (const float*)d_in[18]; P.lk1 = (const float*)d_in[19]; P.lq2 = (const float*)d_in[20]; P.lk2 = (const float*)d_in[21];
    P.subln_g = (const float*)d_in[22]; P.w_o = (const float*)d_in[23]; P.final_g = (const float*)d_in[24];
    P.out = (float*)d_out; P.ws = (char*)d_ws;
    char* ws = (char*)d_ws; int nt = 0;
    const size_t FW = (size_t)DM * FFN;
    add_job(P, nt, P.w_glu, (bf16_t*)(ws + OFF_WGLU), nullptr, DM, 1024, 2048, 0, 1, 0, 1.0f);
    add_job(P, nt, P.w_glu, (bf16_t*)(ws + OFF_WGLU), nullptr, DM, 1024, 2048, 1024, 2, 0, 1.0f);
    add_job(P, nt, P.ffn_w1, (bf16_t*)(ws + OFF_WUP0), P.norm_ffn_g, DM, FFN, FFN, 0, 1, 0, 1.0f);
    add_job(P, nt, P.ffn_w3, (bf16_t*)(ws + OFF_WUP0), P.norm_ffn_g, DM, FFN, FFN, 0, 2, 0, 1.0f);
    add_job(P, nt, P.ffn_w2, (bf16_t*)(ws + OFF_WDN0), nullptr, FFN, DM, DM, 0, 0, 0, 1.0f);
    add_job(P, nt, P.w_kv, (bf16_t*)(ws + OFF_WKVQ), P.kv_norm_g, DM, 2048, 2048, 0, 0, 0, 1.0f);
    add_job(P, nt, P.w_q, (bf16_t*)(ws + OFF_WKVQ), P.norm_mix_g + DM, DM, 1024, 1024, 0, 0, 2048, QSCALE);
    add_job(P, nt, P.w_o, (bf16_t*)(ws + OFF_WO), nullptr, DM, DM, DM, 0, 0, 0, 1.0f);
    add_job(P, nt, P.ffn_w1 + FW, (bf16_t*)(ws + OFF_WUP1), P.norm_ffn_g + DM, DM, FFN, FFN, 0, 1, 0, 1.0f);
    add_job(P, nt, P.ffn_w3 + FW, (bf16_t*)(ws + OFF_WUP1), P.norm_ffn_g + DM, DM, FFN, FFN, 0, 2, 0, 1.0f);
    add_job(P, nt, P.ffn_w2 + FW, (bf16_t*)(ws + OFF_WDN1), nullptr, FFN, DM, DM, 0, 0, 0, 1.0f);
    P.ntiles_w = nt;
    static int grid_blocks = 0;
    if (!grid_blocks) {
        int dev = 0, cus = 0, per_cu = 0;
        hipGetDevice(&dev);
        hipDeviceGetAttribute(&cus, hipDeviceAttributeMultiprocessorCount, dev);
        hipOccupancyMaxActiveBlocksPerMultiprocessor(&per_cu, mega, NTHREADS, 0);
        if (per_cu < 1) per_cu = 1;
        grid_blocks = cus * 1;
    }
    hipMemsetAsync(ws + OFF_BAR, 0, 16384, stream);
    void* args[] = {&P};
    hipError_t e = hipLaunchCooperativeKernel((void*)mega, dim3(grid_blocks), dim3(NTHREADS), args, 0, stream);
    if (e != hipSuccess) fprintf(stderr, "cooperative launch failed: %s (grid %d)\n", hipGetErrorString(e), grid_blocks);
}
```

```cpp
#include <hip/hip_runtime.h>
#include <hip/hip_cooperative_groups.h>
#include <stdint.h>
#include <string.h>
#include <stdio.h>
namespace cg = cooperative_groups;

typedef unsigned short bf16_t;
typedef short bf16x8 __attribute__((ext_vector_type(8)));
typedef float f32x16 __attribute__((ext_vector_type(16)));
typedef float f32x4 __attribute__((ext_vector_type(4)));
typedef float f32x2 __attribute__((ext_vector_type(2)));
typedef unsigned u32x4 __attribute__((ext_vector_type(4)));
typedef unsigned u32x2 __attribute__((ext_vector_type(2)));

#define L_SEQ 16384
#define DM 1024
#define FFN 2816
#define NTHREADS 512
#ifndef REP_ATTN
#define REP_ATTN 1
#endif
#ifndef REP_UP
#define REP_UP 1
#endif
#define REP_GLU 1
#define REP_KVQ 1
#define REP_S5 1
#define REP_SLOC 1
#define REP_PREP 1
#define LDS_BYTES 139280
#define EPSV 1e-6f
#define LAM_INIT 0.35550906759096927f
#define QSCALE 0.18033688011112042f

static constexpr size_t MiB = 1024ull * 1024ull;
static constexpr size_t OFF_WGLU = 0;
static constexpr size_t OFF_WUP0 = 4 * MiB;
static constexpr size_t OFF_WDN0 = 15 * MiB;
static constexpr size_t OFF_WKVQ = 20 * MiB + MiB / 2;
static constexpr size_t OFF_WO = 26 * MiB + MiB / 2;
static constexpr size_t OFF_WUP1 = 28 * MiB + MiB / 2;
static constexpr size_t OFF_WDN1 = 39 * MiB + MiB / 2;
static constexpr size_t OFF_SSQ = 45 * MiB;
static constexpr size_t OFF_A64 = 49 * MiB;
static constexpr size_t OFF_BAR = 49 * MiB + MiB / 2;
static constexpr size_t OFF_A = 50 * MiB;
static constexpr size_t OFF_HN0 = OFF_A;
static constexpr size_t OFF_Z = OFF_A + 32 * MiB;
static constexpr size_t OFF_ACT = OFF_A;
static constexpr size_t OFF_K1 = OFF_A;
static constexpr size_t OFF_K2 = OFF_A + 16 * MiB;
static constexpr size_t OFF_VT = OFF_A + 32 * MiB;
static constexpr size_t OFF_Q1 = OFF_A + 64 * MiB;
static constexpr size_t OFF_Q2 = OFF_A + 80 * MiB;
static constexpr size_t OFF_B = 146 * MiB;
static constexpr size_t OFF_KT = OFF_B;
static constexpr size_t OFF_W1 = OFF_B + 4 * MiB;
static constexpr size_t OFF_W3 = OFF_B + 20 * MiB;
static constexpr size_t OFF_SLOC = OFF_B + 36 * MiB;
static constexpr size_t OFF_SPREV = OFF_B + 44 * MiB;
static constexpr size_t OFF_HB = OFF_B;
static constexpr size_t OFF_ON = OFF_B + 32 * MiB;

struct WJob { const float* src; bf16_t* dst; const float* gain; int K; int N; int ldsrc; int col0; int mode; int rowoff; float scale; int tile0; int ntn; int pad; };

struct Params {
    const float *x, *norm_mix_g, *norm_ffn_g, *ffn_w1, *ffn_w3, *ffn_w2;
    const float *lam_re, *lam_im, *log_dt, *b_re, *b_im, *c_re, *c_im, *ssm_d, *w_glu;
    const float *kv_norm_g, *w_kv, *w_q, *lq1, *lk1, *lq2, *lk2, *subln_g, *w_o, *final_g;
    float* out;
    char* ws;
    WJob jobs[12];
    int njobs; int ntiles_w;
};

__device__ __forceinline__ int get_tid(int wave_s) { int t = wave_s * 64 + (int)__builtin_amdgcn_mbcnt_hi(~0u, __builtin_amdgcn_mbcnt_lo(~0u, 0u)); asm volatile("" : "+v"(t)); return t; }
__device__ __forceinline__ unsigned pk_bf16(float lo, float hi) { unsigned r; asm("v_cvt_pk_bf16_f32 %0, %1, %2" : "=v"(r) : "v"(lo), "v"(hi)); return r; }
__device__ __forceinline__ float bf_lo(unsigned u) { return __uint_as_float(u << 16); }
__device__ __forceinline__ float bf_hi(unsigned u) { return __uint_as_float(u & 0xffff0000u); }
__device__ __forceinline__ float fast_rcp(float x) { return __builtin_amdgcn_rcpf(x); }
__device__ __forceinline__ float fast_exp2(float x) { return __builtin_amdgcn_exp2f(x); }
__device__ __forceinline__ float sigmoidf_(float x) { return fast_rcp(1.0f + fast_exp2(-1.4426950408889634f * x)); }
__device__ __forceinline__ float gelu_tanh(float x) {
    const float u = 0.7978845608028654f * x * (1.0f + 0.044715f * x * x);
    return x * fast_rcp(1.0f + fast_exp2(-2.8853900817779268f * u));
}

struct Seg { const bf16_t* W; long wrs; long wkhi; const bf16_t* X; long xrs; long xkhi; };

struct TileCtx { int wn, wm, lane; };

template <int MB = 2, class Epi>
__device__ __forceinline__ void gemm_tile(const int wave_s, char* lds, const Seg s0, const int nk0_, const Seg s1, const int nk1_, Epi& epi,
                                          const bool pro_done = false, const bool has_next = false, const Seg nx = Seg{nullptr, 0, 0, nullptr, 0, 0}) {
    int tid = get_tid(wave_s);
    const int lane = tid & 63;
    const int wn = wave_s >> 2, wm = wave_s & 3;
    const int lr = lane & 31, h = lane >> 5;
    const int nk0 = nk0_ * 2, nk1 = nk1_ * 2, nk = nk0 + nk1;
    const int cch = (lane & 3) ^ ((lane >> 4) & 3);
    const int row0 = wave_s * 32 + (lane >> 2), rowx = wave_s * (16 * MB) + (lane >> 2);
    f32x16 acc[4][MB];
#pragma unroll
    for (int a = 0; a < 4; ++a)
#pragma unroll
        for (int b = 0; b < MB; ++b)
#pragma unroll
            for (int r = 0; r < 16; ++r) acc[a][b][r] = 0.f;
    auto issue = [&](int t) {
        const bool first = t < nk0;
        const bf16_t* W = first ? s0.W : s1.W; const bf16_t* X = first ? s0.X : s1.X;
        const long wrs = first ? s0.wrs : s1.wrs, xrs = first ? s0.xrs : s1.xrs;
        const long wkhi = first ? s0.wkhi : s1.wkhi, xkhi = first ? s0.xkhi : s1.xkhi;
        const int kt = first ? t : t - nk0;
        const long kc = kt * 2 + (cch >> 1);
        const bf16_t* wp = W + (long)row0 * wrs + kc * wkhi + (cch & 1) * 8;
        const bf16_t* xp = X + (long)rowx * xrs + kc * xkhi + (cch & 1) * 8;
        char* st = lds + (t & 3) * 32768 + wave_s * 2048;
        char* sx = lds + (t & 3) * 32768 + 16384 + wave_s * (1024 * MB);
        __builtin_amdgcn_global_load_lds((const unsigned*)wp, (__attribute__((address_space(3))) unsigned*)(st), 16, 0, 0);
        __builtin_amdgcn_global_load_lds((const unsigned*)(wp + 16 * wrs), (__attribute__((address_space(3))) unsigned*)(st + 1024), 16, 0, 0);
        __builtin_amdgcn_global_load_lds((const unsigned*)xp, (__attribute__((address_space(3))) unsigned*)(sx), 16, 0, 0);
        if (MB == 2) __builtin_amdgcn_global_load_lds((const unsigned*)(xp + 16 * xrs), (__attribute__((address_space(3))) unsigned*)(sx + 1024), 16, 0, 0);
    };
    const int sw = (lr >> 2) & 3;
    const int aoff = (wn * 128 + lr) * 64, boff = 16384 + (wm * (32 * MB) + lr) * 64;
    const int ch0 = ((0 + h) ^ sw) << 4, ch1 = ((2 + h) ^ sw) << 4;
    bf16x8 a0[4], b0[MB], a1[4], b1[MB];
    epi.pre(wm, lane, wn);
    if (!pro_done) { issue(0); issue(1); issue(2); issue(3); }
    if (MB == 2) asm volatile("s_waitcnt vmcnt(12)" ::: "memory"); else asm volatile("s_waitcnt vmcnt(9)" ::: "memory");
    __builtin_amdgcn_s_barrier(); asm volatile("" ::: "memory");
#pragma unroll
    for (int nb = 0; nb < 4; ++nb) a0[nb] = *(const bf16x8*)(lds + aoff + nb * 2048 + ch0);
#pragma unroll
    for (int mb = 0; mb < MB; ++mb) b0[mb] = *(const bf16x8*)(lds + boff + mb * 2048 + ch0);
    for (int t = 0; t < nk; ++t) {
        const char* st = lds + (t & 3) * 32768;
#pragma unroll
        for (int nb = 0; nb < 4; ++nb) a1[nb] = *(const bf16x8*)(st + aoff + nb * 2048 + ch1);
#pragma unroll
        for (int mb = 0; mb < MB; ++mb) b1[mb] = *(const bf16x8*)(st + boff + mb * 2048 + ch1);
#pragma unroll
        for (int nb = 0; nb < 4; ++nb)
#pragma unroll
            for (int mb = 0; mb < MB; ++mb) acc[nb][mb] = __builtin_amdgcn_mfma_f32_32x32x16_bf16(a0[nb], b0[mb], acc[nb][mb], 0, 0, 0);
        const int rem = nk - 1 - t;
        if (MB == 2) { if (rem >= 3) asm volatile("s_waitcnt vmcnt(8)" ::: "memory"); else if (rem == 2) asm volatile("s_waitcnt vmcnt(4)" ::: "memory"); else asm volatile("s_waitcnt vmcnt(0)" ::: "memory"); }
        else { if (rem >= 3) asm volatile("s_waitcnt vmcnt(6)" ::: "memory"); else if (rem == 2) asm volatile("s_waitcnt vmcnt(3)" ::: "memory"); else asm volatile("s_waitcnt vmcnt(0)" ::: "memory"); }
        asm volatile("s_waitcnt lgkmcnt(0)" ::: "memory");
        __builtin_amdgcn_s_barrier(); asm volatile("" ::: "memory");
        if (t + 4 < nk) issue(t + 4);
        if (t + 1 < nk) {
            const char* sn = lds + ((t + 1) & 3) * 32768;
#pragma unroll
            for (int nb = 0; nb < 4; ++nb) a0[nb] = *(const bf16x8*)(sn + aoff + nb * 2048 + ch0);
#pragma unroll
            for (int mb = 0; mb < MB; ++mb) b0[mb] = *(const bf16x8*)(sn + boff + mb * 2048 + ch0);
        }
#pragma unroll
        for (int nb = 0; nb < 4; ++nb)
#pragma unroll
            for (int mb = 0; mb < MB; ++mb) acc[nb][mb] = __builtin_amdgcn_mfma_f32_32x32x16_bf16(a1[nb], b1[mb], acc[nb][mb], 0, 0, 0);
    }
    if (MB == 2 && has_next) {
#pragma unroll
        for (int t = 0; t < 4; ++t) {
            const long kc = t * 2 + (cch >> 1);
            const bf16_t* wp = nx.W + (long)row0 * nx.wrs + kc * nx.wkhi + (cch & 1) * 8;
            const bf16_t* xp = nx.X + (long)rowx * nx.xrs + kc * nx.xkhi + (cch & 1) * 8;
            char* st = lds + t * 32768 + wave_s * 2048;
            __builtin_amdgcn_global_load_lds((const unsigned*)wp, (__attribute__((address_space(3))) unsigned*)(st), 16, 0, 0);
            __builtin_amdgcn_global_load_lds((const unsigned*)(wp + 16 * nx.wrs), (__attribute__((address_space(3))) unsigned*)(st + 1024), 16, 0, 0);
            __builtin_amdgcn_global_load_lds((const unsigned*)xp, (__attribute__((address_space(3))) unsigned*)(st + 16384), 16, 0, 0);
            __builtin_amdgcn_global_load_lds((const unsigned*)(xp + 16 * nx.xrs), (__attribute__((address_space(3))) unsigned*)(st + 16384 + 1024), 16, 0, 0);
        }
    }
    TileCtx c; c.wn = wn; c.wm = wm; c.lane = lane;
    epi(acc, c);
}

template <int NPART>
__device__ __forceinline__ float rstd_from(const float* ssq, int token) {
    float v[NPART];
#pragma unroll
    for (int i = 0; i < NPART; ++i) v[i] = ssq[(size_t)i * L_SEQ + token];
    float s = 0.f;
#pragma unroll
    for (int i = 0; i < NPART; ++i) s += v[i];
    return rsqrtf(s * (1.0f / DM) + EPSV);
}

__device__ __forceinline__ u32x4 widen8(u32x2 A, u32x2 B) {
    const auto r0 = __builtin_amdgcn_permlane32_swap(A[0], B[0], false, false);
    const auto r1 = __builtin_amdgcn_permlane32_swap(A[1], B[1], false, false);
    u32x4 o; o[0] = r0[0]; o[1] = r1[0]; o[2] = r0[1]; o[3] = r1[1]; return o;
}

struct EpiSloc {
    float* dst;
    __device__ __forceinline__ void pre(int, int, int) {}
    __device__ __forceinline__ void operator()(f32x16 (&acc)[4][2], const TileCtx& c) const {
        if (c.wn != 0) return;
        const int lr = c.lane & 31, h = c.lane >> 5;
#pragma unroll
        for (int mb = 0; mb < 2; ++mb) { const int m = c.wm * 64 + mb * 32 + lr;
#pragma unroll
            for (int nb = 0; nb < 4; ++nb)
#pragma unroll
                for (int rq = 0; rq < 4; ++rq) { const int n = nb * 32 + rq * 8 + 4 * h;
                    f32x4 v = {acc[nb][mb][4 * rq], acc[nb][mb][4 * rq + 1], acc[nb][mb][4 * rq + 2], acc[nb][mb][4 * rq + 3]};
                    *(f32x4*)(dst + m * 132 + n) = v; } }
    }
};

struct EpiS5 {
    const bf16_t* hn0; const float* dskip; bf16_t* z; int g; int n0;
    __device__ __forceinline__ void pre(int, int, int) {}
    __device__ __forceinline__ void operator()(f32x16 (&acc)[4][2], const TileCtx& c) const {
        const int lr = c.lane & 31, h = c.lane >> 5;
#pragma unroll
        for (int mb = 0; mb < 2; ++mb) { const int j = c.wm * 64 + mb * 32 + lr;
            u32x2 uu[16], zz[16];
#pragma unroll
            for (int q = 0; q < 16; ++q) { const int n = n0 + c.wn * 128 + (q >> 2) * 32 + (q & 3) * 8 + 4 * h; uu[q] = *(const u32x2*)(hn0 + (size_t)g * 262144 + (size_t)j * 1024 + n); }
            asm volatile("" ::: "memory");
#pragma unroll
            for (int q = 0; q < 16; ++q) { const int nb = q >> 2, rq = q & 3; const int n = n0 + c.wn * 128 + nb * 32 + rq * 8 + 4 * h; const int t = n >> 4, cc = n & 15;
                const size_t off = (size_t)g * 262144 + (size_t)(j * 64 + t) * 16 + cc; const f32x4 d4 = *(const f32x4*)(dskip + g * 16 + cc);
                const float y0 = acc[nb][mb][4 * rq] + d4[0] * bf_lo(uu[q][0]), y1 = acc[nb][mb][4 * rq + 1] + d4[1] * bf_hi(uu[q][0]);
                const float y2 = acc[nb][mb][4 * rq + 2] + d4[2] * bf_lo(uu[q][1]), y3 = acc[nb][mb][4 * rq + 3] + d4[3] * bf_hi(uu[q][1]);
                zz[q][0] = pk_bf16(gelu_tanh(y0), gelu_tanh(y1)); zz[q][1] = pk_bf16(gelu_tanh(y2), gelu_tanh(y3)); (void)off; }
#pragma unroll
            for (int q = 0; q < 16; q += 2) { const int n = n0 + c.wn * 128 + (q >> 2) * 32 + (q & 3) * 8 + 8 * h;
                *(u32x4*)(z + (size_t)g * 262144 + (size_t)(j * 64 + (n >> 4)) * 16 + (n & 15)) = widen8(zz[q], zz[q + 1]); }
            asm volatile("" ::: "memory"); }
    }
};

struct EpiGlu {
    const float* x; float* out; bf16_t* hb; float* ssq; int n0, m0;
    __device__ __forceinline__ void pre(int, int, int) {}
    __device__ __forceinline__ void operator()(f32x16 (&acc)[4][2], const TileCtx& c) const {
        const int lr = c.lane & 31, h = c.lane >> 5;
#pragma unroll
        for (int mb = 0; mb < 2; ++mb) { const int m = m0 + c.wm * 64 + mb * 32 + lr; float s = 0.f;
            const size_t rowoff = (size_t)m * DM + ((n0 + c.wn * 128) >> 1) + 4 * h;
            f32x4 xv[8]; u32x2 pkk[8];
#pragma unroll
            for (int q = 0; q < 8; ++q) xv[q] = *(const f32x4*)(x + rowoff + (q >> 1) * 16 + (q & 1) * 8);
            asm volatile("" ::: "memory");
#pragma unroll
            for (int q = 0; q < 8; ++q) { const int nb = q >> 1, rg = q & 1; const size_t off = rowoff + nb * 16 + rg * 8; f32x4 o;
#pragma unroll
                for (int e = 0; e < 4; ++e) { o[e] = xv[q][e] + acc[nb][mb][rg * 8 + e] * sigmoidf_(acc[nb][mb][rg * 8 + 4 + e]); s += o[e] * o[e]; }
                *(f32x4*)(out + off) = o; pkk[q][0] = pk_bf16(o[0], o[1]); pkk[q][1] = pk_bf16(o[2], o[3]); }
#pragma unroll
            for (int q = 0; q < 8; q += 2) *(u32x4*)(hb + (size_t)m * DM + ((n0 + c.wn * 128) >> 1) + (q >> 1) * 16 + 8 * h) = widen8(pkk[q], pkk[q + 1]);
            asm volatile("" ::: "memory");
            s += __shfl_xor(s, 32);
            if (h == 0) ssq[(size_t)((n0 >> 8) * 2 + c.wn) * L_SEQ + m] = s; }
    }
};

template <int NPART, int MB = 2> struct EpiUp {
    const float* ssq; bf16_t* act; int n0, m0; float rsv[MB];
    __device__ __forceinline__ void pre(int wm, int lane, int) {
#pragma unroll
        for (int mb = 0; mb < MB; ++mb) rsv[mb] = rstd_from<NPART>(ssq, m0 + wm * (32 * MB) + mb * 32 + (lane & 31)); }
    __device__ __forceinline__ void operator()(f32x16 (&acc)[4][MB], const TileCtx& c) const {
        const int lr = c.lane & 31, h = c.lane >> 5;
#pragma unroll
        for (int mb = 0; mb < MB; ++mb) { const int m = m0 + c.wm * (32 * MB) + mb * 32 + lr; const float rs = rsv[mb];
#pragma unroll
            for (int nb = 0; nb < 4; ++nb) { u32x2 pk[2];
#pragma unroll
                for (int rg = 0; rg < 2; ++rg) { float o[4];
#pragma unroll
                    for (int e = 0; e < 4; ++e) { const float a = acc[nb][mb][rg * 8 + e] * rs, b = acc[nb][mb][rg * 8 + 4 + e] * rs; o[e] = a * sigmoidf_(a) * b; }
                    pk[rg][0] = pk_bf16(o[0], o[1]); pk[rg][1] = pk_bf16(o[2], o[3]); }
                *(u32x4*)(act + (size_t)m * FFN + ((n0 + c.wn * 128 + nb * 32) >> 1) + 8 * h) = widen8(pk[0], pk[1]); } }
    }
};

struct EpiRes {
    float* out; bf16_t* hb; float* ssq; int n0, m0;
    __device__ __forceinline__ void pre(int, int, int) {}
    __device__ __forceinline__ void operator()(f32x16 (&acc)[4][2], const TileCtx& c) const {
        const int lr = c.lane & 31, h = c.lane >> 5;
#pragma unroll
        for (int mb = 0; mb < 2; ++mb) { const int m = m0 + c.wm * 64 + mb * 32 + lr; float s = 0.f;
            const size_t rowoff = (size_t)m * DM + n0 + c.wn * 128 + 4 * h;
#pragma unroll
            for (int np = 0; np < 2; ++np) {
                f32x4 o[8];
#pragma unroll
                for (int q = 0; q < 8; ++q) o[q] = *(const f32x4*)(out + rowoff + (np * 2 + (q >> 2)) * 32 + (q & 3) * 8);
                asm volatile("" ::: "memory");
#pragma unroll
                for (int q = 0; q < 8; ++q) { const int nb = np * 2 + (q >> 2), rq = q & 3; const size_t off = rowoff + nb * 32 + rq * 8;
#pragma unroll
                    for (int e = 0; e < 4; ++e) { o[q][e] += acc[nb][mb][4 * rq + e]; s += o[q][e] * o[q][e]; }
                    *(f32x4*)(out + off) = o[q]; }
                if (hb) {
#pragma unroll
                    for (int q = 0; q < 8; q += 2) { u32x2 A, B; A[0] = pk_bf16(o[q][0], o[q][1]); A[1] = pk_bf16(o[q][2], o[q][3]); B[0] = pk_bf16(o[q + 1][0], o[q + 1][1]); B[1] = pk_bf16(o[q + 1][2], o[q + 1][3]);
                        *(u32x4*)(hb + (size_t)m * DM + n0 + c.wn * 128 + (np * 2 + (q >> 2)) * 32 + (q & 3) * 8 + 8 * h) = widen8(A, B); } }
                asm volatile("" ::: "memory");
            }
            s += __shfl_xor(s, 32);
            if (h == 0) ssq[(size_t)((n0 >> 8) * 2 + c.wn) * L_SEQ + m] = s; }
    }
};

struct EpiKvq {
    const float* ssq; char* ws; char* ldsb; int n0, m0; float rsv[2];
    __device__ __forceinline__ void pre(int wm, int lane, int) {
#pragma unroll
        for (int mb = 0; mb < 2; ++mb) rsv[mb] = rstd_from<8>(ssq, m0 + wm * 64 + mb * 32 + (lane & 31)); }
    __device__ __forceinline__ void operator()(f32x16 (&acc)[4][2], const TileCtx& c) const {
        const int lr = c.lane & 31, h = c.lane >> 5;
        const bool isV = (n0 >= 1024 && n0 < 2048);
#pragma unroll
        for (int mb = 0; mb < 2; ++mb) { const int m = m0 + c.wm * 64 + mb * 32 + lr; const float rs = rsv[mb];
            if (isV) {
                const int ml = c.wm * 64 + mb * 32 + lr;
                const int mp = (ml & ~12) | ((ml & 4) << 1) | ((ml & 8) >> 1);
#pragma unroll
                for (int nb = 0; nb < 4; ++nb)
#pragma unroll
                    for (int r = 0; r < 16; ++r) { const int nl = c.wn * 128 + nb * 32 + (r & 3) + 8 * (r >> 2) + 4 * h;
                        *(bf16_t*)(ldsb + nl * 528 + mp * 2) = (bf16_t)(pk_bf16(acc[nb][mb][r] * rs, 0.f) & 0xffffu); }
            } else {
                size_t base; int nl;
                if (n0 < 512) { base = OFF_K1; nl = n0; } else if (n0 < 1024) { base = OFF_K2; nl = n0 - 512; } else if (n0 < 2560) { base = OFF_Q1; nl = n0 - 2048; } else { base = OFF_Q2; nl = n0 - 2560; }
                bf16_t* dst = (bf16_t*)(ws + base);
                float cs[4], sn[4];
#pragma unroll
                for (int e = 0; e < 4; ++e) { const int i = 4 * h + e;
                    const float invf = (i == 0) ? 1.0f : (i == 1) ? 0.19391188f : (i == 2) ? 0.037601817f : (i == 3) ? 0.0072914392f : (i == 4) ? 0.0014142136f : (i == 5) ? 0.00027423282f : (i == 6) ? 5.3176997e-05f : 1.0311653e-05f;
                    const float ang = (float)m * invf; double rev = (double)ang * 0.15915494309189535; rev -= rint(rev); const float fr = (float)rev;
                    cs[e] = __builtin_amdgcn_cosf(fr); sn[e] = __builtin_amdgcn_sinf(fr); }
#pragma unroll
                for (int nb = 0; nb < 4; ++nb) {
                    const int nn = nl + c.wn * 128 + nb * 32; const int head = nn >> 6, d0 = nn & 63;
                    float v[16];
#pragma unroll
                    for (int r = 0; r < 16; ++r) v[r] = acc[nb][mb][r] * rs;
                    if (d0 == 0) {
#pragma unroll
                        for (int e = 0; e < 4; ++e) { const float x1 = v[e], x2 = v[4 + e]; v[e] = x1 * cs[e] - x2 * sn[e]; v[4 + e] = x2 * cs[e] + x1 * sn[e]; }
                    }
#pragma unroll
                    for (int rq = 0; rq < 4; rq += 2) { u32x2 A, B; A[0] = pk_bf16(v[4 * rq], v[4 * rq + 1]); A[1] = pk_bf16(v[4 * rq + 2], v[4 * rq + 3]);
                        B[0] = pk_bf16(v[4 * rq + 4], v[4 * rq + 5]); B[1] = pk_bf16(v[4 * rq + 6], v[4 * rq + 7]);
                        *(u32x4*)(dst + ((size_t)head * L_SEQ + m) * 64 + d0 + rq * 8 + 8 * h) = widen8(A, B); }
                }
            } }
        if (isV) {
            __syncthreads();
            bf16_t* vt = (bf16_t*)(ws + OFF_VT) + (size_t)(n0 - 1024) * L_SEQ + m0;
            const int tid = c.wn * 256 + c.wm * 64 + c.lane;
#pragma unroll
            for (int i = 0; i < 16; ++i) { const int q = tid + 512 * i, row = q >> 5, c16 = q & 31;
                const u32x4 v = *(const u32x4*)(ldsb + row * 528 + c16 * 16);
                *(u32x4*)(vt + (size_t)row * L_SEQ + c16 * 8) = v; }
            __syncthreads();
        }
    }
};

__device__ __forceinline__ void s5_tables(const int wave_s, const Params& p, int g, char* lds) {
    f32x2* apow = (f32x2*)lds;
    f32x2* bb = apow + 65 * 64;
    f32x2* cc = bb + 1024;
    f32x2* zf = cc + 1024;
    int tid = get_tid(wave_s); asm volatile("" : "+v"(tid));
    const float dt = expf(p.log_dt[g]);
    for (int e = tid; e < 65 * 64; e += NTHREADS) {
        const int lag = e >> 6, pp = e & 63;
        const float lr = p.lam_re[g * 64 + pp], li = p.lam_im[g * 64 + pp];
        const float mag = expf(lr * dt * (float)lag);
        double rev = (double)li * (double)dt * (double)lag * 0.15915494309189535; rev -= rint(rev);
        const float fr = (float)rev;
        f32x2 v; v[0] = mag * __builtin_amdgcn_cosf(fr); v[1] = mag * __builtin_amdgcn_sinf(fr); apow[e] = v;
    }
    if (tid < 64) {
        const float lr = p.lam_re[g * 64 + tid], li = p.lam_im[g * 64 + tid];
        const float em1 = expm1f(lr * dt);
        double rev = (double)li * (double)dt * 0.15915494309189535; const double rh = rev * 0.5; rev -= rint(rev);
        const double rh2 = rh - rint(rh);
        const float cth = __builtin_amdgcn_cosf((float)rev), sth = __builtin_amdgcn_sinf((float)rev), shalf = __builtin_amdgcn_sinf((float)rh2);
        const float nr = em1 * cth - 2.0f * shalf * shalf, ni = (1.0f + em1) * sth;
        const float den = lr * lr + li * li;
        f32x2 f; f[0] = (nr * lr + ni * li) / den; f[1] = (ni * lr - nr * li) / den; zf[tid] = f;
    }
    __syncthreads();
    for (int e = tid; e < 1024; e += NTHREADS) {
        const int pp = e >> 4;
        const float br = p.b_re[(size_t)g * 1024 + e], bi = p.b_im[(size_t)g * 1024 + e];
        const f32x2 f = zf[pp]; f32x2 v; v[0] = f[0] * br - f[1] * bi; v[1] = f[0] * bi + f[1] * br; bb[e] = v;
        f32x2 cv; cv[0] = p.c_re[(size_t)g * 1024 + e]; cv[1] = p.c_im[(size_t)g * 1024 + e]; cc[e] = cv;
    }
    __syncthreads();
    bf16_t* kt = (bf16_t*)(p.ws + OFF_KT) + (size_t)g * 127 * 256;
    bf16_t* w1 = (bf16_t*)(p.ws + OFF_W1) + (size_t)g * 128 * 1024;
    bf16_t* w3 = (bf16_t*)(p.ws + OFF_W3) + (size_t)g * 1024 * 128;
    {
        const int pg = tid & 63, lg = tid >> 6, c = pg >> 2, c2 = (pg & 3) * 4;
        float acc[8][4];
#pragma unroll
        for (int l = 0; l < 8; ++l)
#pragma unroll
            for (int k = 0; k < 4; ++k) acc[l][k] = 0.f;
        for (int pp = 0; pp < 64; ++pp) {
            const f32x2 cv = cc[c * 64 + pp];
            float cbr[4], cbi[4];
#pragma unroll
            for (int k = 0; k < 4; ++k) { const f32x2 bv = bb[pp * 16 + c2 + k]; cbr[k] = cv[0] * bv[0] - cv[1] * bv[1]; cbi[k] = cv[0] * bv[1] + cv[1] * bv[0]; }
#pragma unroll
            for (int l = 0; l < 8; ++l) { const f32x2 a = apow[(lg * 8 + l) * 64 + pp];
#pragma unroll
                for (int k = 0; k < 4; ++k) acc[l][k] += cbr[k] * a[0] - cbi[k] * a[1]; }
        }
#pragma unroll
        for (int l = 0; l < 8; ++l) { u32x2 o; o[0] = pk_bf16(acc[l][0], acc[l][1]); o[1] = pk_bf16(acc[l][2], acc[l][3]);
            *(u32x2*)(kt + (size_t)(63 + lg * 8 + l) * 256 + pg * 4) = o; }
        for (int e = tid; e < 63 * 256 / 8; e += NTHREADS) { u32x4 zz = {0u, 0u, 0u, 0u}; *(u32x4*)(kt + e * 8) = zz; }
    }
    for (int q = tid; q < 128 * 128; q += NTHREADS) {
        const int pq = q >> 7, kc = q & 127, tau = kc >> 1, c0 = (kc & 1) * 8, pp = pq & 63, im = pq >> 6;
        const f32x2 a = apow[(63 - tau) * 64 + pp]; float v[8];
#pragma unroll
        for (int e = 0; e < 8; ++e) { const f32x2 b = bb[pp * 16 + c0 + e]; v[e] = im ? (a[0] * b[1] + a[1] * b[0]) : (a[0] * b[0] - a[1] * b[1]); }
        u32x4 o; o[0] = pk_bf16(v[0], v[1]); o[1] = pk_bf16(v[2], v[3]); o[2] = pk_bf16(v[4], v[5]); o[3] = pk_bf16(v[6], v[7]);
        *(u32x4*)(w1 + (size_t)pq * 1024 + kc * 8) = o;
    }
    for (int q = tid; q < 1024 * 16; q += NTHREADS) {
        const int n = q >> 4, p0 = (q & 15) * 8, t = n >> 4, c = n & 15, im = p0 >> 6; float v[8];
#pragma unroll
        for (int e = 0; e < 8; ++e) { const int pp = (p0 + e) & 63; const f32x2 a = apow[(t + 1) * 64 + pp]; const f32x2 cv = cc[c * 64 + pp];
            v[e] = im ? -(cv[0] * a[1] + cv[1] * a[0]) : (cv[0] * a[0] - cv[1] * a[1]); }
        u32x4 o; o[0] = pk_bf16(v[0], v[1]); o[1] = pk_bf16(v[2], v[3]); o[2] = pk_bf16(v[4], v[5]); o[3] = pk_bf16(v[6], v[7]);
        *(u32x4*)(w3 + (size_t)n * 128 + p0) = o;
    }
    if (tid < 64) ((f32x2*)(p.ws + OFF_A64))[g * 64 + tid] = apow[64 * 64 + tid];
    __syncthreads();
}

__device__ __forceinline__ void wtile(const int wave_s, const Params& p, int t, char* lds) {
    int j = 0;
    for (int i = 1; i < p.njobs; ++i) if (t >= p.jobs[i].tile0) j = i;
    const WJob& J = p.jobs[j];
    const int lt = t - J.tile0, kt = lt / J.ntn, nt = lt - kt * J.ntn;
    const int k0 = kt * 64, nl0 = nt * 256;
    float* T = (float*)lds;
    int tid = get_tid(wave_s); asm volatile("" : "+v"(tid));
    const int c4 = (tid & 63) * 4, kb = tid >> 6;
    f32x4 v[8];
#pragma unroll
    for (int i = 0; i < 8; ++i) v[i] = *(const f32x4*)(J.src + (size_t)(k0 + kb + 8 * i) * J.ldsrc + J.col0 + nl0 + c4);
#pragma unroll
    for (int i = 0; i < 8; ++i) { const int kk = kb + 8 * i; float sc = J.scale; if (J.gain) sc *= J.gain[k0 + kk];
        T[kk * 257 + c4] = v[i][0] * sc; T[kk * 257 + c4 + 1] = v[i][1] * sc; T[kk * 257 + c4 + 2] = v[i][2] * sc; T[kk * 257 + c4 + 3] = v[i][3] * sc; }
    __syncthreads();
    { const int nn = tid >> 1, kh = (tid & 1) * 32;
        const int n = nl0 + nn; int row = (J.mode == 0) ? n : ((n >> 3) * 16 + (n & 7) + (J.mode == 2 ? 8 : 0)); row += J.rowoff;
        bf16_t* d = J.dst + (size_t)row * J.K + k0 + kh;
#pragma unroll
        for (int q = 0; q < 4; ++q) { float w[8];
#pragma unroll
            for (int e = 0; e < 8; ++e) w[e] = T[(kh + q * 8 + e) * 257 + nn];
            u32x4 o; o[0] = pk_bf16(w[0], w[1]); o[1] = pk_bf16(w[2], w[3]); o[2] = pk_bf16(w[4], w[5]); o[3] = pk_bf16(w[6], w[7]);
            *(u32x4*)(d + q * 8) = o; } }
    __syncthreads();
}

__device__ __forceinline__ void rms0_item(const int wave_s, const Params& p, int item) {
    const int lane = get_tid(wave_s) & 63, wid = wave_s;
    bf16_t* hn0 = (bf16_t*)(p.ws + OFF_HN0);
    f32x4 g[4];
#pragma unroll
    for (int i = 0; i < 4; ++i) g[i] = *(const f32x4*)(p.norm_mix_g + lane * 4 + 256 * i);
    for (int rb = 0; rb < 2; ++rb) {
        f32x4 v[4][4];
#pragma unroll
        for (int r = 0; r < 4; ++r)
#pragma unroll
            for (int i = 0; i < 4; ++i) v[r][i] = *(const f32x4*)(p.x + (size_t)(item * 64 + wid * 8 + rb * 4 + r) * DM + lane * 4 + 256 * i);
#pragma unroll
        for (int r = 0; r < 4; ++r) {
            const int row = item * 64 + wid * 8 + rb * 4 + r;
            float s = 0.f;
#pragma unroll
            for (int i = 0; i < 4; ++i) s += v[r][i][0] * v[r][i][0] + v[r][i][1] * v[r][i][1] + v[r][i][2] * v[r][i][2] + v[r][i][3] * v[r][i][3];
#pragma unroll
            for (int o = 32; o >= 1; o >>= 1) s += __shfl_xor(s, o);
            const float rs = rsqrtf(s * (1.0f / DM) + EPSV);
#pragma unroll
            for (int i = 0; i < 4; ++i) {
                u32x2 o; o[0] = pk_bf16(v[r][i][0] * rs * g[i][0], v[r][i][1] * rs * g[i][1]); o[1] = pk_bf16(v[r][i][2] * rs * g[i][2], v[r][i][3] * rs * g[i][3]);
                const int col = lane * 4 + 256 * i;
                *(u32x2*)(hn0 + (size_t)(col >> 4) * 262144 + (size_t)(row >> 6) * 1024 + (row & 63) * 16 + (col & 15)) = o; }
        }
    }
}

__device__ __forceinline__ void attn_item(const int wave_s, const Params& p, int head, int qb, float lam, char* lds) {
    int tid = get_tid(wave_s); asm volatile("" : "+v"(tid));
    const int lane = tid & 63, wid = tid >> 6;
    const int mp = wid >> 2, g = wid & 3;
    const int lr = lane & 31, h = lane >> 5, sw = (lane >> 1) & 7;
    const bf16_t* K1 = (const bf16_t*)(p.ws + OFF_K1) + (size_t)head * L_SEQ * 64;
    const bf16_t* K2 = (const bf16_t*)(p.ws + OFF_K2) + (size_t)head * L_SEQ * 64;
    const bf16_t* VT = (const bf16_t*)(p.ws + OFF_VT) + (size_t)head * 128 * L_SEQ;
    const bf16_t* Q = (const bf16_t*)(p.ws + (mp ? OFF_Q2 : OFF_Q1)) + (size_t)head * L_SEQ * 64;
    const int q0 = qb * 128 + g * 32;
    bf16x8 qf[4];
#pragma unroll
    for (int s = 0; s < 4; ++s) qf[s] = *(const bf16x8*)(Q + (size_t)(q0 + lr) * 64 + 16 * s + 8 * h);
    const int nkt = 2 * qb + 2;
    const int my_last = 2 * qb + (g >> 1);
    f32x16 O[4];
#pragma unroll
    for (int e = 0; e < 4; ++e)
#pragma unroll
        for (int r = 0; r < 16; ++r) O[e][r] = 0.f;
    float m_run = 0.f, l_run = 0.f;
    f32x16 negm;
#pragma unroll
    for (int r = 0; r < 16; ++r) negm[r] = 0.f;
    const int lrow = lane >> 3;
    const int ck = (lane & 7) ^ (((wave_s & 1) * 4 + (lane >> 4)) & 7);
    const int cv0 = (lane & 7) ^ (lane >> 4), cv1 = (lane & 7) ^ (4 + (lane >> 4));
    const bf16_t* k1p = K1 + (size_t)(wave_s * 8 + lrow) * 64 + ck * 8;
    const bf16_t* k2p = K2 + (size_t)(wave_s * 8 + lrow) * 64 + ck * 8;
    const bf16_t* v0p = VT + (size_t)(wave_s * 16 + lrow) * L_SEQ + cv0 * 8;
    const bf16_t* v1p = VT + (size_t)(wave_s * 16 + 8 + lrow) * L_SEQ + cv1 * 8;
    auto issue = [&](int kt) {
        char* st = lds + (kt & 3) * 32768;
        __builtin_amdgcn_global_load_lds((const unsigned*)(k1p + (size_t)kt * 4096), (__attribute__((address_space(3))) unsigned*)(st + wave_s * 1024), 16, 0, 0);
        __builtin_amdgcn_global_load_lds((const unsigned*)(k2p + (size_t)kt * 4096), (__attribute__((address_space(3))) unsigned*)(st + 8192 + wave_s * 1024), 16, 0, 0);
        __builtin_amdgcn_global_load_lds((const unsigned*)(v0p + kt * 64), (__attribute__((address_space(3))) unsigned*)(st + 16384 + wave_s * 2048), 16, 0, 0);
        __builtin_amdgcn_global_load_lds((const unsigned*)(v1p + kt * 64), (__attribute__((address_space(3))) unsigned*)(st + 16384 + wave_s * 2048 + 1024), 16, 0, 0);
    };
    issue(0); issue(1);
    if (nkt > 2) issue(2);
    if (nkt > 2) asm volatile("s_waitcnt vmcnt(8)" ::: "memory");
    else asm volatile("s_waitcnt vmcnt(4)" ::: "memory");
    __builtin_amdgcn_s_barrier(); asm volatile("" ::: "memory");
    const int koff_ = mp * 8192 + lr * 128, voff_ = 16384 + lr * 128;
    int chk[4], chv[4];
#pragma unroll
    for (int s = 0; s < 4; ++s) { chk[s] = ((2 * s + h) ^ sw) << 4; chv[s] = chk[s]; }
    bf16x8 kf[8], vf[8];
#pragma unroll
    for (int i = 0; i < 8; ++i) kf[i] = *(const bf16x8*)(lds + koff_ + (i >> 2) * 4096 + chk[i & 3]);
    for (int kt = 0; kt < nkt; ++kt) {
        const bool active = kt <= my_last;
        const char* stg = lds + (kt & 3) * 32768;
        f32x16 S[2];
        bf16x8 pf[2][2];
        if (active) {
#pragma unroll
            for (int kb = 0; kb < 2; ++kb) {
                S[kb] = __builtin_amdgcn_mfma_f32_32x32x16_bf16(kf[kb * 4], qf[0], negm, 0, 0, 0);
#pragma unroll
                for (int s = 1; s < 4; ++s) S[kb] = __builtin_amdgcn_mfma_f32_32x32x16_bf16(kf[kb * 4 + s], qf[s], S[kb], 0, 0, 0);
            }
#pragma unroll
            for (int i = 0; i < 8; ++i) vf[i] = *(const bf16x8*)(stg + voff_ + (i & 3) * 4096 + chv[i >> 2]);
            __builtin_amdgcn_sched_barrier(0);
            float mt = S[0][0];
#pragma unroll
            for (int r = 1; r < 16; ++r) mt = fmaxf(mt, S[0][r]);
#pragma unroll
            for (int r = 0; r < 16; ++r) mt = fmaxf(mt, S[1][r]);
            { const auto sw2 = __builtin_amdgcn_permlane32_swap(__float_as_uint(mt), __float_as_uint(mt), false, false);
              mt = fmaxf(__uint_as_float(sw2[0]), __uint_as_float(sw2[1])); }
            const bool need = (mt > 8.0f) || (kt == 0);
            if (__any(need)) {
                const float d = need ? mt : 0.f;
                const float alpha = fast_exp2(-d);
                m_run += d; l_run *= alpha;
#pragma unroll
                for (int r = 0; r < 16; ++r) negm[r] -= d;
#pragma unroll
                for (int kb = 0; kb < 2; ++kb)
#pragma unroll
                    for (int r = 0; r < 16; ++r) S[kb][r] -= d;
#pragma unroll
                for (int e = 0; e < 4; ++e)
#pragma unroll
                    for (int r = 0; r < 16; ++r) O[e][r] *= alpha;
            }
            f32x2 ls2 = {0.f, 0.f};
#pragma unroll
            for (int kb = 0; kb < 2; ++kb)
#pragma unroll
                for (int s = 0; s < 2; ++s) { float e_[8];
#pragma unroll
                    for (int j = 0; j < 8; ++j) e_[j] = fast_exp2(S[kb][8 * s + j]);
#pragma unroll
                    for (int j = 0; j < 8; j += 2) { f32x2 t2 = {e_[j], e_[j + 1]}; ls2 += t2; }
                    u32x4 pk; pk[0] = pk_bf16(e_[0], e_[1]); pk[1] = pk_bf16(e_[2], e_[3]); pk[2] = pk_bf16(e_[4], e_[5]); pk[3] = pk_bf16(e_[6], e_[7]);
                    pf[kb][s] = __builtin_bit_cast(bf16x8, pk); }
            const float ls = ls2[0] + ls2[1];
            l_run += ls;
        }
        const int rem = nkt - 1 - kt;
        if (rem >= 2) asm volatile("s_waitcnt vmcnt(4)" ::: "memory");
        else asm volatile("s_waitcnt vmcnt(0)" ::: "memory");
        __builtin_amdgcn_s_barrier(); asm volatile("" ::: "memory");
        if (kt + 3 < nkt) issue(kt + 3);
        if (kt + 1 <= my_last) {
            const char* sn = lds + ((kt + 1) & 3) * 32768;
#pragma unroll
            for (int i = 0; i < 8; ++i) kf[i] = *(const bf16x8*)(sn + koff_ + (i >> 2) * 4096 + chk[i & 3]);
        }
        __builtin_amdgcn_sched_barrier(0);
        if (active) {
#pragma unroll
            for (int i = 0; i < 8; ++i) O[i & 3] = __builtin_amdgcn_mfma_f32_32x32x16_bf16(vf[i], pf[0][i >> 2], O[i & 3], 0, 0, 0);
#pragma unroll
            for (int i = 0; i < 8; ++i) vf[i] = *(const bf16x8*)(stg + voff_ + (i & 3) * 4096 + (((4 + 2 * (i >> 2) + h) ^ sw) << 4));
#pragma unroll
            for (int i = 0; i < 8; ++i) O[i & 3] = __builtin_amdgcn_mfma_f32_32x32x16_bf16(vf[i], pf[1][i >> 2], O[i & 3], 0, 0, 0);
        }
    }
    __syncthreads();
    const float lt = l_run + __shfl_xor(l_run, 32);
    const float inv = fast_rcp(lt) * (mp ? lam : 1.0f);
    float* ex = (float*)lds;
    if (mp == 1) {
#pragma unroll
        for (int e = 0; e < 4; ++e)
#pragma unroll
            for (int r = 0; r < 16; ++r) ex[((g * 4 + e) * 16 + r) * 64 + lane] = O[e][r] * inv;
    }
    __syncthreads();
    if (mp == 0) {
        float ss = 0.f;
#pragma unroll
        for (int e = 0; e < 4; ++e)
#pragma unroll
            for (int r = 0; r < 16; ++r) { const float o = O[e][r] * inv - ex[((g * 4 + e) * 16 + r) * 64 + lane]; O[e][r] = o; ss += o * o; }
        ss += __shfl_xor(ss, 32);
        const float rs = rsqrtf(ss * (1.0f / 128.0f) + EPSV) * (1.0f - LAM_INIT);
        bf16_t* on = (bf16_t*)(p.ws + OFF_ON) + (size_t)(q0 + lr) * DM + head * 128;
#pragma unroll
        for (int e = 0; e < 4; ++e)
#pragma unroll
            for (int rq = 0; rq < 4; ++rq) { const int ee = e * 32 + rq * 8 + 4 * h; const f32x4 gg = *(const f32x4*)(p.subln_g + ee);
                u32x2 b; b[0] = pk_bf16(O[e][4 * rq] * rs * gg[0], O[e][4 * rq + 1] * rs * gg[1]); b[1] = pk_bf16(O[e][4 * rq + 2] * rs * gg[2], O[e][4 * rq + 3] * rs * gg[3]);
                *(u32x2*)(on + ee) = b; }
    }
    __syncthreads();
}


#define XB_XCNT(j)  (64 + 64 * (j))
#define XB_XSUB(j)  (1088 + 64 * (j))
#define XB_XGEN(j)  (2112 + 64 * (j))
#define XB_TOP      3136
#define XB_TOPGEN   3200
#define XB_WORDS    3264
__device__ __forceinline__ unsigned xb_ld(unsigned* p) { return __hip_atomic_load(p, __ATOMIC_RELAXED, __HIP_MEMORY_SCOPE_AGENT); }
__device__ __forceinline__ unsigned xb_add(unsigned* p, unsigned v) { return __hip_atomic_fetch_add(p, v, __ATOMIC_RELAXED, __HIP_MEMORY_SCOPE_AGENT); }
__device__ __forceinline__ unsigned xb_xcc_id() { return (unsigned)__builtin_amdgcn_s_getreg((3 << 11) | 20) & 0xFu; }
__device__ __forceinline__ void gbar(const int wave_s, unsigned* bar, volatile unsigned* st) {
    asm volatile("s_waitcnt vmcnt(0)" ::: "memory");
    __syncthreads();
    if (get_tid(wave_s) == 0) {
        __builtin_amdgcn_s_waitcnt(0);
        const unsigned x = st[2], nloc = st[0], nx = st[1];
        const unsigned old = xb_add(&bar[XB_XSUB(x)], 1u);
        const unsigned gen = old / nloc;
        if (old + 1u == (gen + 1u) * nloc) {
            __builtin_amdgcn_fence(__ATOMIC_RELEASE, "agent");
            asm volatile("s_waitcnt vmcnt(0)" ::: "memory");
            const unsigned og = xb_add(&bar[XB_TOP], 1u);
            const unsigned tg = og / nx;
            if (og + 1u == (tg + 1u) * nx) xb_add(&bar[XB_TOPGEN], 1u);
            else while (xb_ld(&bar[XB_TOPGEN]) == tg) __builtin_amdgcn_s_sleep(1);
            __builtin_amdgcn_fence(__ATOMIC_ACQUIRE, "agent");
            xb_add(&bar[XB_XGEN(x)], 1u);
            asm volatile("s_waitcnt vmcnt(0)" ::: "memory");
        } else {
            while (xb_ld(&bar[XB_XGEN(x)]) == gen) __builtin_amdgcn_s_sleep(1);
            __builtin_amdgcn_fence(__ATOMIC_ACQUIRE, "agent");
            asm volatile("s_waitcnt vmcnt(0)" ::: "memory");
        }
    }
    __syncthreads();
}

__device__ __forceinline__ bool tile_map(int r, int bid, int nb, int NT, int& nt, int& mt) {
    if (nb == 256) {
        const int x = bid & 7, li = bid >> 3, q = li + 32 * r;
        if (q >= 8 * NT) return false;
        const int mi = q & 3, rest = q >> 2, mg = rest / NT;
        nt = rest - mg * NT; mt = x * 8 + mg * 4 + mi; return true;
    }
    const int t = bid + r * nb; if (t >= NT * 64) return false;
    nt = t % NT; mt = t / NT; return true;
}

__global__ void __launch_bounds__(NTHREADS) mega(const Params p) {
    __shared__ __attribute__((aligned(16))) char lds[LDS_BYTES];
    cg::grid_group grid = cg::this_grid();
    const int wave_s = __builtin_amdgcn_readfirstlane((int)(threadIdx.x >> 6));
    const int nb = gridDim.x, bid = blockIdx.x;
    char* ws = p.ws;
    bf16_t* hn0 = (bf16_t*)(ws + OFF_HN0);
    bf16_t* hb = (bf16_t*)(ws + OFF_HB);
    float* ssq0 = (float*)(ws + OFF_SSQ);
    float* ssq1 = ssq0 + 16 * L_SEQ; float* ssq2 = ssq1 + 16 * L_SEQ; float* ssq3 = ssq2 + 16 * L_SEQ;
    const Seg nul = {nullptr, 0, 0, nullptr, 0, 0};
    unsigned* bar = (unsigned*)(ws + OFF_BAR);
    volatile unsigned* xst = (volatile unsigned*)(lds + LDS_BYTES - 16);
    if (get_tid(wave_s) == 0) xb_add(&bar[XB_XCNT(xb_xcc_id())], 1u);
    grid.sync();
    if (get_tid(wave_s) == 0) {
        const unsigned x = xb_xcc_id(); unsigned cnt = 0u, mine = 1u;
        for (unsigned j = 0; j < 16; ++j) { const unsigned c = xb_ld(&bar[XB_XCNT(j)]); cnt += (c > 0u) ? 1u : 0u; if (j == x) mine = c; }
        xst[0] = mine ? mine : 1u; xst[1] = cnt ? cnt : 1u; xst[2] = x;
    }
    __syncthreads();

    { const int nwork = p.ntiles_w + 256;
      for (int rep = 0; rep < REP_PREP; ++rep) {
          if (nb >= 128) {
              if (bid < 64) s5_tables(wave_s, p, bid, lds);
              else for (int it = bid - 64; it < 256; it += nb - 64) rms0_item(wave_s, p, it);
          } else {
              for (int it = bid; it < 64 + nwork; it += nb) { if (it < 64) s5_tables(wave_s, p, it, lds); else if (it < 64 + p.ntiles_w) wtile(wave_s, p, it - 64, lds); else rms0_item(wave_s, p, it - 64 - p.ntiles_w); }
          }
      } }
    gbar(wave_s, bar, xst);
    if (nb >= 128 && bid >= 64) for (int it = bid - 64; it < p.ntiles_w; it += nb - 64) wtile(wave_s, p, it, lds);
    for (int rep = 0; rep < REP_SLOC; ++rep)
    for (int g = bid; g < 64; g += nb) {
        Seg s = {(const bf16_t*)(ws + OFF_W1) + (size_t)g * 128 * 1024, 1024, 16, hn0 + (size_t)g * 262144, 1024, 16};
        EpiSloc e = {(float*)lds};
        gemm_tile(wave_s, lds, s, 16, nul, 0, e);
        __syncthreads();
        {
            const int lane_ = get_tid(wave_s) & 63, w_ = wave_s;
            const f32x2 a = ((const f32x2*)(ws + OFF_A64))[g * 64 + lane_];
            const float* sl = (const float*)lds + (w_ * 32) * 132;
            float sr = 0.f, si = 0.f;
#pragma unroll
            for (int j = 0; j < 32; ++j) { const float xr = sl[j * 132 + lane_], xi = sl[j * 132 + 64 + lane_]; const float nr = a[0] * sr - a[1] * si + xr, ni = a[0] * si + a[1] * sr + xi; sr = nr; si = ni; }
            f32x2* carry = (f32x2*)(lds + 135168);
            { f32x2 c; c[0] = sr; c[1] = si; carry[w_ * 64 + lane_] = c; }
            float pr = a[0], pi = a[1];
#pragma unroll
            for (int q = 0; q < 5; ++q) { const float nr = pr * pr - pi * pi, ni = 2.f * pr * pi; pr = nr; pi = ni; }
            __syncthreads();
            sr = 0.f; si = 0.f;
            for (int v = 0; v < w_; ++v) { const f32x2 c = carry[v * 64 + lane_]; const float nr = pr * sr - pi * si + c[0], ni = pr * si + pi * sr + c[1]; sr = nr; si = ni; }
            bf16_t* sp = (bf16_t*)(ws + OFF_SPREV) + (size_t)g * 256 * 128 + (size_t)(w_ * 32) * 128;
#pragma unroll
            for (int j = 0; j < 32; ++j) {
                sp[j * 128 + lane_] = (bf16_t)(pk_bf16(sr, 0.f) & 0xffffu); sp[j * 128 + 64 + lane_] = (bf16_t)(pk_bf16(si, 0.f) & 0xffffu);
                const float xr = sl[j * 132 + lane_], xi = sl[j * 132 + 64 + lane_];
                const float nr = a[0] * sr - a[1] * si + xr, ni = a[0] * si + a[1] * sr + xi; sr = nr; si = ni;
            }
        }
        __syncthreads();
    }
    gbar(wave_s, bar, xst);
    for (int rep = 0; rep < REP_S5; ++rep)
    for (int t0 = bid; t0 < 256; t0 += nb) {
        const int t = (nb == 256) ? ((t0 & 7) * 32 + (t0 >> 3)) : t0;
        const int g = t >> 2, i = 3 - (t & 3);
        const bf16_t* sprev = (const bf16_t*)(ws + OFF_SPREV) + (size_t)g * 256 * 128;
        Seg s0 = {(const bf16_t*)(ws + OFF_KT) + (size_t)g * 127 * 256 + 63 * 256 + (size_t)(i * 256) * 16, 16, -256, hn0 + (size_t)g * 262144, 1024, 16};
        Seg s1 = {(const bf16_t*)(ws + OFF_W3) + (size_t)g * 1024 * 128 + (size_t)(i * 256) * 128, 128, 16, sprev, 128, 16};
        EpiS5 e = {hn0, p.ssm_d, (bf16_t*)(ws + OFF_Z), g, i * 256};
        gemm_tile(wave_s, lds, s0, 4 * (i + 1), s1, 2, e);
    }
    gbar(wave_s, bar, xst);
    for (int rep = 0; rep < REP_GLU; ++rep)
    for (int r = 0, nt, mt; tile_map(r, bid, nb, 8, nt, mt); ++r) {
        Seg s = {(const bf16_t*)(ws + OFF_WGLU) + (size_t)nt * 256 * DM, DM, 16, (const bf16_t*)(ws + OFF_Z) + (size_t)mt * 256 * 16, 16, 262144};
        EpiGlu e = {p.x, p.out, hb, ssq0, nt * 256, mt * 256};
        gemm_tile(wave_s, lds, s, 16, nul, 0, e);
    }
    gbar(wave_s, bar, xst);
#pragma unroll
    for (int layer = 0; layer < 2; ++layer) {
        if (layer == 1) {
            for (int rep = 0; rep < REP_KVQ; ++rep) {
                int nt = 0, mt = 0; bool have = tile_map(0, bid, nb, 12, nt, mt), pro = false;
                for (int r = 0; have; ++r) {
                    int nnt = 0, nmt = 0; const bool hn = tile_map(r + 1, bid, nb, 12, nnt, nmt);
                    Seg s = {(const bf16_t*)(ws + OFF_WKVQ) + (size_t)nt * 256 * DM, DM, 16, hb + (size_t)mt * 256 * DM, DM, 16};
                    Seg sn = {(const bf16_t*)(ws + OFF_WKVQ) + (size_t)nnt * 256 * DM, DM, 16, hb + (size_t)nmt * 256 * DM, DM, 16};
                    const bool curV = (nt >= 4 && nt < 8);
                    EpiKvq e = {ssq1, ws, lds, nt * 256, mt * 256, {0.f, 0.f}};
                    gemm_tile(wave_s, lds, s, 16, nul, 0, e, pro, hn && !curV, sn);
                    pro = hn && !curV; nt = nnt; mt = nmt; have = hn;
                }
            }
            gbar(wave_s, bar, xst);
            {
                float a1 = 0.f, a2 = 0.f;
                for (int i = 0; i < 64; ++i) { a1 += p.lq1[i] * p.lk1[i]; a2 += p.lq2[i] * p.lk2[i]; }
                const float lam = expf(a1) - expf(a2) + LAM_INIT;
                for (int rep = 0; rep < REP_ATTN; ++rep)
                for (int it = bid; it < 1024; it += nb) {
                    const int head = it & 7, r = it >> 3, rnd = r >> 5, j = r & 31;
                    const int qb = (rnd == 0) ? 127 - j : (rnd == 1) ? 64 + j : (rnd == 2) ? 63 - j : j;
                    attn_item(wave_s, p, head, qb, lam, lds);
                }
            }
            gbar(wave_s, bar, xst);
            for (int r = 0, nt, mt; tile_map(r, bid, nb, 4, nt, mt); ++r) {
                Seg s = {(const bf16_t*)(ws + OFF_WO) + (size_t)nt * 256 * DM, DM, 16, (const bf16_t*)(ws + OFF_ON) + (size_t)mt * 256 * DM, DM, 16};
                EpiRes e = {p.out, hb, ssq2, nt * 256, mt * 256};
                gemm_tile(wave_s, lds, s, 16, nul, 0, e);
            }
            gbar(wave_s, bar, xst);
        }
        {
            const bf16_t* wup = (const bf16_t*)(ws + (layer ? OFF_WUP1 : OFF_WUP0));
            for (int rep = 0; rep < REP_UP; ++rep) {
                const int nfull = (nb == 256) ? 5 : (1 << 30);
                int nt = 0, mt = 0; bool have = tile_map(0, bid, nb, 22, nt, mt), pro = false;
                for (int r = 0; have && r < nfull; ++r) {
                    int nnt = 0, nmt = 0; const bool hn = tile_map(r + 1, bid, nb, 22, nnt, nmt) && (r + 1 < nfull);
                    Seg s = {wup + (size_t)nt * 256 * DM, DM, 16, hb + (size_t)mt * 256 * DM, DM, 16};
                    Seg sn = {wup + (size_t)nnt * 256 * DM, DM, 16, hb + (size_t)nmt * 256 * DM, DM, 16};
                    if (layer == 0) { EpiUp<16> e = {ssq0, (bf16_t*)(ws + OFF_ACT), nt * 256, mt * 256, {0.f, 0.f}}; gemm_tile(wave_s, lds, s, 16, nul, 0, e, pro, hn, sn); }
                    else { EpiUp<8> e = {ssq2, (bf16_t*)(ws + OFF_ACT), nt * 256, mt * 256, {0.f, 0.f}}; gemm_tile(wave_s, lds, s, 16, nul, 0, e, pro, hn, sn); }
                    pro = hn; nt = nnt; mt = nmt; have = hn;
                }
                if (nb == 256) {
                    const int x = bid & 7, li = bid >> 3, q = 160 + (li & 15), half = li >> 4;
                    const int mi = q & 3, rest = q >> 2, mg = rest / 22, hnt = rest - mg * 22, hmt = x * 8 + mg * 4 + mi;
                    const int hm0 = hmt * 256 + half * 128;
                    Seg s = {wup + (size_t)hnt * 256 * DM, DM, 16, hb + (size_t)hm0 * DM, DM, 16};
                    if (layer == 0) { EpiUp<16, 1> e = {ssq0, (bf16_t*)(ws + OFF_ACT), hnt * 256, hm0, {0.f}}; gemm_tile<1>(wave_s, lds, s, 16, nul, 0, e); }
                    else { EpiUp<8, 1> e = {ssq2, (bf16_t*)(ws + OFF_ACT), hnt * 256, hm0, {0.f}}; gemm_tile<1>(wave_s, lds, s, 16, nul, 0, e); }
                }
            }
        }
        gbar(wave_s, bar, xst);
        {
            const bf16_t* wdn = (const bf16_t*)(ws + (layer ? OFF_WDN1 : OFF_WDN0));
            for (int r = 0, nt, mt; tile_map(r, bid, nb, 4, nt, mt); ++r) {
                Seg s = {wdn + (size_t)nt * 256 * FFN, FFN, 16, (const bf16_t*)(ws + OFF_ACT) + (size_t)mt * 256 * FFN, FFN, 16};
                EpiRes e = {p.out, layer ? (bf16_t*)nullptr : hb, layer ? ssq3 : ssq1, nt * 256, mt * 256};
                gemm_tile(wave_s, lds, s, FFN / 64, nul, 0, e);
            }
        }
        gbar(wave_s, bar, xst);
    }
    {
        const int lane = get_tid(wave_s) & 63, wid = wave_s;
        for (int row = bid * 8 + wid; row < L_SEQ; row += nb * 8) {
            float s = 0.f;
            for (int i = 0; i < 8; ++i) s += ssq3[(size_t)i * L_SEQ + row];
            const float rs = rsqrtf(s * (1.0f / DM) + EPSV);
#pragma unroll
            for (int i = 0; i < 4; ++i) { const size_t off = (size_t)row * DM + lane * 4 + 256 * i;
                f32x4 v = *(const f32x4*)(p.out + off); const f32x4 g = *(const f32x4*)(p.final_g + lane * 4 + 256 * i);
                v[0] *= rs * g[0]; v[1] *= rs * g[1]; v[2] *= rs * g[2]; v[3] *= rs * g[3]; *(f32x4*)(p.out + off) = v; }
        }
    }
}

static void add_job(Params& P, int& nt, const float* src, bf16_t* dst, const float* gain, int K, int N, int ld, int col0, int mode, int rowoff, float scale) {
    WJob& J = P.jobs[P.njobs++];
    J.src = src; J.dst = dst; J.gain = gain; J.K = K; J.N = N; J.ldsrc = ld; J.col0 = col0; J.mode = mode; J.rowoff = rowoff; J.scale = scale; J.tile0 = nt; J.ntn = N / 256; J.pad = 0;
    nt += (K / 64) * (N / 256);
}

extern "C" void kernel_launch(void* const* d_in, const int* in_sizes, int n_in, void* d_out, int out_size, void* d_ws, size_t ws_size, hipStream_t stream) {
    Params P; memset(&P, 0, sizeof(P));
    P.x = (const float*)d_in[0]; P.norm_mix_g = (const float*)d_in[1]; P.norm_ffn_g = (const float*)d_in[2];
    P.ffn_w1 = (const float*)d_in[3]; P.ffn_w3 = (const float*)d_in[4]; P.ffn_w2 = (const float*)d_in[5];
    P.lam_re = (const float*)d_in[6]; P.lam_im = (const float*)d_in[7]; P.log_dt = (const float*)d_in[8];
    P.b_re = (const float*)d_in[9]; P.b_im = (const float*)d_in[10]; P.c_re = (const float*)d_in[11]; P.c_im = (const float*)d_in[12];
    P.ssm_d = (const float*)d_in[13]; P.w_glu = (const float*)d_in[14]; P.kv_norm_g = (const float*)d_in[15]; P.w_kv = (const float*)d_in[16];
    P.w_q = (const float*)d_in[17]; P.lq1 = (const float*)d_in[18]; P.lk1 = (const float*)d_in[19]; P.lq2 = (const float*)d_in[20]; P.lk2 = (const float*)d_in[21];
    P.subln_g = (const float*)d_in[22]; P.w_o = (const float*)d_in[23]; P.final_g = (const float*)d_in[24];
    P.out = (float*)d_out; P.ws = (char*)d_ws;
    char* ws = (char*)d_ws; int nt = 0;
    const size_t FW = (size_t)DM * FFN;
    add_job(P, nt, P.w_glu, (bf16_t*)(ws + OFF_WGLU), nullptr, DM, 1024, 2048, 0, 1, 0, 1.0f);
    add_job(P, nt, P.w_glu, (bf16_t*)(ws + OFF_WGLU), nullptr, DM, 1024, 2048, 1024, 2, 0, 1.0f);
    add_job(P, nt, P.ffn_w1, (bf16_t*)(ws + OFF_WUP0), P.norm_ffn_g, DM, FFN, FFN, 0, 1, 0, 1.0f);
    add_job(P, nt, P.ffn_w3, (bf16_t*)(ws + OFF_WUP0), P.norm_ffn_g, DM, FFN, FFN, 0, 2, 0, 1.0f);
    add_job(P, nt, P.ffn_w2, (bf16_t*)(ws + OFF_WDN0), nullptr, FFN, DM, DM, 0, 0, 0, 1.0f);
    add_job(P, nt, P.w_kv, (bf16_t*)(ws + OFF_WKVQ), P.kv_norm_g, DM, 2048, 2048, 0, 0, 0, 1.0f);
    add_job(P, nt, P.w_q, (bf16_t*)(ws + OFF_WKVQ), P.norm_mix_g + DM, DM, 1024, 1024, 0, 0, 2048, QSCALE);
    add_job(P, nt, P.w_o, (bf16_t*)(ws + OFF_WO), nullptr, DM, DM, DM, 0, 0, 0, 1.0f);
    add_job(P, nt, P.ffn_w1 + FW, (bf16_t*)(ws + OFF_WUP1), P.norm_ffn_g + DM, DM, FFN, FFN, 0, 1, 0, 1.0f);
    add_job(P, nt, P.ffn_w3 + FW, (bf16_t*)(ws + OFF_WUP1), P.norm_ffn_g + DM, DM, FFN, FFN, 0, 2, 0, 1.0f);
    add_job(P, nt, P.ffn_w2 + FW, (bf16_t*)(ws + OFF_WDN1), nullptr, FFN, DM, DM, 0, 0, 0, 1.0f);
    P.ntiles_w = nt;
    static int grid_blocks = 0;
    if (!grid_blocks) {
        int dev = 0, cus = 0, per_cu = 0;
        hipGetDevice(&dev);
        hipDeviceGetAttribute(&cus, hipDeviceAttributeMultiprocessorCount, dev);
        hipOccupancyMaxActiveBlocksPerMultiprocessor(&per_cu, mega, NTHREADS, 0);
        if (per_cu < 1) per_cu = 1;
        grid_blocks = cus * 1;
    }
    hipMemsetAsync(ws + OFF_BAR, 0, 16384, stream);
    void* args[] = {&P};
    hipError_t e = hipLaunchCooperativeKernel((void*)mega, dim3(grid_blocks), dim3(NTHREADS), args, 0, stream);
    if (e != hipSuccess) fprintf(stderr, "cooperative launch failed: %s (grid %d)\n", hipGetErrorString(e), grid_blocks);
}
```

```cpp
#include <hip/hip_runtime.h>
#include <hip/hip_cooperative_groups.h>
#include <stdint.h>
#include <string.h>
#include <stdio.h>
namespace cg = cooperative_groups;

typedef unsigned short bf16_t;
typedef short bf16x8 __attribute__((ext_vector_type(8)));
typedef float f32x16 __attribute__((ext_vector_type(16)));
typedef float f32x4 __attribute__((ext_vector_type(4)));
typedef float f32x2 __attribute__((ext_vector_type(2)));
typedef unsigned u32x4 __attribute__((ext_vector_type(4)));
typedef unsigned u32x2 __attribute__((ext_vector_type(2)));

#define L_SEQ 16384
#define DM 1024
#define FFN 2816
#define NTHREADS 512
#ifndef REP_ATTN
#define REP_ATTN 1
#endif
#ifndef REP_UP
#define REP_UP 1
#endif
#define REP_GLU 1
#define REP_KVQ 1
#define REP_S5 1
#define REP_SLOC 1
#define REP_PREP 1
#define LDS_BYTES 139280
#define EPSV 1e-6f
#define LAM_INIT 0.35550906759096927f
#define QSCALE 0.18033688011112042f

static constexpr size_t MiB = 1024ull * 1024ull;
static constexpr size_t OFF_WGLU = 0;
static constexpr size_t OFF_WUP0 = 4 * MiB;
static constexpr size_t OFF_WDN0 = 15 * MiB;
static constexpr size_t OFF_WKVQ = 20 * MiB + MiB / 2;
static constexpr size_t OFF_WO = 26 * MiB + MiB / 2;
static constexpr size_t OFF_WUP1 = 28 * MiB + MiB / 2;
static constexpr size_t OFF_WDN1 = 39 * MiB + MiB / 2;
static constexpr size_t OFF_SSQ = 45 * MiB;
static constexpr size_t OFF_A64 = 49 * MiB;
static constexpr size_t OFF_BAR = 49 * MiB + MiB / 2;
static constexpr size_t OFF_A = 50 * MiB;
static constexpr size_t OFF_HN0 = OFF_A;
static constexpr size_t OFF_Z = OFF_A + 32 * MiB;
static constexpr size_t OFF_ACT = OFF_A;
static constexpr size_t OFF_K1 = OFF_A;
static constexpr size_t OFF_K2 = OFF_A + 16 * MiB;
static constexpr size_t OFF_VT = OFF_A + 32 * MiB;
static constexpr size_t OFF_Q1 = OFF_A + 64 * MiB;
static constexpr size_t OFF_Q2 = OFF_A + 80 * MiB;
static constexpr size_t OFF_B = 146 * MiB;
static constexpr size_t OFF_KT = OFF_B;
static constexpr size_t OFF_W1 = OFF_B + 4 * MiB;
static constexpr size_t OFF_W3 = OFF_B + 20 * MiB;
static constexpr size_t OFF_SLOC = OFF_B + 36 * MiB;
static constexpr size_t OFF_SPREV = OFF_B + 44 * MiB;
static constexpr size_t OFF_HB = OFF_B;
static constexpr size_t OFF_ON = OFF_B + 32 * MiB;

struct WJob { const float* src; bf16_t* dst; const float* gain; int K; int N; int ldsrc; int col0; int mode; int rowoff; float scale; int tile0; int ntn; int pad; };

struct Params {
    const float *x, *norm_mix_g, *norm_ffn_g, *ffn_w1, *ffn_w3, *ffn_w2;
    const float *lam_re, *lam_im, *log_dt, *b_re, *b_im, *c_re, *c_im, *ssm_d, *w_glu;
    const float *kv_norm_g, *w_kv, *w_q, *lq1, *lk1, *lq2, *lk2, *subln_g, *w_o, *final_g;
    float* out;
    char* ws;
    WJob jobs[12];
    int njobs; int ntiles_w;
};

__device__ __forceinline__ int get_tid(int wave_s) { int t = wave_s * 64 + (int)__builtin_amdgcn_mbcnt_hi(~0u, __builtin_amdgcn_mbcnt_lo(~0u, 0u)); asm volatile("" : "+v"(t)); return t; }
__device__ __forceinline__ unsigned pk_bf16(float lo, float hi) { unsigned r; asm("v_cvt_pk_bf16_f32 %0, %1, %2" : "=v"(r) : "v"(lo), "v"(hi)); return r; }
__device__ __forceinline__ float bf_lo(unsigned u) { return __uint_as_float(u << 16); }
__device__ __forceinline__ float bf_hi(unsigned u) { return __uint_as_float(u & 0xffff0000u); }
__device__ __forceinline__ float fast_rcp(float x) { return __builtin_amdgcn_rcpf(x); }
__device__ __forceinline__ float fast_exp2(float x) { return __builtin_amdgcn_exp2f(x); }
__device__ __forceinline__ float sigmoidf_(float x) { return fast_rcp(1.0f + fast_exp2(-1.4426950408889634f * x)); }
__device__ __forceinline__ float gelu_tanh(float x) {
    const float u = 0.7978845608028654f * x * (1.0f + 0.044715f * x * x);
    return x * fast_rcp(1.0f + fast_exp2(-2.8853900817779268f * u));
}

struct Seg { const bf16_t* W; long wrs; long wkhi; const bf16_t* X; long xrs; long xkhi; };

struct TileCtx { int wn, wm, lane; };

template <int MB = 2, class Epi>
__device__ __forceinline__ void gemm_tile(const int wave_s, char* lds, const Seg s0, const int nk0_, const Seg s1, const int nk1_, Epi& epi,
                                          const bool pro_done = false, const bool has_next = false, const Seg nx = Seg{nullptr, 0, 0, nullptr, 0, 0}) {
    int tid = get_tid(wave_s);
    const int lane = tid & 63;
    const int wn = wave_s >> 2, wm = wave_s & 3;
    const int lr = lane & 31, h = lane >> 5;
    const int nk0 = nk0_ * 2, nk1 = nk1_ * 2, nk = nk0 + nk1;
    const int cch = (lane & 3) ^ ((lane >> 4) & 3);
    const int row0 = wave_s * 32 + (lane >> 2), rowx = wave_s * (16 * MB) + (lane >> 2);
    f32x16 acc[4][MB];
#pragma unroll
    for (int a = 0; a < 4; ++a)
#pragma unroll
        for (int b = 0; b < MB; ++b)
#pragma unroll
            for (int r = 0; r < 16; ++r) acc[a][b][r] = 0.f;
    auto issue = [&](int t) {
        const bool first = t < nk0;
        const bf16_t* W = first ? s0.W : s1.W; const bf16_t* X = first ? s0.X : s1.X;
        const long wrs = first ? s0.wrs : s1.wrs, xrs = first ? s0.xrs : s1.xrs;
        const long wkhi = first ? s0.wkhi : s1.wkhi, xkhi = first ? s0.xkhi : s1.xkhi;
        const int kt = first ? t : t - nk0;
        const long kc = kt * 2 + (cch >> 1);
        const bf16_t* wp = W + (long)row0 * wrs + kc * wkhi + (cch & 1) * 8;
        const bf16_t* xp = X + (long)rowx * xrs + kc * xkhi + (cch & 1) * 8;
        char* st = lds + (t & 3) * 32768 + wave_s * 2048;
        char* sx = lds + (t & 3) * 32768 + 16384 + wave_s * (1024 * MB);
        __builtin_amdgcn_global_load_lds((const unsigned*)wp, (__attribute__((address_space(3))) unsigned*)(st), 16, 0, 0);
        __builtin_amdgcn_global_load_lds((const unsigned*)(wp + 16 * wrs), (__attribute__((address_space(3))) unsigned*)(st + 1024), 16, 0, 0);
        __builtin_amdgcn_global_load_lds((const unsigned*)xp, (__attribute__((address_space(3))) unsigned*)(sx), 16, 0, 0);
        if (MB == 2) __builtin_amdgcn_global_load_lds((const unsigned*)(xp + 16 * xrs), (__attribute__((address_space(3))) unsigned*)(sx + 1024), 16, 0, 0);
    };
    const int sw = (lr >> 2) & 3;
    const int aoff = (wn * 128 + lr) * 64, boff = 16384 + (wm * (32 * MB) + lr) * 64;
    const int ch0 = ((0 + h) ^ sw) << 4, ch1 = ((2 + h) ^ sw) << 4;
    bf16x8 a0[4], b0[MB], a1[4], b1[MB];
    epi.pre(wm, lane, wn);
    if (!pro_done) { issue(0); issue(1); issue(2); issue(3); }
    if (MB == 2) asm volatile("s_waitcnt vmcnt(12)" ::: "memory"); else asm volatile("s_waitcnt vmcnt(9)" ::: "memory");
    __builtin_amdgcn_s_barrier(); asm volatile("" ::: "memory");
#pragma unroll
    for (int nb = 0; nb < 4; ++nb) a0[nb] = *(const bf16x8*)(lds + aoff + nb * 2048 + ch0);
#pragma unroll
    for (int mb = 0; mb < MB; ++mb) b0[mb] = *(const bf16x8*)(lds + boff + mb * 2048 + ch0);
    for (int t = 0; t < nk; ++t) {
        const char* st = lds + (t & 3) * 32768;
#pragma unroll
        for (int nb = 0; nb < 4; ++nb) a1[nb] = *(const bf16x8*)(st + aoff + nb * 2048 + ch1);
#pragma unroll
        for (int mb = 0; mb < MB; ++mb) b1[mb] = *(const bf16x8*)(st + boff + mb * 2048 + ch1);
#pragma unroll
        for (int nb = 0; nb < 4; ++nb)
#pragma unroll
            for (int mb = 0; mb < MB; ++mb) acc[nb][mb] = __builtin_amdgcn_mfma_f32_32x32x16_bf16(a0[nb], b0[mb], acc[nb][mb], 0, 0, 0);
        const int rem = nk - 1 - t;
        if (MB == 2) { if (rem >= 3) asm volatile("s_waitcnt vmcnt(8)" ::: "memory"); else if (rem == 2) asm volatile("s_waitcnt vmcnt(4)" ::: "memory"); else asm volatile("s_waitcnt vmcnt(0)" ::: "memory"); }
        else { if (rem >= 3) asm volatile("s_waitcnt vmcnt(6)" ::: "memory"); else if (rem == 2) asm volatile("s_waitcnt vmcnt(3)" ::: "memory"); else asm volatile("s_waitcnt vmcnt(0)" ::: "memory"); }
        asm volatile("s_waitcnt lgkmcnt(0)" ::: "memory");
        __builtin_amdgcn_s_barrier(); asm volatile("" ::: "memory");
        if (t + 4 < nk) issue(t + 4);
        if (t + 1 < nk) {
            const char* sn = lds + ((t + 1) & 3) * 32768;
#pragma unroll
            for (int nb = 0; nb < 4; ++nb) a0[nb] = *(const bf16x8*)(sn + aoff + nb * 2048 + ch0);
#pragma unroll
            for (int mb = 0; mb < MB; ++mb) b0[mb] = *(const bf16x8*)(sn + boff + mb * 2048 + ch0);
        }
#pragma unroll
        for (int nb = 0; nb < 4; ++nb)
#pragma unroll
            for (int mb = 0; mb < MB; ++mb) acc[nb][mb] = __builtin_amdgcn_mfma_f32_32x32x16_bf16(a1[nb], b1[mb], acc[nb][mb], 0, 0, 0);
    }
    if (MB == 2 && has_next) {
#pragma unroll
        for (int t = 0; t < 4; ++t) {
            const long kc = t * 2 + (cch >> 1);
            const bf16_t* wp = nx.W + (long)row0 * nx.wrs + kc * nx.wkhi + (cch & 1) * 8;
            const bf16_t* xp = nx.X + (long)rowx * nx.xrs + kc * nx.xkhi + (cch & 1) * 8;
            char* st = lds + t * 32768 + wave_s * 2048;
            __builtin_amdgcn_global_load_lds((const unsigned*)wp, (__attribute__((address_space(3))) unsigned*)(st), 16, 0, 0);
            __builtin_amdgcn_global_load_lds((const unsigned*)(wp + 16 * nx.wrs), (__attribute__((address_space(3))) unsigned*)(st + 1024), 16, 0, 0);
            __builtin_amdgcn_global_load_lds((const unsigned*)xp, (__attribute__((address_space(3))) unsigned*)(st + 16384), 16, 0, 0);
            __builtin_amdgcn_global_load_lds((const unsigned*)(xp + 16 * nx.xrs), (__attribute__((address_space(3))) unsigned*)(st + 16384 + 1024), 16, 0, 0);
        }
    }
    TileCtx c; c.wn = wn; c.wm = wm; c.lane = lane;
    epi(acc, c);
}

template <int NPART>
__device__ __forceinline__ float rstd_from(const float* ssq, int token) {
    float v[NPART];
#pragma unroll
    for (int i = 0; i < NPART; ++i) v[i] = ssq[(size_t)i * L_SEQ + token];
    float s = 0.f;
#pragma unroll
    for (int i = 0; i < NPART; ++i) s += v[i];
    return rsqrtf(s * (1.0f / DM) + EPSV);
}

__device__ __forceinline__ u32x4 widen8(u32x2 A, u32x2 B) {
    const auto r0 = __builtin_amdgcn_permlane32_swap(A[0], B[0], false, false);
    const auto r1 = __builtin_amdgcn_permlane32_swap(A[1], B[1], false, false);
    u32x4 o; o[0] = r0[0]; o[1] = r1[0]; o[2] = r0[1]; o[3] = r1[1]; return o;
}

struct EpiSloc {
    float* dst;
    __device__ __forceinline__ void pre(int, int, int) {}
    __device__ __forceinline__ void operator()(f32x16 (&acc)[4][2], const TileCtx& c) const {
        if (c.wn != 0) return;
        const int lr = c.lane & 31, h = c.lane >> 5;
#pragma unroll
        for (int mb = 0; mb < 2; ++mb) { const int m = c.wm * 64 + mb * 32 + lr;
#pragma unroll
            for (int nb = 0; nb < 4; ++nb)
#pragma unroll
                for (int rq = 0; rq < 4; ++rq) { const int n = nb * 32 + rq * 8 + 4 * h;
                    f32x4 v = {acc[nb][mb][4 * rq], acc[nb][mb][4 * rq + 1], acc[nb][mb][4 * rq + 2], acc[nb][mb][4 * rq + 3]};
                    *(f32x4*)(dst + m * 132 + n) = v; } }
    }
};

struct EpiS5 {
    const bf16_t* hn0; const float* dskip; bf16_t* z; int g; int n0;
    __device__ __forceinline__ void pre(int, int, int) {}
    __device__ __forceinline__ void operator()(f32x16 (&acc)[4][2], const TileCtx& c) const {
        const int lr = c.lane & 31, h = c.lane >> 5;
#pragma unroll
        for (int mb = 0; mb < 2; ++mb) { const int j = c.wm * 64 + mb * 32 + lr;
            u32x2 uu[16], zz[16];
#pragma unroll
            for (int q = 0; q < 16; ++q) { const int n = n0 + c.wn * 128 + (q >> 2) * 32 + (q & 3) * 8 + 4 * h; uu[q] = *(const u32x2*)(hn0 + (size_t)g * 262144 + (size_t)j * 1024 + n); }
            asm volatile("" ::: "memory");
#pragma unroll
            for (int q = 0; q < 16; ++q) { const int nb = q >> 2, rq = q & 3; const int n = n0 + c.wn * 128 + nb * 32 + rq * 8 + 4 * h; const int t = n >> 4, cc = n & 15;
                const size_t off = (size_t)g * 262144 + (size_t)(j * 64 + t) * 16 + cc; const f32x4 d4 = *(const f32x4*)(dskip + g * 16 + cc);
                const float y0 = acc[nb][mb][4 * rq] + d4[0] * bf_lo(uu[q][0]), y1 = acc[nb][mb][4 * rq + 1] + d4[1] * bf_hi(uu[q][0]);
                const float y2 = acc[nb][mb][4 * rq + 2] + d4[2] * bf_lo(uu[q][1]), y3 = acc[nb][mb][4 * rq + 3] + d4[3] * bf_hi(uu[q][1]);
                zz[q][0] = pk_bf16(gelu_tanh(y0), gelu_tanh(y1)); zz[q][1] = pk_bf16(gelu_tanh(y2), gelu_tanh(y3)); (void)off; }
#pragma unroll
            for (int q = 0; q < 16; q += 2) { const int n = n0 + c.wn * 128 + (q >> 2) * 32 + (q & 3) * 8 + 8 * h;
                *(u32x4*)(z + (size_t)g * 262144 + (size_t)(j * 64 + (n >> 4)) * 16 + (n & 15)) = widen8(zz[q], zz[q + 1]); }
            asm volatile("" ::: "memory"); }
    }
};

struct EpiGlu {
    const float* x; float* out; bf16_t* hb; float* ssq; int n0, m0;
    __device__ __forceinline__ void pre(int, int, int) {}
    __device__ __forceinline__ void operator()(f32x16 (&acc)[4][2], const TileCtx& c) const {
        const int lr = c.lane & 31, h = c.lane >> 5;
#pragma unroll
        for (int mb = 0; mb < 2; ++mb) { const int m = m0 + c.wm * 64 + mb * 32 + lr; float s = 0.f;
            const size_t rowoff = (size_t)m * DM + ((n0 + c.wn * 128) >> 1) + 4 * h;
            f32x4 xv[8]; u32x2 pkk[8];
#pragma unroll
            for (int q = 0; q < 8; ++q) xv[q] = *(const f32x4*)(x + rowoff + (q >> 1) * 16 + (q & 1) * 8);
            asm volatile("" ::: "memory");
#pragma unroll
            for (int q = 0; q < 8; ++q) { const int nb = q >> 1, rg = q & 1; const size_t off = rowoff + nb * 16 + rg * 8; f32x4 o;
#pragma unroll
                for (int e = 0; e < 4; ++e) { o[e] = xv[q][e] + acc[nb][mb][rg * 8 + e] * sigmoidf_(acc[nb][mb][rg * 8 + 4 + e]); s += o[e] * o[e]; }
                *(f32x4*)(out + off) = o; pkk[q][0] = pk_bf16(o[0], o[1]); pkk[q][1] = pk_bf16(o[2], o[3]); }
#pragma unroll
            for (int q = 0; q < 8; q += 2) *(u32x4*)(hb + (size_t)m * DM + ((n0 + c.wn * 128) >> 1) + (q >> 1) * 16 + 8 * h) = widen8(pkk[q], pkk[q + 1]);
            asm volatile("" ::: "memory");
            s += __shfl_xor(s, 32);
            if (h == 0) ssq[(size_t)((n0 >> 8) * 2 + c.wn) * L_SEQ + m] = s; }
    }
};

template <int NPART, int MB = 2> struct EpiUp {
    const float* ssq; bf16_t* act; int n0, m0; float rsv[MB];
    __device__ __forceinline__ void pre(int wm, int lane, int) {
#pragma unroll
        for (int mb = 0; mb < MB; ++mb) rsv[mb] = rstd_from<NPART>(ssq, m0 + wm * (32 * MB) + mb * 32 + (lane & 31)); }
    __device__ __forceinline__ void operator()(f32x16 (&acc)[4][MB], const TileCtx& c) const {
        const int lr = c.lane & 31, h = c.lane >> 5;
#pragma unroll
        for (int mb = 0; mb < MB; ++mb) { const int m = m0 + c.wm * (32 * MB) + mb * 32 + lr; const float rs = rsv[mb];
#pragma unroll
            for (int nb = 0; nb < 4; ++nb) { u32x2 pk[2];
#pragma unroll
                for (int rg = 0; rg < 2; ++rg) { float o[4];
#pragma unroll
                    for (int e = 0; e < 4; ++e) { const float a = acc[nb][mb][rg * 8 + e] * rs, b = acc[nb][mb][rg * 8 + 4 + e] * rs; o[e] = a * sigmoidf_(a) * b; }
                    pk[rg][0] = pk_bf16(o[0], o[1]); pk[rg][1] = pk_bf16(o[2], o[3]); }
                *(u32x4*)(act + (size_t)m * FFN + ((n0 + c.wn * 128 + nb * 32) >> 1) + 8 * h) = widen8(pk[0], pk[1]); } }
    }
};

struct EpiRes {
    float* out; bf16_t* hb; float* ssq; int n0, m0;
    __device__ __forceinline__ void pre(int, int, int) {}
    __device__ __forceinline__ void operator()(f32x16 (&acc)[4][2], const TileCtx& c) const {
        const int lr = c.lane & 31, h = c.lane >> 5;
#pragma unroll
        for (int mb = 0; mb < 2; ++mb) { const int m = m0 + c.wm * 64 + mb * 32 + lr; float s = 0.f;
            const size_t rowoff = (size_t)m * DM + n0 + c.wn * 128 + 4 * h;
#pragma unroll
            for (int np = 0; np < 2; ++np) {
                f32x4 o[8];
#pragma unroll
                for (int q = 0; q < 8; ++q) o[q] = *(const f32x4*)(out + rowoff + (np * 2 + (q >> 2)) * 32 + (q & 3) * 8);
                asm volatile("" ::: "memory");
#pragma unroll
                for (int q = 0; q < 8; ++q) { const int nb = np * 2 + (q >> 2), rq = q & 3; const size_t off = rowoff + nb * 32 + rq * 8;
#pragma unroll
                    for (int e = 0; e < 4; ++e) { o[q][e] += acc[nb][mb][4 * rq + e]; s += o[q][e] * o[q][e]; }
                    *(f32x4*)(out + off) = o[q]; }
                if (hb) {
#pragma unroll
                    for (int q = 0; q < 8; q += 2) { u32x2 A, B; A[0] = pk_bf16(o[q][0], o[q][1]); A[1] = pk_bf16(o[q][2], o[q][3]); B[0] = pk_bf16(o[q + 1][0], o[q + 1][1]); B[1] = pk_bf16(o[q + 1][2], o[q + 1][3]);
                        *(u32x4*)(hb + (size_t)m * DM + n0 + c.wn * 128 + (np * 2 + (q >> 2)) * 32 + (q & 3) * 8 + 8 * h) = widen8(A, B); } }
                asm volatile("" ::: "memory");
            }
            s += __shfl_xor(s, 32);
            if (h == 0) ssq[(size_t)((n0 >> 8) * 2 + c.wn) * L_SEQ + m] = s; }
    }
};

struct EpiKvq {
    const float* ssq; char* ws; char* ldsb; int n0, m0; float rsv[2];
    __device__ __forceinline__ void pre(int wm, int lane, int) {
#pragma unroll
        for (int mb = 0; mb < 2; ++mb) rsv[mb] = rstd_from<8>(ssq, m0 + wm * 64 + mb * 32 + (lane & 31)); }
    __device__ __forceinline__ void operator()(f32x16 (&acc)[4][2], const TileCtx& c) const {
        const int lr = c.lane & 31, h = c.lane >> 5;
        const bool isV = (n0 >= 1024 && n0 < 2048);
#pragma unroll
        for (int mb = 0; mb < 2; ++mb) { const int m = m0 + c.wm * 64 + mb * 32 + lr; const float rs = rsv[mb];
            if (isV) {
                const int ml = c.wm * 64 + mb * 32 + lr;
                const int mp = (ml & ~12) | ((ml & 4) << 1) | ((ml & 8) >> 1);
#pragma unroll
                for (int nb = 0; nb < 4; ++nb)
#pragma unroll
                    for (int r = 0; r < 16; ++r) { const int nl = c.wn * 128 + nb * 32 + (r & 3) + 8 * (r >> 2) + 4 * h;
                        *(bf16_t*)(ldsb + nl * 528 + mp * 2) = (bf16_t)(pk_bf16(acc[nb][mb][r] * rs, 0.f) & 0xffffu); }
            } else {
                size_t base; int nl;
                if (n0 < 512) { base = OFF_K1; nl = n0; } else if (n0 < 1024) { base = OFF_K2; nl = n0 - 512; } else if (n0 < 2560) { base = OFF_Q1; nl = n0 - 2048; } else { base = OFF_Q2; nl = n0 - 2560; }
                bf16_t* dst = (bf16_t*)(ws + base);
                float cs[4], sn[4];
#pragma unroll
                for (int e = 0; e < 4; ++e) { const int i = 4 * h + e;
                    const float invf = (i == 0) ? 1.0f : (i == 1) ? 0.19391188f : (i == 2) ? 0.037601817f : (i == 3) ? 0.0072914392f : (i == 4) ? 0.0014142136f : (i == 5) ? 0.00027423282f : (i == 6) ? 5.3176997e-05f : 1.0311653e-05f;
                    const float ang = (float)m * invf; double rev = (double)ang * 0.15915494309189535; rev -= rint(rev); const float fr = (float)rev;
                    cs[e] = __builtin_amdgcn_cosf(fr); sn[e] = __builtin_amdgcn_sinf(fr); }
#pragma unroll
                for (int nb = 0; nb < 4; ++nb) {
                    const int nn = nl + c.wn * 128 + nb * 32; const int head = nn >> 6, d0 = nn & 63;
                    float v[16];
#pragma unroll
                    for (int r = 0; r < 16; ++r) v[r] = acc[nb][mb][r] * rs;
                    if (d0 == 0) {
#pragma unroll
                        for (int e = 0; e < 4; ++e) { const float x1 = v[e], x2 = v[4 + e]; v[e] = x1 * cs[e] - x2 * sn[e]; v[4 + e] = x2 * cs[e] + x1 * sn[e]; }
                    }
#pragma unroll
                    for (int rq = 0; rq < 4; rq += 2) { u32x2 A, B; A[0] = pk_bf16(v[4 * rq], v[4 * rq + 1]); A[1] = pk_bf16(v[4 * rq + 2], v[4 * rq + 3]);
                        B[0] = pk_bf16(v[4 * rq + 4], v[4 * rq + 5]); B[1] = pk_bf16(v[4 * rq + 6], v[4 * rq + 7]);
                        *(u32x4*)(dst + ((size_t)head * L_SEQ + m) * 64 + d0 + rq * 8 + 8 * h) = widen8(A, B); }
                }
            } }
        if (isV) {
            __syncthreads();
            bf16_t* vt = (bf16_t*)(ws + OFF_VT) + (size_t)(n0 - 1024) * L_SEQ + m0;
            const int tid = c.wn * 256 + c.wm * 64 + c.lane;
#pragma unroll
            for (int i = 0; i < 16; ++i) { const int q = tid + 512 * i, row = q >> 5, c16 = q & 31;
                const u32x4 v = *(const u32x4*)(ldsb + row * 528 + c16 * 16);
                *(u32x4*)(vt + (size_t)row * L_SEQ + c16 * 8) = v; }
            __syncthreads();
        }
    }
};

__device__ __forceinline__ void s5_tables(const int wave_s, const Params& p, int g, char* lds) {
    f32x2* apow = (f32x2*)lds;
    f32x2* bb = apow + 65 * 64;
    f32x2* cc = bb + 1024;
    f32x2* zf = cc + 1024;
    int tid = get_tid(wave_s); asm volatile("" : "+v"(tid));
    const float dt = expf(p.log_dt[g]);
    for (int e = tid; e < 65 * 64; e += NTHREADS) {
        const int lag = e >> 6, pp = e & 63;
        const float lr = p.lam_re[g * 64 + pp], li = p.lam_im[g * 64 + pp];
        const float mag = expf(lr * dt * (float)lag);
        double rev = (double)li * (double)dt * (double)lag * 0.15915494309189535; rev -= rint(rev);
        const float fr = (float)rev;
        f32x2 v; v[0] = mag * __builtin_amdgcn_cosf(fr); v[1] = mag * __builtin_amdgcn_sinf(fr); apow[e] = v;
    }
    if (tid < 64) {
        const float lr = p.lam_re[g * 64 + tid], li = p.lam_im[g * 64 + tid];
        const float em1 = expm1f(lr * dt);
        double rev = (double)li * (double)dt * 0.15915494309189535; const double rh = rev * 0.5; rev -= rint(rev);
        const double rh2 = rh - rint(rh);
        const float cth = __builtin_amdgcn_cosf((float)rev), sth = __builtin_amdgcn_sinf((float)rev), shalf = __builtin_amdgcn_sinf((float)rh2);
        const float nr = em1 * cth - 2.0f * shalf * shalf, ni = (1.0f + em1) * sth;
        const float den = lr * lr + li * li;
        f32x2 f; f[0] = (nr * lr + ni * li) / den; f[1] = (ni * lr - nr * li) / den; zf[tid] = f;
    }
    __syncthreads();
    for (int e = tid; e < 1024; e += NTHREADS) {
        const int pp = e >> 4;
        const float br = p.b_re[(size_t)g * 1024 + e], bi = p.b_im[(size_t)g * 1024 + e];
        const f32x2 f = zf[pp]; f32x2 v; v[0] = f[0] * br - f[1] * bi; v[1] = f[0] * bi + f[1] * br; bb[e] = v;
        f32x2 cv; cv[0] = p.c_re[(size_t)g * 1024 + e]; cv[1] = p.c_im[(size_t)g * 1024 + e]; cc[e] = cv;
    }
    __syncthreads();
    bf16_t* kt = (bf16_t*)(p.ws + OFF_KT) + (size_t)g * 127 * 256;
    bf16_t* w1 = (bf16_t*)(p.ws + OFF_W1) + (size_t)g * 128 * 1024;
    bf16_t* w3 = (bf16_t*)(p.ws + OFF_W3) + (size_t)g * 1024 * 128;
    {
        const int pg = tid & 63, lg = tid >> 6, c = pg >> 2, c2 = (pg & 3) * 4;
        float acc[8][4];
#pragma unroll
        for (int l = 0; l < 8; ++l)
#pragma unroll
            for (int k = 0; k < 4; ++k) acc[l][k] = 0.f;
        for (int pp = 0; pp < 64; ++pp) {
            const f32x2 cv = cc[c * 64 + pp];
            float cbr[4], cbi[4];
#pragma unroll
            for (int k = 0; k < 4; ++k) { const f32x2 bv = bb[pp * 16 + c2 + k]; cbr[k] = cv[0] * bv[0] - cv[1] * bv[1]; cbi[k] = cv[0] * bv[1] + cv[1] * bv[0]; }
#pragma unroll
            for (int l = 0; l < 8; ++l) { const f32x2 a = apow[(lg * 8 + l) * 64 + pp];
#pragma unroll
                for (int k = 0; k < 4; ++k) acc[l][k] += cbr[k] * a[0] - cbi[k] * a[1]; }
        }
#pragma unroll
        for (int l = 0; l < 8; ++l) { u32x2 o; o[0] = pk_bf16(acc[l][0], acc[l][1]); o[1] = pk_bf16(acc[l][2], acc[l][3]);
            *(u32x2*)(kt + (size_t)(63 + lg * 8 + l) * 256 + pg * 4) = o; }
        for (int e = tid; e < 63 * 256 / 8; e += NTHREADS) { u32x4 zz = {0u, 0u, 0u, 0u}; *(u32x4*)(kt + e * 8) = zz; }
    }
    for (int q = tid; q < 128 * 128; q += NTHREADS) {
        const int pq = q >> 7, kc = q & 127, tau = kc >> 1, c0 = (kc & 1) * 8, pp = pq & 63, im = pq >> 6;
        const f32x2 a = apow[(63 - tau) * 64 + pp]; float v[8];
#pragma unroll
        for (int e = 0; e < 8; ++e) { const f32x2 b = bb[pp * 16 + c0 + e]; v[e] = im ? (a[0] * b[1] + a[1] * b[0]) : (a[0] * b[0] - a[1] * b[1]); }
        u32x4 o; o[0] = pk_bf16(v[0], v[1]); o[1] = pk_bf16(v[2], v[3]); o[2] = pk_bf16(v[4], v[5]); o[3] = pk_bf16(v[6], v[7]);
        *(u32x4*)(w1 + (size_t)pq * 1024 + kc * 8) = o;
    }
    for (int q = tid; q < 1024 * 16; q += NTHREADS) {
        const int n = q >> 4, p0 = (q & 15) * 8, t = n >> 4, c = n & 15, im = p0 >> 6; float v[8];
#pragma unroll
        for (int e = 0; e < 8; ++e) { const int pp = (p0 + e) & 63; const f32x2 a = apow[(t + 1) * 64 + pp]; const f32x2 cv = cc[c * 64 + pp];
            v[e] = im ? -(cv[0] * a[1] + cv[1] * a[0]) : (cv[0] * a[0] - cv[1] * a[1]); }
        u32x4 o; o[0] = pk_bf16(v[0], v[1]); o[1] = pk_bf16(v[2], v[3]); o[2] = pk_bf16(v[4], v[5]); o[3] = pk_bf16(v[6], v[7]);
        *(u32x4*)(w3 + (size_t)n * 128 + p0) = o;
    }
    if (tid < 64) ((f32x2*)(p.ws + OFF_A64))[g * 64 + tid] = apow[64 * 64 + tid];
    __syncthreads();
}

__device__ __forceinline__ void wtile(const int wave_s, const Params& p, int t, char* lds) {
    int j = 0;
    for (int i = 1; i < p.njobs; ++i) if (t >= p.jobs[i].tile0) j = i;
    const WJob& J = p.jobs[j];
    const int lt = t - J.tile0, kt = lt / J.ntn, nt = lt - kt * J.ntn;
    const int k0 = kt * 64, nl0 = nt * 256;
    float* T = (float*)lds;
    int tid = get_tid(wave_s); asm volatile("" : "+v"(tid));
    const int c4 = (tid & 63) * 4, kb = tid >> 6;
    f32x4 v[8];
#pragma unroll
    for (int i = 0; i < 8; ++i) v[i] = *(const f32x4*)(J.src + (size_t)(k0 + kb + 8 * i) * J.ldsrc + J.col0 + nl0 + c4);
#pragma unroll
    for (int i = 0; i < 8; ++i) { const int kk = kb + 8 * i; float sc = J.scale; if (J.gain) sc *= J.gain[k0 + kk];
        T[kk * 257 + c4] = v[i][0] * sc; T[kk * 257 + c4 + 1] = v[i][1] * sc; T[kk * 257 + c4 + 2] = v[i][2] * sc; T[kk * 257 + c4 + 3] = v[i][3] * sc; }
    __syncthreads();
    { const int nn = tid >> 1, kh = (tid & 1) * 32;
        const int n = nl0 + nn; int row = (J.mode == 0) ? n : ((n >> 3) * 16 + (n & 7) + (J.mode == 2 ? 8 : 0)); row += J.rowoff;
        bf16_t* d = J.dst + (size_t)row * J.K + k0 + kh;
#pragma unroll
        for (int q = 0; q < 4; ++q) { float w[8];
#pragma unroll
            for (int e = 0; e < 8; ++e) w[e] = T[(kh + q * 8 + e) * 257 + nn];
            u32x4 o; o[0] = pk_bf16(w[0], w[1]); o[1] = pk_bf16(w[2], w[3]); o[2] = pk_bf16(w[4], w[5]); o[3] = pk_bf16(w[6], w[7]);
            *(u32x4*)(d + q * 8) = o; } }
    __syncthreads();
}

__device__ __forceinline__ void rms0_item(const int wave_s, const Params& p, int item) {
    const int lane = get_tid(wave_s) & 63, wid = wave_s;
    bf16_t* hn0 = (bf16_t*)(p.ws + OFF_HN0);
    f32x4 g[4];
#pragma unroll
    for (int i = 0; i < 4; ++i) g[i] = *(const f32x4*)(p.norm_mix_g + lane * 4 + 256 * i);
    for (int rb = 0; rb < 2; ++rb) {
        f32x4 v[4][4];
#pragma unroll
        for (int r = 0; r < 4; ++r)
#pragma unroll
            for (int i = 0; i < 4; ++i) v[r][i] = *(const f32x4*)(p.x + (size_t)(item * 64 + wid * 8 + rb * 4 + r) * DM + lane * 4 + 256 * i);
#pragma unroll
        for (int r = 0; r < 4; ++r) {
            const int row = item * 64 + wid * 8 + rb * 4 + r;
            float s = 0.f;
#pragma unroll
            for (int i = 0; i < 4; ++i) s += v[r][i][0] * v[r][i][0] + v[r][i][1] * v[r][i][1] + v[r][i][2] * v[r][i][2] + v[r][i][3] * v[r][i][3];
#pragma unroll
            for (int o = 32; o >= 1; o >>= 1) s += __shfl_xor(s, o);
            const float rs = rsqrtf(s * (1.0f / DM) + EPSV);
#pragma unroll
            for (int i = 0; i < 4; ++i) {
                u32x2 o; o[0] = pk_bf16(v[r][i][0] * rs * g[i][0], v[r][i][1] * rs * g[i][1]); o[1] = pk_bf16(v[r][i][2] * rs * g[i][2], v[r][i][3] * rs * g[i][3]);
                const int col = lane * 4 + 256 * i;
                *(u32x2*)(hn0 + (size_t)(col >> 4) * 262144 + (size_t)(row >> 6) * 1024 + (row & 63) * 16 + (col & 15)) = o; }
        }
    }
}

__device__ __forceinline__ void attn_item(const int wave_s, const Params& p, int head, int qb, float lam, char* lds) {
    int tid = get_tid(wave_s); asm volatile("" : "+v"(tid));
    const int lane = tid & 63, wid = tid >> 6;
    const int mp = wid >> 2, g = wid & 3;
    const int lr = lane & 31, h = lane >> 5, sw = (lane >> 1) & 7;
    const bf16_t* K1 = (const bf16_t*)(p.ws + OFF_K1) + (size_t)head * L_SEQ * 64;
    const bf16_t* K2 = (const bf16_t*)(p.ws + OFF_K2) + (size_t)head * L_SEQ * 64;
    const bf16_t* VT = (const bf16_t*)(p.ws + OFF_VT) + (size_t)head * 128 * L_SEQ;
    const bf16_t* Q = (const bf16_t*)(p.ws + (mp ? OFF_Q2 : OFF_Q1)) + (size_t)head * L_SEQ * 64;
    const int q0 = qb * 128 + g * 32;
    bf16x8 qf[4];
#pragma unroll
    for (int s = 0; s < 4; ++s) qf[s] = *(const bf16x8*)(Q + (size_t)(q0 + lr) * 64 + 16 * s + 8 * h);
    const int nkt = 2 * qb + 2;
    const int my_last = 2 * qb + (g >> 1);
    f32x16 O[4];
#pragma unroll
    for (int e = 0; e < 4; ++e)
#pragma unroll
        for (int r = 0; r < 16; ++r) O[e][r] = 0.f;
    float m_run = 0.f, l_run = 0.f;
    f32x16 negm;
#pragma unroll
    for (int r = 0; r < 16; ++r) negm[r] = 0.f;
    const int lrow = lane >> 3;
    const int ck = (lane & 7) ^ (((wave_s & 1) * 4 + (lane >> 4)) & 7);
    const int cv0 = (lane & 7) ^ (lane >> 4), cv1 = (lane & 7) ^ (4 + (lane >> 4));
    const bf16_t* k1p = K1 + (size_t)(wave_s * 8 + lrow) * 64 + ck * 8;
    const bf16_t* k2p = K2 + (size_t)(wave_s * 8 + lrow) * 64 + ck * 8;
    const bf16_t* v0p = VT + (size_t)(wave_s * 16 + lrow) * L_SEQ + cv0 * 8;
    const bf16_t* v1p = VT + (size_t)(wave_s * 16 + 8 + lrow) * L_SEQ + cv1 * 8;
    auto issue = [&](int kt) {
        char* st = lds + (kt & 3) * 32768;
        __builtin_amdgcn_global_load_lds((const unsigned*)(k1p + (size_t)kt * 4096), (__attribute__((address_space(3))) unsigned*)(st + wave_s * 1024), 16, 0, 0);
        __builtin_amdgcn_global_load_lds((const unsigned*)(k2p + (size_t)kt * 4096), (__attribute__((address_space(3))) unsigned*)(st + 8192 + wave_s * 1024), 16, 0, 0);
        __builtin_amdgcn_global_load_lds((const unsigned*)(v0p + kt * 64), (__attribute__((address_space(3))) unsigned*)(st + 16384 + wave_s * 2048), 16, 0, 0);
        __builtin_amdgcn_global_load_lds((const unsigned*)(v1p + kt * 64), (__attribute__((address_space(3))) unsigned*)(st + 16384 + wave_s * 2048 + 1024), 16, 0, 0);
    };
    issue(0); issue(1);
    if (nkt > 2) issue(2);
    if (nkt > 2) asm volatile("s_waitcnt vmcnt(8)" ::: "memory");
    else asm volatile("s_waitcnt vmcnt(4)" ::: "memory");
    __builtin_amdgcn_s_barrier(); asm volatile("" ::: "memory");
    const int koff_ = mp * 8192 + lr * 128, voff_ = 16384 + lr * 128;
    int chk[4], chv[4];
#pragma unroll
    for (int s = 0; s < 4; ++s) { chk[s] = ((2 * s + h) ^ sw) << 4; chv[s] = chk[s]; }
    bf16x8 kf[8], vf[8];
#pragma unroll
    for (int i = 0; i < 8; ++i) kf[i] = *(const bf16x8*)(lds + koff_ + (i >> 2) * 4096 + chk[i & 3]);
    for (int kt = 0; kt < nkt; ++kt) {
        const bool active = kt <= my_last;
        const char* stg = lds + (kt & 3) * 32768;
        f32x16 S[2];
        bf16x8 pf[2][2];
        if (active) {
#pragma unroll
            for (int kb = 0; kb < 2; ++kb) {
                S[kb] = __builtin_amdgcn_mfma_f32_32x32x16_bf16(kf[kb * 4], qf[0], negm, 0, 0, 0);
#pragma unroll
                for (int s = 1; s < 4; ++s) S[kb] = __builtin_amdgcn_mfma_f32_32x32x16_bf16(kf[kb * 4 + s], qf[s], S[kb], 0, 0, 0);
            }
#pragma unroll
            for (int i = 0; i < 8; ++i) vf[i] = *(const bf16x8*)(stg + voff_ + (i & 3) * 4096 + chv[i >> 2]);
            __builtin_amdgcn_sched_barrier(0);
            float mt = S[0][0];
#pragma unroll
            for (int r = 1; r < 16; ++r) mt = fmaxf(mt, S[0][r]);
#pragma unroll
            for (int r = 0; r < 16; ++r) mt = fmaxf(mt, S[1][r]);
            { const auto sw2 = __builtin_amdgcn_permlane32_swap(__float_as_uint(mt), __float_as_uint(mt), false, false);
              mt = fmaxf(__uint_as_float(sw2[0]), __uint_as_float(sw2[1])); }
            const bool need = (mt > 8.0f) || (kt == 0);
            if (__any(need)) {
                const float d = need ? mt : 0.f;
                const float alpha = fast_exp2(-d);
                m_run += d; l_run *= alpha;
#pragma unroll
                for (int r = 0; r < 16; ++r) negm[r] -= d;
#pragma unroll
                for (int kb = 0; kb < 2; ++kb)
#pragma unroll
                    for (int r = 0; r < 16; ++r) S[kb][r] -= d;
#pragma unroll
                for (int e = 0; e < 4; ++e)
#pragma unroll
                    for (int r = 0; r < 16; ++r) O[e][r] *= alpha;
            }
            f32x2 ls2 = {0.f, 0.f};
#pragma unroll
            for (int kb = 0; kb < 2; ++kb)
#pragma unroll
                for (int s = 0; s < 2; ++s) { float e_[8];
#pragma unroll
                    for (int j = 0; j < 8; ++j) e_[j] = fast_exp2(S[kb][8 * s + j]);
#pragma unroll
                    for (int j = 0; j < 8; j += 2) { f32x2 t2 = {e_[j], e_[j + 1]}; ls2 += t2; }
                    u32x4 pk; pk[0] = pk_bf16(e_[0], e_[1]); pk[1] = pk_bf16(e_[2], e_[3]); pk[2] = pk_bf16(e_[4], e_[5]); pk[3] = pk_bf16(e_[6], e_[7]);
                    pf[kb][s] = __builtin_bit_cast(bf16x8, pk); }
            const float ls = ls2[0] + ls2[1];
            l_run += ls;
        }
        const int rem = nkt - 1 - kt;
        if (rem >= 2) asm volatile("s_waitcnt vmcnt(4)" ::: "memory");
        else asm volatile("s_waitcnt vmcnt(0)" ::: "memory");
        __builtin_amdgcn_s_barrier(); asm volatile("" ::: "memory");
        if (kt + 3 < nkt) issue(kt + 3);
        if (kt + 1 <= my_last) {
            const char* sn = lds + ((kt + 1) & 3) * 32768;
#pragma unroll
            for (int i = 0; i < 8; ++i) kf[i] = *(const bf16x8*)(sn + koff_ + (i >> 2) * 4096 + chk[i & 3]);
        }
        __builtin_amdgcn_sched_barrier(0);
        if (active) {
#pragma unroll
            for (int i = 0; i < 8; ++i) O[i & 3] = __builtin_amdgcn_mfma_f32_32x32x16_bf16(vf[i], pf[0][i >> 2], O[i & 3], 0, 0, 0);
#pragma unroll
            for (int i = 0; i < 8; ++i) vf[i] = *(const bf16x8*)(stg + voff_ + (i & 3) * 4096 + (((4 + 2 * (i >> 2) + h) ^ sw) << 4));
#pragma unroll
            for (int i = 0; i < 8; ++i) O[i & 3] = __builtin_amdgcn_mfma_f32_32x32x16_bf16(vf[i], pf[1][i >> 2], O[i & 3], 0, 0, 0);
        }
    }
    __syncthreads();
    const float lt = l_run + __shfl_xor(l_run, 32);
    const float inv = fast_rcp(lt) * (mp ? lam : 1.0f);
    float* ex = (float*)lds;
    if (mp == 1) {
#pragma unroll
        for (int e = 0; e < 4; ++e)
#pragma unroll
            for (int r = 0; r < 16; ++r) ex[((g * 4 + e) * 16 + r) * 64 + lane] = O[e][r] * inv;
    }
    __syncthreads();
    if (mp == 0) {
        float ss = 0.f;
#pragma unroll
        for (int e = 0; e < 4; ++e)
#pragma unroll
            for (int r = 0; r < 16; ++r) { const float o = O[e][r] * inv - ex[((g * 4 + e) * 16 + r) * 64 + lane]; O[e][r] = o; ss += o * o; }
        ss += __shfl_xor(ss, 32);
        const float rs = rsqrtf(ss * (1.0f / 128.0f) + EPSV) * (1.0f - LAM_INIT);
        bf16_t* on = (bf16_t*)(p.ws + OFF_ON) + (size_t)(q0 + lr) * DM + head * 128;
#pragma unroll
        for (int e = 0; e < 4; ++e)
#pragma unroll
            for (int rq = 0; rq < 4; ++rq) { const int ee = e * 32 + rq * 8 + 4 * h; const f32x4 gg = *(const f32x4*)(p.subln_g + ee);
                u32x2 b; b[0] = pk_bf16(O[e][4 * rq] * rs * gg[0], O[e][4 * rq + 1] * rs * gg[1]); b[1] = pk_bf16(O[e][4 * rq + 2] * rs * gg[2], O[e][4 * rq + 3] * rs * gg[3]);
                *(u32x2*)(on + ee) = b; }
    }
    __syncthreads();
}


#define XB_XCNT(j)  (64 + 64 * (j))
#define XB_XSUB(j)  (1088 + 64 * (j))
#define XB_XGEN(j)  (2112 + 64 * (j))
#define XB_TOP      3136
#define XB_TOPGEN   3200
#define XB_WORDS    3264
__device__ __forceinline__ unsigned xb_ld(unsigned* p) { return __hip_atomic_load(p, __ATOMIC_RELAXED, __HIP_MEMORY_SCOPE_AGENT); }
__device__ __forceinline__ unsigned xb_add(unsigned* p, unsigned v) { return __hip_atomic_fetch_add(p, v, __ATOMIC_RELAXED, __HIP_MEMORY_SCOPE_AGENT); }
__device__ __forceinline__ unsigned xb_xcc_id() { return (unsigned)__builtin_amdgcn_s_getreg((3 << 11) | 20) & 0xFu; }
__device__ __forceinline__ void gbar(const int wave_s, unsigned* bar, volatile unsigned* st) {
    asm volatile("s_waitcnt vmcnt(0)" ::: "memory");
    __syncthreads();
    if (get_tid(wave_s) == 0) {
        __builtin_amdgcn_s_waitcnt(0);
        const unsigned x = st[2], nloc = st[0], nx = st[1];
        const unsigned old = xb_add(&bar[XB_XSUB(x)], 1u);
        const unsigned gen = old / nloc;
        if (old + 1u == (gen + 1u) * nloc) {
            __builtin_amdgcn_fence(__ATOMIC_RELEASE, "agent");
            asm volatile("s_waitcnt vmcnt(0)" ::: "memory");
            const unsigned og = xb_add(&bar[XB_TOP], 1u);
            const unsigned tg = og / nx;
            if (og + 1u == (tg + 1u) * nx) xb_add(&bar[XB_TOPGEN], 1u);
            else while (xb_ld(&bar[XB_TOPGEN]) == tg) __builtin_amdgcn_s_sleep(1);
            __builtin_amdgcn_fence(__ATOMIC_ACQUIRE, "agent");
            xb_add(&bar[XB_XGEN(x)], 1u);
            asm volatile("s_waitcnt vmcnt(0)" ::: "memory");
        } else {
            while (xb_ld(&bar[XB_XGEN(x)]) == gen) __builtin_amdgcn_s_sleep(1);
            __builtin_amdgcn_fence(__ATOMIC_ACQUIRE, "agent");
            asm volatile("s_waitcnt vmcnt(0)" ::: "memory");
        }
    }
    __syncthreads();
}

__device__ __forceinline__ bool tile_map(int r, int bid, int nb, int NT, int& nt, int& mt) {
    if (nb == 256) {
        const int x = bid & 7, li = bid >> 3, q = li + 32 * r;
        if (q >= 8 * NT) return false;
        const int mi = q & 3, rest = q >> 2, mg = rest / NT;
        nt = rest - mg * NT; mt = x * 8 + mg * 4 + mi; return true;
    }
    const int t = bid + r * nb; if (t >= NT * 64) return false;
    nt = t % NT; mt = t / NT; return true;
}

__global__ void __launch_bounds__(NTHREADS) mega(const Params p) {
    __shared__ __attribute__((aligned(16))) char lds[LDS_BYTES];
    cg::grid_group grid = cg::this_grid();
    const int wave_s = __builtin_amdgcn_readfirstlane((int)(threadIdx.x >> 6));
    const int nb = gridDim.x, bid = blockIdx.x;
    char* ws = p.ws;
    bf16_t* hn0 = (bf16_t*)(ws + OFF_HN0);
    bf16_t* hb = (bf16_t*)(ws + OFF_HB);
    float* ssq0 = (float*)(ws + OFF_SSQ);
    float* ssq1 = ssq0 + 16 * L_SEQ; float* ssq2 = ssq1 + 16 * L_SEQ; float* ssq3 = ssq2 + 16 * L_SEQ;
    const Seg nul = {nullptr, 0, 0, nullptr, 0, 0};
    unsigned* bar = (unsigned*)(ws + OFF_BAR);
    volatile unsigned* xst = (volatile unsigned*)(lds + LDS_BYTES - 16);
    unsigned* xtab = bar + 4096;
    {
        const int tid0 = get_tid(wave_s);
        if (tid0 == 0) __hip_atomic_store(xtab + bid, xb_xcc_id(), __ATOMIC_RELAXED, __HIP_MEMORY_SCOPE_AGENT);
        if (bid == 0) for (int i = tid0; i < XB_WORDS; i += NTHREADS) __hip_atomic_store(bar + i, 0u, __ATOMIC_RELAXED, __HIP_MEMORY_SCOPE_AGENT);
    }
    grid.sync();
    if (wave_s == 0) {
        const int l0 = get_tid(wave_s);
        const unsigned x = xb_xcc_id(); unsigned mine = 0u, mask = 0u;
        for (int i = l0; i < nb; i += 64) { const unsigned v = xb_ld(xtab + i) & 15u; mine += (v == x) ? 1u : 0u; mask |= 1u << v; }
#pragma unroll
        for (int o = 32; o >= 1; o >>= 1) { mine += __shfl_xor(mine, o); mask |= __shfl_xor(mask, o); }
        if (l0 == 0) { xst[0] = mine ? mine : 1u; xst[1] = (unsigned)__builtin_popcount(mask); xst[2] = x; }
    }
    __syncthreads();

    { const int nwork = p.ntiles_w + 256;
      for (int rep = 0; rep < REP_PREP; ++rep) {
          if (nb >= 128) {
              if (bid < 64) s5_tables(wave_s, p, bid, lds);
              else for (int it = bid - 64; it < 256; it += nb - 64) rms0_item(wave_s, p, it);
          } else {
              for (int it = bid; it < 64 + nwork; it += nb) { if (it < 64) s5_tables(wave_s, p, it, lds); else if (it < 64 + p.ntiles_w) wtile(wave_s, p, it - 64, lds); else rms0_item(wave_s, p, it - 64 - p.ntiles_w); }
          }
      } }
    gbar(wave_s, bar, xst);
    if (nb >= 128 && bid >= 64) for (int it = bid - 64; it < p.ntiles_w; it += nb - 64) wtile(wave_s, p, it, lds);
    for (int rep = 0; rep < REP_SLOC; ++rep)
    for (int g = bid; g < 64; g += nb) {
        Seg s = {(const bf16_t*)(ws + OFF_W1) + (size_t)g * 128 * 1024, 1024, 16, hn0 + (size_t)g * 262144, 1024, 16};
        EpiSloc e = {(float*)lds};
        gemm_tile(wave_s, lds, s, 16, nul, 0, e);
        __syncthreads();
        {
            const int lane_ = get_tid(wave_s) & 63, w_ = wave_s;
            const f32x2 a = ((const f32x2*)(ws + OFF_A64))[g * 64 + lane_];
            const float* sl = (const float*)lds + (w_ * 32) * 132;
            float sr = 0.f, si = 0.f;
#pragma unroll
            for (int j = 0; j < 32; ++j) { const float xr = sl[j * 132 + lane_], xi = sl[j * 132 + 64 + lane_]; const float nr = a[0] * sr - a[1] * si + xr, ni = a[0] * si + a[1] * sr + xi; sr = nr; si = ni; }
            f32x2* carry = (f32x2*)(lds + 135168);
            { f32x2 c; c[0] = sr; c[1] = si; carry[w_ * 64 + lane_] = c; }
            float pr = a[0], pi = a[1];
#pragma unroll
            for (int q = 0; q < 5; ++q) { const float nr = pr * pr - pi * pi, ni = 2.f * pr * pi; pr = nr; pi = ni; }
            __syncthreads();
            sr = 0.f; si = 0.f;
            for (int v = 0; v < w_; ++v) { const f32x2 c = carry[v * 64 + lane_]; const float nr = pr * sr - pi * si + c[0], ni = pr * si + pi * sr + c[1]; sr = nr; si = ni; }
            bf16_t* sp = (bf16_t*)(ws + OFF_SPREV) + (size_t)g * 256 * 128 + (size_t)(w_ * 32) * 128;
#pragma unroll
            for (int j = 0; j < 32; ++j) {
                sp[j * 128 + lane_] = (bf16_t)(pk_bf16(sr, 0.f) & 0xffffu); sp[j * 128 + 64 + lane_] = (bf16_t)(pk_bf16(si, 0.f) & 0xffffu);
                const float xr = sl[j * 132 + lane_], xi = sl[j * 132 + 64 + lane_];
                const float nr = a[0] * sr - a[1] * si + xr, ni = a[0] * si + a[1] * sr + xi; sr = nr; si = ni;
            }
        }
        __syncthreads();
    }
    gbar(wave_s, bar, xst);
    for (int rep = 0; rep < REP_S5; ++rep)
    for (int t0 = bid; t0 < 256; t0 += nb) {
        const int t = (nb == 256) ? ((t0 & 7) * 32 + (t0 >> 3)) : t0;
        const int g = t >> 2, i = 3 - (t & 3);
        const bf16_t* sprev = (const bf16_t*)(ws + OFF_SPREV) + (size_t)g * 256 * 128;
        Seg s0 = {(const bf16_t*)(ws + OFF_KT) + (size_t)g * 127 * 256 + 63 * 256 + (size_t)(i * 256) * 16, 16, -256, hn0 + (size_t)g * 262144, 1024, 16};
        Seg s1 = {(const bf16_t*)(ws + OFF_W3) + (size_t)g * 1024 * 128 + (size_t)(i * 256) * 128, 128, 16, sprev, 128, 16};
        EpiS5 e = {hn0, p.ssm_d, (bf16_t*)(ws + OFF_Z), g, i * 256};
        gemm_tile(wave_s, lds, s0, 4 * (i + 1), s1, 2, e);
    }
    gbar(wave_s, bar, xst);
    for (int rep = 0; rep < REP_GLU; ++rep)
    for (int r = 0, nt, mt; tile_map(r, bid, nb, 8, nt, mt); ++r) {
        Seg s = {(const bf16_t*)(ws + OFF_WGLU) + (size_t)nt * 256 * DM, DM, 16, (const bf16_t*)(ws + OFF_Z) + (size_t)mt * 256 * 16, 16, 262144};
        EpiGlu e = {p.x, p.out, hb, ssq0, nt * 256, mt * 256};
        gemm_tile(wave_s, lds, s, 16, nul, 0, e);
    }
    gbar(wave_s, bar, xst);
#pragma unroll
    for (int layer = 0; layer < 2; ++layer) {
        if (layer == 1) {
            for (int rep = 0; rep < REP_KVQ; ++rep) {
                int nt = 0, mt = 0; bool have = tile_map(0, bid, nb, 12, nt, mt), pro = false;
                for (int r = 0; have; ++r) {
                    int nnt = 0, nmt = 0; const bool hn = tile_map(r + 1, bid, nb, 12, nnt, nmt);
                    Seg s = {(const bf16_t*)(ws + OFF_WKVQ) + (size_t)nt * 256 * DM, DM, 16, hb + (size_t)mt * 256 * DM, DM, 16};
                    Seg sn = {(const bf16_t*)(ws + OFF_WKVQ) + (size_t)nnt * 256 * DM, DM, 16, hb + (size_t)nmt * 256 * DM, DM, 16};
                    const bool curV = (nt >= 4 && nt < 8);
                    EpiKvq e = {ssq1, ws, lds, nt * 256, mt * 256, {0.f, 0.f}};
                    gemm_tile(wave_s, lds, s, 16, nul, 0, e, pro, hn && !curV, sn);
                    pro = hn && !curV; nt = nnt; mt = nmt; have = hn;
                }
            }
            gbar(wave_s, bar, xst);
            {
                float a1 = 0.f, a2 = 0.f;
                for (int i = 0; i < 64; ++i) { a1 += p.lq1[i] * p.lk1[i]; a2 += p.lq2[i] * p.lk2[i]; }
                const float lam = expf(a1) - expf(a2) + LAM_INIT;
                for (int rep = 0; rep < REP_ATTN; ++rep)
                for (int it = bid; it < 1024; it += nb) {
                    const int head = it & 7, r = it >> 3, rnd = r >> 5, j = r & 31;
                    const int qb = (rnd == 0) ? 127 - j : (rnd == 1) ? 64 + j : (rnd == 2) ? 63 - j : j;
                    attn_item(wave_s, p, head, qb, lam, lds);
                }
            }
            gbar(wave_s, bar, xst);
            for (int r = 0, nt, mt; tile_map(r, bid, nb, 4, nt, mt); ++r) {
                Seg s = {(const bf16_t*)(ws + OFF_WO) + (size_t)nt * 256 * DM, DM, 16, (const bf16_t*)(ws + OFF_ON) + (size_t)mt * 256 * DM, DM, 16};
                EpiRes e = {p.out, hb, ssq2, nt * 256, mt * 256};
                gemm_tile(wave_s, lds, s, 16, nul, 0, e);
            }
            gbar(wave_s, bar, xst);
        }
        {
            const bf16_t* wup = (const bf16_t*)(ws + (layer ? OFF_WUP1 : OFF_WUP0));
            for (int rep = 0; rep < REP_UP; ++rep) {
                const int nfull = (nb == 256) ? 5 : (1 << 30);
                int nt = 0, mt = 0; bool have = tile_map(0, bid, nb, 22, nt, mt), pro = false;
                for (int r = 0; have && r < nfull; ++r) {
                    int nnt = 0, nmt = 0; const bool hn = tile_map(r + 1, bid, nb, 22, nnt, nmt) && (r + 1 < nfull);
                    Seg s = {wup + (size_t)nt * 256 * DM, DM, 16, hb + (size_t)mt * 256 * DM, DM, 16};
                    Seg sn = {wup + (size_t)nnt * 256 * DM, DM, 16, hb + (size_t)nmt * 256 * DM, DM, 16};
                    if (layer == 0) { EpiUp<16> e = {ssq0, (bf16_t*)(ws + OFF_ACT), nt * 256, mt * 256, {0.f, 0.f}}; gemm_tile(wave_s, lds, s, 16, nul, 0, e, pro, hn, sn); }
                    else { EpiUp<8> e = {ssq2, (bf16_t*)(ws + OFF_ACT), nt * 256, mt * 256, {0.f, 0.f}}; gemm_tile(wave_s, lds, s, 16, nul, 0, e, pro, hn, sn); }
                    pro = hn; nt = nnt; mt = nmt; have = hn;
                }
                if (nb == 256) {
                    const int x = bid & 7, li = bid >> 3, q = 160 + (li & 15), half = li >> 4;
                    const int mi = q & 3, rest = q >> 2, mg = rest / 22, hnt = rest - mg * 22, hmt = x * 8 + mg * 4 + mi;
                    const int hm0 = hmt * 256 + half * 128;
                    Seg s = {wup + (size_t)hnt * 256 * DM, DM, 16, hb + (size_t)hm0 * DM, DM, 16};
                    if (layer == 0) { EpiUp<16, 1> e = {ssq0, (bf16_t*)(ws + OFF_ACT), hnt * 256, hm0, {0.f}}; gemm_tile<1>(wave_s, lds, s, 16, nul, 0, e); }
                    else { EpiUp<8, 1> e = {ssq2, (bf16_t*)(ws + OFF_ACT), hnt * 256, hm0, {0.f}}; gemm_tile<1>(wave_s, lds, s, 16, nul, 0, e); }
                }
            }
        }
        gbar(wave_s, bar, xst);
        {
            const bf16_t* wdn = (const bf16_t*)(ws + (layer ? OFF_WDN1 : OFF_WDN0));
            for (int r = 0, nt, mt; tile_map(r, bid, nb, 4, nt, mt); ++r) {
                Seg s = {wdn + (size_t)nt * 256 * FFN, FFN, 16, (const bf16_t*)(ws + OFF_ACT) + (size_t)mt * 256 * FFN, FFN, 16};
                EpiRes e = {p.out, layer ? (bf16_t*)nullptr : hb, layer ? ssq3 : ssq1, nt * 256, mt * 256};
                gemm_tile(wave_s, lds, s, FFN / 64, nul, 0, e);
            }
        }
        gbar(wave_s, bar, xst);
    }
    {
        const int lane = get_tid(wave_s) & 63, wid = wave_s;
        for (int row = bid * 8 + wid; row < L_SEQ; row += nb * 8) {
            float s = 0.f;
            for (int i = 0; i < 8; ++i) s += ssq3[(size_t)i * L_SEQ + row];
            const float rs = rsqrtf(s * (1.0f / DM) + EPSV);
#pragma unroll
            for (int i = 0; i < 4; ++i) { const size_t off = (size_t)row * DM + lane * 4 + 256 * i;
                f32x4 v = *(const f32x4*)(p.out + off); const f32x4 g = *(const f32x4*)(p.final_g + lane * 4 + 256 * i);
                v[0] *= rs * g[0]; v[1] *= rs * g[1]; v[2] *= rs * g[2]; v[3] *= rs * g[3]; *(f32x4*)(p.out + off) = v; }
        }
    }
}

static void add_job(Params& P, int& nt, const float* src, bf16_t* dst, const float* gain, int K, int N, int ld, int col0, int mode, int rowoff, float scale) {
    WJob& J = P.jobs[P.njobs++];
    J.src = src; J.dst = dst; J.gain = gain; J.K = K; J.N = N; J.ldsrc = ld; J.col0 = col0; J.mode = mode; J.rowoff = rowoff; J.scale = scale; J.tile0 = nt; J.ntn = N / 256; J.pad = 0;
    nt += (K / 64) * (N / 256);
}

extern "C" void kernel_launch(void* const* d_in, const int* in_sizes, int n_in, void* d_out, int out_size, void* d_ws, size_t ws_size, hipStream_t stream) {
    Params P; memset(&P, 0, sizeof(P));
    P.x = (const float*)d_in[0]; P.norm_mix_g = (const float*)d_in[1]; P.norm_ffn_g = (const float*)d_in[2];
    P.ffn_w1 = (const float*)d_in[3]; P.ffn_w3 = (const float*)d_in[4]; P.ffn_w2 = (const float*)d_in[5];
    P.lam_re = (const float*)d_in[6]; P.lam_im = (const float*)d_in[7]; P.log_dt = (const float*)d_in[8];
    P.b_re = (const float*)d_in[9]; P.b_im = (const float*)d_in[10]; P.c_re = (const float*)d_in[11]; P.c_im = (const float*)d_in[12];
    P.ssm_d = (const float*)d_in[13]; P.w_glu = (const float*)d_in[14]; P.kv_norm_g = (const float*)d_in[15]; P.w_kv = (const float*)d_in[16];
    P.w_q = (const float*)d_in[17]; P.lq1 = (const float*)d_in[18]; P.lk1 = (const float*)d_in[19]; P.lq2 = (const float*)d_in[20]; P.lk2 = (const float*)d_in[21];
    P.subln_g = (const float*)d_in[22]; P.w_o = (const float*)d_in[23]; P.final_g = (const float*)d_in[24];
    P.out = (float*)d_out; P.ws = (char*)d_ws;
    char* ws = (char*)d_ws; int nt = 0;
    const size_t FW = (size_t)DM * FFN;
    add_job(P, nt, P.w_glu, (bf16_t*)(ws + OFF_WGLU), nullptr, DM, 1024, 2048, 0, 1, 0, 1.0f);
    add_job(P, nt, P.w_glu, (bf16_t*)(ws + OFF_WGLU), nullptr, DM, 1024, 2048, 1024, 2, 0, 1.0f);
    add_job(P, nt, P.ffn_w1, (bf16_t*)(ws + OFF_WUP0), P.norm_ffn_g, DM, FFN, FFN, 0, 1, 0, 1.0f);
    add_job(P, nt, P.ffn_w3, (bf16_t*)(ws + OFF_WUP0), P.norm_ffn_g, DM, FFN, FFN, 0, 2, 0, 1.0f);
    add_job(P, nt, P.ffn_w2, (bf16_t*)(ws + OFF_WDN0), nullptr, FFN, DM, DM, 0, 0, 0, 1.0f);
    add_job(P, nt, P.w_kv, (bf16_t*)(ws + OFF_WKVQ), P.kv_norm_g, DM, 2048, 2048, 0, 0, 0, 1.0f);
    add_job(P, nt, P.w_q, (bf16_t*)(ws + OFF_WKVQ), P.norm_mix_g + DM, DM, 1024, 1024, 0, 0, 2048, QSCALE);
    add_job(P, nt, P.w_o, (bf16_t*)(ws + OFF_WO), nullptr, DM, DM, DM, 0, 0, 0, 1.0f);
    add_job(P, nt, P.ffn_w1 + FW, (bf16_t*)(ws + OFF_WUP1), P.norm_ffn_g + DM, DM, FFN, FFN, 0, 1, 0, 1.0f);
    add_job(P, nt, P.ffn_w3 + FW, (bf16_t*)(ws + OFF_WUP1), P.norm_ffn_g + DM, DM, FFN, FFN, 0, 2, 0, 1.0f);
    add_job(P, nt, P.ffn_w2 + FW, (bf16_t*)(ws + OFF_WDN1), nullptr, FFN, DM, DM, 0, 0, 0, 1.0f);
    P.ntiles_w = nt;
    static int grid_blocks = 0;
    if (!grid_blocks) {
        int dev = 0, cus = 0, per_cu = 0;
        hipGetDevice(&dev);
        hipDeviceGetAttribute(&cus, hipDeviceAttributeMultiprocessorCount, dev);
        hipOccupancyMaxActiveBlocksPerMultiprocessor(&per_cu, mega, NTHREADS, 0);
        if (per_cu < 1) per_cu = 1;
        grid_blocks = cus * 1;
    }
    void* args[] = {&P};
    hipError_t e = hipLaunchCooperativeKernel((void*)mega, dim3(grid_blocks), dim3(NTHREADS), args, 0, stream);
    if (e != hipSuccess) fprintf(stderr, "cooperative launch failed: %s (grid %d)\n", hipGetErrorString(e), grid_blocks);
}
```
